# Optimizing an MI355X kernel written in HIP

```python
import math
import jax, jax.numpy as jnp
from jax import lax
import numpy as np

D_MODEL = 1024
BATCH = 4
SEQ = 8192
DEPTH = 1

GLA_HEADS = 4
GLA_DK = 64
GLA_DV = 128
GLA_LOWRANK = 16
GLA_TAU = 16.0
GLA_CHUNK = 64
MOBA_HEADS = 8
MOBA_DH = 64
MOBA_BLOCK = 256
MOBA_TOPK = 3
MOBA_QCHUNK = 128
REL_BUCKETS = 32
REL_MAX_DIST = 128
MEM_LEN = 256
MEM_HEADS = 4
MEM_DH = 128
N_GROUPS = 4
EXPERTS_PER_GROUP = 8
N_EXPERTS = N_GROUPS * EXPERTS_PER_GROUP
TOPK_IN_GROUP = 2
D_EXPERT = 512
MOE_BLOCK = 128
EPS = 1e-6

GLA_QK = GLA_HEADS * GLA_DK
GLA_V = GLA_HEADS * GLA_DV
MOBA_W = MOBA_HEADS * MOBA_DH
MEM_W = MEM_HEADS * MEM_DH
IN_SPLITS = (GLA_QK, GLA_QK, GLA_V, GLA_V, GLA_LOWRANK, MOBA_W, MOBA_W, MOBA_W, D_MODEL, D_MODEL)
D_IN = sum(IN_SPLITS)
SPLIT_POINTS = tuple(sum(IN_SPLITS[:i + 1]) for i in range(len(IN_SPLITS) - 1))

kernel_name = 'hybrid_gla_moba_hmoe_block'


def rmsnorm(x, g):
    xf = x.astype(jnp.float32)
    y = xf * lax.rsqrt(jnp.mean(xf * xf, axis=-1, keepdims=True) + EPS)
    return (y * g.astype(jnp.float32)).astype(x.dtype)


def gla_chunked(q, k, v, log_a):
    B, S = q.shape[0], q.shape[1]
    C = GLA_CHUNK
    N = S // C

    def chunks(t):
        return t.astype(jnp.float32).reshape(B, N, C, GLA_HEADS, t.shape[-1]).transpose(0, 3, 1, 2, 4)

    q, k, v, log_a = chunks(q) * (GLA_DK ** -0.5), chunks(k), chunks(v), chunks(log_a)
    b = jnp.cumsum(log_a, axis=3)
    b_last = b[:, :, :, C - 1:]
    b_mid = b[:, :, :, C // 2 - 1:C // 2]
    att = jnp.einsum('bhncd,bhnsd->bhncs', q * jnp.exp(b - b_mid), k * jnp.exp(b_mid - b))
    causal = jnp.tril(jnp.ones((C, C), dtype=bool))
    att = jnp.where(causal, att, 0.0)
    o_intra = jnp.einsum('bhncs,bhnsv->bhncv', att, v)
    kv = jnp.einsum('bhncd,bhncv->bhndv', k * jnp.exp(b_last - b), v)
    decay = jnp.exp(b_last[:, :, :, 0])

    def step(state, inp):
        dec, kv_c = inp
        return dec[..., None] * state + kv_c, state

    init = jnp.zeros((B, GLA_HEADS, GLA_DK, GLA_DV), jnp.float32)
    _, states = lax.scan(step, init, (jnp.moveaxis(decay, 2, 0), jnp.moveaxis(kv, 2, 0)))
    states = jnp.moveaxis(states, 0, 2)
    o_inter = jnp.einsum('bhncd,bhndv->bhncv', q * jnp.exp(b), states)
    o = o_intra + o_inter
    return o.transpose(0, 2, 3, 1, 4).reshape(B, S, GLA_HEADS, GLA_DV)


def t5_bucket(dist):
    n = jnp.maximum(dist, 0)
    max_exact = REL_BUCKETS // 2
    nf = jnp.maximum(n, 1).astype(jnp.float32)
    large = max_exact + (jnp.log(nf / max_exact) / math.log(REL_MAX_DIST / max_exact)
                         * (REL_BUCKETS - max_exact)).astype(jnp.int32)
    large = jnp.minimum(large, REL_BUCKETS - 1)
    return jnp.where(n < max_exact, n, large)


def moba_attention(q, k, v, rel_bias):
    B, S = q.shape[0], q.shape[1]
    H, BS, QC = MOBA_HEADS, MOBA_BLOCK, MOBA_QCHUNK
    Sp = -(-S // BS) * BS
    NB = Sp // BS
    NC = Sp // QC
    K = min(MOBA_TOPK, NB)

    def heads(t):
        t = t.reshape(B, S, H, MOBA_DH).transpose(0, 2, 1, 3)
        return jnp.pad(t, ((0, 0), (0, 0), (0, Sp - S), (0, 0)))

    q = heads(q) * (MOBA_DH ** -0.5)
    kb = heads(k).reshape(B, H, NB, BS, MOBA_DH)
    vb = heads(v).reshape(B, H, NB, BS, MOBA_DH)
    k_mean = jnp.mean(kb.astype(jnp.float32), axis=3)
    gate = jnp.einsum('bhsd,bhnd->bhsn', q.astype(jnp.float32), k_mean)
    q_blk = jnp.arange(Sp) // BS
    fully_past = jnp.arange(NB)[None, :] < q_blk[:, None]
    gate = jnp.where(fully_past, gate, -jnp.inf)
    _, sel = lax.top_k(gate, K)
    sel_valid = sel < q_blk[:, None]

    def to_chunks(t):
        return jnp.moveaxis(t.reshape(B, H, NC, QC, t.shape[-1]), 2, 0)

    bias_hb = rel_bias.T.astype(jnp.float32)
    b_idx = jnp.arange(B)[:, None, None, None]
    h_idx = jnp.arange(H)[None, :, None, None]
    offs = jnp.arange(BS)

    def one_chunk(args):
        c, qc, selc, validc = args
        q_pos = c * QC + jnp.arange(QC)
        own = (c * QC) // BS
        k_own = lax.dynamic_index_in_dim(kb, own, axis=2, keepdims=False)
        v_own = lax.dynamic_index_in_dim(vb, own, axis=2, keepdims=False)
        d_own = q_pos[:, None] - (own * BS + offs)[None, :]
        s_own = jnp.einsum('bhqd,bhkd->bhqk', qc, k_own).astype(jnp.float32) + bias_hb[:, t5_bucket(d_own)]
        s_own = jnp.where(d_own >= 0, s_own, -jnp.inf)
        k_sel = kb[b_idx, h_idx, selc]
        v_sel = vb[b_idx, h_idx, selc]
        d_sel = q_pos[:, None, None] - (selc[..., None] * BS + offs)
        s_sel = (jnp.einsum('bhqd,bhqjkd->bhqjk', qc, k_sel).astype(jnp.float32)
                 + bias_hb[h_idx[..., None], t5_bucket(d_sel)])
        s_sel = jnp.where(validc[..., None], s_sel, -jnp.inf)
        logits = jnp.concatenate([s_own, s_sel.reshape(B, H, QC, K * BS)], axis=-1)
        p = jax.nn.softmax(logits, axis=-1)
        p_own = p[..., :BS].astype(v_own.dtype)
        p_sel = p[..., BS:].reshape(B, H, QC, K, BS).astype(v_sel.dtype)
        return (jnp.einsum('bhqk,bhkd->bhqd', p_own, v_own)
                + jnp.einsum('bhqjk,bhqjkd->bhqd', p_sel, v_sel))

    out = lax.map(one_chunk, (jnp.arange(NC), to_chunks(q), to_chunks(sel), to_chunks(sel_valid)))
    out = out.transpose(1, 0, 3, 2, 4).reshape(B, Sp, H * MOBA_DH)
    return out[:, :S]


def mixer(h, rel_bias, w_in, w_alpha_up, b_alpha, g_gla_head, w_proj_gla, w_proj_moba, w_out):
    B, S, _ = h.shape
    proj = h @ w_in
    q_g, k_g, v_g, r_g, a_lr, q_m, k_m, v_m, z_g, z_m = jnp.split(proj, SPLIT_POINTS, axis=-1)
    log_a = jax.nn.log_sigmoid((a_lr @ w_alpha_up + b_alpha).astype(jnp.float32)) / GLA_TAU
    o_g = gla_chunked(q_g.reshape(B, S, GLA_HEADS, GLA_DK), k_g.reshape(B, S, GLA_HEADS, GLA_DK),
                      v_g.reshape(B, S, GLA_HEADS, GLA_DV), log_a.reshape(B, S, GLA_HEADS, GLA_DK))
    o_g = rmsnorm(o_g, g_gla_head).reshape(B, S, GLA_V).astype(h.dtype) * jax.nn.silu(r_g)
    o_m = moba_attention(q_m, k_m, v_m, rel_bias)
    merged = jax.nn.sigmoid(z_g) * (o_g @ w_proj_gla) + jax.nn.sigmoid(z_m) * (o_m @ w_proj_moba)
    return merged @ w_out


def memory_attention(h, mem_n, w_cq, w_ckv, w_co):
    B, S, _ = h.shape
    M = mem_n.shape[1]
    q = (h @ w_cq).reshape(B, S, MEM_HEADS, MEM_DH)
    k, v = jnp.split((mem_n @ w_ckv).reshape(B, M, 2, MEM_HEADS, MEM_DH), 2, axis=2)
    k, v = k[:, :, 0], v[:, :, 0]
    s = jnp.einsum('bqhd,bkhd->bhqk', q, k).astype(jnp.float32) * (MEM_DH ** -0.5)
    p = jax.nn.softmax(s, axis=-1).astype(v.dtype)
    o = jnp.einsum('bhqk,bkhd->bqhd', p, v).reshape(B, S, MEM_W)
    return o @ w_co


def hier_moe(h, w_rg, b_rg, w_re, b_re, w_gate, w_up, w_down):
    B, S, D = h.shape
    T = B * S
    xt = h.reshape(T, D)
    g_prob = jax.nn.softmax((xt @ w_rg).astype(jnp.float32) + b_rg, axis=-1)
    p_grp, grp = lax.top_k(g_prob, 1)
    e_logits = ((xt @ w_re).astype(jnp.float32) + b_re).reshape(T, N_GROUPS, EXPERTS_PER_GROUP)
    e_in = jnp.take_along_axis(e_logits, grp[:, :, None], axis=1)[:, 0]
    top_p, top_i = lax.top_k(jax.nn.softmax(e_in, axis=-1), TOPK_IN_GROUP)
    weights = p_grp * top_p / jnp.sum(top_p, axis=-1, keepdims=True)
    expert = grp * EXPERTS_PER_GROUP + top_i
    A = T * TOPK_IN_GROUP
    flat_e = expert.reshape(A)
    flat_t = jnp.repeat(jnp.arange(T, dtype=jnp.int32), TOPK_IN_GROUP)
    flat_w = weights.reshape(A)
    order = jnp.argsort(flat_e)
    se = flat_e[order]
    counts = jnp.zeros((N_EXPERTS,), jnp.int32).at[flat_e].add(1)
    padded = (counts + MOE_BLOCK - 1) // MOE_BLOCK * MOE_BLOCK
    start = jnp.cumsum(counts) - counts
    pend = jnp.cumsum(padded)
    pstart = pend - padded
    dest = pstart[se] + (jnp.arange(A) - start[se])
    cap = (A + N_EXPERTS * (MOE_BLOCK - 1) + MOE_BLOCK - 1) // MOE_BLOCK * MOE_BLOCK
    n_blk = cap // MOE_BLOCK
    buf_t = jnp.zeros((cap,), jnp.int32).at[dest].set(flat_t[order])
    buf_w = jnp.zeros((cap,), jnp.float32).at[dest].set(flat_w[order])
    blk_e = jnp.minimum(jnp.searchsorted(pend, jnp.arange(n_blk) * MOE_BLOCK, side='right'), N_EXPERTS - 1)

    def run_block(args):
        e, tok, w = args
        xb = xt[tok]
        hid = jax.nn.silu(xb @ w_gate[e]) * (xb @ w_up[e])
        return (hid @ w_down[e]) * w[:, None].astype(xb.dtype)

    yb = lax.map(run_block, (blk_e, buf_t.reshape(n_blk, MOE_BLOCK), buf_w.reshape(n_blk, MOE_BLOCK)))
    out = jnp.zeros((T, D), h.dtype).at[buf_t].add(yb.reshape(cap, D).astype(h.dtype))
    return out.reshape(B, S, D)


def setup_inputs(seed: int = 0) -> dict:
    key = jax.random.key(seed)
    ks = jax.random.split(key, 26)
    f32 = jnp.float32
    L = DEPTH

    def nrm(k, shape, scale):
        return jax.random.normal(k, shape, f32) * scale

    def gain(k, shape):
        return 1.0 + 0.02 * jax.random.normal(k, shape, f32)

    return {
        'x': nrm(ks[0], (BATCH, SEQ, D_MODEL), 1.0),
        'mem': nrm(ks[1], (BATCH, MEM_LEN, D_MODEL), 1.0),
        'g_mem': gain(ks[2], (D_MODEL,)),
        'rel_bias': nrm(ks[3], (REL_BUCKETS, MOBA_HEADS), 0.5),
        'g_mix': gain(ks[4], (L, D_MODEL)),
        'w_in': nrm(ks[5], (L, D_MODEL, D_IN), D_MODEL ** -0.5),
        'w_alpha_up': nrm(ks[6], (L, GLA_LOWRANK, GLA_QK), GLA_LOWRANK ** -0.5),
        'b_alpha': nrm(ks[7], (L, GLA_QK), 0.1),
        'g_gla_head': gain(ks[8], (L, GLA_HEADS, GLA_DV)),
        'w_proj_gla': nrm(ks[9], (L, GLA_V, D_MODEL), GLA_V ** -0.5),
        'w_proj_moba': nrm(ks[10], (L, MOBA_W, D_MODEL), MOBA_W ** -0.5),
        'w_out': nrm(ks[11], (L, D_MODEL, D_MODEL), D_MODEL ** -0.5),
        'g_cross': gain(ks[12], (L, D_MODEL)),
        'w_cq': nrm(ks[13], (L, D_MODEL, MEM_W), D_MODEL ** -0.5),
        'w_ckv': nrm(ks[14], (L, D_MODEL, 2 * MEM_W), D_MODEL ** -0.5),
        'w_co': nrm(ks[15], (L, MEM_W, D_MODEL), MEM_W ** -0.5),
        'g_moe': gain(ks[16], (L, D_MODEL)),
        'w_router_group': nrm(ks[17], (L, D_MODEL, N_GROUPS), D_MODEL ** -0.5),
        'b_router_group': nrm(ks[18], (L, N_GROUPS), 0.01),
        'w_router_expert': nrm(ks[19], (L, D_MODEL, N_EXPERTS), D_MODEL ** -0.5),
        'b_router_expert': nrm(ks[20], (L, N_EXPERTS), 0.01),
        'w_exp_gate': nrm(ks[21], (L, N_EXPERTS, D_MODEL, D_EXPERT), D_MODEL ** -0.5),
        'w_exp_up': nrm(ks[22], (L, N_EXPERTS, D_MODEL, D_EXPERT), D_MODEL ** -0.5),
        'w_exp_down': nrm(ks[23], (L, N_EXPERTS, D_EXPERT, D_MODEL), D_EXPERT ** -0.5),
        'g_final': gain(ks[24], (D_MODEL,)),
    }


def reference(x, mem, g_mem, rel_bias, g_mix, w_in, w_alpha_up, b_alpha, g_gla_head, w_proj_gla,
              w_proj_moba, w_out, g_cross, w_cq, w_ckv, w_co, g_moe, w_router_group, b_router_group,
              w_router_expert, b_router_expert, w_exp_gate, w_exp_up, w_exp_down, g_final):
    mem_n = rmsnorm(mem, g_mem)
    for l in range(DEPTH):
        x = x + mixer(rmsnorm(x, g_mix[l]), rel_bias, w_in[l], w_alpha_up[l], b_alpha[l], g_gla_head[l],
                      w_proj_gla[l], w_proj_moba[l], w_out[l])
        x = x + memory_attention(rmsnorm(x, g_cross[l]), mem_n, w_cq[l], w_ckv[l], w_co[l])
        x = x + hier_moe(rmsnorm(x, g_moe[l]), w_router_group[l], b_router_group[l], w_router_expert[l],
                         b_router_expert[l], w_exp_gate[l], w_exp_up[l], w_exp_down[l])
    return rmsnorm(x, g_final)
```

```cpp
#include <hip/hip_runtime.h>
#include <cstdio>
#include <cstdint>
namespace pg8 {
#define PG8_LAS __attribute__((address_space(3)))
typedef unsigned short bf16_t;
typedef short bf16x8 __attribute__((ext_vector_type(8)));
typedef float f32x4 __attribute__((ext_vector_type(4)));
typedef unsigned u32x4 __attribute__((ext_vector_type(4)));
constexpr int BM = 256, BK = 64, HALF = 128, HTB = HALF * BK * 2  , STAGE_BYTES = 8 * HTB, NXCD = 8, WGM = 8;

__host__ __device__ __forceinline__ int lds_byte(int r, int c) { const int st = (r >> 4) * 2 + (c >> 5), rr = r & 15, cc = c & 31, ob = rr * 64 + cc * 2; return st * 1024 + (ob ^ (((ob >> 9) & 1) << 5)); }
__host__ __device__ __forceinline__ void stage_rc(int b, int& R, int& C) { const int st = b / 1024, sb = b % 1024, swz = sb ^ (((sb >> 9) & 1) << 5); R = (st >> 1) * 16 + swz / 64; C = (st & 1) * 32 + (swz % 64) / 2; }
__host__ __device__ __forceinline__ int perm32(int rho) { const int n = rho >> 4, i = rho & 15; return 8 * (i >> 2) + 4 * n + (i & 3); }

struct Unit { int pm, pn; };
struct Gemm { const bf16_t* A; const bf16_t* Bt; int M, N, K; };

struct StaticOrder {
    int nM, nN, nwg, G, c;
    __host__ __device__ void init(int M, int N, int G_, int c_) { nM = M / BM; nN = N / BM; nwg = nM * nN; G = G_; c = c_; }
    __host__ __device__ bool next(int i, Unit& u) const {
        const long L = (long)i * G + c; if (L >= nwg) return false;
        int wgid = (int)L; { const int q = nwg / NXCD, r = nwg % NXCD, xcd = wgid % NXCD, off = wgid / NXCD; wgid = (xcd < r ? xcd * (q + 1) : r * (q + 1) + (xcd - r) * q) + off; }
        const int nig = WGM * nN, gid = wgid / nig, fm = gid * WGM, gsz = (nM - fm) < WGM ? (nM - fm) : WGM;
        u.pm = fm + ((wgid % nig) % gsz); u.pn = (wgid % nig) / gsz; return true;
    }
    __device__ __forceinline__ void a_ready(const Unit&) const {}
    __device__ __forceinline__ void done(const Unit&) const {}
};

__device__ __forceinline__ unsigned cvt_pk_bf16(float lo, float hi) { unsigned r; asm volatile("v_cvt_pk_bf16_f32 %0, %1, %2" : "=v"(r) : "v"(lo), "v"(hi)); return r; }
typedef float f32x2 __attribute__((ext_vector_type(2)));
__device__ __forceinline__ float bf2f(unsigned short h) { return __uint_as_float(((unsigned)h) << 16); }
__device__ __forceinline__ float bflo(unsigned w) { return __uint_as_float(w << 16); }
__device__ __forceinline__ float bfhi(unsigned w) { return __uint_as_float(w & 0xffff0000u); }
__device__ __forceinline__ float sigmoid_f(float x) { return 1.0f / (1.0f + __expf(-x)); }
__device__ __forceinline__ float silu_f(float x) { return x / (1.0f + __expf(-x)); }
__device__ __forceinline__ float logsigmoid_f(float x) { return fminf(x, 0.f) - log1pf(__expf(-fabsf(x))); }
__device__ __forceinline__ u32x4 pack8(const f32x4 v0, const f32x4 v1) { u32x4 w; w.x = cvt_pk_bf16(v0[0], v0[1]); w.y = cvt_pk_bf16(v0[2], v0[3]); w.z = cvt_pk_bf16(v1[0], v1[1]); w.w = cvt_pk_bf16(v1[2], v1[3]); return w; }

struct EpiInProj {
    static constexpr bool PERM = true, AFTER_DRAIN = false;
    bf16_t *QG, *KG, *SR, *QM, *KM; float* LA; const float* rstd; const float* b_alpha;
    __device__ __forceinline__ void operator()(const f32x4 (&acc)[2][2][4][2], const Unit& u, int wr, int wc, int fr, int fq) const {
        const int pn = u.pn; bf16_t* dst; int ldc, cbase, mode = 0; float sc = 1.f;
        if (pn == 0) { dst = QG; ldc = 256; cbase = 0; sc = 0.125f; }
        else if (pn == 1) { dst = KG; ldc = 256; cbase = 0; }
        else if (pn <= 3) { dst = SR; ldc = 512; cbase = (pn - 2) * 256; mode = 1; }
        else if (pn == 4) { dst = nullptr; ldc = 256; cbase = 0; mode = 3; }
        else if (pn <= 6) { dst = QM; ldc = 512; cbase = (pn - 5) * 256; sc = 0.125f; }
        else { dst = KM; ldc = 512; cbase = (pn - 7) * 256; }
        const int row0 = u.pm * BM + wr * 64 + fr, col0 = cbase + wc * 32 + 8 * fq;
#pragma unroll
        for (int ai = 0; ai < 2; ++ai)
#pragma unroll
            for (int m = 0; m < 4; ++m) { const int row = row0 + ai * HALF + m * 16; const float rs = rstd[row] * sc;
#pragma unroll
                for (int bj = 0; bj < 2; ++bj) { f32x4 v0 = acc[ai][bj][m][0] * rs, v1 = acc[ai][bj][m][1] * rs; const int col = col0 + bj * HALF;
                    if (mode == 3) { const f32x4 b0 = *(const f32x4*)(b_alpha + col), b1 = *(const f32x4*)(b_alpha + col + 4);
#pragma unroll
                        for (int e = 0; e < 4; ++e) { v0[e] = logsigmoid_f(v0[e] + b0[e]) * 0.0625f; v1[e] = logsigmoid_f(v1[e] + b1[e]) * 0.0625f; }
                        float* o = LA + (size_t)row * 256 + col; *(f32x4*)o = v0; *(f32x4*)(o + 4) = v1; }
                    else { if (mode == 1) {
#pragma unroll
                            for (int e = 0; e < 4; ++e) { v0[e] = silu_f(v0[e]); v1[e] = silu_f(v1[e]); } }
                        *(u32x4*)(dst + (size_t)row * ldc + col) = pack8(v0, v1); } } }
    }
};
struct EpiVT {
    static constexpr bool PERM = true, AFTER_DRAIN = false;
    bf16_t* VT; int ldc; const float* rstd;
    __device__ __forceinline__ void operator()(const f32x4 (&acc)[2][2][4][2], const Unit& u, int wr, int wc, int fr, int fq) const {
        const int row0 = u.pm * BM + wr * 64 + fr, col0 = u.pn * BM + wc * 32 + 8 * fq;
        f32x4 rs[2][2];
#pragma unroll
        for (int bj = 0; bj < 2; ++bj) { rs[bj][0] = *(const f32x4*)(rstd + col0 + bj * HALF); rs[bj][1] = *(const f32x4*)(rstd + col0 + bj * HALF + 4); }
#pragma unroll
        for (int ai = 0; ai < 2; ++ai)
#pragma unroll
            for (int m = 0; m < 4; ++m) { const int row = row0 + ai * HALF + m * 16;
#pragma unroll
                for (int bj = 0; bj < 2; ++bj) *(u32x4*)(VT + (size_t)row * ldc + col0 + bj * HALF) = pack8(acc[ai][bj][m][0] * rs[bj][0], acc[ai][bj][m][1] * rs[bj][1]); }
    }
};
template <int ACT> struct EpiRowBf16 {
    static constexpr bool PERM = true, AFTER_DRAIN = false;
    bf16_t* O; int ldc; const float* rowscale; float sc;
    __device__ __forceinline__ void operator()(const f32x4 (&acc)[2][2][4][2], const Unit& u, int wr, int wc, int fr, int fq) const {
        const int row0 = u.pm * BM + wr * 64 + fr, col0 = u.pn * BM + wc * 32 + 8 * fq;
#pragma unroll
        for (int ai = 0; ai < 2; ++ai)
#pragma unroll
            for (int m = 0; m < 4; ++m) { const int row = row0 + ai * HALF + m * 16; const float rs = (rowscale ? rowscale[row] : 1.f) * sc;
#pragma unroll
                for (int bj = 0; bj < 2; ++bj) { f32x4 v0 = acc[ai][bj][m][0] * rs, v1 = acc[ai][bj][m][1] * rs;
                    if (ACT == 2) {
#pragma unroll
                        for (int e = 0; e < 4; ++e) { v0[e] = sigmoid_f(v0[e]); v1[e] = sigmoid_f(v1[e]); } }
                    *(u32x4*)(O + (size_t)row * ldc + col0 + bj * HALF) = pack8(v0, v1); } }
    }
};
struct EpiMerge {
    static constexpr bool PERM = true, AFTER_DRAIN = false;
    bf16_t* O; const bf16_t* SZ; const bf16_t* T1;
    __device__ __forceinline__ void operator()(const f32x4 (&acc)[2][2][4][2], const Unit& u, int wr, int wc, int fr, int fq) const {
        const int row0 = u.pm * BM + wr * 64 + fr, col0 = u.pn * BM + wc * 32 + 8 * fq;
#pragma unroll
        for (int ai = 0; ai < 2; ++ai)
#pragma unroll
            for (int m = 0; m < 4; ++m) { const int row = row0 + ai * HALF + m * 16;
#pragma unroll
                for (int bj = 0; bj < 2; ++bj) { const int col = col0 + bj * HALF;
                    const u32x4 g = *(const u32x4*)(SZ + (size_t)row * 2048 + col), z = *(const u32x4*)(SZ + (size_t)row * 2048 + 1024 + col), t = *(const u32x4*)(T1 + (size_t)row * 1024 + col);
                    const f32x4 a0 = acc[ai][bj][m][0], a1 = acc[ai][bj][m][1]; f32x4 v0, v1;
                    v0[0] = bflo(g.x) * bflo(t.x) + bflo(z.x) * a0[0]; v0[1] = bfhi(g.x) * bfhi(t.x) + bfhi(z.x) * a0[1];
                    v0[2] = bflo(g.y) * bflo(t.y) + bflo(z.y) * a0[2]; v0[3] = bfhi(g.y) * bfhi(t.y) + bfhi(z.y) * a0[3];
                    v1[0] = bflo(g.z) * bflo(t.z) + bflo(z.z) * a1[0]; v1[1] = bfhi(g.z) * bfhi(t.z) + bfhi(z.z) * a1[1];
                    v1[2] = bflo(g.w) * bflo(t.w) + bflo(z.w) * a1[2]; v1[3] = bfhi(g.w) * bfhi(t.w) + bfhi(z.w) * a1[3];
                    *(u32x4*)(O + (size_t)row * 1024 + col) = pack8(v0, v1); } }
    }
};
struct EpiResF32 {
    static constexpr bool PERM = false, AFTER_DRAIN = false;
    const float* base; float* out;
    __device__ __forceinline__ void operator()(const f32x4 (&acc)[2][2][4][2], const Unit& u, int wr, int wc, int fr, int fq) const {
        const int row0 = u.pm * BM + wr * 64 + fr, col0 = u.pn * BM + wc * 32 + 4 * fq;
#pragma unroll
        for (int ai = 0; ai < 2; ++ai)
#pragma unroll
            for (int m = 0; m < 4; ++m) { const size_t off = (size_t)(row0 + ai * HALF + m * 16) * 1024 + col0;
#pragma unroll
                for (int bj = 0; bj < 2; ++bj)
#pragma unroll
                    for (int n = 0; n < 2; ++n) { const f32x4 b = *(const f32x4*)(base + off + bj * HALF + n * 16); *(f32x4*)(out + off + bj * HALF + n * 16) = b + acc[ai][bj][m][n]; } }
    }
};
struct EpiLogits {
    static constexpr bool PERM = false, AFTER_DRAIN = false;
    float* LG;
    __device__ __forceinline__ void operator()(const f32x4 (&acc)[2][2][4][2], const Unit& u, int wr, int wc, int fr, int fq) const {
        const int row0 = u.pm * BM + wr * 64 + fr, col0 = wc * 32 + 4 * fq;
#pragma unroll
        for (int ai = 0; ai < 2; ++ai)
#pragma unroll
            for (int m = 0; m < 4; ++m) { float* o = LG + (size_t)(row0 + ai * HALF + m * 16) * 72;
#pragma unroll
                for (int n = 0; n < 2; ++n) { const int col = col0 + n * 16; if (col < 72) *(f32x4*)(o + col) = acc[ai][0][m][n]; } }
    }
};
struct EpiMoe1 {
    static constexpr bool PERM = true, AFTER_DRAIN = false;
    bf16_t* HID; const float* rstd_slot;
    __device__ __forceinline__ void operator()(const f32x4 (&acc)[2][2][4][2], const Unit& u, int wr, int wc, int fr, int fq) const {
        const int row0 = u.pm * BM + wr * 64 + fr, col0 = (u.pn & 3) * 128 + wc * 32 + 8 * fq;
#pragma unroll
        for (int ai = 0; ai < 2; ++ai)
#pragma unroll
            for (int m = 0; m < 4; ++m) { const int row = row0 + ai * HALF + m * 16; const float rs = rstd_slot[row];
                f32x4 v0, v1;
#pragma unroll
                for (int e = 0; e < 4; ++e) { v0[e] = silu_f(acc[ai][0][m][0][e] * rs) * (acc[ai][1][m][0][e] * rs); v1[e] = silu_f(acc[ai][0][m][1][e] * rs) * (acc[ai][1][m][1][e] * rs); }
                *(u32x4*)(HID + (size_t)row * 512 + col0) = pack8(v0, v1); }
    }
};
struct EpiMoe2 {
    static constexpr bool PERM = true, AFTER_DRAIN = false;
    bf16_t* Y; const float* w_slot;
    __device__ __forceinline__ void operator()(const f32x4 (&acc)[2][2][4][2], const Unit& u, int wr, int wc, int fr, int fq) const {
        const int row0 = u.pm * BM + wr * 64 + fr, col0 = (u.pn & 3) * BM + wc * 32 + 8 * fq;
#pragma unroll
        for (int ai = 0; ai < 2; ++ai)
#pragma unroll
            for (int m = 0; m < 4; ++m) { const int row = row0 + ai * HALF + m * 16; const float rs = w_slot[row];
#pragma unroll
                for (int bj = 0; bj < 2; ++bj) *(u32x4*)(Y + (size_t)row * 1024 + col0 + bj * HALF) = pack8(acc[ai][bj][m][0] * rs, acc[ai][bj][m][1] * rs); }
    }
};
struct MoeOrder {
    const PG8_LAS int* tile_e; int ntile, G, c;
    __device__ __forceinline__ bool next(int i, Unit& u) const {
        const long L = (long)i * G + c; if (L >= (long)ntile * 4) return false;
        const int pm = (int)(L >> 2), j = (int)(L & 3); u.pm = pm; u.pn = __builtin_amdgcn_readfirstlane(tile_e[pm]) * 4 + j; return true;
    }
    __device__ __forceinline__ void a_ready(const Unit&) const {}
    __device__ __forceinline__ void done(const Unit&) const {}
};
template <class Epi, class Sched, bool ALIGN_EPI = false, bool SP2 = false>
__device__ __forceinline__ void gemm_phase(PG8_LAS unsigned char* lds, const Gemm g, const Sched& S, const Epi& E) {
    const int tid = threadIdx.x, wid = __builtin_amdgcn_readfirstlane(tid >> 6), lane = tid & 63, wr = wid >> 2, wc = wid & 3, fr = lane & 15, fq = lane >> 4;
    const int K = g.K, nt = K / BK;
    unsigned voffA[2], voffB[2];
#pragma unroll
    for (int i = 0; i < 2; ++i) { int R, C; stage_rc(tid * 16 + i * 8192, R, C); const int Rb = Epi::PERM ? ((R & ~31) + perm32(R & 31)) : R;
        voffA[i] = (unsigned)(R * K + C) * 2u; voffB[i] = (unsigned)(Rb * K + C) * 2u; }
    const size_t kstep = (size_t)(BK * 2);
    const size_t hstep = (size_t)HALF * K * 2;
    const size_t tstep = 2 * hstep;
    const unsigned ldsw = (unsigned)wid * 1024u;
    const int aoff = lds_byte(wr * 64 + fr, fq * 8), boff = lds_byte(wc * 32 + fr, fq * 8);
#define PG8_SA(b, h) (((b) * 2 + (h)) * HTB)
#define PG8_SB(b, h) ((4 + (b) * 2 + (h)) * HTB)
#define PG8_STAGE(bufoff, gbase, voff) do { _Pragma("unroll") for (int _i = 0; _i < 2; ++_i) \
        __builtin_amdgcn_global_load_lds((const unsigned*)((const char*)(gbase) + (voff)[_i]), (PG8_LAS unsigned*)(lds + (bufoff) + ldsw + _i * 8192), 16, 0, 0); } while (0)
#define PG8_LDA(dst, b, h) do { _Pragma("unroll") for (int m = 0; m < 4; ++m) _Pragma("unroll") for (int k = 0; k < 2; ++k) dst[m][k] = *(const PG8_LAS bf16x8*)(lds + PG8_SA(b, h) + aoff + m * 2048 + k * 1024); } while (0)
#define PG8_LDB(dst, b, h) do { _Pragma("unroll") for (int n = 0; n < 2; ++n) _Pragma("unroll") for (int k = 0; k < 2; ++k) dst[n][k] = *(const PG8_LAS bf16x8*)(lds + PG8_SB(b, h) + boff + n * 2048 + k * 1024); } while (0)
#define PG8_MMA(ai, bj, At, Bt) do { __builtin_amdgcn_s_setprio(1); _Pragma("unroll") for (int m = 0; m < 4; ++m) _Pragma("unroll") for (int n = 0; n < 2; ++n) _Pragma("unroll") for (int k = 0; k < 2; ++k) \
        acc[ai][bj][m][n] = __builtin_amdgcn_mfma_f32_16x16x32_bf16(Bt[n][k], At[m][k], acc[ai][bj][m][n], 0, 0, 0); __builtin_amdgcn_s_setprio(0); } while (0)
#define PG8_WAIT_V(n) asm volatile("s_waitcnt vmcnt(" #n ")" ::: "memory")
#define PG8_WAIT_L(n) asm volatile("s_waitcnt lgkmcnt(" #n ")" ::: "memory")
#define PG8_BAR __builtin_amdgcn_s_barrier()
#define PG8_SCHED __builtin_amdgcn_sched_barrier(0)
    Unit cur, nxt; int ui = 0;
    if (!S.next(0, cur)) return;
    f32x4 acc[2][2][4][2];
#pragma unroll
    for (int a = 0; a < 2; ++a)
#pragma unroll
        for (int b = 0; b < 2; ++b)
#pragma unroll
            for (int m = 0; m < 4; ++m)
#pragma unroll
                for (int n = 0; n < 2; ++n) acc[a][b][m][n] = (f32x4){0.f, 0.f, 0.f, 0.f};
    bf16x8 At[4][2], B0[2][2], B1[2][2];
    const char* cA = (const char*)g.A + (size_t)cur.pm * tstep; const char* cB = (const char*)g.Bt + (size_t)cur.pn * tstep;
    S.a_ready(cur);
    if constexpr (SP2) {
        PG8_STAGE(PG8_SB(0, 0), cB, voffB); PG8_STAGE(PG8_SB(0, 1), cB + hstep, voffB); PG8_STAGE(PG8_SA(0, 0), cA, voffA); PG8_STAGE(PG8_SA(0, 1), cA + hstep, voffA);
        if (wr == 1) PG8_BAR;
        PG8_WAIT_V(2); PG8_BAR;
        PG8_STAGE(PG8_SB(1, 0), cB + kstep, voffB); PG8_STAGE(PG8_SA(1, 0), cA + kstep, voffA); PG8_STAGE(PG8_SB(1, 1), cB + hstep + kstep, voffB);
        PG8_WAIT_V(6); PG8_BAR;
    } else {
        PG8_STAGE(PG8_SB(0, 0), cB, voffB); PG8_STAGE(PG8_SA(0, 0), cA, voffA); PG8_STAGE(PG8_SB(0, 1), cB + hstep, voffB); PG8_STAGE(PG8_SA(0, 1), cA + hstep, voffA);
        if (wr == 1) PG8_BAR;
        PG8_WAIT_V(4); PG8_BAR;
        PG8_STAGE(PG8_SB(1, 0), cB + kstep, voffB); PG8_STAGE(PG8_SA(1, 0), cA + kstep, voffA); PG8_STAGE(PG8_SB(1, 1), cB + hstep + kstep, voffB);
        PG8_WAIT_V(6); PG8_BAR;
    }
    for (;;) {
        const bool has_next = S.next(ui + 1, nxt);
        const char* nA = has_next ? (const char*)g.A + (size_t)nxt.pm * tstep : cA; const char* nB = has_next ? (const char*)g.Bt + (size_t)nxt.pn * tstep : cB;
        for (int t = 0; t < nt; t += 2) {
            const bool last = (t == nt - 2);
            const char* a1 = cA + (size_t)(t + 1) * kstep;
            const char* a2 = last ? nA : cA + (size_t)(t + 2) * kstep; const char* b2 = last ? nB : cB + (size_t)(t + 2) * kstep;
            const char* a3 = a2 + kstep; const char* b3 = b2 + kstep;
            if (last && has_next) S.a_ready(nxt);
            if constexpr (SP2) {
            PG8_LDB(B0, 0, 0); PG8_LDB(B1, 0, 1); PG8_SCHED; PG8_LDA(At, 0, 0); PG8_STAGE(PG8_SA(1, 1), a1 + hstep, voffA);
            PG8_WAIT_V(8); PG8_WAIT_L(0); PG8_BAR; PG8_MMA(0, 0, At, B0); PG8_MMA(0, 1, At, B1); PG8_BAR; PG8_SCHED;
            PG8_LDA(At, 0, 1); PG8_STAGE(PG8_SB(0, 0), b2, voffB); PG8_STAGE(PG8_SB(0, 1), b2 + hstep, voffB); PG8_STAGE(PG8_SA(0, 0), a2, voffA);
            PG8_WAIT_V(8); PG8_WAIT_L(0); PG8_BAR; PG8_MMA(1, 0, At, B0); PG8_MMA(1, 1, At, B1); PG8_BAR; PG8_SCHED;
            PG8_LDB(B0, 1, 0); PG8_LDB(B1, 1, 1); PG8_SCHED; PG8_LDA(At, 1, 0); PG8_STAGE(PG8_SA(0, 1), a2 + hstep, voffA);
            PG8_WAIT_V(8); PG8_WAIT_L(0); PG8_BAR; PG8_MMA(0, 0, At, B0); PG8_MMA(0, 1, At, B1); PG8_BAR; PG8_SCHED;
            PG8_LDA(At, 1, 1); PG8_STAGE(PG8_SB(1, 0), b3, voffB); PG8_STAGE(PG8_SB(1, 1), b3 + hstep, voffB); PG8_STAGE(PG8_SA(1, 0), a3, voffA);
            PG8_WAIT_V(8); PG8_WAIT_L(0); PG8_BAR; PG8_MMA(1, 0, At, B0); PG8_MMA(1, 1, At, B1); PG8_BAR; PG8_SCHED;
            } else {
            PG8_LDB(B0, 0, 0); PG8_SCHED; PG8_LDA(At, 0, 0); PG8_STAGE(PG8_SA(1, 1), a1 + hstep, voffA);
            PG8_WAIT_L(8); PG8_BAR; PG8_WAIT_L(0); PG8_MMA(0, 0, At, B0); PG8_BAR; PG8_SCHED;
            PG8_LDB(B1, 0, 1); PG8_STAGE(PG8_SB(0, 0), b2, voffB);
            PG8_BAR; PG8_WAIT_L(0); PG8_MMA(0, 1, At, B1); PG8_BAR;
            PG8_LDA(At, 0, 1); PG8_STAGE(PG8_SA(0, 0), a2, voffA);
            PG8_BAR; PG8_WAIT_L(0); PG8_MMA(1, 0, At, B0); PG8_BAR; PG8_SCHED;
            PG8_STAGE(PG8_SB(0, 1), b2 + hstep, voffB);
            PG8_WAIT_V(6); PG8_BAR; PG8_MMA(1, 1, At, B1); PG8_BAR;
            PG8_LDB(B0, 1, 0); PG8_SCHED; PG8_LDA(At, 1, 0); PG8_STAGE(PG8_SA(0, 1), a2 + hstep, voffA);
            PG8_WAIT_L(8); PG8_BAR; PG8_WAIT_L(0); PG8_MMA(0, 0, At, B0); PG8_BAR; PG8_SCHED;
            PG8_LDB(B1, 1, 1); PG8_STAGE(PG8_SB(1, 0), b3, voffB);
            PG8_BAR; PG8_WAIT_L(0); PG8_MMA(0, 1, At, B1); PG8_BAR;
            PG8_LDA(At, 1, 1); PG8_STAGE(PG8_SA(1, 0), a3, voffA);
            PG8_BAR; PG8_WAIT_L(0); PG8_MMA(1, 0, At, B0); PG8_BAR; PG8_SCHED;
            PG8_STAGE(PG8_SB(1, 1), b3 + hstep, voffB);
            PG8_WAIT_V(6); PG8_BAR; PG8_MMA(1, 1, At, B1); PG8_BAR;
            }
        }
        if constexpr (ALIGN_EPI) { if (wr == 0) PG8_BAR; }
        if constexpr (!Epi::AFTER_DRAIN) { E(acc, cur, wr, wc, fr, fq); S.done(cur); }
        if (!has_next) break;
#pragma unroll
        for (int a = 0; a < 2; ++a)
#pragma unroll
            for (int b = 0; b < 2; ++b)
#pragma unroll
                for (int m = 0; m < 4; ++m)
#pragma unroll
                    for (int n = 0; n < 2; ++n) acc[a][b][m][n] = (f32x4){0.f, 0.f, 0.f, 0.f};
        cur = nxt; cA = nA; cB = nB; ++ui;
        if constexpr (ALIGN_EPI) { if (wr == 1) PG8_BAR; }
    }
    PG8_WAIT_V(0);
    if constexpr (!ALIGN_EPI) { if (wr == 0) PG8_BAR; }
    PG8_BAR;
    if constexpr (Epi::AFTER_DRAIN) { E.fused(acc, cur, wr, wc, fr, fq, lds, wid, lane); S.done(cur); }
#undef PG8_SA
#undef PG8_SB
#undef PG8_STAGE
#undef PG8_LDA
#undef PG8_LDB
#undef PG8_MMA
#undef PG8_WAIT_V
#undef PG8_WAIT_L
#undef PG8_BAR
#undef PG8_SCHED
}
}
#define GAS __attribute__((address_space(1)))
#define LAS __attribute__((address_space(3)))
typedef unsigned short bf16;
typedef unsigned v4u __attribute__((ext_vector_type(4)));
typedef float f32x4 __attribute__((ext_vector_type(4)));
typedef short bf16x8 __attribute__((ext_vector_type(8)));
typedef GAS unsigned gu32;
typedef GAS unsigned long long gu64;
#define RLX_AGENT __ATOMIC_RELAXED, __HIP_MEMORY_SCOPE_AGENT
#define LDS_WAIT() asm volatile("s_waitcnt lgkmcnt(0)" ::: "memory")
#define VM_WAIT() asm volatile("s_waitcnt vmcnt(0)" ::: "memory")
__device__ __forceinline__ unsigned long long rt() { return __builtin_amdgcn_s_memrealtime(); }
__device__ __forceinline__ unsigned f2bf(float f) { unsigned u = __builtin_bit_cast(unsigned, f); return (u + 0x7fffu + ((u >> 16) & 1u)) >> 16; }
__device__ __forceinline__ unsigned pk2(float lo, float hi) { return f2bf(lo) | (f2bf(hi) << 16); }
#define XB_TMO      128
#define XB_XCNT(j)  (256  + 64 * (j))
#define XB_XSUB(j)  (1280 + 64 * (j))
#define XB_XGEN(j)  (2304 + 64 * (j))
#define XB_TOP      3328
#define XB_TOPGEN   3392
#define XCD_BAR_WORDS 3456
#define XB_SPIN_CAP (1u << 18)

__device__ __forceinline__ unsigned xb_ld(unsigned* p)              { return __hip_atomic_load(p, __ATOMIC_RELAXED, __HIP_MEMORY_SCOPE_AGENT); }
__device__ __forceinline__ unsigned xb_add(unsigned* p, unsigned v) { return __hip_atomic_fetch_add(p, v, __ATOMIC_RELAXED, __HIP_MEMORY_SCOPE_AGENT); }
__device__ __forceinline__ unsigned xb_xcc_id() { return (unsigned)__builtin_amdgcn_s_getreg((3 << 11) | 20) & 0xFu; }
#define XB_SPIN(cond, bar) do { unsigned _sp = 0; while (cond) { __builtin_amdgcn_s_sleep(1); \
    if ((++_sp & 255u) == 0u) { if (xb_ld(&(bar)[XB_TMO])) break; if (_sp > XB_SPIN_CAP) { atomicAdd(&(bar)[XB_TMO], 1u); break; } } } } while (0)

struct XcdBarrier {
    unsigned* bar; unsigned x;
    volatile LAS unsigned* st;
};

__device__ __forceinline__ XcdBarrier xcd_barrier_post(unsigned* bar, volatile LAS unsigned* st) {
    XcdBarrier b; b.bar = bar; b.x = xb_xcc_id(); b.st = st;
    if (threadIdx.x == 0) (void)xb_add(&bar[XB_XCNT(b.x)], 1u);
    return b;
}
__device__ __forceinline__ void xcd_barrier_complete(unsigned* bar, unsigned x, unsigned& nloc, unsigned& nx) {
    const unsigned G = gridDim.x * gridDim.y * gridDim.z;
    unsigned sum, cnt, mine, sp = 0u;
    for (;;) {
        sum = 0u; cnt = 0u; mine = 0u;
#pragma unroll
        for (unsigned j = 0; j < 16; ++j) { const unsigned c = xb_ld(&bar[XB_XCNT(j)]); sum += c; cnt += (c > 0u) ? 1u : 0u; mine = (j == x) ? c : mine; }
        if (sum == G) break;
        __builtin_amdgcn_s_sleep(1);
        if ((++sp & 255u) == 0u) { if (xb_ld(&bar[XB_TMO])) break; if (sp > XB_SPIN_CAP) { atomicAdd(&bar[XB_TMO], 1u); break; } }
    }
    nloc = mine > 0u ? mine : 1u; nx = cnt > 0u ? cnt : 1u;
}

__device__ __forceinline__ void xcd_barrier(const XcdBarrier& b) {
    asm volatile("s_waitcnt vmcnt(0)" ::: "memory");
    __syncthreads();
    if (threadIdx.x == 0) {
        unsigned* bar = b.bar;
        __builtin_amdgcn_s_waitcnt(0);
        unsigned nloc = b.st[0], nx = b.st[1];
        if (nloc == 0u) { xcd_barrier_complete(bar, b.x, nloc, nx); b.st[0] = nloc; b.st[1] = nx; }
        const unsigned old = xb_add(&bar[XB_XSUB(b.x)], 1u);
        const unsigned gen = old / nloc;
        if (old + 1u == (gen + 1u) * nloc) {
            __builtin_amdgcn_fence(__ATOMIC_RELEASE, "agent");
            asm volatile("s_waitcnt vmcnt(0)" ::: "memory");
            const unsigned og = xb_add(&bar[XB_TOP], 1u);
            const unsigned tg = og / nx;
            if (og + 1u == (tg + 1u) * nx) xb_add(&bar[XB_TOPGEN], 1u);
            else XB_SPIN(xb_ld(&bar[XB_TOPGEN]) == tg, bar);
            __builtin_amdgcn_fence(__ATOMIC_ACQUIRE, "agent");
            xb_add(&bar[XB_XGEN(b.x)], 1u);
            asm volatile("s_waitcnt vmcnt(0)" ::: "memory");
        } else {
            XB_SPIN(xb_ld(&bar[XB_XGEN(b.x)]) == gen, bar);
            __builtin_amdgcn_fence(__ATOMIC_ACQUIRE, "agent");
            asm volatile("s_waitcnt vmcnt(0)" ::: "memory");
        }
    }
    __syncthreads();
}

constexpr int NWAVES = 8, NTHR = 512;
constexpr int M = 32768, D = 1024, SEQ = 8192, NB = 4;
constexpr int DIN = 5136;
constexpr int MOE_CAP_TILES = 288, MOE_CAP = MOE_CAP_TILES * 256;
constexpr int LIST_CAP = 256 * 496;
constexpr float EPS = 1e-6f;
#ifndef MK_ONE_LAUNCH
#define MK_ONE_LAUNCH 0
#endif
constexpr int NPHASE = 20;

constexpr size_t MiB = 1u << 20, KiB = 1u << 10;
constexpr size_t WS_CTL = 0, CTL_ZERO_BYTES = 1 * MiB;
constexpr int CW_TMO = 0, CW_CODE = 1, CW_BAR = 4096, CW_LCNT = 16384, CW_ECNT = 20480, CW_WQ = 24576;
constexpr size_t WS_RSTD0 = 1 * MiB, WS_RSTD1 = WS_RSTD0 + 128 * KiB, WS_RSTD2 = WS_RSTD1 + 128 * KiB;
constexpr size_t WS_DEC = 1 * MiB + 512 * KiB;
constexpr size_t WS_KMEAN = 2 * MiB, WS_KNMAX = 2 * MiB + 256 * KiB;
constexpr size_t WS_MOE_E = 2 * MiB + 512 * KiB, WS_MOE_POS = WS_MOE_E + 256 * KiB, WS_MOE_W = WS_MOE_POS + 256 * KiB, WS_SLOT_OF = WS_MOE_W + 256 * KiB;
constexpr size_t WS_W_SLOT = 4 * MiB, WS_RSTD_SLOT = 4 * MiB + 512 * KiB, WS_TILE_E = 5 * MiB;
constexpr size_t WS_MEMN = 6 * MiB, WS_MKV = 8 * MiB;
constexpr size_t WS_W1T = 10 * MiB, WS_WVT = WS_W1T + 4608 * KiB, WS_WZT = WS_WVT + 2 * MiB, WS_PGT = WS_WZT + 4 * MiB, WS_PMT = WS_PGT + 1 * MiB, WS_WOUTT = WS_PMT + 1 * MiB,
                 WS_WCQT = WS_WOUTT + 2 * MiB, WS_WCKVT = WS_WCQT + 1 * MiB, WS_WCOT = WS_WCKVT + 2 * MiB, WS_WRT = WS_WCOT + 1 * MiB;
static_assert(WS_WRT + 1 * MiB <= 30 * MiB, "weights");
constexpr size_t WS_XB = 30 * MiB, WS_QG = 94 * MiB, WS_KG = 110 * MiB, WS_SR = 126 * MiB, WS_QM = 158 * MiB, WS_KM = 190 * MiB, WS_VT = 222 * MiB, WS_OG = 286 * MiB;
constexpr size_t WS_LISTS = 318 * MiB, WS_PARTO = 334 * MiB, WS_PARTL = 430 * MiB, WS_REFS = 433 * MiB, WS_SEL = 434 * MiB;
constexpr size_t WS_SZ = 318 * MiB, WS_T1 = 446 * MiB, WS_MG = 30 * MiB;
constexpr size_t WS_X1B = 94 * MiB, WS_QC = 158 * MiB;
constexpr size_t WS_WGUT = 30 * MiB, WS_WDT = 94 * MiB, WS_X2HL = 126 * MiB, WS_XG = 254 * MiB, WS_HID = 398 * MiB, WS_LG = 470 * MiB;
constexpr size_t WS_END = 512 * MiB;
static_assert(WS_T1 + 64 * MiB <= WS_END && WS_LG + 9 * MiB <= WS_END && WS_XG + 144 * MiB <= WS_HID && WS_HID + 72 * MiB <= WS_LG, "map");
constexpr size_t DO_ST = 0, DO_LA = 64 * MiB;

constexpr int RING_OFF = 0, RING_BYTES = 131072;
constexpr int LDSCTL_OFF = RING_BYTES, MISC_OFF = LDSCTL_OFF + 320;
constexpr int TBL_TILE = RING_BYTES + 1024, TBL_TAB = TBL_TILE + 1280, TBL_BC = TBL_TAB + 512, TBL_EB = TBL_BC + 64;
constexpr int LDS_BYTES = 147456;
static_assert(TBL_EB + 256 <= LDS_BYTES, "LDS map");

struct Args { const float* in[25]; float* out; unsigned char* ws; int ph_lo, ph_hi; };
struct Frame {
    LAS unsigned char* lds; unsigned char* ldsg;
    volatile LAS unsigned* MISC; gu32* ctl;
    int tid, lane, wave, vcu, G;
    unsigned char* ws; float* out;
};
__device__ __forceinline__ float wave_sum(float v) {
#pragma unroll
    for (int o = 1; o < 64; o <<= 1) v += __shfl_xor(v, o);
    return v;
}
__device__ __forceinline__ float wave_max(float v) {
#pragma unroll
    for (int o = 1; o < 64; o <<= 1) v = fmaxf(v, __shfl_xor(v, o));
    return v;
}
__device__ __forceinline__ float bf2f(bf16 h) { return __uint_as_float(((unsigned)h) << 16); }
__device__ __forceinline__ float bflo(unsigned w) { return __uint_as_float(w << 16); }
__device__ __forceinline__ float bfhi(unsigned w) { return __uint_as_float(w & 0xffff0000u); }
__device__ __forceinline__ void unpack8(const v4u w, float* f) { f[0] = bflo(w.x); f[1] = bfhi(w.x); f[2] = bflo(w.y); f[3] = bfhi(w.y); f[4] = bflo(w.z); f[5] = bfhi(w.z); f[6] = bflo(w.w); f[7] = bfhi(w.w); }
__device__ __forceinline__ v4u pack8f(const float* f) { v4u w; w.x = pk2(f[0], f[1]); w.y = pk2(f[2], f[3]); w.z = pk2(f[4], f[5]); w.w = pk2(f[6], f[7]); return w; }
__device__ __forceinline__ int t5_bucket(int n) {
    if (n < 16) return n;
    int b = 16;
    b += (n >= 19) + (n >= 21) + (n >= 24) + (n >= 27) + (n >= 31) + (n >= 35) + (n >= 40) + (n >= 46) + (n >= 52) + (n >= 59) + (n >= 67) + (n >= 77) + (n >= 87) + (n >= 99) + (n >= 113);
    return b;
}

__device__ __forceinline__ void tr_item(const float* src, int ldw, const float* gain, bf16* dst, int K, int k0, LAS float* scr, int lane) {
#pragma unroll 8
    for (int i = 0; i < 32; ++i) { const int kk = 2 * i + (lane >> 5); float v = src[(size_t)(k0 + kk) * ldw + (lane & 31)]; if (gain) v *= gain[k0 + kk]; scr[kk * 33 + (lane & 31)] = v; }
    LDS_WAIT(); asm volatile("" ::: "memory");
    const int c = lane & 7;
#pragma unroll
    for (int j = 0; j < 4; ++j) { const int n = (lane >> 3) + 8 * j; const LAS float* s = scr + (8 * c) * 33 + n;
        v4u o; o.x = pk2(s[0 * 33], s[1 * 33]); o.y = pk2(s[2 * 33], s[3 * 33]); o.z = pk2(s[4 * 33], s[5 * 33]); o.w = pk2(s[6 * 33], s[7 * 33]);
        *(GAS v4u*)(dst + (size_t)n * K + k0 + 8 * c) = o; }
    LDS_WAIT(); asm volatile("" ::: "memory");
}
__device__ __forceinline__ void tr_item_alpha(const float* w_in, const float* wau, const float* gain, bf16* dst, int k0, int n0, LAS float* scr, int lane) {
    float wa[16];
#pragma unroll
    for (int r = 0; r < 16; ++r) wa[r] = wau[r * 256 + n0 + (lane & 31)];
#pragma unroll 4
    for (int i = 0; i < 32; ++i) { const int kk = 2 * i + (lane >> 5); const float* a = w_in + (size_t)(k0 + kk) * DIN + 1536; float v = 0.f;
#pragma unroll
        for (int r = 0; r < 16; ++r) v += a[r] * wa[r];
        scr[kk * 33 + (lane & 31)] = v * gain[k0 + kk]; }
    LDS_WAIT(); asm volatile("" ::: "memory");
    const int c = lane & 7;
#pragma unroll
    for (int j = 0; j < 4; ++j) { const int n = (lane >> 3) + 8 * j; const LAS float* s = scr + (8 * c) * 33 + n;
        v4u o; o.x = pk2(s[0 * 33], s[1 * 33]); o.y = pk2(s[2 * 33], s[3 * 33]); o.z = pk2(s[4 * 33], s[5 * 33]); o.w = pk2(s[6 * 33], s[7 * 33]);
        *(GAS v4u*)(dst + (size_t)(n0 + n) * 1024 + k0 + 8 * c) = o; }
    LDS_WAIT(); asm volatile("" ::: "memory");
}
struct TrJob { int src, col0, ldw, gain, K, ncols, drow; unsigned dst_off_kib; };
__constant__ TrJob kJobs[15] = {
    {5, 0, DIN, 4, 1024, 256, 0, (unsigned)(WS_W1T / 1024)},
    {5, 256, DIN, 4, 1024, 256, 256, (unsigned)(WS_W1T / 1024)},
    {5, 1024, DIN, 4, 1024, 512, 512, (unsigned)(WS_W1T / 1024)},
    {5, 1552, DIN, 4, 1024, 512, 1280, (unsigned)(WS_W1T / 1024)},
    {5, 2064, DIN, 4, 1024, 512, 1792, (unsigned)(WS_W1T / 1024)},
    {5, 512, DIN, 4, 1024, 512, 0, (unsigned)(WS_WVT / 1024)},
    {5, 2576, DIN, 4, 1024, 512, 512, (unsigned)(WS_WVT / 1024)},
    {5, 3088, DIN, 4, 1024, 1024, 0, (unsigned)(WS_WZT / 1024)},
    {5, 4112, DIN, 4, 1024, 1024, 1024, (unsigned)(WS_WZT / 1024)},
    {9, 0, 1024, -1, 512, 1024, 0, (unsigned)(WS_PGT / 1024)},
    {10, 0, 1024, -1, 512, 1024, 0, (unsigned)(WS_PMT / 1024)},
    {11, 0, 1024, -1, 1024, 1024, 0, (unsigned)(WS_WOUTT / 1024)},
    {13, 0, 512, 12, 1024, 512, 0, (unsigned)(WS_WCQT / 1024)},
    {14, 0, 1024, -1, 1024, 1024, 0, (unsigned)(WS_WCKVT / 1024)},
    {15, 0, 1024, -1, 512, 1024, 0, (unsigned)(WS_WCOT / 1024)},
};
__device__ __forceinline__ void p0_prologue(Frame& F, const Args& A) {
    LAS float* scr = (LAS float*)(F.lds + RING_OFF + F.wave * 16384);
    const int gw = F.vcu * NWAVES + F.wave, NGW = F.G * NWAVES;
    int total = 0;
#pragma unroll 1
    for (int j = 0; j < 15; ++j) total += (kJobs[j].K / 64) * (kJobs[j].ncols / 32);
    const int alpha_items = 16 * 8;
#pragma unroll 1
    for (int it = gw; it < total + alpha_items; it += NGW) {
        if (it >= total) { const int r = it - total; tr_item_alpha(A.in[5], A.in[6], A.in[4], (bf16*)(F.ws + WS_W1T) + (size_t)1024 * 1024, (r >> 3) * 64, (r & 7) * 32, scr, F.lane); continue; }
        int r = it, j = 0;
#pragma unroll 1
        for (; j < 15; ++j) { const int n = (kJobs[j].K / 64) * (kJobs[j].ncols / 32); if (r < n) break; r -= n; }
        const TrJob jb = kJobs[j]; const int nblk = jb.ncols / 32, kb = r / nblk, nb = r % nblk;
        tr_item(A.in[jb.src] + jb.col0 + nb * 32, jb.ldw, jb.gain >= 0 ? A.in[jb.gain] : nullptr, (bf16*)(F.ws + (size_t)jb.dst_off_kib * 1024) + (size_t)(jb.drow + nb * 32) * jb.K, jb.K, kb * 64, scr, F.lane);
    }
    { bf16* wrt = (bf16*)(F.ws + WS_WRT); const float* g = A.in[16]; const float* wg = A.in[17]; const float* we = A.in[19];
        for (int i = blockIdx.x * NTHR + F.tid; i < 256 * 2048; i += F.G * NTHR) { const int o = i >> 11, k = i & 2047, kk = k & 1023; unsigned v = 0;
            if (o < 72) { const int oo = o < 36 ? o : o - 36; const float w = g[kk] * (oo < 4 ? wg[kk * 4 + oo] : we[kk * 32 + oo - 4]); const unsigned hi = f2bf(w);
                if (o < 36) v = hi; else if (k < 1024) v = f2bf(w - __uint_as_float(hi << 16)); }
            wrt[i] = (bf16)v; } }
    { const float* x = A.in[0]; bf16* xb = (bf16*)(F.ws + WS_XB); float* rstd0 = (float*)(F.ws + WS_RSTD0);
        for (int m = gw; m < M; m += NGW) { const GAS f32x4* xr = (const GAS f32x4*)(x + (size_t)m * D) + F.lane; f32x4 v[4]; float s = 0.f;
#pragma unroll
            for (int j = 0; j < 4; ++j) { v[j] = xr[64 * j]; s += (v[j].x * v[j].x + v[j].y * v[j].y) + (v[j].z * v[j].z + v[j].w * v[j].w); }
            s = wave_sum(s); if (F.lane == 0) rstd0[m] = rsqrtf(s * (1.f / D) + EPS);
            GAS unsigned long long* o8 = (GAS unsigned long long*)(xb + (size_t)m * D) + F.lane;
#pragma unroll
            for (int j = 0; j < 4; ++j) o8[64 * j] = (unsigned long long)pk2(v[j].x, v[j].y) | ((unsigned long long)pk2(v[j].z, v[j].w) << 32); } }
    { const float* mem = A.in[1]; const float* gm = A.in[2]; bf16* mn = (bf16*)(F.ws + WS_MEMN);
        for (int m = gw; m < 1024; m += NGW) { const GAS f32x4* xr = (const GAS f32x4*)(mem + (size_t)m * D) + F.lane; const GAS f32x4* gr = (const GAS f32x4*)gm + F.lane; f32x4 v[4]; float s = 0.f;
#pragma unroll
            for (int j = 0; j < 4; ++j) { v[j] = xr[64 * j]; s += (v[j].x * v[j].x + v[j].y * v[j].y) + (v[j].z * v[j].z + v[j].w * v[j].w); }
            s = wave_sum(s); const float rs = rsqrtf(s * (1.f / D) + EPS);
            GAS unsigned long long* o8 = (GAS unsigned long long*)(mn + (size_t)m * D) + F.lane;
#pragma unroll
            for (int j = 0; j < 4; ++j) { const f32x4 g = gr[64 * j]; o8[64 * j] = (unsigned long long)pk2(v[j].x * rs * g.x, v[j].y * rs * g.y) | ((unsigned long long)pk2(v[j].z * rs * g.z, v[j].w * rs * g.w) << 32); } } }
}
__device__ __forceinline__ void expert_weights(Frame& F, const Args& A) {
    LAS float* scr = (LAS float*)(F.lds + RING_OFF + F.wave * 16384);
    const int gw = F.vcu * NWAVES + F.wave, NGW = F.G * NWAVES;
    bf16* wgut = (bf16*)(F.ws + WS_WGUT); bf16* wdt = (bf16*)(F.ws + WS_WDT);
#pragma unroll 1
    for (int it = gw; it < 32 * 768; it += NGW) { const int e = it / 768, r = it % 768;
        if (r < 512) { const int up = r >> 8, rr = r & 255, kb = rr >> 4, nb = rr & 15, c0 = nb * 32;
            tr_item(A.in[up ? 22 : 21] + (size_t)e * 1024 * 512 + c0, 512, A.in[16], wgut + ((size_t)e * 1024 + (c0 >> 7) * 256 + (c0 & 127) + up * 128) * 1024, 1024, kb * 64, scr, F.lane); }
        else { const int rr = r - 512, kb = rr >> 5, nb = rr & 31;
            tr_item(A.in[23] + (size_t)e * 512 * 1024 + nb * 32, 1024, nullptr, wdt + ((size_t)e * 1024 + nb * 32) * 512, 512, kb * 64, scr, F.lane); } }
}

constexpr int GS = 65;
__device__ __forceinline__ void gla_load_b(Frame& F, const float* LA, int m0, int h, float* Bs) {
#pragma unroll 1
    for (int i = F.tid; i < 4096; i += NTHR) { const int c = i >> 6, d = i & 63; Bs[c * GS + d] = LA[(size_t)(m0 + c) * 256 + h * 64 + d]; }
    __syncthreads();
    if (F.tid < 64) { float s = 0.f;
#pragma unroll 8
        for (int c = 0; c < 64; ++c) { s += Bs[c * GS + F.tid]; Bs[c * GS + F.tid] = s; } }
    __syncthreads();
}
__device__ __forceinline__ void gla_a_phase(Frame& F) {
    float* lf = (float*)(F.ldsg + RING_OFF); float* Bs = lf; float* Ks = lf + 64 * GS; float* Vs = Ks + 64 * GS;
    const float* LA = (const float*)((unsigned char*)F.out + DO_LA); float* ST = (float*)((unsigned char*)F.out + DO_ST);
    const bf16* KG = (const bf16*)(F.ws + WS_KG); const bf16* VT = (const bf16*)(F.ws + WS_VT); float* DEC = (float*)(F.ws + WS_DEC);
#pragma unroll 1
    for (int u = blockIdx.x; u < 2048; u += F.G) {
        const int bh = u >> 7, n = u & 127, b = bh >> 2, h = bh & 3, m0 = b * SEQ + n * 64;
        gla_load_b(F, LA, m0, h, Bs);
#pragma unroll 1
        for (int i = F.tid; i < 4096; i += NTHR) { const int c = i >> 6, d = i & 63; Ks[c * GS + d] = bf2f(KG[(size_t)(m0 + c) * 256 + h * 64 + d]) * __expf(Bs[63 * GS + d] - Bs[c * GS + d]); }
#pragma unroll 1
        for (int i = F.tid; i < 8192; i += NTHR) { const int v = i >> 6, c = i & 63; Vs[v * GS + c] = bf2f(VT[(size_t)(h * 128 + v) * M + m0 + c]); }
        __syncthreads();
        { const int v = F.tid & 127, dg = F.tid >> 7; float acc[16];
#pragma unroll
            for (int i = 0; i < 16; ++i) acc[i] = 0.f;
#pragma unroll 4
            for (int c = 0; c < 64; ++c) { const float vv = Vs[v * GS + c];
#pragma unroll
                for (int i = 0; i < 16; ++i) acc[i] += Ks[c * GS + dg * 16 + i] * vv; }
            float* o = ST + ((size_t)u * 128 + v) * 64 + dg * 16;
#pragma unroll
            for (int i = 0; i < 16; i += 4) *(f32x4*)(o + i) = (f32x4){acc[i], acc[i + 1], acc[i + 2], acc[i + 3]}; }
        if (F.tid < 64) DEC[u * 64 + F.tid] = __expf(Bs[63 * GS + F.tid]);
        __syncthreads();
    }
}
__device__ __forceinline__ void gla_scan_phase(Frame& F) {
    float* ST = (float*)((unsigned char*)F.out + DO_ST); const float* DEC = (const float*)(F.ws + WS_DEC);
#pragma unroll 1
    for (int g = blockIdx.x * NTHR + F.tid; g < 16 * 8192; g += F.G * NTHR) { const int bh = g >> 13, vd = g & 8191, d = vd & 63; float st = 0.f;
        float* p = ST + (size_t)bh * 128 * 8192 + vd; const float* dc = DEC + bh * 128 * 64 + d;
#pragma unroll 1
        for (int n0 = 0; n0 < 128; n0 += 8) { float kv[8], de[8];
#pragma unroll
            for (int i = 0; i < 8; ++i) { kv[i] = p[(size_t)(n0 + i) * 8192]; de[i] = dc[(n0 + i) * 64]; }
#pragma unroll
            for (int i = 0; i < 8; ++i) { p[(size_t)(n0 + i) * 8192] = st; st = de[i] * st + kv[i]; } } }
}
__device__ __forceinline__ void gla_b_phase(Frame& F, const Args& A) {
    float* lf = (float*)(F.ldsg + RING_OFF); float* Bs = lf; float* Qe = lf + 64 * GS; float* Ke = Qe + 64 * GS; float* Vs = Ke + 64 * GS; float* Sin = Vs + 128 * GS; float* Pr = Sin + 128 * GS;
    const float* LA = (const float*)((unsigned char*)F.out + DO_LA); const float* ST = (const float*)((unsigned char*)F.out + DO_ST);
    const bf16* QG = (const bf16*)(F.ws + WS_QG); const bf16* KG = (const bf16*)(F.ws + WS_KG); const bf16* VT = (const bf16*)(F.ws + WS_VT); const bf16* SR = (const bf16*)(F.ws + WS_SR);
    bf16* OG = (bf16*)(F.ws + WS_OG); const float* gg = A.in[8];
#pragma unroll 1
    for (int u = blockIdx.x; u < 2048; u += F.G) {
        const int bh = u >> 7, n = u & 127, b = bh >> 2, h = bh & 3, m0 = b * SEQ + n * 64;
        gla_load_b(F, LA, m0, h, Bs);
#pragma unroll 1
        for (int i = F.tid; i < 4096; i += NTHR) { const int c = i >> 6, d = i & 63; const float bb = Bs[c * GS + d], bm = Bs[31 * GS + d]; const size_t gi = (size_t)(m0 + c) * 256 + h * 64 + d;
            Qe[c * GS + d] = bf2f(QG[gi]) * __expf(bb - bm); Ke[c * GS + d] = bf2f(KG[gi]) * __expf(bm - bb); }
#pragma unroll 1
        for (int i = F.tid; i < 8192; i += NTHR) { const int v = i >> 6, c = i & 63; Vs[v * GS + c] = bf2f(VT[(size_t)(h * 128 + v) * M + m0 + c]); }
#pragma unroll 1
        for (int i = F.tid; i < 8192; i += NTHR) { const int v = i >> 6, d = i & 63; Sin[v * GS + d] = ST[(size_t)u * 8192 + i] * __expf(Bs[31 * GS + d]); }
        __syncthreads();
        { const int c = F.tid >> 3, sg = F.tid & 7; float a[8];
#pragma unroll
            for (int j = 0; j < 8; ++j) a[j] = 0.f;
#pragma unroll 4
            for (int d = 0; d < 64; ++d) { const float q = Qe[c * GS + d];
#pragma unroll
                for (int j = 0; j < 8; ++j) a[j] += q * Ke[(sg * 8 + j) * GS + d]; }
#pragma unroll
            for (int j = 0; j < 8; ++j) Bs[c * GS + sg * 8 + j] = (sg * 8 + j <= c) ? a[j] : 0.f; }
        __syncthreads();
        { const int v = F.tid & 127, cg = F.tid >> 7; float o[16];
#pragma unroll
            for (int i = 0; i < 16; ++i) o[i] = 0.f;
#pragma unroll 4
            for (int s = 0; s < 64; ++s) { const float vv = Vs[v * GS + s], sv = Sin[v * GS + s];
#pragma unroll
                for (int i = 0; i < 16; ++i) o[i] += Bs[(cg * 16 + i) * GS + s] * vv + Qe[(cg * 16 + i) * GS + s] * sv; }
#pragma unroll
            for (int i = 0; i < 16; ++i) { const float q = wave_sum(o[i] * o[i]); if (F.lane == 0) Pr[(cg * 16 + i) * 2 + (F.wave & 1)] = q; }
            __syncthreads();
            const float gv = gg[h * 128 + v];
#pragma unroll
            for (int i = 0; i < 16; ++i) { const int c = cg * 16 + i; const float rs = rsqrtf((Pr[c * 2] + Pr[c * 2 + 1]) * (1.f / 128.f) + EPS); const size_t gi = (size_t)(m0 + c) * 512 + h * 128 + v;
                OG[gi] = (bf16)f2bf(o[i] * rs * gv * bf2f(SR[gi])); } }
        __syncthreads();
    }
}

__device__ __forceinline__ int list_off(int j) { return 256 * (31 * j - (j * (j - 1)) / 2); }
__device__ __forceinline__ void moba_kmean_phase(Frame& F) {
    float* lf = (float*)(F.ldsg + RING_OFF); float* part = lf; float* pmx = lf + 512;
    const bf16* KM = (const bf16*)(F.ws + WS_KM); float* kmean = (float*)(F.ws + WS_KMEAN); float* knmax = (float*)(F.ws + WS_KNMAX);
#pragma unroll 1
    for (int u = blockIdx.x; u < 1024; u += F.G) { const int bh = u >> 5, j = u & 31, b = bh >> 3, h = bh & 7; const size_t m0 = (size_t)b * SEQ + j * 256 + F.wave * 32;
        float s = 0.f, mx = 0.f;
#pragma unroll 4
        for (int r = 0; r < 32; ++r) { const float v = bf2f(KM[(m0 + r) * 512 + h * 64 + F.lane]); s += v; mx = fmaxf(mx, wave_sum(v * v)); }
        part[F.wave * 64 + F.lane] = s; if (F.lane == 0) pmx[F.wave] = mx;
        __syncthreads();
        if (F.tid < 64) { float t = 0.f;
#pragma unroll
            for (int w = 0; w < 8; ++w) t += part[w * 64 + F.tid];
            kmean[u * 64 + F.tid] = t * (1.f / 256.f); }
        if (F.tid == 0) { float t = 0.f;
#pragma unroll
            for (int w = 0; w < 8; ++w) t = fmaxf(t, pmx[w]);
            knmax[u] = sqrtf(t); }
        __syncthreads();
    }
}
__device__ __forceinline__ void moba_gate_phase(Frame& F, const Args& A) {
    float* lf = (float*)(F.ldsg + RING_OFF); float* km = lf; float* knm = lf + 2048;
    const bf16* QM = (const bf16*)(F.ws + WS_QM); const float* kmean = (const float*)(F.ws + WS_KMEAN); const float* knmax = (const float*)(F.ws + WS_KNMAX);
    unsigned* SEL = (unsigned*)(F.ws + WS_SEL); float* REFS = (float*)(F.ws + WS_REFS); unsigned* LISTS = (unsigned*)(F.ws + WS_LISTS); const float* rb = A.in[3];
#pragma unroll 1
    for (int u = blockIdx.x; u < 1024; u += F.G) { const int bh = u >> 5, qb = u & 31, b = bh >> 3, h = bh & 7;
#pragma unroll 1
        for (int i = F.tid; i < 2048; i += NTHR) km[i] = kmean[bh * 2048 + i];
        if (F.tid < 32) knm[F.tid] = knmax[bh * 32 + F.tid];
        __syncthreads();
        if (F.tid < 256) { const int t = qb * 256 + F.tid; const size_t m = (size_t)b * SEQ + t; float q[64]; float qn = 0.f;
#pragma unroll
            for (int c = 0; c < 8; ++c) { const v4u w = *(const GAS v4u*)(QM + m * 512 + h * 64 + c * 8); unpack8(w, q + c * 8); }
#pragma unroll
            for (int d = 0; d < 64; ++d) qn += q[d] * q[d];
            qn = sqrtf(qn);
            float v0 = -INFINITY, v1 = -INFINITY, v2 = -INFINITY; int i0 = 0, i1 = 0, i2 = 0;
#pragma unroll 1
            for (int j = 0; j < qb; ++j) { float g = 0.f;
#pragma unroll
                for (int d = 0; d < 64; ++d) g += q[d] * km[j * 64 + d];
                if (g > v0) { v2 = v1; i2 = i1; v1 = v0; i1 = i0; v0 = g; i0 = j; } else if (g > v1) { v2 = v1; i2 = i1; v1 = g; i1 = j; } else if (g > v2) { v2 = g; i2 = j; } }
            const int nsel = qb < 3 ? qb : 3;
            float kx = knm[qb]; if (nsel > 0) kx = fmaxf(kx, knm[i0]); if (nsel > 1) kx = fmaxf(kx, knm[i1]); if (nsel > 2) kx = fmaxf(kx, knm[i2]);
            float bmx = rb[h];
#pragma unroll 1
            for (int k = 1; k < 32; ++k) bmx = fmaxf(bmx, rb[k * 8 + h]);
            SEL[m * 8 + h] = (unsigned)i0 | ((unsigned)i1 << 5) | ((unsigned)i2 << 10) | ((unsigned)nsel << 15);
            REFS[m * 8 + h] = qn * kx + bmx;
            const int sel[3] = {i0, i1, i2};
#pragma unroll
            for (int r = 0; r < 3; ++r) if (r < nsel) { const unsigned pos = atomicAdd((unsigned*)(F.ctl + CW_LCNT) + bh * 32 + sel[r], 1u); LISTS[(size_t)bh * LIST_CAP + list_off(sel[r]) + pos] = ((unsigned)t << 2) | (unsigned)r; } }
        __syncthreads();
    }
}
__device__ __forceinline__ void moba_load_kv(Frame& F, const Args& A, int b, int h, int j, float* Ks, float* Vs, float* tab) {
    const bf16* KM = (const bf16*)(F.ws + WS_KM); const bf16* VT = (const bf16*)(F.ws + WS_VT);
    const size_t mk = (size_t)b * SEQ + j * 256;
#pragma unroll 1
    for (int i = F.tid; i < 2048; i += NTHR) { const int key = i >> 3, c = i & 7; float f[8]; unpack8(*(const GAS v4u*)(KM + (mk + key) * 512 + h * 64 + c * 8), f);
#pragma unroll
        for (int e = 0; e < 8; ++e) Ks[key * 64 + c * 8 + e] = f[e]; }
#pragma unroll 1
    for (int i = F.tid; i < 2048; i += NTHR) { const int d = i & 63, kg = i >> 6; float f[8]; unpack8(*(const GAS v4u*)(VT + (size_t)(512 + h * 64 + d) * M + mk + kg * 8), f);
#pragma unroll
        for (int e = 0; e < 8; ++e) Vs[(kg * 8 + e) * 64 + d] = f[e]; }
    if (F.tid < 128) tab[F.tid] = A.in[3][t5_bucket(F.tid) * 8 + h];
}
__device__ __forceinline__ void moba_part_phase(Frame& F, const Args& A) {
    float* Ks = (float*)(F.ldsg + RING_OFF); float* Vs = Ks + 256 * 64; float* tab = (float*)(F.ldsg + TBL_TAB); volatile int* bc = (volatile int*)(F.ldsg + TBL_BC);
    const bf16* QM = (const bf16*)(F.ws + WS_QM); const float* REFS = (const float*)(F.ws + WS_REFS); const unsigned* LISTS = (const unsigned*)(F.ws + WS_LISTS);
    bf16* PARTO = (bf16*)(F.ws + WS_PARTO); float* PARTL = (float*)(F.ws + WS_PARTL);
#pragma unroll 1
    for (;;) {
        if (F.tid == 0) bc[0] = (int)atomicAdd((unsigned*)(F.ctl + CW_WQ), 1u);
        __syncthreads();
        const int u = bc[0];
        __syncthreads();
        if (u >= 31 * 32) break;
        const int j = u >> 5, bh = u & 31, b = bh >> 3, h = bh & 7;
        const int n = (int)__hip_atomic_load((unsigned*)(F.ctl + CW_LCNT) + bh * 32 + j, RLX_AGENT);
        moba_load_kv(F, A, b, h, j, Ks, Vs, tab);
        __syncthreads();
#pragma unroll 1
        for (int it = F.tid; it < n; it += NTHR) { const unsigned e = LISTS[(size_t)bh * LIST_CAP + list_off(j) + it]; const int t = (int)(e >> 2), r = (int)(e & 3u); const size_t m = (size_t)b * SEQ + t;
            float q[64], o[64];
#pragma unroll
            for (int c = 0; c < 8; ++c) unpack8(*(const GAS v4u*)(QM + m * 512 + h * 64 + c * 8), q + c * 8);
#pragma unroll
            for (int d = 0; d < 64; ++d) o[d] = 0.f;
            const float ref = REFS[m * 8 + h]; float l = 0.f; const int dbase = t - j * 256;
#pragma unroll 1
            for (int key = 0; key < 256; ++key) { float s = 0.f; const f32x4* kr = (const f32x4*)(Ks + key * 64); const f32x4* vr = (const f32x4*)(Vs + key * 64);
#pragma unroll
                for (int c = 0; c < 16; ++c) { const f32x4 kk = kr[c]; s += q[4 * c] * kk.x + q[4 * c + 1] * kk.y + q[4 * c + 2] * kk.z + q[4 * c + 3] * kk.w; }
                const int dist = dbase - key; s += tab[dist < 127 ? dist : 127];
                const float p = __expf(s - ref); l += p;
#pragma unroll
                for (int c = 0; c < 16; ++c) { const f32x4 vv = vr[c]; o[4 * c] += p * vv.x; o[4 * c + 1] += p * vv.y; o[4 * c + 2] += p * vv.z; o[4 * c + 3] += p * vv.w; } }
            const size_t pi = (m * 8 + h) * 3 + r; PARTL[pi] = l;
#pragma unroll
            for (int c = 0; c < 8; ++c) *(GAS v4u*)(PARTO + pi * 64 + c * 8) = pack8f(o + c * 8); }
        __syncthreads();
    }
}
__device__ __forceinline__ void moba_own_phase(Frame& F, const Args& A) {
    float* Ks = (float*)(F.ldsg + RING_OFF); float* Vs = Ks + 256 * 64; float* tab = (float*)(F.ldsg + TBL_TAB);
    bf16* QM = (bf16*)(F.ws + WS_QM); const float* REFS = (const float*)(F.ws + WS_REFS); const unsigned* SEL = (const unsigned*)(F.ws + WS_SEL);
    const bf16* PARTO = (const bf16*)(F.ws + WS_PARTO); const float* PARTL = (const float*)(F.ws + WS_PARTL);
#pragma unroll 1
    for (int u = blockIdx.x; u < 1024; u += F.G) { const int bh = u >> 5, qb = u & 31, b = bh >> 3, h = bh & 7;
        moba_load_kv(F, A, b, h, qb, Ks, Vs, tab);
        __syncthreads();
        { const int qi = F.tid >> 1, half = F.tid & 1; const size_t m = (size_t)b * SEQ + qb * 256 + qi; float q[64], o[64];
#pragma unroll
            for (int c = 0; c < 8; ++c) unpack8(*(const GAS v4u*)(QM + m * 512 + h * 64 + c * 8), q + c * 8);
#pragma unroll
            for (int d = 0; d < 64; ++d) o[d] = 0.f;
            const float ref = REFS[m * 8 + h]; float l = 0.f;
#pragma unroll 1
            for (int key = half; key <= qi; key += 2) { float s = 0.f; const f32x4* kr = (const f32x4*)(Ks + key * 64); const f32x4* vr = (const f32x4*)(Vs + key * 64);
#pragma unroll
                for (int c = 0; c < 16; ++c) { const f32x4 kk = kr[c]; s += q[4 * c] * kk.x + q[4 * c + 1] * kk.y + q[4 * c + 2] * kk.z + q[4 * c + 3] * kk.w; }
                const int dist = qi - key; s += tab[dist < 127 ? dist : 127];
                const float p = __expf(s - ref); l += p;
#pragma unroll
                for (int c = 0; c < 16; ++c) { const f32x4 vv = vr[c]; o[4 * c] += p * vv.x; o[4 * c + 1] += p * vv.y; o[4 * c + 2] += p * vv.z; o[4 * c + 3] += p * vv.w; } }
            l += __shfl_xor(l, 1);
#pragma unroll
            for (int d = 0; d < 64; ++d) o[d] += __shfl_xor(o[d], 1);
            const unsigned sel = SEL[m * 8 + h]; const int nsel = (int)(sel >> 15);
#pragma unroll 1
            for (int r = 0; r < nsel; ++r) { const size_t pi = (m * 8 + h) * 3 + r; l += PARTL[pi];
#pragma unroll
                for (int c = 0; c < 8; ++c) { float f[8]; unpack8(*(const GAS v4u*)(PARTO + pi * 64 + c * 8), f);
#pragma unroll
                    for (int e = 0; e < 8; ++e) o[c * 8 + e] += f[e]; } }
            const float il = 1.f / l;
#pragma unroll
            for (int d = 0; d < 64; ++d) o[d] *= il;
            if (half == 0) {
#pragma unroll
                for (int c = 0; c < 4; ++c) *(GAS v4u*)(QM + m * 512 + h * 64 + c * 8) = pack8f(o + c * 8); }
            else {
#pragma unroll
                for (int c = 4; c < 8; ++c) *(GAS v4u*)(QM + m * 512 + h * 64 + c * 8) = pack8f(o + c * 8); } }
        __syncthreads();
    }
}

__device__ __forceinline__ void memattn_phase(Frame& F) {
    bf16* Ks = (bf16*)(F.ldsg + RING_OFF); bf16* Vs = Ks + 256 * 128;
    bf16* QC = (bf16*)(F.ws + WS_QC); const bf16* MKV = (const bf16*)(F.ws + WS_MKV);
#pragma unroll 1
    for (int u = blockIdx.x; u < 512; u += F.G) { const int qt = u & 31, bhd = u >> 5, b = bhd >> 2, hd = bhd & 3;
#pragma unroll 1
        for (int i = F.tid; i < 4096; i += NTHR) { const int key = i >> 4, c = i & 15; const bf16* src = MKV + (size_t)(b * 256 + key) * 1024 + hd * 128 + c * 8;
            *(v4u*)(Ks + key * 128 + c * 8) = *(const GAS v4u*)src; *(v4u*)(Vs + key * 128 + c * 8) = *(const GAS v4u*)(src + 512); }
        __syncthreads();
        { const int qi = F.tid >> 1, half = F.tid & 1; const size_t m = (size_t)b * SEQ + qt * 256 + qi; bf16* qp = QC + m * 512 + hd * 128 + half * 64; float q[64], o[64];
#pragma unroll
            for (int c = 0; c < 8; ++c) unpack8(*(const GAS v4u*)(qp + c * 8), q + c * 8);
#pragma unroll
            for (int d = 0; d < 64; ++d) o[d] = 0.f;
            float mx = -INFINITY, l = 0.f;
#pragma unroll 1
            for (int key = 0; key < 256; ++key) { float s = 0.f; const v4u* kr = (const v4u*)(Ks + key * 128 + half * 64); const v4u* vr = (const v4u*)(Vs + key * 128 + half * 64);
#pragma unroll
                for (int c = 0; c < 8; ++c) { float f[8]; unpack8(kr[c], f);
#pragma unroll
                    for (int e = 0; e < 8; ++e) s += q[c * 8 + e] * f[e]; }
                s += __shfl_xor(s, 1);
                if (s > mx) { const float cr = __expf(mx - s); l *= cr;
#pragma unroll
                    for (int d = 0; d < 64; ++d) o[d] *= cr;
                    mx = s; }
                const float p = __expf(s - mx); l += p;
#pragma unroll
                for (int c = 0; c < 8; ++c) { float f[8]; unpack8(vr[c], f);
#pragma unroll
                    for (int e = 0; e < 8; ++e) o[c * 8 + e] += p * f[e]; } }
            const float il = 1.f / l;
#pragma unroll
            for (int d = 0; d < 64; ++d) o[d] *= il;
#pragma unroll
            for (int c = 0; c < 8; ++c) *(GAS v4u*)(qp + c * 8) = pack8f(o + c * 8); }
        __syncthreads();
    }
}

template <bool SPLIT> __device__ __forceinline__ void rownorm_phase(Frame& F, bf16* dst, float* rstd) {
    const int gw = F.vcu * NWAVES + F.wave, NGW = F.G * NWAVES; constexpr int LD = SPLIT ? 2048 : 1024;
    for (int m = gw; m < M; m += NGW) { const GAS f32x4* xr = (const GAS f32x4*)(F.out + (size_t)m * D) + F.lane; f32x4 v[4]; float s = 0.f;
#pragma unroll
        for (int j = 0; j < 4; ++j) { v[j] = xr[64 * j]; s += (v[j].x * v[j].x + v[j].y * v[j].y) + (v[j].z * v[j].z + v[j].w * v[j].w); }
        s = wave_sum(s); if (F.lane == 0) rstd[m] = rsqrtf(s * (1.f / D) + EPS);
        GAS unsigned long long* o8 = (GAS unsigned long long*)(dst + (size_t)m * LD) + F.lane;
#pragma unroll
        for (int j = 0; j < 4; ++j) { const unsigned h0 = f2bf(v[j].x), h1 = f2bf(v[j].y), h2 = f2bf(v[j].z), h3 = f2bf(v[j].w);
            o8[64 * j] = (unsigned long long)(h0 | (h1 << 16)) | ((unsigned long long)(h2 | (h3 << 16)) << 32);
            if (SPLIT) o8[256 + 64 * j] = (unsigned long long)pk2(v[j].x - __uint_as_float(h0 << 16), v[j].y - __uint_as_float(h1 << 16)) | ((unsigned long long)pk2(v[j].z - __uint_as_float(h2 << 16), v[j].w - __uint_as_float(h3 << 16)) << 32); } }
}
__device__ __forceinline__ void route_phase(Frame& F, const Args& A) {
    const float* LG = (const float*)(F.ws + WS_LG); const float* rstd2 = (const float*)(F.ws + WS_RSTD2); const float* brg = A.in[18]; const float* bre = A.in[20];
    int* ME = (int*)(F.ws + WS_MOE_E); int* MP = (int*)(F.ws + WS_MOE_POS); float* MW = (float*)(F.ws + WS_MOE_W);
    for (int m = blockIdx.x * NTHR + F.tid; m < M; m += F.G * NTHR) { const float rs = rstd2[m]; const float* lg = LG + (size_t)m * 72;
        float gl[4]; int grp = 0; float gmx = -INFINITY;
#pragma unroll
        for (int o = 0; o < 4; ++o) { gl[o] = (lg[o] + lg[36 + o]) * rs + brg[o]; if (gl[o] > gmx) { gmx = gl[o]; grp = o; } }
        float gs = 0.f;
#pragma unroll
        for (int o = 0; o < 4; ++o) gs += __expf(gl[o] - gmx);
        const float pg = 1.f / gs;
        float el[8]; float emx = -INFINITY;
#pragma unroll
        for (int i = 0; i < 8; ++i) { el[i] = (lg[4 + grp * 8 + i] + lg[40 + grp * 8 + i]) * rs + bre[grp * 8 + i]; emx = fmaxf(emx, el[i]); }
        float p0 = -1.f, p1 = -1.f; int i0 = 0, i1 = 0;
#pragma unroll
        for (int i = 0; i < 8; ++i) { const float p = __expf(el[i] - emx); if (p > p0) { p1 = p0; i1 = i0; p0 = p; i0 = i; } else if (p > p1) { p1 = p; i1 = i; } }
        const float inv = pg / (p0 + p1);
        const int e0 = grp * 8 + i0, e1 = grp * 8 + i1;
        const unsigned q0 = atomicAdd((unsigned*)(F.ctl + CW_ECNT) + e0, 1u), q1 = atomicAdd((unsigned*)(F.ctl + CW_ECNT) + e1, 1u);
        ME[m * 2] = e0; ME[m * 2 + 1] = e1; MP[m * 2] = (int)q0; MP[m * 2 + 1] = (int)q1; MW[m * 2] = p0 * inv; MW[m * 2 + 1] = p1 * inv; }
}
__device__ __forceinline__ int moe_bases(Frame& F) {
    volatile int* eb = (volatile int*)(F.ldsg + TBL_EB); volatile int* tl = (volatile int*)(F.ldsg + TBL_TILE);
    if (F.tid == 0) { int base = 0;
        for (int e = 0; e < 32; ++e) { const int c = (int)__hip_atomic_load((unsigned*)(F.ctl + CW_ECNT) + e, RLX_AGENT); eb[e] = base; const int nt = (c + 255) >> 8; for (int t = 0; t < nt; ++t) tl[(base >> 8) + t] = e; base += nt << 8; }
        eb[32] = base; }
    __syncthreads();
    return eb[32] >> 8;
}
__device__ __forceinline__ void moe_slot_phase(Frame& F) {
    (void)moe_bases(F);
    volatile int* eb = (volatile int*)(F.ldsg + TBL_EB);
    const int gw = F.vcu * NWAVES + F.wave, NGW = F.G * NWAVES;
    const int* ME = (const int*)(F.ws + WS_MOE_E); const int* MP = (const int*)(F.ws + WS_MOE_POS); const float* MW = (const float*)(F.ws + WS_MOE_W); int* SO = (int*)(F.ws + WS_SLOT_OF);
    float* WSL = (float*)(F.ws + WS_W_SLOT); float* RSL = (float*)(F.ws + WS_RSTD_SLOT); const float* rstd2 = (const float*)(F.ws + WS_RSTD2);
    const bf16* X2 = (const bf16*)(F.ws + WS_X2HL); bf16* XG = (bf16*)(F.ws + WS_XG);
    for (int a = gw; a < 2 * M; a += NGW) { const int m = a >> 1; const int slot = eb[ME[a]] + MP[a];
        if (F.lane == 0) { SO[a] = slot; WSL[slot] = MW[a]; RSL[slot] = rstd2[m]; }
        const GAS v4u* s = (const GAS v4u*)(X2 + (size_t)m * 2048) + F.lane; GAS v4u* d = (GAS v4u*)(XG + (size_t)slot * 1024) + F.lane;
        d[0] = s[0]; d[64] = s[64]; }
}
__device__ __forceinline__ void final_phase(Frame& F, const Args& A) {
    const int gw = F.vcu * NWAVES + F.wave, NGW = F.G * NWAVES; const int* SO = (const int*)(F.ws + WS_SLOT_OF); const bf16* Y = (const bf16*)(F.ws + WS_XG); const float* gf = A.in[24];
    for (int m = gw; m < M; m += NGW) { const int s0 = SO[m * 2], s1 = SO[m * 2 + 1];
        GAS f32x4* xr = (GAS f32x4*)(F.out + (size_t)m * D) + F.lane; const GAS unsigned long long* y0 = (const GAS unsigned long long*)(Y + (size_t)s0 * 1024) + F.lane; const GAS unsigned long long* y1 = (const GAS unsigned long long*)(Y + (size_t)s1 * 1024) + F.lane;
        f32x4 v[4]; float s = 0.f;
#pragma unroll
        for (int j = 0; j < 4; ++j) { v[j] = xr[64 * j]; const unsigned long long a = y0[64 * j], c = y1[64 * j];
            v[j].x += bflo((unsigned)a) + bflo((unsigned)c); v[j].y += bfhi((unsigned)a) + bfhi((unsigned)c); v[j].z += bflo((unsigned)(a >> 32)) + bflo((unsigned)(c >> 32)); v[j].w += bfhi((unsigned)(a >> 32)) + bfhi((unsigned)(c >> 32));
            s += (v[j].x * v[j].x + v[j].y * v[j].y) + (v[j].z * v[j].z + v[j].w * v[j].w); }
        s = wave_sum(s); const float rs = rsqrtf(s * (1.f / D) + EPS); const GAS f32x4* gr = (const GAS f32x4*)gf + F.lane;
#pragma unroll
        for (int j = 0; j < 4; ++j) { const f32x4 g = gr[64 * j]; xr[64 * j] = (f32x4){v[j].x * rs * g.x, v[j].y * rs * g.y, v[j].z * rs * g.z, v[j].w * rs * g.w}; } }
}

__global__ void __launch_bounds__(NWAVES * 64, 2) fwd_kernel(Args args) {
    extern __shared__ __attribute__((aligned(16))) unsigned char lds[];
    Frame F;
    F.lds = (LAS unsigned char*)lds; F.ldsg = lds;
    F.MISC = (volatile LAS unsigned*)(F.lds + MISC_OFF);
    F.tid = threadIdx.x; F.lane = F.tid & 63; F.wave = __builtin_amdgcn_readfirstlane(F.tid >> 6);
    F.G = gridDim.x; { const int bx = blockIdx.x; F.vcu = (F.G % 8 == 0) ? (bx % 8) * (F.G / 8) + bx / 8 : bx; }
    F.ws = args.ws; F.out = args.out; F.ctl = (gu32*)(args.ws + WS_CTL);
    for (int u = F.tid; u < (LDS_BYTES - LDSCTL_OFF) / 4; u += NWAVES * 64) ((LAS unsigned*)(F.lds + LDSCTL_OFF))[u] = 0u;
    __syncthreads();
#if MK_ONE_LAUNCH
    XcdBarrier bar = xcd_barrier_post((unsigned*)(F.ctl + CW_BAR), F.MISC + 8);
#define GRID_BAR() xcd_barrier(bar)
#else
#define GRID_BAR() do { if (F.tid == 0) __hip_atomic_store(F.ctl + CW_TMO, 0xBADBA0u, RLX_AGENT); } while (0)
#endif
    const int lo = args.ph_lo, hi = args.ph_hi;
#define IN(k) (lo <= (k) && (k) < hi)
#define SEAM(k) do { if (IN(k) && IN((k) + 1)) GRID_BAR(); } while (0)
    unsigned char* ws = args.ws;
    bf16* XB = (bf16*)(ws + WS_XB);
    const float* rstd0 = (const float*)(ws + WS_RSTD0);

    if (IN(0)) { p0_prologue(F, args); } SEAM(0);
    if (IN(1)) {
        { pg8::Gemm g{XB, (const bf16*)(ws + WS_W1T), M, 2304, 1024}; pg8::StaticOrder S; S.init(M, 2304, F.G, (int)blockIdx.x);
          pg8::EpiInProj E{(bf16*)(ws + WS_QG), (bf16*)(ws + WS_KG), (bf16*)(ws + WS_SR), (bf16*)(ws + WS_QM), (bf16*)(ws + WS_KM), (float*)((unsigned char*)args.out + DO_LA), rstd0, args.in[7]};
          pg8::gemm_phase<pg8::EpiInProj, pg8::StaticOrder, true, true>(F.lds + RING_OFF, g, S, E); }
        { pg8::Gemm g{(const bf16*)(ws + WS_WVT), XB, 1024, M, 1024}; pg8::StaticOrder S; S.init(1024, M, F.G, (int)blockIdx.x);
          pg8::EpiVT E{(bf16*)(ws + WS_VT), M, rstd0};
          pg8::gemm_phase<pg8::EpiVT, pg8::StaticOrder, true, true>(F.lds + RING_OFF, g, S, E); }
        { pg8::Gemm g{(const bf16*)(ws + WS_MEMN), (const bf16*)(ws + WS_WCKVT), 1024, 1024, 1024}; pg8::StaticOrder S; S.init(1024, 1024, F.G, (int)blockIdx.x);
          pg8::EpiRowBf16<0> E{(bf16*)(ws + WS_MKV), 1024, nullptr, 1.f};
          pg8::gemm_phase<pg8::EpiRowBf16<0>, pg8::StaticOrder, true, true>(F.lds + RING_OFF, g, S, E); }
    } SEAM(1);
    if (IN(2)) { gla_a_phase(F); moba_kmean_phase(F); } SEAM(2);
    if (IN(3)) { gla_scan_phase(F); moba_gate_phase(F, args); } SEAM(3);
    if (IN(4)) { gla_b_phase(F, args); moba_part_phase(F, args); } SEAM(4);
    if (IN(5)) { moba_own_phase(F, args); } SEAM(5);
    if (IN(6)) {
        { pg8::Gemm g{XB, (const bf16*)(ws + WS_WZT), M, 2048, 1024}; pg8::StaticOrder S; S.init(M, 2048, F.G, (int)blockIdx.x);
          pg8::EpiRowBf16<2> E{(bf16*)(ws + WS_SZ), 2048, rstd0, 1.f};
          pg8::gemm_phase<pg8::EpiRowBf16<2>, pg8::StaticOrder, true, true>(F.lds + RING_OFF, g, S, E); }
        { pg8::Gemm g{(const bf16*)(ws + WS_OG), (const bf16*)(ws + WS_PGT), M, 1024, 512}; pg8::StaticOrder S; S.init(M, 1024, F.G, (int)blockIdx.x);
          pg8::EpiRowBf16<0> E{(bf16*)(ws + WS_T1), 1024, nullptr, 1.f};
          pg8::gemm_phase<pg8::EpiRowBf16<0>, pg8::StaticOrder, true, true>(F.lds + RING_OFF, g, S, E); }
    } SEAM(6);
    if (IN(7)) { pg8::Gemm g{(const bf16*)(ws + WS_QM), (const bf16*)(ws + WS_PMT), M, 1024, 512}; pg8::StaticOrder S; S.init(M, 1024, F.G, (int)blockIdx.x);
        pg8::EpiMerge E{(bf16*)(ws + WS_MG), (const bf16*)(ws + WS_SZ), (const bf16*)(ws + WS_T1)};
        pg8::gemm_phase<pg8::EpiMerge, pg8::StaticOrder, true, true>(F.lds + RING_OFF, g, S, E); } SEAM(7);
    if (IN(8)) { pg8::Gemm g{(const bf16*)(ws + WS_MG), (const bf16*)(ws + WS_WOUTT), M, 1024, 1024}; pg8::StaticOrder S; S.init(M, 1024, F.G, (int)blockIdx.x);
        pg8::EpiResF32 E{args.in[0], args.out};
        pg8::gemm_phase<pg8::EpiResF32, pg8::StaticOrder, true, true>(F.lds + RING_OFF, g, S, E); } SEAM(8);
    if (IN(9)) { rownorm_phase<false>(F, (bf16*)(ws + WS_X1B), (float*)(ws + WS_RSTD1)); } SEAM(9);
    if (IN(10)) { pg8::Gemm g{(const bf16*)(ws + WS_X1B), (const bf16*)(ws + WS_WCQT), M, 512, 1024}; pg8::StaticOrder S; S.init(M, 512, F.G, (int)blockIdx.x);
        pg8::EpiRowBf16<0> E{(bf16*)(ws + WS_QC), 512, (const float*)(ws + WS_RSTD1), 0.08838834764831845f};
        pg8::gemm_phase<pg8::EpiRowBf16<0>, pg8::StaticOrder, true, true>(F.lds + RING_OFF, g, S, E); } SEAM(10);
    if (IN(11)) { memattn_phase(F); } SEAM(11);
    if (IN(12)) { pg8::Gemm g{(const bf16*)(ws + WS_QC), (const bf16*)(ws + WS_WCOT), M, 1024, 512}; pg8::StaticOrder S; S.init(M, 1024, F.G, (int)blockIdx.x);
        pg8::EpiResF32 E{args.out, args.out};
        pg8::gemm_phase<pg8::EpiResF32, pg8::StaticOrder, true, true>(F.lds + RING_OFF, g, S, E); } SEAM(12);
    if (IN(13)) { rownorm_phase<true>(F, (bf16*)(ws + WS_X2HL), (float*)(ws + WS_RSTD2)); expert_weights(F, args); } SEAM(13);
    if (IN(14)) { pg8::Gemm g{(const bf16*)(ws + WS_X2HL), (const bf16*)(ws + WS_WRT), M, 256, 2048}; pg8::StaticOrder S; S.init(M, 256, F.G, (int)blockIdx.x);
        pg8::EpiLogits E{(float*)(ws + WS_LG)};
        pg8::gemm_phase<pg8::EpiLogits, pg8::StaticOrder, true, true>(F.lds + RING_OFF, g, S, E); } SEAM(14);
    if (IN(15)) { route_phase(F, args); } SEAM(15);
    if (IN(16)) { moe_slot_phase(F); } SEAM(16);
    if (IN(17)) { const int ntile = moe_bases(F);
        pg8::Gemm g{(const bf16*)(ws + WS_XG), (const bf16*)(ws + WS_WGUT), MOE_CAP, 32 * 1024, 1024}; pg8::MoeOrder S{(const LAS int*)(F.lds + TBL_TILE), ntile, F.G, (int)blockIdx.x};
        pg8::EpiMoe1 E{(bf16*)(ws + WS_HID), (const float*)(ws + WS_RSTD_SLOT)};
        pg8::gemm_phase<pg8::EpiMoe1, pg8::MoeOrder, true, true>(F.lds + RING_OFF, g, S, E); } SEAM(17);
    if (IN(18)) { const int ntile = moe_bases(F);
        pg8::Gemm g{(const bf16*)(ws + WS_HID), (const bf16*)(ws + WS_WDT), MOE_CAP, 32 * 1024, 512}; pg8::MoeOrder S{(const LAS int*)(F.lds + TBL_TILE), ntile, F.G, (int)blockIdx.x};
        pg8::EpiMoe2 E{(bf16*)(ws + WS_XG), (const float*)(ws + WS_W_SLOT)};
        pg8::gemm_phase<pg8::EpiMoe2, pg8::MoeOrder, true, true>(F.lds + RING_OFF, g, S, E); } SEAM(18);
    if (IN(19)) { final_phase(F, args); }
#undef IN
#undef SEAM
}

extern "C" void kernel_launch(void* const* d_in, const int* in_sizes, int n_in, void* d_out, int out_size, void* d_ws, size_t ws_size, hipStream_t stream) {
    static int grid = 0;
    if (grid == 0) {
        if (n_in != 25 || in_sizes[0] != M * D || out_size != M * D || ws_size < WS_END) { fprintf(stderr, "kernel_launch: unexpected shapes (n_in %d in0 %d out %d ws %zu)\n", n_in, n_in > 0 ? in_sizes[0] : -1, out_size, ws_size); grid = -1; return; }
        int dev = 0, cus = 0, per_cu = 0;
        if (hipGetDevice(&dev) != hipSuccess || hipDeviceGetAttribute(&cus, hipDeviceAttributeMultiprocessorCount, dev) != hipSuccess) { grid = -1; return; }
        if (hipFuncSetAttribute((const void*)fwd_kernel, hipFuncAttributeMaxDynamicSharedMemorySize, LDS_BYTES) != hipSuccess) { fprintf(stderr, "kernel_launch: hipFuncSetAttribute failed\n"); grid = -1; return; }
        if (hipOccupancyMaxActiveBlocksPerMultiprocessor(&per_cu, (const void*)fwd_kernel, NWAVES * 64, LDS_BYTES) != hipSuccess || per_cu < 1) fprintf(stderr, "kernel_launch: occupancy query reports %d\n", per_cu);
        (void)hipGetLastError();
        grid = cus;
    }
    if (grid < 0) return;
    if (hipMemsetAsync((char*)d_ws + WS_CTL, 0, CTL_ZERO_BYTES, stream) != hipSuccess) return;
    Args a{};
    for (int i = 0; i < 25; ++i) a.in[i] = (const float*)d_in[i];
    a.out = (float*)d_out; a.ws = (unsigned char*)d_ws;
#if MK_ONE_LAUNCH
    a.ph_lo = 0; a.ph_hi = NPHASE;
    hipLaunchKernelGGL(fwd_kernel, dim3(grid), dim3(NWAVES * 64), LDS_BYTES, stream, a);
#else
    for (int p = 0; p < NPHASE; ++p) { a.ph_lo = p; a.ph_hi = p + 1; hipLaunchKernelGGL(fwd_kernel, dim3(grid), dim3(NWAVES * 64), LDS_BYTES, stream, a); }
#endif
}
```

```cpp
#include <hip/hip_runtime.h>
#include <cstdio>
#include <cstdint>
#define MK_ONE_LAUNCH 1
namespace pg8 {
#define PG8_LAS __attribute__((address_space(3)))
typedef unsigned short bf16_t;
typedef short bf16x8 __attribute__((ext_vector_type(8)));
typedef float f32x4 __attribute__((ext_vector_type(4)));
typedef unsigned u32x4 __attribute__((ext_vector_type(4)));
constexpr int BM = 256, BK = 64, HALF = 128, HTB = HALF * BK * 2  , STAGE_BYTES = 8 * HTB, NXCD = 8, WGM = 8;

__host__ __device__ __forceinline__ int lds_byte(int r, int c) { const int st = (r >> 4) * 2 + (c >> 5), rr = r & 15, cc = c & 31, ob = rr * 64 + cc * 2; return st * 1024 + (ob ^ (((ob >> 9) & 1) << 5)); }
__host__ __device__ __forceinline__ void stage_rc(int b, int& R, int& C) { const int st = b / 1024, sb = b % 1024, swz = sb ^ (((sb >> 9) & 1) << 5); R = (st >> 1) * 16 + swz / 64; C = (st & 1) * 32 + (swz % 64) / 2; }
__host__ __device__ __forceinline__ int perm32(int rho) { const int n = rho >> 4, i = rho & 15; return 8 * (i >> 2) + 4 * n + (i & 3); }

struct Unit { int pm, pn, lm, ln, ty; };
struct Gemm { const bf16_t* A; const bf16_t* Bt; int M, N, K; };

struct StaticOrder {
    static constexpr bool GATHER = false;
    int nM, nN, nwg, G, c;
    __host__ __device__ void init(int M, int N, int G_, int c_) { nM = M / BM; nN = N / BM; nwg = nM * nN; G = G_; c = c_; }
    __host__ __device__ bool next(int i, Unit& u) const {
        const long L = (long)i * G + c; if (L >= nwg) return false;
        int wgid = (int)L; { const int q = nwg / NXCD, r = nwg % NXCD, xcd = wgid % NXCD, off = wgid / NXCD; wgid = (xcd < r ? xcd * (q + 1) : r * (q + 1) + (xcd - r) * q) + off; }
        const int nig = WGM * nN, gid = wgid / nig, fm = gid * WGM, gsz = (nM - fm) < WGM ? (nM - fm) : WGM;
        u.pm = fm + ((wgid % nig) % gsz); u.pn = (wgid % nig) / gsz; u.lm = u.pm; u.ln = u.pn; u.ty = 0; return true;
    }
    __device__ __forceinline__ void a_ready(const Unit&) const {}
    __device__ __forceinline__ void done(const Unit&) const {}
};

__device__ __forceinline__ unsigned cvt_pk_bf16(float lo, float hi) { unsigned r; asm volatile("v_cvt_pk_bf16_f32 %0, %1, %2" : "=v"(r) : "v"(lo), "v"(hi)); return r; }
typedef float f32x2 __attribute__((ext_vector_type(2)));
__device__ __forceinline__ float bf2f(unsigned short h) { return __uint_as_float(((unsigned)h) << 16); }
__device__ __forceinline__ float bflo(unsigned w) { return __uint_as_float(w << 16); }
__device__ __forceinline__ float bfhi(unsigned w) { return __uint_as_float(w & 0xffff0000u); }
__device__ __forceinline__ float sigmoid_f(float x) { return __builtin_amdgcn_rcpf(1.0f + __builtin_amdgcn_exp2f(-1.4426950408889634f * x)); }
__device__ __forceinline__ float silu_f(float x) { return x * __builtin_amdgcn_rcpf(1.0f + __builtin_amdgcn_exp2f(-1.4426950408889634f * x)); }
__device__ __forceinline__ float logsigmoid_f(float x) { return fminf(x, 0.f) - 0.6931471805599453f * __builtin_amdgcn_logf(1.0f + __builtin_amdgcn_exp2f(-1.4426950408889634f * fabsf(x))); }
__device__ __forceinline__ u32x4 pack8(const f32x4 v0, const f32x4 v1) { u32x4 w; w.x = cvt_pk_bf16(v0[0], v0[1]); w.y = cvt_pk_bf16(v0[2], v0[3]); w.z = cvt_pk_bf16(v1[0], v1[1]); w.w = cvt_pk_bf16(v1[2], v1[3]); return w; }

struct EpiInProj {
    static constexpr bool PERM = true, AFTER_DRAIN = false, MIDK = false;
    bf16_t *QG, *KG, *SR, *QM, *KM, *SZ; float* LA; const float* rstd; const float* b_alpha;
    __device__ __forceinline__ void operator()(const f32x4 (&acc)[2][2][4][2], const Unit& u, int wr, int wc, int fr, int fq) const {
        const int pn = u.ln; bf16_t* dst; int ldc, cbase, mode = 0; float sc = 1.f;
        if (pn == 0) { dst = QG; ldc = 256; cbase = 0; sc = 0.125f; }
        else if (pn == 1) { dst = KG; ldc = 256; cbase = 0; }
        else if (pn <= 3) { dst = SR; ldc = 512; cbase = (pn - 2) * 256; mode = 1; }
        else if (pn == 4) { dst = nullptr; ldc = 256; cbase = 0; mode = 3; }
        else if (pn <= 6) { dst = QM; ldc = 512; cbase = (pn - 5) * 256; sc = 0.125f * 1.4426950408889634f; }
        else if (pn <= 8) { dst = KM; ldc = 512; cbase = (pn - 7) * 256; }
        else { dst = SZ; ldc = 2048; cbase = (pn - 9) * 256; mode = 2; }
        const int row0 = u.lm * BM + wr * 64 + fr, col0 = cbase + wc * 32 + 8 * fq;
#pragma unroll
        for (int ai = 0; ai < 2; ++ai)
#pragma unroll
            for (int m = 0; m < 4; ++m) { const int row = row0 + ai * HALF + m * 16; const float rs = sc;
#pragma unroll
                for (int bj = 0; bj < 2; ++bj) { f32x4 v0 = acc[ai][bj][m][0] * rs, v1 = acc[ai][bj][m][1] * rs; const int col = col0 + bj * HALF;
                    if (mode == 3) { const f32x4 b0 = *(const f32x4*)(b_alpha + col), b1 = *(const f32x4*)(b_alpha + col + 4);
#pragma unroll
                        for (int e = 0; e < 4; ++e) { v0[e] = logsigmoid_f(v0[e] + b0[e]) * 0.0625f; v1[e] = logsigmoid_f(v1[e] + b1[e]) * 0.0625f; }
                        float* o = LA + (size_t)row * 256 + col; *(f32x4*)o = v0; *(f32x4*)(o + 4) = v1; }
                    else { if (mode == 1) {
#pragma unroll
                            for (int e = 0; e < 4; ++e) { v0[e] = silu_f(v0[e]); v1[e] = silu_f(v1[e]); } }
                        else if (mode == 2) {
#pragma unroll
                            for (int e = 0; e < 4; ++e) { v0[e] = sigmoid_f(v0[e]); v1[e] = sigmoid_f(v1[e]); } }
                        *(u32x4*)(dst + (size_t)row * ldc + col) = pack8(v0, v1); } } }
    }
};
struct EpiVT {
    static constexpr bool PERM = true, AFTER_DRAIN = false, MIDK = false;
    bf16_t* VT; int ldc; const float* rstd;
    __device__ __forceinline__ void operator()(const f32x4 (&acc)[2][2][4][2], const Unit& u, int wr, int wc, int fr, int fq) const {
        const int row0 = u.lm * BM + wr * 64 + fr, col0 = u.ln * BM + wc * 32 + 8 * fq;
#pragma unroll
        for (int ai = 0; ai < 2; ++ai)
#pragma unroll
            for (int m = 0; m < 4; ++m) { const int row = row0 + ai * HALF + m * 16;
#pragma unroll
                for (int bj = 0; bj < 2; ++bj) *(u32x4*)(VT + (size_t)row * ldc + col0 + bj * HALF) = pack8(acc[ai][bj][m][0], acc[ai][bj][m][1]); }
    }
};
template <int ACT> struct EpiRowBf16 {
    static constexpr bool PERM = true, AFTER_DRAIN = false, MIDK = false;
    bf16_t* O; int ldc; const float* rowscale; float sc;
    __device__ __forceinline__ void operator()(const f32x4 (&acc)[2][2][4][2], const Unit& u, int wr, int wc, int fr, int fq) const {
        const int row0 = u.lm * BM + wr * 64 + fr, col0 = u.ln * BM + wc * 32 + 8 * fq;
#pragma unroll
        for (int ai = 0; ai < 2; ++ai)
#pragma unroll
            for (int m = 0; m < 4; ++m) { const int row = row0 + ai * HALF + m * 16; const float rs = (rowscale ? rowscale[row] : 1.f) * sc;
#pragma unroll
                for (int bj = 0; bj < 2; ++bj) { f32x4 v0 = acc[ai][bj][m][0] * rs, v1 = acc[ai][bj][m][1] * rs;
                    if (ACT == 2) {
#pragma unroll
                        for (int e = 0; e < 4; ++e) { v0[e] = sigmoid_f(v0[e]); v1[e] = sigmoid_f(v1[e]); } }
                    *(u32x4*)(O + (size_t)row * ldc + col0 + bj * HALF) = pack8(v0, v1); } }
    }
};
struct EpiMerge {
    static constexpr bool PERM = true, AFTER_DRAIN = false, MIDK = false;
    bf16_t* O; const bf16_t* SZ; const bf16_t* T1;
    __device__ __forceinline__ void operator()(const f32x4 (&acc)[2][2][4][2], const Unit& u, int wr, int wc, int fr, int fq) const {
        const int row0 = u.lm * BM + wr * 64 + fr, col0 = u.ln * BM + wc * 32 + 8 * fq;
#pragma unroll
        for (int ai = 0; ai < 2; ++ai)
#pragma unroll
            for (int m = 0; m < 4; ++m) { const int row = row0 + ai * HALF + m * 16;
#pragma unroll
                for (int bj = 0; bj < 2; ++bj) { const int col = col0 + bj * HALF;
                    const u32x4 g = *(const u32x4*)(SZ + (size_t)row * 2048 + col), z = *(const u32x4*)(SZ + (size_t)row * 2048 + 1024 + col), t = *(const u32x4*)(T1 + (size_t)row * 1024 + col);
                    const f32x4 a0 = acc[ai][bj][m][0], a1 = acc[ai][bj][m][1]; f32x4 v0, v1;
                    v0[0] = bflo(g.x) * bflo(t.x) + bflo(z.x) * a0[0]; v0[1] = bfhi(g.x) * bfhi(t.x) + bfhi(z.x) * a0[1];
                    v0[2] = bflo(g.y) * bflo(t.y) + bflo(z.y) * a0[2]; v0[3] = bfhi(g.y) * bfhi(t.y) + bfhi(z.y) * a0[3];
                    v1[0] = bflo(g.z) * bflo(t.z) + bflo(z.z) * a1[0]; v1[1] = bfhi(g.z) * bfhi(t.z) + bfhi(z.z) * a1[1];
                    v1[2] = bflo(g.w) * bflo(t.w) + bflo(z.w) * a1[2]; v1[3] = bfhi(g.w) * bfhi(t.w) + bfhi(z.w) * a1[3];
                    *(u32x4*)(O + (size_t)row * 1024 + col) = pack8(v0, v1); } }
    }
};
struct EpiResF32 {
    static constexpr bool PERM = false, AFTER_DRAIN = false, MIDK = false;
    const float* base; float* out;
    __device__ __forceinline__ void operator()(const f32x4 (&acc)[2][2][4][2], const Unit& u, int wr, int wc, int fr, int fq) const {
        const int row0 = u.lm * BM + wr * 64 + fr, col0 = u.ln * BM + wc * 32 + 4 * fq;
#pragma unroll
        for (int ai = 0; ai < 2; ++ai)
#pragma unroll
            for (int m = 0; m < 4; ++m) { const size_t off = (size_t)(row0 + ai * HALF + m * 16) * 1024 + col0;
#pragma unroll
                for (int bj = 0; bj < 2; ++bj)
#pragma unroll
                    for (int n = 0; n < 2; ++n) { const f32x4 b = *(const f32x4*)(base + off + bj * HALF + n * 16); *(f32x4*)(out + off + bj * HALF + n * 16) = b + acc[ai][bj][m][n]; } }
    }
};
template <bool SPLIT> struct EpiResNorm {
    static constexpr bool PERM = true, AFTER_DRAIN = false, MIDK = false;
    const float* base; float* out; bf16_t* H; bf16_t* L; float* SS;
    __device__ __forceinline__ void operator()(const f32x4 (&acc)[2][2][4][2], const Unit& u, int wr, int wc, int fr, int fq) const {
        const int row0 = u.lm * BM + wr * 64 + fr, col0 = u.ln * BM + wc * 32 + 8 * fq;
#pragma unroll
        for (int ai = 0; ai < 2; ++ai)
#pragma unroll
            for (int m = 0; m < 4; ++m) { const int row = row0 + ai * HALF + m * 16; const size_t off = (size_t)row * 1024 + col0; float ss = 0.f;
#pragma unroll
                for (int bj = 0; bj < 2; ++bj) { const f32x4 v0 = *(const f32x4*)(base + off + bj * HALF) + acc[ai][bj][m][0], v1 = *(const f32x4*)(base + off + bj * HALF + 4) + acc[ai][bj][m][1];
                    *(f32x4*)(out + off + bj * HALF) = v0; *(f32x4*)(out + off + bj * HALF + 4) = v1;
                    ss += (v0[0] * v0[0] + v0[1] * v0[1]) + (v0[2] * v0[2] + v0[3] * v0[3]) + (v1[0] * v1[0] + v1[1] * v1[1]) + (v1[2] * v1[2] + v1[3] * v1[3]);
                    const u32x4 h = pack8(v0, v1); *(u32x4*)(H + off + bj * HALF) = h;
                    if (SPLIT) { f32x4 r0, r1; r0[0] = v0[0] - bflo(h.x); r0[1] = v0[1] - bfhi(h.x); r0[2] = v0[2] - bflo(h.y); r0[3] = v0[3] - bfhi(h.y); r1[0] = v1[0] - bflo(h.z); r1[1] = v1[1] - bfhi(h.z); r1[2] = v1[2] - bflo(h.w); r1[3] = v1[3] - bfhi(h.w);
                        *(u32x4*)(L + off + bj * HALF) = pack8(r0, r1); } }
                ss += __shfl_xor(ss, 16); ss += __shfl_xor(ss, 32);
                if (fq == 0) SS[(size_t)row * 16 + u.ln * 4 + wc] = ss; }
    }
};
struct EpiLogits {
    static constexpr bool PERM = false, AFTER_DRAIN = false, MIDK = false;
    float* LG; int ld, ncols;
    __device__ __forceinline__ void operator()(const f32x4 (&acc)[2][2][4][2], const Unit& u, int wr, int wc, int fr, int fq) const {
        const int row0 = u.lm * BM + wr * 64 + fr, col0 = wc * 32 + 4 * fq;
#pragma unroll
        for (int ai = 0; ai < 2; ++ai)
#pragma unroll
            for (int m = 0; m < 4; ++m) { float* o = LG + (size_t)(row0 + ai * HALF + m * 16) * ld;
#pragma unroll
                for (int n = 0; n < 2; ++n) { const int col = col0 + n * 16; if (col < ncols) *(f32x4*)(o + col) = acc[ai][0][m][n]; } }
    }
};
struct EpiMoe1 {
    static constexpr bool PERM = true, AFTER_DRAIN = false, MIDK = false;
    bf16_t* HID; const float* rstd_slot;
    __device__ __forceinline__ void operator()(const f32x4 (&acc)[2][2][4][2], const Unit& u, int wr, int wc, int fr, int fq) const {
        const int row0 = u.lm * BM + wr * 64 + fr, col0 = u.ln * 128 + wc * 32 + 8 * fq;
#pragma unroll
        for (int ai = 0; ai < 2; ++ai)
#pragma unroll
            for (int m = 0; m < 4; ++m) { const int row = row0 + ai * HALF + m * 16; const float rs = rstd_slot[row];
                f32x4 v0, v1;
#pragma unroll
                for (int e = 0; e < 4; ++e) { v0[e] = silu_f(acc[ai][0][m][0][e] * rs) * (acc[ai][1][m][0][e] * rs); v1[e] = silu_f(acc[ai][0][m][1][e] * rs) * (acc[ai][1][m][1][e] * rs); }
                *(u32x4*)(HID + (size_t)row * 512 + col0) = pack8(v0, v1); }
    }
};
struct EpiMoe2 {
    static constexpr bool PERM = true, AFTER_DRAIN = false, MIDK = false;
    bf16_t* Y; const float* w_slot;
    __device__ __forceinline__ void operator()(const f32x4 (&acc)[2][2][4][2], const Unit& u, int wr, int wc, int fr, int fq) const {
        const int row0 = u.lm * BM + wr * 64 + fr, col0 = u.ln * BM + wc * 32 + 8 * fq;
#pragma unroll
        for (int ai = 0; ai < 2; ++ai)
#pragma unroll
            for (int m = 0; m < 4; ++m) { const int row = row0 + ai * HALF + m * 16; const float rs = w_slot[row];
#pragma unroll
                for (int bj = 0; bj < 2; ++bj) *(u32x4*)(Y + (size_t)row * 1024 + col0 + bj * HALF) = pack8(acc[ai][bj][m][0] * rs, acc[ai][bj][m][1] * rs); }
    }
};
struct EpiP1 {
    static constexpr bool PERM = true, AFTER_DRAIN = false, MIDK = false;
    EpiInProj e0; EpiVT e1; EpiRowBf16<0> e2, e3;
    __device__ __forceinline__ void operator()(const f32x4 (&acc)[2][2][4][2], const Unit& u, int wr, int wc, int fr, int fq) const {
        if (u.ty == 0) e0(acc, u, wr, wc, fr, fq); else if (u.ty == 1) e1(acc, u, wr, wc, fr, fq); else if (u.ty == 2) e2(acc, u, wr, wc, fr, fq); else e3(acc, u, wr, wc, fr, fq);
    }
};
struct EpiMerge2 {
    static constexpr bool PERM = true, AFTER_DRAIN = false, MIDK = true;
    bf16_t* O; const bf16_t* SZ;
    __device__ __forceinline__ void mid(f32x4 (&acc)[2][2][4][2], const Unit& u, int wr, int wc, int fr, int fq) const {
        const int row0 = u.lm * BM + wr * 64 + fr, col0 = u.ln * BM + wc * 32 + 8 * fq;
#pragma unroll
        for (int ai = 0; ai < 2; ++ai)
#pragma unroll
            for (int m = 0; m < 4; ++m) { const int row = row0 + ai * HALF + m * 16;
#pragma unroll
                for (int bj = 0; bj < 2; ++bj) { const int col = col0 + bj * HALF; const u32x4 g = *(const u32x4*)(SZ + (size_t)row * 2048 + col), z = *(const u32x4*)(SZ + (size_t)row * 2048 + 1024 + col);
                    f32x4 r0, r1;
                    r0[0] = bflo(g.x) * __builtin_amdgcn_rcpf(fmaxf(bflo(z.x), 1e-30f)); r0[1] = bfhi(g.x) * __builtin_amdgcn_rcpf(fmaxf(bfhi(z.x), 1e-30f)); r0[2] = bflo(g.y) * __builtin_amdgcn_rcpf(fmaxf(bflo(z.y), 1e-30f)); r0[3] = bfhi(g.y) * __builtin_amdgcn_rcpf(fmaxf(bfhi(z.y), 1e-30f));
                    r1[0] = bflo(g.z) * __builtin_amdgcn_rcpf(fmaxf(bflo(z.z), 1e-30f)); r1[1] = bfhi(g.z) * __builtin_amdgcn_rcpf(fmaxf(bfhi(z.z), 1e-30f)); r1[2] = bflo(g.w) * __builtin_amdgcn_rcpf(fmaxf(bflo(z.w), 1e-30f)); r1[3] = bfhi(g.w) * __builtin_amdgcn_rcpf(fmaxf(bfhi(z.w), 1e-30f));
                    acc[ai][bj][m][0] = acc[ai][bj][m][0] * r0; acc[ai][bj][m][1] = acc[ai][bj][m][1] * r1; } }
    }
    __device__ __forceinline__ void operator()(const f32x4 (&acc)[2][2][4][2], const Unit& u, int wr, int wc, int fr, int fq) const {
        const int row0 = u.lm * BM + wr * 64 + fr, col0 = u.ln * BM + wc * 32 + 8 * fq;
#pragma unroll
        for (int ai = 0; ai < 2; ++ai)
#pragma unroll
            for (int m = 0; m < 4; ++m) { const int row = row0 + ai * HALF + m * 16;
#pragma unroll
                for (int bj = 0; bj < 2; ++bj) { const int col = col0 + bj * HALF; const u32x4 z = *(const u32x4*)(SZ + (size_t)row * 2048 + 1024 + col);
                    f32x4 v0 = acc[ai][bj][m][0], v1 = acc[ai][bj][m][1];
                    v0[0] *= bflo(z.x); v0[1] *= bfhi(z.x); v0[2] *= bflo(z.y); v0[3] *= bfhi(z.y); v1[0] *= bflo(z.z); v1[1] *= bfhi(z.z); v1[2] *= bflo(z.w); v1[3] *= bfhi(z.w);
                    *(u32x4*)(O + (size_t)row * 1024 + col) = pack8(v0, v1); } }
    }
};
template <bool BASE_F32> struct EpiResSplit {
    static constexpr bool PERM = true, AFTER_DRAIN = false, MIDK = false;
    const float* basef; const bf16_t* baseH; const bf16_t* baseL; bf16_t* H; bf16_t* L; float* SS;
    __device__ __forceinline__ void operator()(const f32x4 (&acc)[2][2][4][2], const Unit& u, int wr, int wc, int fr, int fq) const {
        const int row0 = u.lm * BM + wr * 64 + fr, col0 = u.ln * BM + wc * 32 + 8 * fq;
#pragma unroll
        for (int ai = 0; ai < 2; ++ai)
#pragma unroll
            for (int m = 0; m < 4; ++m) { const int row = row0 + ai * HALF + m * 16; const size_t off = (size_t)row * 1024 + col0; float ss = 0.f;
#pragma unroll
                for (int bj = 0; bj < 2; ++bj) { f32x4 v0, v1;
                    if (BASE_F32) { v0 = *(const f32x4*)(basef + off + bj * HALF); v1 = *(const f32x4*)(basef + off + bj * HALF + 4); }
                    else { const u32x4 bh = *(const u32x4*)(baseH + off + bj * HALF), bl = *(const u32x4*)(baseL + off + bj * HALF);
                        v0[0] = bflo(bh.x) + bflo(bl.x); v0[1] = bfhi(bh.x) + bfhi(bl.x); v0[2] = bflo(bh.y) + bflo(bl.y); v0[3] = bfhi(bh.y) + bfhi(bl.y); v1[0] = bflo(bh.z) + bflo(bl.z); v1[1] = bfhi(bh.z) + bfhi(bl.z); v1[2] = bflo(bh.w) + bflo(bl.w); v1[3] = bfhi(bh.w) + bfhi(bl.w); }
                    v0 = v0 + acc[ai][bj][m][0]; v1 = v1 + acc[ai][bj][m][1];
                    ss += (v0[0] * v0[0] + v0[1] * v0[1]) + (v0[2] * v0[2] + v0[3] * v0[3]) + (v1[0] * v1[0] + v1[1] * v1[1]) + (v1[2] * v1[2] + v1[3] * v1[3]);
                    const u32x4 h = pack8(v0, v1); *(u32x4*)(H + off + bj * HALF) = h;
                    f32x4 r0, r1; r0[0] = v0[0] - bflo(h.x); r0[1] = v0[1] - bfhi(h.x); r0[2] = v0[2] - bflo(h.y); r0[3] = v0[3] - bfhi(h.y); r1[0] = v1[0] - bflo(h.z); r1[1] = v1[1] - bfhi(h.z); r1[2] = v1[2] - bflo(h.w); r1[3] = v1[3] - bfhi(h.w);
                    *(u32x4*)(L + off + bj * HALF) = pack8(r0, r1); }
                ss += __shfl_xor(ss, 16); ss += __shfl_xor(ss, 32);
                if (fq == 0) SS[(size_t)row * 16 + u.ln * 4 + wc] = ss; }
    }
};
template <int NM0, int NN0, int A00, int B00, int NM1, int NN1, int A01, int B01, int NM2, int NN2, int A02, int B02, int NM3, int NN3, int A03, int B03>
struct MultiOrder {
    static constexpr bool GATHER = false;
    int G, c;
    __device__ __forceinline__ bool next(int i, Unit& u) const {
        constexpr int C0 = NM0 * NN0, C1 = NM1 * NN1, C2 = NM2 * NN2, C3 = NM3 * NN3;
        long L = (long)i * G + c; int s, nwg, nNs, nMs, a0s, b0s;
        if (L < C0) { s = 0; nwg = C0; nNs = NN0; nMs = NM0; a0s = A00; b0s = B00; }
        else if (L < C0 + C1) { L -= C0; s = 1; nwg = C1; nNs = NN1; nMs = NM1; a0s = A01; b0s = B01; }
        else if (L < C0 + C1 + C2) { L -= C0 + C1; s = 2; nwg = C2; nNs = NN2; nMs = NM2; a0s = A02; b0s = B02; }
        else if (L < C0 + C1 + C2 + C3) { L -= C0 + C1 + C2; s = 3; nwg = C3; nNs = NN3; nMs = NM3; a0s = A03; b0s = B03; }
        else return false;
        int wgid = (int)L; { const int q = nwg / NXCD, r = nwg % NXCD, xcd = wgid % NXCD, off = wgid / NXCD; wgid = (xcd < r ? xcd * (q + 1) : r * (q + 1) + (xcd - r) * q) + off; }
        const int nig = WGM * nNs, gid = wgid / nig, fm = gid * WGM, gsz = (nMs - fm) < WGM ? (nMs - fm) : WGM;
        u.lm = fm + ((wgid % nig) % gsz); u.ln = (wgid % nig) / gsz; u.pm = a0s + u.lm; u.pn = b0s + u.ln; u.ty = s; return true;
    }
    __device__ __forceinline__ void a_ready(const Unit&) const {}
    __device__ __forceinline__ void done(const Unit&) const {}
};
struct MoeOrder {
    static constexpr bool GATHER = false;
    const PG8_LAS int* tile_e; int ntile, G, c;
    __device__ __forceinline__ bool next(int i, Unit& u) const {
        const long L = (long)i * G + c; if (L >= (long)ntile * 4) return false;
        const int pm = (int)(L >> 2), j = (int)(L & 3); u.pm = pm; u.pn = __builtin_amdgcn_readfirstlane(tile_e[pm]) * 4 + j; u.lm = pm; u.ln = j; u.ty = 0; return true;
    }
    __device__ __forceinline__ void a_ready(const Unit&) const {}
    __device__ __forceinline__ void done(const Unit&) const {}
};
struct MoeGatherOrder {
    static constexpr bool GATHER = true;
    const PG8_LAS int* tile_e; const PG8_LAS int* rows; int ntile, G, c;
    __device__ __forceinline__ bool next(int i, Unit& u) const {
        const long L = (long)i * G + c; if (L >= (long)ntile * 4) return false;
        const int pm = (int)(L >> 2), j = (int)(L & 3); u.pm = pm; u.pn = __builtin_amdgcn_readfirstlane(tile_e[pm]) * 4 + j; u.lm = pm; u.ln = j; u.ty = 0; return true;
    }
    __device__ __forceinline__ int row(int ui, int r) const { return rows[ui * 256 + r]; }
    __device__ __forceinline__ void a_ready(const Unit&) const {}
    __device__ __forceinline__ void done(const Unit&) const {}
};
#ifndef PROBE_ACC
#define PROBE_ACC -1
#endif
#ifndef PROBE_N
#define PROBE_N 0
#endif
#define PG8_PB(id) do { if ((id) == PROBE_ACC && (PROBE_N == 0 || g.N == PROBE_N)) g_t0 = __builtin_amdgcn_s_memrealtime(); } while (0)
#define PG8_PE(id) do { if ((id) == PROBE_ACC && (PROBE_N == 0 || g.N == PROBE_N) && wid == 0 && lane == 0) { const unsigned d_ = (unsigned)(__builtin_amdgcn_s_memrealtime() - g_t0); __hip_atomic_fetch_add((PG8_LAS unsigned*)(lds + 147776 + 4 * 16), d_, __ATOMIC_RELAXED, __HIP_MEMORY_SCOPE_WORKGROUP); } } while (0)
template <class Epi, class Sched, bool ALIGN_EPI = false, bool SP2 = false>
__device__ __forceinline__ void gemm_phase(PG8_LAS unsigned char* lds, const Gemm g, const Sched& S, const Epi& E) {
    const int tid = threadIdx.x, wid = __builtin_amdgcn_readfirstlane(tid >> 6), lane = tid & 63, wr = wid >> 2, wc = wid & 3, fr = lane & 15, fq = lane >> 4;
    const int K = g.K, nt = K / BK; unsigned long long g_t0 = 0; (void)g_t0; PG8_PB(42);
    unsigned voffA[2], voffB[2];
#pragma unroll
    for (int i = 0; i < 2; ++i) { int R, C; stage_rc(tid * 16 + i * 8192, R, C); const int Rb = Epi::PERM ? ((R & ~31) + perm32(R & 31)) : R;
        voffA[i] = (unsigned)(R * K + C) * 2u; voffB[i] = (unsigned)(Rb * K + C) * 2u; }
    static_assert(!Sched::GATHER || SP2, "gathered A rows: SP2 loop only");
    unsigned gA[2][2], gN[2][2];
#define PG8_GOFF(dst, ui_) do { _Pragma("unroll") for (int _h = 0; _h < 2; ++_h) _Pragma("unroll") for (int _i = 0; _i < 2; ++_i) { int _R, _C; stage_rc(tid * 16 + _i * 8192, _R, _C); dst[_h][_i] = (unsigned)(S.row((ui_), _h * HALF + _R) * K + _C) * 2u; } } while (0)
#define PG8_STAGE_A(bufoff, gbase, hh, un_) do { if constexpr (Sched::GATHER) { unsigned _vo[2] = {(un_) ? gN[hh][0] : gA[hh][0], (un_) ? gN[hh][1] : gA[hh][1]}; PG8_STAGE(bufoff, gbase, _vo); } else { PG8_STAGE(bufoff, (gbase) + ((hh) ? hstep : 0), voffA); } } while (0)
    const size_t kstep = (size_t)(BK * 2);
    const size_t hstep = (size_t)HALF * K * 2;
    const size_t tstep = 2 * hstep;
    const unsigned ldsw = (unsigned)wid * 1024u;
    const int aoff = lds_byte(wr * 64 + fr, fq * 8), boff = lds_byte(wc * 32 + fr, fq * 8);
#define PG8_SA(b, h) (((b) * 2 + (h)) * HTB)
#define PG8_SB(b, h) ((4 + (b) * 2 + (h)) * HTB)
#define PG8_STAGE(bufoff, gbase, voff) do { _Pragma("unroll") for (int _i = 0; _i < 2; ++_i) \
        __builtin_amdgcn_global_load_lds((const unsigned*)((const char*)(gbase) + (voff)[_i]), (PG8_LAS unsigned*)(lds + (bufoff) + ldsw + _i * 8192), 16, 0, 0); } while (0)
#define PG8_LDA(dst, b, h) do { _Pragma("unroll") for (int m = 0; m < 4; ++m) _Pragma("unroll") for (int k = 0; k < 2; ++k) dst[m][k] = *(const PG8_LAS bf16x8*)(lds + PG8_SA(b, h) + aoff + m * 2048 + k * 1024); } while (0)
#define PG8_LDB(dst, b, h) do { _Pragma("unroll") for (int n = 0; n < 2; ++n) _Pragma("unroll") for (int k = 0; k < 2; ++k) dst[n][k] = *(const PG8_LAS bf16x8*)(lds + PG8_SB(b, h) + boff + n * 2048 + k * 1024); } while (0)
#define PG8_MMA(ai, bj, At, Bt) do { __builtin_amdgcn_s_setprio(1); _Pragma("unroll") for (int m = 0; m < 4; ++m) _Pragma("unroll") for (int n = 0; n < 2; ++n) _Pragma("unroll") for (int k = 0; k < 2; ++k) \
        acc[ai][bj][m][n] = __builtin_amdgcn_mfma_f32_16x16x32_bf16(Bt[n][k], At[m][k], acc[ai][bj][m][n], 0, 0, 0); __builtin_amdgcn_s_setprio(0); } while (0)
#define PG8_WAIT_V(n) asm volatile("s_waitcnt vmcnt(" #n ")" ::: "memory")
#define PG8_WAIT_L(n) asm volatile("s_waitcnt lgkmcnt(" #n ")" ::: "memory")
#define PG8_BAR __builtin_amdgcn_s_barrier()
#define PG8_SCHED __builtin_amdgcn_sched_barrier(0)
    Unit cur, nxt; int ui = 0;
    if (!S.next(0, cur)) return;
    f32x4 acc[2][2][4][2];
#pragma unroll
    for (int a = 0; a < 2; ++a)
#pragma unroll
        for (int b = 0; b < 2; ++b)
#pragma unroll
            for (int m = 0; m < 4; ++m)
#pragma unroll
                for (int n = 0; n < 2; ++n) acc[a][b][m][n] = (f32x4){0.f, 0.f, 0.f, 0.f};
    bf16x8 At[4][2], B0[2][2], B1[2][2];
    const char* cA = (const char*)g.A + (Sched::GATHER ? (size_t)0 : (size_t)cur.pm * tstep); const char* cB = (const char*)g.Bt + (size_t)cur.pn * tstep;
    if constexpr (Sched::GATHER) { PG8_GOFF(gA, 0); }
    S.a_ready(cur);
    if constexpr (SP2) {
        PG8_STAGE(PG8_SB(0, 0), cB, voffB); PG8_STAGE(PG8_SB(0, 1), cB + hstep, voffB); PG8_STAGE_A(PG8_SA(0, 0), cA, 0, false); PG8_STAGE_A(PG8_SA(0, 1), cA, 1, false);
        if (wr == 1) PG8_BAR;
        PG8_WAIT_V(2); PG8_BAR;
        PG8_STAGE(PG8_SB(1, 0), cB + kstep, voffB); PG8_STAGE_A(PG8_SA(1, 0), cA + kstep, 0, false); PG8_STAGE(PG8_SB(1, 1), cB + hstep + kstep, voffB);
        PG8_WAIT_V(6); PG8_BAR;
    } else {
        PG8_STAGE(PG8_SB(0, 0), cB, voffB); PG8_STAGE(PG8_SA(0, 0), cA, voffA); PG8_STAGE(PG8_SB(0, 1), cB + hstep, voffB); PG8_STAGE(PG8_SA(0, 1), cA + hstep, voffA);
        if (wr == 1) PG8_BAR;
        PG8_WAIT_V(4); PG8_BAR;
        PG8_STAGE(PG8_SB(1, 0), cB + kstep, voffB); PG8_STAGE(PG8_SA(1, 0), cA + kstep, voffA); PG8_STAGE(PG8_SB(1, 1), cB + hstep + kstep, voffB);
        PG8_WAIT_V(6); PG8_BAR;
    }
    PG8_PE(42);
    for (;;) {
        const bool has_next = S.next(ui + 1, nxt); PG8_PB(40);
        if constexpr (Sched::GATHER) { if (has_next) PG8_GOFF(gN, ui + 1); }
        const char* nA = (has_next && !Sched::GATHER) ? (const char*)g.A + (size_t)nxt.pm * tstep : cA; const char* nB = has_next ? (const char*)g.Bt + (size_t)nxt.pn * tstep : cB;
        for (int t = 0; t < nt; t += 2) {
            if constexpr (Epi::MIDK) { if (t == (nt >> 1)) { int t_ = threadIdx.x; asm volatile("" : "+v"(t_)); const int l_ = t_ & 63, w_ = __builtin_amdgcn_readfirstlane(t_ >> 6); E.mid(acc, cur, w_ >> 2, w_ & 3, l_ & 15, l_ >> 4); } }
            const bool last = (t == nt - 2); const bool un = last && has_next;
            const char* a1 = cA + (size_t)(t + 1) * kstep;
            const char* a2 = last ? nA : cA + (size_t)(t + 2) * kstep; const char* b2 = last ? nB : cB + (size_t)(t + 2) * kstep;
            const char* a3 = a2 + kstep; const char* b3 = b2 + kstep;
            if (last && has_next) S.a_ready(nxt);
            if constexpr (SP2) {
            PG8_LDB(B0, 0, 0); PG8_LDB(B1, 0, 1); PG8_SCHED; PG8_LDA(At, 0, 0); PG8_STAGE_A(PG8_SA(1, 1), a1, 1, false);
            PG8_WAIT_V(8); PG8_WAIT_L(0); PG8_BAR; PG8_MMA(0, 0, At, B0); PG8_MMA(0, 1, At, B1); PG8_BAR; PG8_SCHED;
            PG8_LDA(At, 0, 1); PG8_STAGE(PG8_SB(0, 0), b2, voffB); PG8_STAGE(PG8_SB(0, 1), b2 + hstep, voffB); PG8_STAGE_A(PG8_SA(0, 0), a2, 0, un);
            PG8_WAIT_V(8); PG8_WAIT_L(0); PG8_BAR; PG8_MMA(1, 0, At, B0); PG8_MMA(1, 1, At, B1); PG8_BAR; PG8_SCHED;
            PG8_LDB(B0, 1, 0); PG8_LDB(B1, 1, 1); PG8_SCHED; PG8_LDA(At, 1, 0); PG8_STAGE_A(PG8_SA(0, 1), a2, 1, un);
            PG8_WAIT_V(8); PG8_WAIT_L(0); PG8_BAR; PG8_MMA(0, 0, At, B0); PG8_MMA(0, 1, At, B1); PG8_BAR; PG8_SCHED;
            PG8_LDA(At, 1, 1); PG8_STAGE(PG8_SB(1, 0), b3, voffB); PG8_STAGE(PG8_SB(1, 1), b3 + hstep, voffB); PG8_STAGE_A(PG8_SA(1, 0), a3, 0, un);
            PG8_WAIT_V(8); PG8_WAIT_L(0); PG8_BAR; PG8_MMA(1, 0, At, B0); PG8_MMA(1, 1, At, B1); PG8_BAR; PG8_SCHED;
            } else {
            PG8_LDB(B0, 0, 0); PG8_SCHED; PG8_LDA(At, 0, 0); PG8_STAGE(PG8_SA(1, 1), a1 + hstep, voffA);
            PG8_WAIT_L(8); PG8_BAR; PG8_WAIT_L(0); PG8_MMA(0, 0, At, B0); PG8_BAR; PG8_SCHED;
            PG8_LDB(B1, 0, 1); PG8_STAGE(PG8_SB(0, 0), b2, voffB);
            PG8_BAR; PG8_WAIT_L(0); PG8_MMA(0, 1, At, B1); PG8_BAR;
            PG8_LDA(At, 0, 1); PG8_STAGE(PG8_SA(0, 0), a2, voffA);
            PG8_BAR; PG8_WAIT_L(0); PG8_MMA(1, 0, At, B0); PG8_BAR; PG8_SCHED;
            PG8_STAGE(PG8_SB(0, 1), b2 + hstep, voffB);
            PG8_WAIT_V(6); PG8_BAR; PG8_MMA(1, 1, At, B1); PG8_BAR;
            PG8_LDB(B0, 1, 0); PG8_SCHED; PG8_LDA(At, 1, 0); PG8_STAGE(PG8_SA(0, 1), a2 + hstep, voffA);
            PG8_WAIT_L(8); PG8_BAR; PG8_WAIT_L(0); PG8_MMA(0, 0, At, B0); PG8_BAR; PG8_SCHED;
            PG8_LDB(B1, 1, 1); PG8_STAGE(PG8_SB(1, 0), b3, voffB);
            PG8_BAR; PG8_WAIT_L(0); PG8_MMA(0, 1, At, B1); PG8_BAR;
            PG8_LDA(At, 1, 1); PG8_STAGE(PG8_SA(1, 0), a3, voffA);
            PG8_BAR; PG8_WAIT_L(0); PG8_MMA(1, 0, At, B0); PG8_BAR; PG8_SCHED;
            PG8_STAGE(PG8_SB(1, 1), b3 + hstep, voffB);
            PG8_WAIT_V(6); PG8_BAR; PG8_MMA(1, 1, At, B1); PG8_BAR;
            }
        }
        PG8_PE(40); PG8_PB(41);
        if constexpr (ALIGN_EPI) { if (wr == 0) PG8_BAR; }
        if constexpr (!Epi::AFTER_DRAIN) { int t_ = threadIdx.x; asm volatile("" : "+v"(t_)); const int l_ = t_ & 63, w_ = __builtin_amdgcn_readfirstlane(t_ >> 6); E(acc, cur, w_ >> 2, w_ & 3, l_ & 15, l_ >> 4); S.done(cur); }
        PG8_PE(41);
        if (!has_next) break;
#pragma unroll
        for (int a = 0; a < 2; ++a)
#pragma unroll
            for (int b = 0; b < 2; ++b)
#pragma unroll
                for (int m = 0; m < 4; ++m)
#pragma unroll
                    for (int n = 0; n < 2; ++n) acc[a][b][m][n] = (f32x4){0.f, 0.f, 0.f, 0.f};
        cur = nxt; cA = nA; cB = nB; ++ui;
        if constexpr (Sched::GATHER) { _Pragma("unroll") for (int _h = 0; _h < 2; ++_h) _Pragma("unroll") for (int _i = 0; _i < 2; ++_i) gA[_h][_i] = gN[_h][_i]; }
        if constexpr (ALIGN_EPI) { if (wr == 1) PG8_BAR; }
    }
    PG8_PB(43);
    PG8_WAIT_V(0);
    if constexpr (!ALIGN_EPI) { if (wr == 0) PG8_BAR; }
    PG8_BAR;
    if constexpr (Epi::AFTER_DRAIN) { E.fused(acc, cur, wr, wc, fr, fq, lds, wid, lane); S.done(cur); }
    PG8_PE(43);
#undef PG8_SA
#undef PG8_SB
#undef PG8_STAGE
#undef PG8_STAGE_A
#undef PG8_GOFF
#undef PG8_LDA
#undef PG8_LDB
#undef PG8_MMA
#undef PG8_WAIT_V
#undef PG8_WAIT_L
#undef PG8_BAR
#undef PG8_SCHED
}
}
#define GAS __attribute__((address_space(1)))
#define LAS __attribute__((address_space(3)))
typedef unsigned short bf16;
typedef unsigned v4u __attribute__((ext_vector_type(4)));
typedef float f32x4 __attribute__((ext_vector_type(4)));
typedef short bf16x8 __attribute__((ext_vector_type(8)));
typedef GAS unsigned gu32;
typedef GAS unsigned long long gu64;
#define RLX_AGENT __ATOMIC_RELAXED, __HIP_MEMORY_SCOPE_AGENT
#define LDS_WAIT() asm volatile("s_waitcnt lgkmcnt(0)" ::: "memory")
#define VM_WAIT() asm volatile("s_waitcnt vmcnt(0)" ::: "memory")
__device__ __forceinline__ unsigned long long rt() { return __builtin_amdgcn_s_memrealtime(); }
__device__ __forceinline__ unsigned f2bf(float f) { unsigned u = __builtin_bit_cast(unsigned, f); return (u + 0x7fffu + ((u >> 16) & 1u)) >> 16; }
__device__ __forceinline__ unsigned pk2(float lo, float hi) { return f2bf(lo) | (f2bf(hi) << 16); }
#define XB_TMO      128
#define XB_XCNT(j)  (256  + 64 * (j))
#define XB_XSUB(j)  (1280 + 64 * (j))
#define XB_XGEN(j)  (2304 + 64 * (j))
#define XB_TOP      3328
#define XB_TOPGEN   3392
#define XCD_BAR_WORDS 3456
#define XB_SPIN_CAP (1u << 18)

__device__ __forceinline__ unsigned xb_ld(unsigned* p)              { return __hip_atomic_load(p, __ATOMIC_RELAXED, __HIP_MEMORY_SCOPE_AGENT); }
__device__ __forceinline__ unsigned xb_add(unsigned* p, unsigned v) { return __hip_atomic_fetch_add(p, v, __ATOMIC_RELAXED, __HIP_MEMORY_SCOPE_AGENT); }
__device__ __forceinline__ unsigned xb_xcc_id() { return (unsigned)__builtin_amdgcn_s_getreg((3 << 11) | 20) & 0xFu; }
#define XB_SPIN(cond, bar) do { unsigned _sp = 0; while (cond) { __builtin_amdgcn_s_sleep(1); \
    if ((++_sp & 255u) == 0u) { if (xb_ld(&(bar)[XB_TMO])) break; if (_sp > XB_SPIN_CAP) { atomicAdd(&(bar)[XB_TMO], 1u); break; } } } } while (0)

struct XcdBarrier {
    unsigned* bar; unsigned x;
    volatile LAS unsigned* st;
};

__device__ __forceinline__ XcdBarrier xcd_barrier_post(unsigned* bar, volatile LAS unsigned* st) {
    XcdBarrier b; b.bar = bar; b.x = xb_xcc_id(); b.st = st;
    if (threadIdx.x == 0) (void)xb_add(&bar[XB_XCNT(b.x)], 1u);
    return b;
}
__device__ __forceinline__ void xcd_barrier_complete(unsigned* bar, unsigned x, unsigned& nloc, unsigned& nx) {
    const unsigned G = gridDim.x * gridDim.y * gridDim.z;
    unsigned sum, cnt, mine, sp = 0u;
    for (;;) {
        sum = 0u; cnt = 0u; mine = 0u;
#pragma unroll
        for (unsigned j = 0; j < 16; ++j) { const unsigned c = xb_ld(&bar[XB_XCNT(j)]); sum += c; cnt += (c > 0u) ? 1u : 0u; mine = (j == x) ? c : mine; }
        if (sum == G) break;
        __builtin_amdgcn_s_sleep(1);
        if ((++sp & 255u) == 0u) { if (xb_ld(&bar[XB_TMO])) break; if (sp > XB_SPIN_CAP) { atomicAdd(&bar[XB_TMO], 1u); break; } }
    }
    nloc = mine > 0u ? mine : 1u; nx = cnt > 0u ? cnt : 1u;
}

__device__ __forceinline__ void xcd_barrier(const XcdBarrier& b) {
    asm volatile("s_waitcnt vmcnt(0)" ::: "memory");
    __syncthreads();
    if (threadIdx.x == 0) {
        unsigned* bar = b.bar;
        __builtin_amdgcn_s_waitcnt(0);
        unsigned nloc = b.st[0], nx = b.st[1];
        if (nloc == 0u) { xcd_barrier_complete(bar, b.x, nloc, nx); b.st[0] = nloc; b.st[1] = nx; }
        const unsigned old = xb_add(&bar[XB_XSUB(b.x)], 1u);
        const unsigned gen = old / nloc;
        if (old + 1u == (gen + 1u) * nloc) {
            __builtin_amdgcn_fence(__ATOMIC_RELEASE, "agent");
            asm volatile("s_waitcnt vmcnt(0)" ::: "memory");
            const unsigned og = xb_add(&bar[XB_TOP], 1u);
            const unsigned tg = og / nx;
            if (og + 1u == (tg + 1u) * nx) xb_add(&bar[XB_TOPGEN], 1u);
            else XB_SPIN(xb_ld(&bar[XB_TOPGEN]) == tg, bar);
            __builtin_amdgcn_fence(__ATOMIC_ACQUIRE, "agent");
            xb_add(&bar[XB_XGEN(b.x)], 1u);
            asm volatile("s_waitcnt vmcnt(0)" ::: "memory");
        } else {
            XB_SPIN(xb_ld(&bar[XB_XGEN(b.x)]) == gen, bar);
            __builtin_amdgcn_fence(__ATOMIC_ACQUIRE, "agent");
            asm volatile("s_waitcnt vmcnt(0)" ::: "memory");
        }
    }
    __syncthreads();
}

constexpr int NWAVES = 8, NTHR = 512;
constexpr int M = 32768, D = 1024, SEQ = 8192, NB = 4;
constexpr int DIN = 5136;
constexpr int MOE_CAP_TILES = 288, MOE_CAP = MOE_CAP_TILES * 256;
constexpr int LIST_CAP = 256 * 496;
constexpr float EPS = 1e-6f;
#ifndef MK_ONE_LAUNCH
#define MK_ONE_LAUNCH 0
#endif
constexpr int NPHASE = 20;

constexpr size_t MiB = 1u << 20, KiB = 1u << 10;
constexpr size_t WS_CTL = 0, CTL_ZERO_BYTES = 1 * MiB;
constexpr int CW_TMO = 0, CW_CODE = 1, CW_BAR = 4096, CW_LCNT = 16384, CW_ECNT = 20480, CW_WQ = 24576;
constexpr size_t WS_RSTD0 = 1 * MiB, WS_RSTD1 = WS_RSTD0 + 128 * KiB, WS_RSTD2 = WS_RSTD1 + 128 * KiB;
constexpr size_t WS_DEC = 1 * MiB + 512 * KiB;
constexpr size_t WS_KMEAN = 2 * MiB, WS_KNMAX = 2 * MiB + 256 * KiB;
constexpr size_t WS_MOE_E = 2 * MiB + 512 * KiB, WS_MOE_POS = WS_MOE_E + 256 * KiB, WS_MOE_W = WS_MOE_POS + 256 * KiB, WS_SLOT_OF = WS_MOE_W + 256 * KiB;
constexpr size_t WS_W_SLOT = 4 * MiB, WS_RSTD_SLOT = 4 * MiB + 512 * KiB, WS_TILE_E = 5 * MiB;
constexpr size_t WS_MEMN = 6 * MiB, WS_MKV = 8 * MiB;
constexpr size_t WS_W1T = 10 * MiB  , WS_WVT = WS_W1T + 8704 * KiB, WS_PGMT = WS_WVT + 2 * MiB  , WS_WOUTT = WS_PGMT + 2 * MiB,
                 WS_WCQT = WS_WOUTT + 2 * MiB, WS_WCKVT = WS_WCQT + 1 * MiB, WS_WCOT = WS_WCKVT + 2 * MiB, WS_WRT = WS_WCOT + 1 * MiB;
static_assert(WS_WRT + 1 * MiB <= 30 * MiB, "weights");
constexpr size_t WS_XB = 30 * MiB, WS_QG = 94 * MiB, WS_KG = 110 * MiB, WS_SR = 126 * MiB, WS_QM = 158 * MiB, WS_KM = 190 * MiB, WS_VT = 222 * MiB, WS_OGM = 286 * MiB  , WS_SZ = 350 * MiB;
constexpr size_t WS_LISTS = 478 * MiB, WS_REFS = 494 * MiB, WS_SEL = 495 * MiB, WS_PARTL = 496 * MiB;
constexpr size_t WS_MG = 30 * MiB, WS_X1H = 94 * MiB, WS_X1L = 158 * MiB, WS_QC = 476 * MiB, WS_SS2 = 508 * MiB, WS_SS1 = 510 * MiB;
constexpr size_t WS_X2H = 222 * MiB, WS_X2L = 286 * MiB;
constexpr size_t WS_WGUT = 30 * MiB, WS_WDT = 350 * MiB, WS_LG = 454 * MiB, WS_LG2 = 464 * MiB, WS_HID = 382 * MiB, WS_XG = 30 * MiB  ;
constexpr size_t WS_END = 512 * MiB;
static_assert(WS_XG + 144 * MiB <= WS_X2H && WS_WDT + 32 * MiB <= WS_HID && WS_HID + 72 * MiB <= WS_LG && WS_LG2 + 5 * MiB <= WS_QC && WS_PARTL + 3 * MiB <= WS_END && WS_SS1 + 2 * MiB <= WS_END, "map");
constexpr size_t DO_ST = 0, DO_LA = 64 * MiB, DO_SB = 96 * MiB, DO_PARTO = 0;
constexpr size_t WS_TOK = 5 * MiB + 64 * KiB;
constexpr size_t WS_EMID = 5 * MiB + 512 * KiB;

constexpr int RING_OFF = 0, RING_BYTES = 147456;
constexpr int LDSCTL_OFF = RING_BYTES, MISC_OFF = LDSCTL_OFF + 320;
constexpr int TBL_TILE = RING_BYTES + 1024, TBL_TAB = TBL_TILE + 1280, TBL_BC = TBL_TAB + 512, TBL_EB = TBL_BC + 64;
constexpr int TBL_ROWS = 155648;
constexpr int LDS_BYTES = 163840;
static_assert(TBL_EB + 256 + 1088 * 4 <= TBL_ROWS && TBL_ROWS + 6 * 1024 <= LDS_BYTES, "LDS tables");
static_assert(TBL_EB + 256 + 1088 * 4 <= LDS_BYTES, "LDS map");

struct Args { const float* in[25]; float* out; unsigned char* ws; int ph_lo, ph_hi; };
struct Frame {
    unsigned long long pacc, pt0;
    LAS unsigned char* lds; unsigned char* ldsg;
    volatile LAS unsigned* MISC; gu32* ctl;
    int vcu, G;
    unsigned char* ws; float* out;
};
template <class T> __device__ __forceinline__ T* uniform_ptr(T* p) { const unsigned long long v = (unsigned long long)p; const unsigned lo = __builtin_amdgcn_readfirstlane((unsigned)v), hi = __builtin_amdgcn_readfirstlane((unsigned)(v >> 32)); return (T*)(((unsigned long long)hi << 32) | lo); }
__device__ __forceinline__ float wave_sum(float v) {
#pragma unroll
    for (int o = 1; o < 64; o <<= 1) v += __shfl_xor(v, o);
    return v;
}
__device__ __forceinline__ float wave_max(float v) {
#pragma unroll
    for (int o = 1; o < 64; o <<= 1) v = fmaxf(v, __shfl_xor(v, o));
    return v;
}
__device__ __forceinline__ float bf2f(bf16 h) { return __uint_as_float(((unsigned)h) << 16); }
__device__ __forceinline__ float bflo(unsigned w) { return __uint_as_float(w << 16); }
__device__ __forceinline__ float bfhi(unsigned w) { return __uint_as_float(w & 0xffff0000u); }
__device__ __forceinline__ void unpack8(const v4u w, float* f) { f[0] = bflo(w.x); f[1] = bfhi(w.x); f[2] = bflo(w.y); f[3] = bfhi(w.y); f[4] = bflo(w.z); f[5] = bfhi(w.z); f[6] = bflo(w.w); f[7] = bfhi(w.w); }
__device__ __forceinline__ v4u pack8f(const float* f) { v4u w; w.x = pk2(f[0], f[1]); w.y = pk2(f[2], f[3]); w.z = pk2(f[4], f[5]); w.w = pk2(f[6], f[7]); return w; }
__device__ __forceinline__ int t5_bucket(int n) {
    if (n < 16) return n;
    int b = 16;
    b += (n >= 19) + (n >= 21) + (n >= 24) + (n >= 27) + (n >= 31) + (n >= 35) + (n >= 40) + (n >= 46) + (n >= 52) + (n >= 59) + (n >= 67) + (n >= 77) + (n >= 87) + (n >= 99) + (n >= 113);
    return b;
}

#ifndef PROBE_ACC
#define PROBE_ACC -1
#endif
#define PB(i) do { if ((i) == PROBE_ACC) F.pt0 = __builtin_amdgcn_s_memrealtime(); } while (0)
#define PE(i) do { if ((i) == PROBE_ACC) F.pacc += __builtin_amdgcn_s_memrealtime() - F.pt0; } while (0)
#define PHASE_IDS int tid = threadIdx.x; asm volatile("" : "+v"(tid)); const int lane = tid & 63; const int wave = __builtin_amdgcn_readfirstlane(tid >> 6); (void)lane; (void)wave
struct TrDesc { const float* src; const float* gain; bf16* dst; int ldw, K, k0; };
__device__ __forceinline__ void tr_load(const TrDesc& t, int lane, f32x4 (&v)[8]) {
#pragma unroll
    for (int i = 0; i < 8; ++i) { const int id = i * 64 + lane, kk = id >> 3, c4 = (id & 7) * 4; v[i] = *(const GAS f32x4*)(t.src + (size_t)(t.k0 + kk) * t.ldw + c4); }
}
__device__ __forceinline__ void tr_finish(const TrDesc& t, int lane, const f32x4 (&v)[8], LAS float* scr) {
#pragma unroll
    for (int i = 0; i < 8; ++i) { const int id = i * 64 + lane, kk = id >> 3, c4 = (id & 7) * 4; const float g = t.gain ? t.gain[t.k0 + kk] : 1.f; LAS float* p = scr + kk * 33 + c4; p[0] = v[i][0] * g; p[1] = v[i][1] * g; p[2] = v[i][2] * g; p[3] = v[i][3] * g; }
    LDS_WAIT(); asm volatile("" ::: "memory");
    const int c = lane & 7;
#pragma unroll
    for (int j = 0; j < 4; ++j) { const int n = (lane >> 3) + 8 * j; const LAS float* s2 = scr + (8 * c) * 33 + n;
        v4u o; o.x = pk2(s2[0 * 33], s2[1 * 33]); o.y = pk2(s2[2 * 33], s2[3 * 33]); o.z = pk2(s2[4 * 33], s2[5 * 33]); o.w = pk2(s2[6 * 33], s2[7 * 33]);
        *(GAS v4u*)(t.dst + (size_t)n * t.K + t.k0 + 8 * c) = o; }
    LDS_WAIT(); asm volatile("" ::: "memory");
}
__device__ __forceinline__ void tr_item_alpha(const float* w_in, const float* wau, const float* gain, bf16* dst, int k0, int n0, LAS float* scr, int lane) {
    const float* a = w_in + (size_t)(k0 + lane) * DIN + 1536; const f32x4 a0 = *(const GAS f32x4*)a, a1 = *(const GAS f32x4*)(a + 4), a2 = *(const GAS f32x4*)(a + 8), a3 = *(const GAS f32x4*)(a + 12);
    const float gk = gain[k0 + lane]; const float av[16] = {a0[0], a0[1], a0[2], a0[3], a1[0], a1[1], a1[2], a1[3], a2[0], a2[1], a2[2], a2[3], a3[0], a3[1], a3[2], a3[3]};
#pragma unroll 4
    for (int n = 0; n < 32; ++n) { float v = 0.f;
#pragma unroll
        for (int r = 0; r < 16; ++r) v += av[r] * wau[r * 256 + n0 + n];
        scr[lane * 33 + n] = v * gk; }
    LDS_WAIT(); asm volatile("" ::: "memory");
    const int c = lane & 7;
#pragma unroll
    for (int j = 0; j < 4; ++j) { const int n = (lane >> 3) + 8 * j; const LAS float* s = scr + (8 * c) * 33 + n;
        v4u o; o.x = pk2(s[0 * 33], s[1 * 33]); o.y = pk2(s[2 * 33], s[3 * 33]); o.z = pk2(s[4 * 33], s[5 * 33]); o.w = pk2(s[6 * 33], s[7 * 33]);
        *(GAS v4u*)(dst + (size_t)(n0 + n) * 1024 + k0 + 8 * c) = o; }
    LDS_WAIT(); asm volatile("" ::: "memory");
}
struct TrJob { int src, col0, ldw, gain, K  , ncols, drow; unsigned dst_off_kib; int kdst  , koff  ; };
__constant__ TrJob kJobs[15] = {
    {5, 0, DIN, 4, 1024, 256, 0, (unsigned)(WS_W1T / 1024), 1024, 0},
    {5, 256, DIN, 4, 1024, 256, 256, (unsigned)(WS_W1T / 1024), 1024, 0},
    {5, 1024, DIN, 4, 1024, 512, 512, (unsigned)(WS_W1T / 1024), 1024, 0},
    {5, 1552, DIN, 4, 1024, 512, 1280, (unsigned)(WS_W1T / 1024), 1024, 0},
    {5, 2064, DIN, 4, 1024, 512, 1792, (unsigned)(WS_W1T / 1024), 1024, 0},
    {5, 3088, DIN, 4, 1024, 1024, 2304, (unsigned)(WS_W1T / 1024), 1024, 0},
    {5, 4112, DIN, 4, 1024, 1024, 3328, (unsigned)(WS_W1T / 1024), 1024, 0},
    {5, 512, DIN, 4, 1024, 512, 0, (unsigned)(WS_WVT / 1024), 1024, 0},
    {5, 2576, DIN, 4, 1024, 512, 512, (unsigned)(WS_WVT / 1024), 1024, 0},
    {9, 0, 1024, -1, 512, 1024, 0, (unsigned)(WS_PGMT / 1024), 1024, 0},
    {10, 0, 1024, -1, 512, 1024, 0, (unsigned)(WS_PGMT / 1024), 1024, 512},
    {11, 0, 1024, -1, 1024, 1024, 0, (unsigned)(WS_WOUTT / 1024), 1024, 0},
    {13, 0, 512, 12, 1024, 512, 0, (unsigned)(WS_WCQT / 1024), 1024, 0},
    {14, 0, 1024, -1, 1024, 1024, 0, (unsigned)(WS_WCKVT / 1024), 1024, 0},
    {15, 0, 1024, -1, 512, 1024, 0, (unsigned)(WS_WCOT / 1024), 512, 0},
};

__device__ __forceinline__ void p0_prologue(Frame& F, const Args& A) {
    PHASE_IDS;
    LAS float* scr = (LAS float*)(F.lds + RING_OFF + wave * 16384);
    const int gw = F.vcu * NWAVES + wave, NGW = F.G * NWAVES;
    PB(20);
    int total = 0;
#pragma unroll 1
    for (int j = 0; j < 15; ++j) total += (kJobs[j].K / 64) * (kJobs[j].ncols / 32);
    const int alpha_items = 16 * 8;
#pragma unroll 1
    for (int it = gw; it < total + alpha_items; it += NGW) {
        if (it >= total) { const int r = it - total; tr_item_alpha(A.in[5], A.in[6], A.in[4], (bf16*)(F.ws + WS_W1T) + (size_t)1024 * 1024, (r >> 3) * 64, (r & 7) * 32, scr, lane); continue; }
        int r = it, j = 0;
#pragma unroll 1
        for (; j < 15; ++j) { const int n = (kJobs[j].K / 64) * (kJobs[j].ncols / 32); if (r < n) break; r -= n; }
        const TrJob jb = kJobs[j]; const int nblk = jb.ncols / 32, kb = r / nblk, nb = r % nblk;
        const TrDesc t{A.in[jb.src] + jb.col0 + nb * 32, jb.gain >= 0 ? A.in[jb.gain] : nullptr, (bf16*)(F.ws + (size_t)jb.dst_off_kib * 1024) + (size_t)(jb.drow + nb * 32) * jb.kdst + jb.koff, jb.ldw, jb.kdst, kb * 64};
        f32x4 v[8]; tr_load(t, lane, v); tr_finish(t, lane, v, scr);
    }
    PE(20); PB(21);
    { bf16* wrt = (bf16*)(F.ws + WS_WRT); const float* g = A.in[16]; const float* wg = A.in[17]; const float* we = A.in[19];
        for (int i = blockIdx.x * NTHR + tid; i < 2 * 256 * 1024; i += F.G * NTHR) { const int mat = i >> 18, o = (i >> 10) & 255, kk = i & 1023; unsigned v = 0;
            if (o < (mat ? 36 : 72)) { const int oo = o < 36 ? o : o - 36; const float w = g[kk] * (oo < 4 ? wg[kk * 4 + oo] : we[kk * 32 + oo - 4]); const unsigned hi = f2bf(w);
                v = o < 36 ? hi : f2bf(w - __uint_as_float(hi << 16)); }
            wrt[i] = (bf16)v; } }
    PE(21); PB(22);
    { const float* x = A.in[0]; bf16* xb = (bf16*)(F.ws + WS_XB); float* rstd0 = (float*)(F.ws + WS_RSTD0);
        int m = gw;
        if (m < M) { f32x4 v[4];
#pragma unroll
            for (int j = 0; j < 4; ++j) v[j] = ((const GAS f32x4*)(x + (size_t)m * D))[64 * j + lane];
#pragma unroll 1
            for (;;) { const int mn = m + NGW; const bool more = mn < M; f32x4 w[4];
                if (more) {
#pragma unroll
                    for (int j = 0; j < 4; ++j) w[j] = ((const GAS f32x4*)(x + (size_t)mn * D))[64 * j + lane]; }
                float s = 0.f;
#pragma unroll
                for (int j = 0; j < 4; ++j) s += (v[j].x * v[j].x + v[j].y * v[j].y) + (v[j].z * v[j].z + v[j].w * v[j].w);
                s = wave_sum(s); const float rs = rsqrtf(s * (1.f / D) + EPS);
                GAS unsigned long long* o8 = (GAS unsigned long long*)(xb + (size_t)m * D) + lane;
#pragma unroll
                for (int j = 0; j < 4; ++j) o8[64 * j] = (unsigned long long)pk2(v[j].x * rs, v[j].y * rs) | ((unsigned long long)pk2(v[j].z * rs, v[j].w * rs) << 32);
                if (!more) break;
                m = mn;
#pragma unroll
                for (int j = 0; j < 4; ++j) v[j] = w[j]; } } }
    PE(22); PB(23);
    { const float* mem = A.in[1]; const float* gm = A.in[2]; bf16* mn = (bf16*)(F.ws + WS_MEMN);
        for (int m = gw; m < 1024; m += NGW) { const GAS f32x4* xr = (const GAS f32x4*)(mem + (size_t)m * D) + lane; const GAS f32x4* gr = (const GAS f32x4*)gm + lane; f32x4 v[4]; float s = 0.f;
#pragma unroll
            for (int j = 0; j < 4; ++j) { v[j] = xr[64 * j]; s += (v[j].x * v[j].x + v[j].y * v[j].y) + (v[j].z * v[j].z + v[j].w * v[j].w); }
            s = wave_sum(s); const float rs = rsqrtf(s * (1.f / D) + EPS);
            GAS unsigned long long* o8 = (GAS unsigned long long*)(mn + (size_t)m * D) + lane;
#pragma unroll
            for (int j = 0; j < 4; ++j) { const f32x4 g = gr[64 * j]; o8[64 * j] = (unsigned long long)pk2(v[j].x * rs * g.x, v[j].y * rs * g.y) | ((unsigned long long)pk2(v[j].z * rs * g.z, v[j].w * rs * g.w) << 32); } } }
}
__device__ __forceinline__ TrDesc expert_item(const Args& A, unsigned char* ws, int it) {
    bf16* wgut = (bf16*)(ws + WS_WGUT); bf16* wdt = (bf16*)(ws + WS_WDT); const int e = it / 768, r = it % 768;
    if (r < 512) { const int up = r >> 8, rr = r & 255, kb = rr >> 4, nb = rr & 15, c0 = nb * 32;
        return TrDesc{A.in[up ? 22 : 21] + (size_t)e * 1024 * 512 + c0, A.in[16], wgut + ((size_t)e * 1024 + (c0 >> 7) * 256 + (c0 & 127) + up * 128) * 1024, 512, 1024, kb * 64}; }
    const int rr = r - 512, kb = rr >> 5, nb = rr & 31;
    return TrDesc{A.in[23] + (size_t)e * 512 * 1024 + nb * 32, nullptr, wdt + ((size_t)e * 1024 + nb * 32) * 512, 1024, 512, kb * 64};
}
__device__ __forceinline__ void expert_weights(Frame& F, const Args& A) {
    PHASE_IDS;
    LAS float* scr = (LAS float*)(F.lds + RING_OFF + wave * 16384);
    const int gw = F.vcu * NWAVES + wave, NGW = F.G * NWAVES;
    int it = gw; if (it >= 32 * 768) return;
    TrDesc cur = expert_item(A, F.ws, it); f32x4 v[8]; tr_load(cur, lane, v);
#pragma unroll 1
    for (;;) { const int nx = it + NGW; const bool more = nx < 32 * 768;
        TrDesc nd = cur; f32x4 w[8];
        if (more) { nd = expert_item(A, F.ws, nx); tr_load(nd, lane, w); }
        tr_finish(cur, lane, v, scr);
        if (!more) break;
        cur = nd; it = nx;
#pragma unroll
        for (int i = 0; i < 8; ++i) v[i] = w[i]; }
}

typedef short mb_bf16x8 __attribute__((ext_vector_type(8)));
typedef unsigned mb_u32x2 __attribute__((ext_vector_type(2)));
__device__ __forceinline__ unsigned mb_cvt_pk(float lo, float hi) { unsigned r; asm volatile("v_cvt_pk_bf16_f32 %0, %1, %2" : "=v"(r) : "v"(lo), "v"(hi)); return r; }
constexpr int GS = 65;
__device__ __forceinline__ void gla_load_b(Frame& F, int tid, const float* LA, int m0, int h, float* Bs) {
#pragma unroll 1
    for (int i = tid; i < 4096; i += NTHR) { const int c = i >> 6, d = i & 63; Bs[c * GS + d] = LA[(size_t)(m0 + c) * 256 + h * 64 + d]; }
    __syncthreads();
    if (tid < 64) { float s = 0.f;
#pragma unroll 8
        for (int c = 0; c < 64; ++c) { s += Bs[c * GS + tid]; Bs[c * GS + tid] = s; } }
    __syncthreads();
}
constexpr int GL_STR = 144;
__device__ __forceinline__ void gla_a_phase(Frame& F) {
    PHASE_IDS;
    LAS float* tot = (LAS float*)(F.lds + RING_OFF); LAS unsigned char* Kt = F.lds + RING_OFF + 2048;
    const float* LA = (const float*)((unsigned char*)F.out + DO_LA); float* ST = (float*)((unsigned char*)F.out + DO_ST);
    const bf16* KG = (const bf16*)(F.ws + WS_KG); const bf16* VT = (const bf16*)(F.ws + WS_VT); float* DEC = (float*)(F.ws + WS_DEC); float* EMID = (float*)(F.ws + WS_EMID);
    const int d = tid & 63, seg = wave, lq = lane & 15, g = lane >> 4;
#pragma unroll 1
    for (int u = blockIdx.x; u < 2048; u += F.G) {
        const int bh = u >> 7, n = u & 127, b = bh >> 2, h = bh & 3, m0 = b * SEQ + n * 64;
        float a[8], kk[8];
#pragma unroll
        for (int i = 0; i < 8; ++i) { const size_t gi = (size_t)(m0 + seg * 8 + i) * 256 + h * 64 + d; a[i] = LA[gi]; kk[i] = bf2f(KG[gi]); }
#pragma unroll
        for (int i = 1; i < 8; ++i) a[i] += a[i - 1];
        tot[seg * 64 + d] = a[7];
        __syncthreads();
        float off = 0.f, total = 0.f;
#pragma unroll
        for (int s2 = 0; s2 < 8; ++s2) { const float t = tot[s2 * 64 + d]; if (s2 < seg) off += t; total += t; }
        { v4u w; float e[8];
#pragma unroll
            for (int i = 0; i < 8; ++i) e[i] = kk[i] * __expf(total - (off + a[i]));
            w.x = pk2(e[0], e[1]); w.y = pk2(e[2], e[3]); w.z = pk2(e[4], e[5]); w.w = pk2(e[6], e[7]);
            *(LAS v4u*)(Kt + d * GL_STR + seg * 16) = w; }
        if (seg == 0) { DEC[u * 64 + d] = __expf(total); EMID[u * 64 + d] = __expf((tot[d] + tot[64 + d]) + (tot[128 + d] + tot[192 + d])); }
        __syncthreads();
        { mb_bf16x8 bf[2];
#pragma unroll
            for (int ks = 0; ks < 2; ++ks) bf[ks] = *(const GAS mb_bf16x8*)(VT + (size_t)(h * 128 + wave * 16 + lq) * M + m0 + 32 * ks + 8 * g);
#pragma unroll
            for (int dt = 0; dt < 4; ++dt) { f32x4 acc = (f32x4){0.f, 0.f, 0.f, 0.f};
#pragma unroll
                for (int ks = 0; ks < 2; ++ks) { const mb_bf16x8 af = *(const LAS mb_bf16x8*)(Kt + (dt * 16 + lq) * GL_STR + ks * 64 + g * 16); acc = __builtin_amdgcn_mfma_f32_16x16x32_bf16(af, bf[ks], acc, 0, 0, 0); }
                *(GAS f32x4*)(ST + ((size_t)u * 128 + wave * 16 + lq) * 64 + dt * 16 + 4 * g) = acc; } }
        __syncthreads();
    }
}
__device__ __forceinline__ void gla_scan_phase(Frame& F) {
    PHASE_IDS;
    const float* ST = (const float*)((unsigned char*)F.out + DO_ST); bf16* SB = (bf16*)((unsigned char*)F.out + DO_SB); const float* DEC = (const float*)(F.ws + WS_DEC); const float* EMID = (const float*)(F.ws + WS_EMID);
#pragma unroll 1
    for (int g = blockIdx.x * NTHR + tid; g < 16 * 8192; g += F.G * NTHR) { const int bh = g >> 13, vd = g & 8191, d = vd & 63; float st = 0.f;
        const float* p = ST + (size_t)bh * 128 * 8192 + vd; bf16* q = SB + (size_t)bh * 128 * 8192 + vd; const float* dc = DEC + bh * 128 * 64 + d; const float* em = EMID + bh * 128 * 64 + d;
#pragma unroll 1
        for (int n0 = 0; n0 < 128; n0 += 16) { float kv[16], de[16], ee[16];
#pragma unroll
            for (int i = 0; i < 16; ++i) { kv[i] = p[(size_t)(n0 + i) * 8192]; de[i] = dc[(n0 + i) * 64]; ee[i] = em[(n0 + i) * 64]; }
#pragma unroll
            for (int i = 0; i < 16; ++i) { q[(size_t)(n0 + i) * 8192] = (bf16)f2bf(st * ee[i]); st = de[i] * st + kv[i]; } } }
}
constexpr int GB_TOT = 0, GB_QE = 2048, GB_KE = GB_QE + 64 * GL_STR, GB_VT = GB_KE + 64 * GL_STR, GB_SB = GB_VT + 128 * GL_STR, GB_UNIT = GB_SB + 128 * GL_STR;
static_assert(2 * GB_UNIT <= RING_BYTES && GB_UNIT % 16 == 0, "GLA-B LDS");
typedef float gb_f32x2 __attribute__((ext_vector_type(2)));
__device__ __forceinline__ void gla_b_phase(Frame& F, const Args& A) {
    PHASE_IDS;
    const float* LA = (const float*)((unsigned char*)F.out + DO_LA); const bf16* SB = (const bf16*)((unsigned char*)F.out + DO_SB);
    const bf16* QG = (const bf16*)(F.ws + WS_QG); const bf16* KG = (const bf16*)(F.ws + WS_KG); const bf16* VT = (const bf16*)(F.ws + WS_VT); const bf16* SR = (const bf16*)(F.ws + WS_SR);
    bf16* OG = (bf16*)(F.ws + WS_OGM); const float* gg = A.in[8];
    const int U = wave >> 2, lt = tid & 255, dp = lt & 31, seg = lt >> 5, lq = lane & 15, g = lane >> 4, ct = wave & 3;
    LAS unsigned char* base = F.lds + RING_OFF + U * GB_UNIT;
    LAS float* tot = (LAS float*)(base + GB_TOT); LAS unsigned char* Qe = base + GB_QE; LAS unsigned char* Ke = base + GB_KE; LAS unsigned char* Vt = base + GB_VT; LAS unsigned char* Sb = base + GB_SB;
    gb_f32x2 a[8]; unsigned q2[8], k2[8]; v4u vc[4], sc[4];
#define GB_LOAD(PR_) do { const int u_ = 2 * (PR_) + U, bh_ = u_ >> 7, n_ = u_ & 127, b_ = bh_ >> 2, h_ = bh_ & 3, m0_ = b_ * SEQ + n_ * 64; \
        _Pragma("unroll") for (int i = 0; i < 8; ++i) { const size_t gi = (size_t)(m0_ + seg * 8 + i) * 256 + h_ * 64 + 2 * dp; a[i] = *(const GAS gb_f32x2*)(LA + gi); q2[i] = *(const GAS unsigned*)(QG + gi); k2[i] = *(const GAS unsigned*)(KG + gi); } \
        _Pragma("unroll") for (int i = 0; i < 4; ++i) { const int ch = lt + i * 256, v = ch >> 3, c8 = ch & 7; vc[i] = *(const GAS v4u*)(VT + (size_t)(h_ * 128 + v) * M + m0_ + c8 * 8); sc[i] = *(const GAS v4u*)(SB + ((size_t)u_ * 128 + v) * 64 + c8 * 8); } } while (0)
    int pr = blockIdx.x;
    if (pr < 1024) GB_LOAD(pr);
#pragma unroll 1
    for (; pr < 1024; pr += F.G) {
        const int u = 2 * pr + U, bh = u >> 7, n = u & 127, b = bh >> 2, h = bh & 3, m0 = b * SEQ + n * 64;
#pragma unroll
        for (int i = 1; i < 8; ++i) a[i] += a[i - 1];
        *(LAS gb_f32x2*)(tot + seg * 64 + 2 * dp) = a[7];
#pragma unroll
        for (int i = 0; i < 4; ++i) { const int ch = lt + i * 256, v = ch >> 3, c8 = ch & 7; *(LAS v4u*)(Vt + v * GL_STR + c8 * 16) = vc[i]; *(LAS v4u*)(Sb + v * GL_STR + c8 * 16) = sc[i]; }
        __syncthreads();
        { gb_f32x2 off = (gb_f32x2){0.f, 0.f}, bmid = (gb_f32x2){0.f, 0.f};
#pragma unroll
            for (int s2 = 0; s2 < 7; ++s2) { const gb_f32x2 t = *(const LAS gb_f32x2*)(tot + s2 * 64 + 2 * dp); if (s2 < seg) off += t; if (s2 < 4) bmid += t; }
#pragma unroll
            for (int i = 0; i < 8; ++i) { const int c = seg * 8 + i; const gb_f32x2 bb = off + a[i];
                *(LAS unsigned*)(Qe + c * GL_STR + dp * 4) = mb_cvt_pk(bflo(q2[i]) * __expf(bb.x - bmid.x), bfhi(q2[i]) * __expf(bb.y - bmid.y));
                *(LAS unsigned*)(Ke + c * GL_STR + dp * 4) = mb_cvt_pk(bflo(k2[i]) * __expf(bmid.x - bb.x), bfhi(k2[i]) * __expf(bmid.y - bb.y)); } }
        __syncthreads();
        if (pr + F.G < 1024) GB_LOAD(pr + F.G);
        {
            const size_t mrow = (size_t)(m0 + ct * 16 + lq) * 512 + h * 128;
            mb_u32x2 srv[8];
#pragma unroll
            for (int vt = 0; vt < 8; ++vt) srv[vt] = *(const GAS mb_u32x2*)(SR + mrow + vt * 16 + 4 * g);
            mb_bf16x8 bq[2];
#pragma unroll
            for (int ks = 0; ks < 2; ++ks) bq[ks] = *(const LAS mb_bf16x8*)(Qe + (ct * 16 + lq) * GL_STR + ks * 64 + g * 16);
            f32x4 sa[4];
#pragma unroll
            for (int st = 0; st < 4; ++st) { sa[st] = (f32x4){0.f, 0.f, 0.f, 0.f};
                if (st <= ct) {
#pragma unroll
                    for (int ks = 0; ks < 2; ++ks) { const mb_bf16x8 af = *(const LAS mb_bf16x8*)(Ke + (st * 16 + lq) * GL_STR + ks * 64 + g * 16); sa[st] = __builtin_amdgcn_mfma_f32_16x16x32_bf16(af, bq[ks], sa[st], 0, 0, 0); }
                    if (st == ct) {
#pragma unroll
                        for (int r = 0; r < 4; ++r) if (4 * g + r > lq) sa[st][r] = 0.f; } } }
            mb_bf16x8 pb[2];
#pragma unroll
            for (int kp = 0; kp < 2; ++kp) { v4u pw; pw.x = mb_cvt_pk(sa[2 * kp][0], sa[2 * kp][1]); pw.y = mb_cvt_pk(sa[2 * kp][2], sa[2 * kp][3]); pw.z = mb_cvt_pk(sa[2 * kp + 1][0], sa[2 * kp + 1][1]); pw.w = mb_cvt_pk(sa[2 * kp + 1][2], sa[2 * kp + 1][3]); pb[kp] = __builtin_bit_cast(mb_bf16x8, pw); }
            f32x4 o[8]; float ss = 0.f;
#pragma unroll
            for (int vt = 0; vt < 8; ++vt) { o[vt] = (f32x4){0.f, 0.f, 0.f, 0.f};
#pragma unroll
                for (int kp = 0; kp < 2; ++kp) if (2 * kp <= ct) { const mb_u32x2 a0 = *(const LAS mb_u32x2*)(Vt + (vt * 16 + lq) * GL_STR + kp * 64 + g * 8), a1 = *(const LAS mb_u32x2*)(Vt + (vt * 16 + lq) * GL_STR + kp * 64 + 32 + g * 8);
                    v4u aw; aw.x = a0.x; aw.y = a0.y; aw.z = a1.x; aw.w = a1.y; o[vt] = __builtin_amdgcn_mfma_f32_16x16x32_bf16(__builtin_bit_cast(mb_bf16x8, aw), pb[kp], o[vt], 0, 0, 0); }
#pragma unroll
                for (int ks = 0; ks < 2; ++ks) { const mb_bf16x8 af = *(const LAS mb_bf16x8*)(Sb + (vt * 16 + lq) * GL_STR + ks * 64 + g * 16); o[vt] = __builtin_amdgcn_mfma_f32_16x16x32_bf16(af, bq[ks], o[vt], 0, 0, 0); }
                ss += (o[vt][0] * o[vt][0] + o[vt][1] * o[vt][1]) + (o[vt][2] * o[vt][2] + o[vt][3] * o[vt][3]); }
            ss += __shfl_xor(ss, 16); ss += __shfl_xor(ss, 32);
            const float rs = rsqrtf(ss * (1.f / 128.f) + EPS);
#pragma unroll
            for (int vt = 0; vt < 8; ++vt) { const int v = vt * 16 + 4 * g; const f32x4 gv = *(const GAS f32x4*)(gg + h * 128 + v); const mb_u32x2 sr = srv[vt];
                mb_u32x2 w; w.x = mb_cvt_pk(o[vt][0] * rs * gv[0] * bflo(sr.x), o[vt][1] * rs * gv[1] * bfhi(sr.x)); w.y = mb_cvt_pk(o[vt][2] * rs * gv[2] * bflo(sr.y), o[vt][3] * rs * gv[3] * bfhi(sr.y));
                *(GAS mb_u32x2*)(OG + (size_t)(m0 + ct * 16 + lq) * 1024 + h * 128 + v) = w; } }
        __syncthreads();
    }
#undef GB_LOAD
}

__device__ __forceinline__ int list_off(int j) { return 256 * (31 * j - (j * (j - 1)) / 2); }
__device__ __forceinline__ void moba_kmean_phase(Frame& F) {
    PHASE_IDS;
    float* lf = (float*)(F.ldsg + RING_OFF); float* part = lf; float* pmx = lf + 512;
    const bf16* KM = (const bf16*)(F.ws + WS_KM); float* kmean = (float*)(F.ws + WS_KMEAN); float* knmax = (float*)(F.ws + WS_KNMAX);
    const int c8 = tid & 7, r0 = tid >> 3;
#pragma unroll 1
    for (int u = blockIdx.x; u < 1024; u += F.G) { const int bh = u >> 5, j = u & 31, b = bh >> 3, h = bh & 7; const size_t m0 = (size_t)b * SEQ + j * 256;
        v4u w[4];
#pragma unroll
        for (int i = 0; i < 4; ++i) w[i] = *(const GAS v4u*)(KM + (m0 + r0 + 64 * i) * 512 + h * 64 + c8 * 8);
        float acc[8]; float mx = 0.f;
#pragma unroll
        for (int e = 0; e < 8; ++e) acc[e] = 0.f;
#pragma unroll
        for (int i = 0; i < 4; ++i) { float f[8]; unpack8(w[i], f); float q = 0.f;
#pragma unroll
            for (int e = 0; e < 8; ++e) { acc[e] += f[e]; q += f[e] * f[e]; }
            q += __shfl_xor(q, 1); q += __shfl_xor(q, 2); q += __shfl_xor(q, 4); mx = fmaxf(mx, q); }
#pragma unroll
        for (int e = 0; e < 8; ++e) { acc[e] += __shfl_xor(acc[e], 8); acc[e] += __shfl_xor(acc[e], 16); acc[e] += __shfl_xor(acc[e], 32); }
        mx = wave_max(mx);
        if (lane < 8) {
#pragma unroll
            for (int e = 0; e < 8; ++e) part[wave * 64 + lane * 8 + e] = acc[e]; }
        if (lane == 0) pmx[wave] = mx;
        __syncthreads();
        if (tid < 64) { float t = 0.f;
#pragma unroll
            for (int w2 = 0; w2 < 8; ++w2) t += part[w2 * 64 + tid];
            kmean[u * 64 + tid] = t * (1.f / 256.f); }
        if (tid == 0) { float t = 0.f;
#pragma unroll
            for (int w2 = 0; w2 < 8; ++w2) t = fmaxf(t, pmx[w2]);
            knmax[u] = sqrtf(t); }
        __syncthreads();
    }
}
__device__ __forceinline__ void moba_gate_phase(Frame& F, const Args& A) {
    PHASE_IDS;
    LAS unsigned char* kmh = F.lds + RING_OFF; LAS unsigned char* kml = kmh + 32 * 144;
    float* lf = (float*)(F.ldsg + RING_OFF + 2 * 32 * 144); float* knm = lf; unsigned* hist = (unsigned*)(lf + 32); unsigned* hbase = hist + 32;
    const bf16* QM = (const bf16*)(F.ws + WS_QM); const float* kmean = (const float*)(F.ws + WS_KMEAN); const float* knmax = (const float*)(F.ws + WS_KNMAX);
    unsigned* SEL = (unsigned*)(F.ws + WS_SEL); float* REFS = (float*)(F.ws + WS_REFS); unsigned* LISTS = (unsigned*)(F.ws + WS_LISTS); const float* rb = A.in[3];
    const int lq = lane & 15, g = lane >> 4;
#pragma unroll 1
    for (int u = blockIdx.x, kk = 0; u < 1024; u += F.G, ++kk) { const int bh = u >> 5, qx = (kk & 2) ? ((u & 31) + 16) & 31 : (u & 31), qb = (kk & 1) ? 31 - qx : qx, b = bh >> 3, h = bh & 7;
        { const int j = tid >> 4, c4 = (tid & 15) * 4; const f32x4 v = *(const GAS f32x4*)(kmean + bh * 2048 + j * 64 + c4);
            const unsigned h0 = f2bf(v[0]), h1 = f2bf(v[1]), h2 = f2bf(v[2]), h3 = f2bf(v[3]);
            *(LAS mb_u32x2*)(kmh + j * 144 + c4 * 2) = (mb_u32x2){h0 | (h1 << 16), h2 | (h3 << 16)};
            *(LAS mb_u32x2*)(kml + j * 144 + c4 * 2) = (mb_u32x2){pk2(v[0] - __uint_as_float(h0 << 16), v[1] - __uint_as_float(h1 << 16)), pk2(v[2] - __uint_as_float(h2 << 16), v[3] - __uint_as_float(h3 << 16))}; }
        if (tid < 32) { knm[tid] = knmax[bh * 32 + tid]; hist[tid] = 0u; }
        __syncthreads();
        float bmx = rb[h];
#pragma unroll 1
        for (int k = 1; k < 32; ++k) bmx = fmaxf(bmx, rb[k * 8 + h]);
        const int nsel = qb < 3 ? qb : 3;
        int sel0[2], sel1[2], sel2[2]; unsigned rk0[2], rk1[2], rk2[2];
#pragma unroll
        for (int qt = 0; qt < 2; ++qt) { const int qi = (wave * 2 + qt) * 16 + lq, t = qb * 256 + qi; const size_t m = (size_t)b * SEQ + t;
            mb_bf16x8 qf[2]; qf[0] = *(const GAS mb_bf16x8*)(QM + m * 512 + h * 64 + 8 * g); qf[1] = *(const GAS mb_bf16x8*)(QM + m * 512 + h * 64 + 32 + 8 * g);
            float qn = 0.f;
#pragma unroll
            for (int ks = 0; ks < 2; ++ks) { const v4u w = __builtin_bit_cast(v4u, qf[ks]); float f[8]; unpack8(w, f);
#pragma unroll
                for (int e = 0; e < 8; ++e) qn += f[e] * f[e]; }
            qn += __shfl_xor(qn, 16); qn += __shfl_xor(qn, 32); qn = sqrtf(qn);
            f32x4 sc[2];
#pragma unroll
            for (int jt = 0; jt < 2; ++jt) { sc[jt] = (f32x4){0.f, 0.f, 0.f, 0.f};
#pragma unroll
                for (int ks = 0; ks < 2; ++ks) { const mb_bf16x8 ah = *(const LAS mb_bf16x8*)(kmh + (jt * 16 + lq) * 144 + ks * 64 + g * 16), al = *(const LAS mb_bf16x8*)(kml + (jt * 16 + lq) * 144 + ks * 64 + g * 16);
                    sc[jt] = __builtin_amdgcn_mfma_f32_16x16x32_bf16(ah, qf[ks], sc[jt], 0, 0, 0); sc[jt] = __builtin_amdgcn_mfma_f32_16x16x32_bf16(al, qf[ks], sc[jt], 0, 0, 0); } }
            float v0 = -INFINITY, v1 = -INFINITY, v2 = -INFINITY; int i0 = 0, i1 = 0, i2 = 0;
#define TOP3_INS(G_, J_) do { const float g_ = (G_); const int j_ = (J_); if (g_ > v0) { v2 = v1; i2 = i1; v1 = v0; i1 = i0; v0 = g_; i0 = j_; } else if (g_ > v1) { v2 = v1; i2 = i1; v1 = g_; i1 = j_; } else if (g_ > v2) { v2 = g_; i2 = j_; } } while (0)
#pragma unroll
            for (int jt = 0; jt < 2; ++jt)
#pragma unroll
                for (int r = 0; r < 4; ++r) { const int j = jt * 16 + 4 * g + r; const float gv = j < qb ? sc[jt][r] : -INFINITY; TOP3_INS(gv, j); }
#pragma unroll
            for (int mk = 16; mk <= 32; mk <<= 1) { const float p0 = __shfl_xor(v0, mk), p1 = __shfl_xor(v1, mk), p2 = __shfl_xor(v2, mk); const int j0 = __shfl_xor(i0, mk), j1 = __shfl_xor(i1, mk), j2 = __shfl_xor(i2, mk);
                TOP3_INS(p0, j0); TOP3_INS(p1, j1); TOP3_INS(p2, j2); }
#undef TOP3_INS
            sel0[qt] = i0; sel1[qt] = i1; sel2[qt] = i2; rk0[qt] = 0; rk1[qt] = 0; rk2[qt] = 0;
            if (g == 0) {
                float kx = knm[qb]; if (nsel > 0) kx = fmaxf(kx, knm[i0]); if (nsel > 1) kx = fmaxf(kx, knm[i1]); if (nsel > 2) kx = fmaxf(kx, knm[i2]);
                SEL[m * 8 + h] = (unsigned)i0 | ((unsigned)i1 << 5) | ((unsigned)i2 << 10) | ((unsigned)nsel << 15);
                REFS[m * 8 + h] = qn * kx + bmx * 1.4426950408889634f;
                if (nsel > 0) rk0[qt] = __hip_atomic_fetch_add(hist + i0, 1u, __ATOMIC_RELAXED, __HIP_MEMORY_SCOPE_WORKGROUP);
                if (nsel > 1) rk1[qt] = __hip_atomic_fetch_add(hist + i1, 1u, __ATOMIC_RELAXED, __HIP_MEMORY_SCOPE_WORKGROUP);
                if (nsel > 2) rk2[qt] = __hip_atomic_fetch_add(hist + i2, 1u, __ATOMIC_RELAXED, __HIP_MEMORY_SCOPE_WORKGROUP); } }
        __syncthreads();
        if (tid < qb) { const unsigned c = hist[tid]; hbase[tid] = c ? atomicAdd((unsigned*)(F.ctl + CW_LCNT) + bh * 32 + tid, c) : 0u; }
        __syncthreads();
        if (g == 0) { unsigned* lb = LISTS + (size_t)bh * LIST_CAP;
#pragma unroll
            for (int qt = 0; qt < 2; ++qt) { const unsigned tq = (unsigned)(qb * 256 + (wave * 2 + qt) * 16 + lq);
                if (nsel > 0) lb[list_off(sel0[qt]) + hbase[sel0[qt]] + rk0[qt]] = (tq << 2);
                if (nsel > 1) lb[list_off(sel1[qt]) + hbase[sel1[qt]] + rk1[qt]] = (tq << 2) | 1u;
                if (nsel > 2) lb[list_off(sel2[qt]) + hbase[sel2[qt]] + rk2[qt]] = (tq << 2) | 2u; } }
        __syncthreads();
    }
}
constexpr size_t PARTO_N1 = 524288;
constexpr int MB_KSTR = 144, MB_VSTR = 528, MB_KBYTES = 256 * MB_KSTR, MB_VBYTES = 80 * MB_VSTR, MB_TABX = MB_KBYTES + MB_VBYTES, MB_TABN = 768;
static_assert(MB_TABX + MB_TABN * 4 <= RING_BYTES, "MoBA LDS");
__device__ __forceinline__ void moba_stage_const(int tid, LAS unsigned char* Vl) {
    for (int i = tid; i < 16 * 32; i += NTHR) { const int r = i >> 5, c = i & 31; const unsigned w = r == 0 ? 0x3f803f80u : 0u; *(LAS v4u*)(Vl + (64 + r) * MB_VSTR + c * 16) = (v4u){w, w, w, w}; }
}
__device__ __forceinline__ void moba_stage_kv(Frame& F, int tid, const Args& A, int b, int h, int j, LAS unsigned char* Kl, LAS unsigned char* Vl, LAS float* tabx) {
    const bf16* KM = (const bf16*)(F.ws + WS_KM); const bf16* VT = (const bf16*)(F.ws + WS_VT);
    const size_t mk = (size_t)b * SEQ + j * 256;
    v4u kv[4], vv[4]; float tb[2];
#pragma unroll
    for (int i = 0; i < 4; ++i) { const int ch = tid + i * NTHR, key = ch >> 3, c = ch & 7; kv[i] = *(const GAS v4u*)(KM + (mk + key) * 512 + h * 64 + c * 8); }
#pragma unroll
    for (int i = 0; i < 4; ++i) { const int ch = tid + i * NTHR, d = ch >> 5, c = ch & 31; vv[i] = *(const GAS v4u*)(VT + (size_t)(512 + h * 64 + d) * M + mk + c * 8); }
#pragma unroll
    for (int i = 0; i < 2; ++i) { const int idx = tid + i * NTHR, dist = idx - 255; tb[i] = (idx < MB_TABN && dist >= 0) ? A.in[3][t5_bucket(dist < 127 ? dist : 127) * 8 + h] * 1.4426950408889634f : -INFINITY; }
#pragma unroll
    for (int i = 0; i < 4; ++i) { const int ch = tid + i * NTHR, key = ch >> 3, c = ch & 7; *(LAS v4u*)(Kl + key * MB_KSTR + c * 16) = kv[i]; }
#pragma unroll
    for (int i = 0; i < 4; ++i) { const int ch = tid + i * NTHR, d = ch >> 5, c = ch & 31; *(LAS v4u*)(Vl + d * MB_VSTR + c * 16) = vv[i]; }
#pragma unroll
    for (int i = 0; i < 2; ++i) { const int idx = tid + i * NTHR; if (idx < MB_TABN) tabx[idx] = tb[i]; }
}
template <int NG>
__device__ __forceinline__ void moba_groups(const LAS unsigned char* Kl, const LAS unsigned char* Vl, const LAS float* tabx, const mb_bf16x8 (&qf)[NG][2], const float (&ref)[NG], const int (&qrel)[NG],
                                            const int (&ntile)[NG], const bool (&far)[NG], f32x4 (&o)[NG][5], int lane) {
    const int lq = lane & 15, g = lane >> 4;
    int nmax = ntile[0];
#pragma unroll
    for (int gi = 1; gi < NG; ++gi) nmax = ntile[gi] > nmax ? ntile[gi] : nmax;
    const LAS unsigned char* kp = Kl + lq * MB_KSTR + g * 16;
    const LAS unsigned char* vp = Vl + lq * MB_VSTR + g * 8;
#pragma unroll
    for (int hf = 0; hf < 2; ++hf) { if (8 * hf < nmax) {
        f32x4 sa[NG][8];
#pragma unroll
        for (int gi = 0; gi < NG; ++gi) {
            if (far[gi]) { const float c = tabx[255 + 127] - ref[gi];
#pragma unroll
                for (int t = 0; t < 8; ++t) sa[gi][t] = (f32x4){c, c, c, c}; }
            else { const int qc = qrel[gi] < 511 ? qrel[gi] : 511; const LAS float* lb = tabx + (qc - 4 * g + 12);
#pragma unroll
                for (int t = 0; t < 8; ++t) { sa[gi][t] = (f32x4){0.f, 0.f, 0.f, 0.f};
                    if (8 * hf + t < ntile[gi]) {
#pragma unroll
                        for (int r = 0; r < 4; ++r) sa[gi][t][r] = lb[243 - 16 * (8 * hf + t) - r] - ref[gi]; } } } }
#pragma unroll
        for (int t = 0; t < 8; ++t) { const int T = 8 * hf + t; if (T < nmax) {
                const mb_bf16x8 k0 = *(const LAS mb_bf16x8*)(kp + T * 16 * MB_KSTR), k1 = *(const LAS mb_bf16x8*)(kp + T * 16 * MB_KSTR + 64);
#pragma unroll
                for (int gi = 0; gi < NG; ++gi) if (T < ntile[gi]) { sa[gi][t] = __builtin_amdgcn_mfma_f32_16x16x32_bf16(k0, qf[gi][0], sa[gi][t], 0, 0, 0); sa[gi][t] = __builtin_amdgcn_mfma_f32_16x16x32_bf16(k1, qf[gi][1], sa[gi][t], 0, 0, 0); } } }
#pragma unroll
        for (int gi = 0; gi < NG; ++gi)
#pragma unroll
            for (int t = 0; t < 8; ++t) { if (8 * hf + t < ntile[gi]) {
#pragma unroll
                    for (int r = 0; r < 4; ++r) sa[gi][t][r] = __builtin_amdgcn_exp2f(sa[gi][t][r]); } }
#pragma unroll
        for (int k2 = 0; k2 < 4; ++k2) { const int ks = 4 * hf + k2; if (2 * ks < nmax) {
                mb_bf16x8 pb[NG];
#pragma unroll
                for (int gi = 0; gi < NG; ++gi) { v4u pw; pw.x = mb_cvt_pk(sa[gi][2 * k2][0], sa[gi][2 * k2][1]); pw.y = mb_cvt_pk(sa[gi][2 * k2][2], sa[gi][2 * k2][3]); pw.z = mb_cvt_pk(sa[gi][2 * k2 + 1][0], sa[gi][2 * k2 + 1][1]); pw.w = mb_cvt_pk(sa[gi][2 * k2 + 1][2], sa[gi][2 * k2 + 1][3]); pb[gi] = __builtin_bit_cast(mb_bf16x8, pw); }
#pragma unroll
                for (int dt = 0; dt < 5; ++dt) { const mb_u32x2 a0 = *(const LAS mb_u32x2*)(vp + dt * 16 * MB_VSTR + ks * 64), a1 = *(const LAS mb_u32x2*)(vp + dt * 16 * MB_VSTR + ks * 64 + 32);
                    v4u aw; aw.x = a0.x; aw.y = a0.y; aw.z = a1.x; aw.w = a1.y; const mb_bf16x8 af = __builtin_bit_cast(mb_bf16x8, aw);
#pragma unroll
                    for (int gi = 0; gi < NG; ++gi) if (2 * ks < ntile[gi]) o[gi][dt] = __builtin_amdgcn_mfma_f32_16x16x32_bf16(af, pb[gi], o[gi][dt], 0, 0, 0); } } } } }
}
__device__ __forceinline__ void moba_part_phase(Frame& F, const Args& A, int wq_word) {
    PHASE_IDS;
    LAS unsigned char* Kl = F.lds + RING_OFF; LAS unsigned char* Vl = Kl + MB_KBYTES; LAS float* tabx = (LAS float*)(F.lds + RING_OFF + MB_TABX); volatile LAS int* bc = (volatile LAS int*)(F.lds + TBL_BC);
    const bf16* QM = (const bf16*)(F.ws + WS_QM); const float* REFS = (const float*)(F.ws + WS_REFS); const unsigned* LISTS = (const unsigned*)(F.ws + WS_LISTS);
    bf16* PARTO0 = (bf16*)((unsigned char*)F.out + DO_PARTO); bf16* PARTO1 = (bf16*)(F.ws + WS_XB); float* PARTL = (float*)(F.ws + WS_PARTL);
    const int lq = lane & 15, g = lane >> 4;
    moba_stage_const(tid, Vl);
#pragma unroll 1
    for (;;) {
        PB(5); PB(8);
        if (tid == 0) bc[0] = (int)atomicAdd((unsigned*)(F.ctl + wq_word), 1u);
        __syncthreads();
        const int u = __builtin_amdgcn_readfirstlane(bc[0]);
        __syncthreads();
        if (u >= 31 * 32) break;
        const int j = u >> 5, bh = u & 31, b = bh >> 3, h = bh & 7;
        const int n = __builtin_amdgcn_readfirstlane((int)__hip_atomic_load((unsigned*)(F.ctl + CW_LCNT) + bh * 32 + j, RLX_AGENT));
        moba_stage_kv(F, tid, A, b, h, j, Kl, Vl, tabx);
        __syncthreads(); PE(5); PB(6);
        const unsigned* lst = LISTS + (size_t)bh * LIST_CAP + list_off(j);
#define MB_IDX(G_) (((G_) * 16 + lq < n) ? (G_) * 16 + lq : (((G_) * 16 < n) ? (G_) * 16 : 0))
#define MB_LOADQ(E_, Q_, R_) do { const size_t m_ = (size_t)b * SEQ + ((E_) >> 2); const bf16* qrow_ = QM + m_ * 512 + h * 64; Q_[0] = *(const GAS mb_bf16x8*)(qrow_ + 8 * g); Q_[1] = *(const GAS mb_bf16x8*)(qrow_ + 32 + 8 * g); R_ = REFS[m_ * 8 + h]; } while (0)
        int pr = wave;
        if (pr * 32 < n) {
            unsigned ea[2];
            ea[0] = lst[MB_IDX(2 * pr)]; ea[1] = lst[MB_IDX(2 * pr + 1)];
#pragma unroll 1
            for (;;) {
                unsigned eb[2]; eb[0] = lst[MB_IDX(2 * pr + 2 * NWAVES)]; eb[1] = lst[MB_IDX(2 * pr + 2 * NWAVES + 1)];
                mb_bf16x8 qa[2][2]; float ra[2];
                MB_LOADQ(ea[0], qa[0], ra[0]); MB_LOADQ(ea[1], qa[1], ra[1]);
                int qrel[2], nt[2]; bool far[2];
#pragma unroll
                for (int gi = 0; gi < 2; ++gi) { qrel[gi] = (int)(ea[gi] >> 2) - j * 256; far[gi] = __all(qrel[gi] - 255 >= 113); nt[gi] = ((2 * pr + gi) * 16 < n) ? 16 : 0; }
                f32x4 o[2][5];
#pragma unroll
                for (int gi = 0; gi < 2; ++gi)
#pragma unroll
                    for (int dt = 0; dt < 5; ++dt) o[gi][dt] = (f32x4){0.f, 0.f, 0.f, 0.f};
                if (PROBE_ACC == 9 || PROBE_ACC == 10) asm volatile("s_waitcnt vmcnt(0)" ::: "memory"); PB(9); moba_groups<2>(Kl, Vl, tabx, qa, ra, qrel, nt, far, o, lane); PE(9);
#pragma unroll
                for (int gi = 0; gi < 2; ++gi) { if ((2 * pr + gi) * 16 + lq < n) { const size_t m = (size_t)b * SEQ + (ea[gi] >> 2); const size_t pi = (m * 8 + h) * 3 + (ea[gi] & 3u); if (g == 0) PARTL[pi] = o[gi][4][0];
#pragma unroll
                        for (int dt = 0; dt < 4; ++dt) { mb_u32x2 w; w.x = mb_cvt_pk(o[gi][dt][0], o[gi][dt][1]); w.y = mb_cvt_pk(o[gi][dt][2], o[gi][dt][3]); *(GAS mb_u32x2*)((pi < PARTO_N1 ? PARTO0 + pi * 64 : PARTO1 + (pi - PARTO_N1) * 64) + dt * 16 + g * 4) = w; } } }
                pr += NWAVES; if (pr * 32 >= n) break;
                ea[0] = eb[0]; ea[1] = eb[1];
            }
        }
#undef MB_IDX
        PE(6); PB(7);
        __syncthreads(); PE(7); PE(8);
    }
}
__device__ __forceinline__ void moba_own_phase(Frame& F, const Args& A, bf16* OUT) {
    PHASE_IDS;
    LAS unsigned char* Kl = F.lds + RING_OFF; LAS unsigned char* Vl = Kl + MB_KBYTES; LAS float* tabx = (LAS float*)(F.lds + RING_OFF + MB_TABX);
    const bf16* QM = (const bf16*)(F.ws + WS_QM); const float* REFS = (const float*)(F.ws + WS_REFS);
    const bf16* PARTO0 = (const bf16*)((unsigned char*)F.out + DO_PARTO); const bf16* PARTO1 = (const bf16*)(F.ws + WS_XB); const float* PARTL = (const float*)(F.ws + WS_PARTL);
    const int lq = lane & 15, g = lane >> 4;
    moba_stage_const(tid, Vl);
#pragma unroll 1
    for (int u = blockIdx.x; u < 1024; u += F.G) { const int bh = u >> 5, qb = u & 31, b = bh >> 3, h = bh & 7; const int nsel = qb < 3 ? qb : 3;
        PB(1); PB(4); moba_stage_kv(F, tid, A, b, h, qb, Kl, Vl, tabx);
        int grp[2] = {wave, 15 - wave}; size_t mq[2]; mb_bf16x8 qa[2][2]; float ra[2];
#pragma unroll
        for (int gi = 0; gi < 2; ++gi) { mq[gi] = (size_t)b * SEQ + qb * 256 + grp[gi] * 16 + lq; MB_LOADQ(((unsigned)(qb * 256 + grp[gi] * 16 + lq)) << 2, qa[gi], ra[gi]); }
        float pl[2][3]; mb_u32x2 po[2][3][4];
#pragma unroll
        for (int gi = 0; gi < 2; ++gi)
#pragma unroll
            for (int r = 0; r < 3; ++r) { pl[gi][r] = 0.f;
#pragma unroll
                for (int dt = 0; dt < 4; ++dt) po[gi][r][dt] = (mb_u32x2){0u, 0u};
                if (r < nsel) { const size_t pi = (mq[gi] * 8 + h) * 3 + r; pl[gi][r] = PARTL[pi];
#pragma unroll
                    for (int dt = 0; dt < 4; ++dt) po[gi][r][dt] = *(const GAS mb_u32x2*)((pi < PARTO_N1 ? PARTO0 + pi * 64 : PARTO1 + (pi - PARTO_N1) * 64) + dt * 16 + g * 4); } }
        __syncthreads(); PE(1); PB(2);
        { int qrel[2], nt[2]; bool far[2];
#pragma unroll
            for (int gi = 0; gi < 2; ++gi) { qrel[gi] = grp[gi] * 16 + lq; nt[gi] = grp[gi] + 1; far[gi] = false; }
            f32x4 o[2][5];
#pragma unroll
            for (int gi = 0; gi < 2; ++gi)
#pragma unroll
                for (int dt = 0; dt < 5; ++dt) o[gi][dt] = (f32x4){0.f, 0.f, 0.f, 0.f};
            moba_groups<2>(Kl, Vl, tabx, qa, ra, qrel, nt, far, o, lane); PE(2); PB(3);
#pragma unroll
            for (int gi = 0; gi < 2; ++gi) { float l = __shfl(o[gi][4][0], lq);
#pragma unroll
                for (int r = 0; r < 3; ++r) { l += pl[gi][r];
#pragma unroll
                    for (int dt = 0; dt < 4; ++dt) { o[gi][dt][0] += bflo(po[gi][r][dt].x); o[gi][dt][1] += bfhi(po[gi][r][dt].x); o[gi][dt][2] += bflo(po[gi][r][dt].y); o[gi][dt][3] += bfhi(po[gi][r][dt].y); } }
                const float il = 1.f / l;
#pragma unroll
                for (int dt = 0; dt < 4; ++dt) { mb_u32x2 w; w.x = mb_cvt_pk(o[gi][dt][0] * il, o[gi][dt][1] * il); w.y = mb_cvt_pk(o[gi][dt][2] * il, o[gi][dt][3] * il); *(GAS mb_u32x2*)(OUT + mq[gi] * 1024 + 512 + h * 64 + dt * 16 + g * 4) = w; } } }
        PE(3);
        __syncthreads(); PE(4);
    }
#undef MB_LOADQ
}
constexpr int MA_KSTR = 272, MA_VSTR = 528, MA_KBYTES = 256 * MA_KSTR, MA_VBYTES = 128 * MA_VSTR;
static_assert(MA_KBYTES + MA_VBYTES <= RING_BYTES, "mem-attn LDS");
__device__ __forceinline__ void memattn_phase(Frame& F, bf16* OUT) {
    PHASE_IDS;
    LAS unsigned char* Kl = F.lds + RING_OFF; LAS unsigned char* Vl = Kl + MA_KBYTES;
    bf16* QC = (bf16*)(F.ws + WS_QC); const float* SS1 = (const float*)(F.ws + WS_SS1); const bf16* MK = (const bf16*)(F.ws + WS_MKV); const bf16* MVT = MK + 1024 * 512;
    const int lq = lane & 15, g = lane >> 4;
    const int per = (512 + F.G - 1) / F.G; int staged = -1;
#pragma unroll 1
    for (int u = blockIdx.x * per; u < blockIdx.x * per + per && u < 512; ++u) { const int qt = u & 31, bhd = u >> 5, b = bhd >> 2, hd = bhd & 3;
        if (bhd != staged) { __syncthreads();
#pragma unroll
            for (int i = 0; i < 8; ++i) { const int ch = tid + i * NTHR, key = ch >> 4, c = ch & 15; *(LAS v4u*)(Kl + key * MA_KSTR + c * 16) = *(const GAS v4u*)(MK + (size_t)(b * 256 + key) * 512 + hd * 128 + c * 8); }
#pragma unroll
            for (int i = 0; i < 8; ++i) { const int ch = tid + i * NTHR, d = ch >> 5, c = ch & 31; *(LAS v4u*)(Vl + d * MA_VSTR + c * 16) = *(const GAS v4u*)(MVT + (size_t)(hd * 128 + d) * 1024 + b * 256 + c * 8); }
            staged = bhd; __syncthreads(); }
#pragma unroll 1
        for (int grp = wave; grp < 16; grp += NWAVES) {
            const size_t m = (size_t)b * SEQ + qt * 256 + grp * 16 + lq; bf16* qrow = QC + m * 512 + hd * 128;
            mb_bf16x8 qf[4];
#pragma unroll
            for (int s = 0; s < 4; ++s) qf[s] = *(const GAS mb_bf16x8*)(qrow + 32 * s + 8 * g);
            f32x4 sa[16]; const LAS unsigned char* kp = Kl + lq * MA_KSTR + g * 16;
#pragma unroll
            for (int t = 0; t < 16; ++t) { sa[t] = (f32x4){0.f, 0.f, 0.f, 0.f};
#pragma unroll
                for (int s = 0; s < 4; ++s) { const mb_bf16x8 kf = *(const LAS mb_bf16x8*)(kp + t * 16 * MA_KSTR + s * 64); sa[t] = __builtin_amdgcn_mfma_f32_16x16x32_bf16(kf, qf[s], sa[t], 0, 0, 0); } }
            { float ssum = 0.f;
#pragma unroll
                for (int i = 0; i < 4; ++i) { const f32x4 p = *(const GAS f32x4*)(SS1 + m * 16 + 4 * i); ssum += (p[0] + p[1]) + (p[2] + p[3]); }
                const float rs1 = rsqrtf(ssum * (1.f / D) + EPS);
#pragma unroll
                for (int t = 0; t < 16; ++t) sa[t] = sa[t] * rs1; }
            float mx = -INFINITY;
#pragma unroll
            for (int t = 0; t < 16; ++t) mx = fmaxf(fmaxf(mx, fmaxf(sa[t][0], sa[t][1])), fmaxf(sa[t][2], sa[t][3]));
            mx = fmaxf(mx, __shfl_xor(mx, 16)); mx = fmaxf(mx, __shfl_xor(mx, 32));
            float l = 0.f;
#pragma unroll
            for (int t = 0; t < 16; ++t)
#pragma unroll
                for (int r = 0; r < 4; ++r) { const float p = __expf(sa[t][r] - mx); sa[t][r] = p; l += p; }
            l += __shfl_xor(l, 16); l += __shfl_xor(l, 32);
            f32x4 o[8];
#pragma unroll
            for (int dt = 0; dt < 8; ++dt) o[dt] = (f32x4){0.f, 0.f, 0.f, 0.f};
            const LAS unsigned char* vp = Vl + lq * MA_VSTR + g * 8;
#pragma unroll
            for (int ks = 0; ks < 8; ++ks) {
                v4u pw; pw.x = mb_cvt_pk(sa[2 * ks][0], sa[2 * ks][1]); pw.y = mb_cvt_pk(sa[2 * ks][2], sa[2 * ks][3]); pw.z = mb_cvt_pk(sa[2 * ks + 1][0], sa[2 * ks + 1][1]); pw.w = mb_cvt_pk(sa[2 * ks + 1][2], sa[2 * ks + 1][3]);
                const mb_bf16x8 pb = __builtin_bit_cast(mb_bf16x8, pw);
#pragma unroll
                for (int dt = 0; dt < 8; ++dt) { const mb_u32x2 a0 = *(const LAS mb_u32x2*)(vp + dt * 16 * MA_VSTR + ks * 64), a1 = *(const LAS mb_u32x2*)(vp + dt * 16 * MA_VSTR + ks * 64 + 32);
                    v4u aw; aw.x = a0.x; aw.y = a0.y; aw.z = a1.x; aw.w = a1.y;
                    o[dt] = __builtin_amdgcn_mfma_f32_16x16x32_bf16(__builtin_bit_cast(mb_bf16x8, aw), pb, o[dt], 0, 0, 0); } }
            const float il = 1.f / l;
#pragma unroll
            for (int dt = 0; dt < 8; ++dt) { mb_u32x2 w; w.x = mb_cvt_pk(o[dt][0] * il, o[dt][1] * il); w.y = mb_cvt_pk(o[dt][2] * il, o[dt][3] * il); *(GAS mb_u32x2*)(OUT + m * 512 + hd * 128 + dt * 16 + g * 4) = w; }
        }
    }
    __syncthreads();
}

template <bool SPLIT> __device__ __forceinline__ void rownorm_phase(Frame& F, bf16* dst, float* rstd) {
    PHASE_IDS;
    const int gw = F.vcu * NWAVES + wave, NGW = F.G * NWAVES; constexpr int LD = SPLIT ? 2048 : 1024;
    for (int m = gw; m < M; m += NGW) { const GAS f32x4* xr = (const GAS f32x4*)(F.out + (size_t)m * D) + lane; f32x4 v[4]; float s = 0.f;
#pragma unroll
        for (int j = 0; j < 4; ++j) { v[j] = xr[64 * j]; s += (v[j].x * v[j].x + v[j].y * v[j].y) + (v[j].z * v[j].z + v[j].w * v[j].w); }
        s = wave_sum(s); if (lane == 0) rstd[m] = rsqrtf(s * (1.f / D) + EPS);
        GAS unsigned long long* o8 = (GAS unsigned long long*)(dst + (size_t)m * LD) + lane;
#pragma unroll
        for (int j = 0; j < 4; ++j) { const unsigned h0 = f2bf(v[j].x), h1 = f2bf(v[j].y), h2 = f2bf(v[j].z), h3 = f2bf(v[j].w);
            o8[64 * j] = (unsigned long long)(h0 | (h1 << 16)) | ((unsigned long long)(h2 | (h3 << 16)) << 32);
            if (SPLIT) o8[256 + 64 * j] = (unsigned long long)pk2(v[j].x - __uint_as_float(h0 << 16), v[j].y - __uint_as_float(h1 << 16)) | ((unsigned long long)pk2(v[j].z - __uint_as_float(h2 << 16), v[j].w - __uint_as_float(h3 << 16)) << 32); } }
}
constexpr int RCH = 128, NCH = M / RCH;
__device__ __forceinline__ void route_phase(Frame& F, const Args& A) {
    PHASE_IDS;
    const float* LG = (const float*)(F.ws + WS_LG); const float* LG2 = (const float*)(F.ws + WS_LG2); const float* SS2 = (const float*)(F.ws + WS_SS2); float* rstd2 = (float*)(F.ws + WS_RSTD2); const float* brg = A.in[18]; const float* bre = A.in[20];
    int* ME = (int*)(F.ws + WS_MOE_E); int* MP = (int*)(F.ws + WS_MOE_POS); float* MW = (float*)(F.ws + WS_MOE_W); unsigned* CNT = (unsigned*)(F.ws + WS_TILE_E);
    unsigned* hist = (unsigned*)(F.ldsg + RING_OFF);
#pragma unroll 1
    for (int ch = blockIdx.x; ch < NCH; ch += F.G) {
        if (tid < 32) hist[tid] = 0u;
        __syncthreads();
        if (tid < RCH) { const int m = ch * RCH + tid; float ssum = 0.f;
#pragma unroll
            for (int i = 0; i < 4; ++i) { const f32x4 p = *(const GAS f32x4*)(SS2 + (size_t)m * 16 + 4 * i); ssum += (p[0] + p[1]) + (p[2] + p[3]); }
            const float rs = rsqrtf(ssum * (1.f / D) + EPS); rstd2[m] = rs; const float* lg = LG + (size_t)m * 72; const float* lg2 = LG2 + (size_t)m * 36;
            float gl[4]; int grp = 0; float gmx = -INFINITY;
#pragma unroll
            for (int o = 0; o < 4; ++o) { gl[o] = (lg[o] + lg[36 + o] + lg2[o]) * rs + brg[o]; if (gl[o] > gmx) { gmx = gl[o]; grp = o; } }
            float gs = 0.f;
#pragma unroll
            for (int o = 0; o < 4; ++o) gs += __expf(gl[o] - gmx);
            const float pg = 1.f / gs;
            float el[8]; float emx = -INFINITY;
#pragma unroll
            for (int i = 0; i < 8; ++i) { el[i] = (lg[4 + grp * 8 + i] + lg[40 + grp * 8 + i] + lg2[4 + grp * 8 + i]) * rs + bre[grp * 8 + i]; emx = fmaxf(emx, el[i]); }
            float p0 = -1.f, p1 = -1.f; int i0 = 0, i1 = 0;
#pragma unroll
            for (int i = 0; i < 8; ++i) { const float p = __expf(el[i] - emx); if (p > p0) { p1 = p0; i1 = i0; p0 = p; i0 = i; } else if (p > p1) { p1 = p; i1 = i; } }
            const float inv = pg / (p0 + p1);
            const int e0 = grp * 8 + i0, e1 = grp * 8 + i1;
            const unsigned q0 = __hip_atomic_fetch_add(hist + e0, 1u, __ATOMIC_RELAXED, __HIP_MEMORY_SCOPE_WORKGROUP), q1 = __hip_atomic_fetch_add(hist + e1, 1u, __ATOMIC_RELAXED, __HIP_MEMORY_SCOPE_WORKGROUP);
            ME[m * 2] = e0; ME[m * 2 + 1] = e1; MP[m * 2] = (int)q0; MP[m * 2 + 1] = (int)q1; MW[m * 2] = p0 * inv; MW[m * 2 + 1] = p1 * inv; }
        __syncthreads();
        if (tid < 32) CNT[ch * 32 + tid] = hist[tid];
        __syncthreads();
    }
}
__device__ __forceinline__ int moe_bases(Frame& F, int mych) {
    PHASE_IDS;
    volatile int* eb = (volatile int*)(F.ldsg + TBL_EB); volatile int* tl = (volatile int*)(F.ldsg + TBL_TILE); volatile int* part = (volatile int*)(F.ldsg + TBL_EB + 256);
    const unsigned* CNT = (const unsigned*)(F.ws + WS_TILE_E);
    { const int e = tid & 31, pt = tid >> 5; int s = 0, sp = 0;
#pragma unroll 1
        for (int c = pt * (NCH / 16); c < (pt + 1) * (NCH / 16); ++c) { const int v = (int)CNT[c * 32 + e]; s += v; if (c < mych) sp += v; }
        part[pt * 32 + e] = s; part[512 + pt * 32 + e] = sp; }
    __syncthreads();
    if (tid < 32) { int s = 0, sp = 0;
#pragma unroll
        for (int p = 0; p < 16; ++p) { s += part[p * 32 + tid]; sp += part[512 + p * 32 + tid]; }
        part[1024 + tid] = s; part[1056 + tid] = sp; }
    __syncthreads();
    if (tid == 0) { int base = 0;
        for (int e = 0; e < 32; ++e) { const int c = part[1024 + e]; eb[e] = base; const int nt = (c + 255) >> 8; for (int t = 0; t < nt; ++t) tl[(base >> 8) + t] = e; base += nt << 8; }
        eb[32] = base; }
    __syncthreads();
    return eb[32] >> 8;
}
__device__ __forceinline__ void moe_slot_phase(Frame& F) {
    PHASE_IDS;
    volatile int* eb = (volatile int*)(F.ldsg + TBL_EB); volatile int* part = (volatile int*)(F.ldsg + TBL_EB + 256);
    const int* ME = (const int*)(F.ws + WS_MOE_E); const int* MP = (const int*)(F.ws + WS_MOE_POS); const float* MW = (const float*)(F.ws + WS_MOE_W); int* SO = (int*)(F.ws + WS_SLOT_OF);
    float* WSL = (float*)(F.ws + WS_W_SLOT); float* RSL = (float*)(F.ws + WS_RSTD_SLOT); const float* rstd2 = (const float*)(F.ws + WS_RSTD2); int* TOK = (int*)(F.ws + WS_TOK);
#pragma unroll 1
    for (int ch = blockIdx.x; ch < NCH; ch += F.G) {
        (void)moe_bases(F, ch);
        if (ch < 32) { const int e = ch; for (int sl = eb[e] + part[1024 + e] + tid; sl < eb[e + 1]; sl += NTHR) { TOK[sl] = 0; WSL[sl] = 0.f; RSL[sl] = 1.f; } }
        if (tid < RCH * 2) { const int a = ch * RCH * 2 + tid, m = a >> 1; const int e = ME[a]; const int slot = eb[e] + part[1056 + e] + MP[a];
            SO[a] = slot; WSL[slot] = MW[a]; RSL[slot] = rstd2[m]; TOK[slot] = m; }
        __syncthreads();
    }
}
__device__ __forceinline__ void final_phase(Frame& F, const Args& A) {
    PHASE_IDS;
    const int gw = F.vcu * NWAVES + wave, NGW = F.G * NWAVES; const int* SO = (const int*)(F.ws + WS_SLOT_OF); const bf16* Y = (const bf16*)(F.ws + WS_XG); const float* gf = A.in[24];
    const bf16* XH = (const bf16*)(F.ws + WS_X2H); const bf16* XL = (const bf16*)(F.ws + WS_X2L);
    f32x4 gv[4];
#pragma unroll
    for (int j = 0; j < 4; ++j) gv[j] = ((const GAS f32x4*)gf)[64 * j + lane];
    typedef unsigned long long u64;
    u64 ya[4], yb[4], xh[4], xl[4];
#define FIN_LOAD(m_) do { const int s0_ = SO[(m_) * 2], s1_ = SO[(m_) * 2 + 1]; const GAS u64* y0_ = (const GAS u64*)(Y + (size_t)s0_ * 1024) + lane; const GAS u64* y1_ = (const GAS u64*)(Y + (size_t)s1_ * 1024) + lane; \
        const GAS u64* h_ = (const GAS u64*)(XH + (size_t)(m_) * 1024) + lane; const GAS u64* l_ = (const GAS u64*)(XL + (size_t)(m_) * 1024) + lane; \
        _Pragma("unroll") for (int j = 0; j < 4; ++j) { ya[j] = y0_[64 * j]; yb[j] = y1_[64 * j]; xh[j] = h_[64 * j]; xl[j] = l_[64 * j]; } } while (0)
    int m = gw; if (m >= M) return;
    FIN_LOAD(m);
#pragma unroll 1
    for (;;) {
        f32x4 v[4]; float s = 0.f;
#pragma unroll
        for (int j = 0; j < 4; ++j) { const u64 a = ya[j], c = yb[j], hh = xh[j], ll = xl[j];
            v[j].x = (bflo((unsigned)hh) + bflo((unsigned)ll)) + (bflo((unsigned)a) + bflo((unsigned)c)); v[j].y = (bfhi((unsigned)hh) + bfhi((unsigned)ll)) + (bfhi((unsigned)a) + bfhi((unsigned)c));
            v[j].z = (bflo((unsigned)(hh >> 32)) + bflo((unsigned)(ll >> 32))) + (bflo((unsigned)(a >> 32)) + bflo((unsigned)(c >> 32))); v[j].w = (bfhi((unsigned)(hh >> 32)) + bfhi((unsigned)(ll >> 32))) + (bfhi((unsigned)(a >> 32)) + bfhi((unsigned)(c >> 32)));
            s += (v[j].x * v[j].x + v[j].y * v[j].y) + (v[j].z * v[j].z + v[j].w * v[j].w); }
        const int mn = m + NGW; const bool more = mn < M;
        if (more) FIN_LOAD(mn);
        s = wave_sum(s); const float rs = rsqrtf(s * (1.f / D) + EPS); GAS f32x4* xr = (GAS f32x4*)(F.out + (size_t)m * D) + lane;
#pragma unroll
        for (int j = 0; j < 4; ++j) xr[64 * j] = (f32x4){v[j].x * rs * gv[j].x, v[j].y * rs * gv[j].y, v[j].z * rs * gv[j].z, v[j].w * rs * gv[j].w};
        if (!more) break;
        m = mn;
    }
#undef FIN_LOAD
}

__global__ void __launch_bounds__(NWAVES * 64, 2) fwd_kernel(Args args) {
    extern __shared__ __attribute__((aligned(16))) unsigned char lds[];
    Frame F; F.pacc = 0; F.pt0 = 0;
    F.lds = (LAS unsigned char*)lds; F.ldsg = lds;
    F.MISC = (volatile LAS unsigned*)(F.lds + MISC_OFF);
    const int tid = threadIdx.x;
    F.G = gridDim.x; { const int bx = blockIdx.x; F.vcu = (F.G % 8 == 0) ? (bx % 8) * (F.G / 8) + bx / 8 : bx; }
    F.ws = uniform_ptr(args.ws); F.out = uniform_ptr(args.out); F.ctl = (gu32*)(F.ws + WS_CTL);
    for (int u = tid; u < (LDS_BYTES - LDSCTL_OFF) / 4; u += NWAVES * 64) ((LAS unsigned*)(F.lds + LDSCTL_OFF))[u] = 0u;
    __syncthreads();
#if MK_ONE_LAUNCH
    XcdBarrier bar = xcd_barrier_post((unsigned*)(F.ctl + CW_BAR), F.MISC + 8);
#define GRID_BAR() xcd_barrier(bar)
#else
#define GRID_BAR() do { if (tid == 0) __hip_atomic_store(F.ctl + CW_TMO, 0xBADBA0u, RLX_AGENT); } while (0)
#endif
    const int lo = args.ph_lo, hi = args.ph_hi;
#define IN(k) (lo <= (k) && (k) < hi)
#ifndef PROBE_MASK
#define PROBE_MASK 0
#endif
#ifndef PG8_ALIGN_EPI
#define PG8_ALIGN_EPI true
#endif
#define REP(k) _Pragma("unroll") for (int rep_ = 0; rep_ < 1 + ((PROBE_MASK >> (k)) & 1); ++rep_)
#ifndef PROBE_A
#define PROBE_A -1
#define PROBE_B -1
#endif
#ifndef PROBE_AMP
#define PROBE_AMP 4
#endif
#ifndef PROBE_BLOCK
#define PROBE_BLOCK 0
#endif
    unsigned long long ts_a = 0, ts_b = 0;
#define STAMP(i) do { if ((i) == PROBE_A) ts_a = __builtin_amdgcn_s_memrealtime(); if ((i) == PROBE_B) ts_b = __builtin_amdgcn_s_memrealtime(); } while (0)
#define SEAM(k) do { if (IN(k) && IN((k) + 1)) { GRID_BAR(); if ((PROBE_MASK >> 6) & 1) GRID_BAR(); } STAMP((k) + 1); } while (0)
    STAMP(0);
    unsigned char* ws = F.ws;
    bf16* XB = (bf16*)(ws + WS_XB);
    const float* rstd0 = (const float*)(ws + WS_RSTD0);

    if (IN(0)) REP(0) { p0_prologue(F, args); } SEAM(0);
    if (IN(1)) REP(1) {
        constexpr int TS = 512 * 1024;
        static_assert(WS_XB % TS == 0 && WS_W1T % TS == 0 && WS_WVT % TS == 0 && WS_MEMN % TS == 0 && WS_WCKVT % TS == 0, "tile-aligned matrices");
        pg8::Gemm g{(const bf16*)ws, (const bf16*)ws, M, 4352, 1024};
        typedef pg8::MultiOrder<128, 17, (int)(WS_XB / TS), (int)(WS_W1T / TS), 4, 128, (int)(WS_WVT / TS), (int)(WS_XB / TS), 4, 2, (int)(WS_MEMN / TS), (int)(WS_WCKVT / TS), 2, 4, (int)(WS_WCKVT / TS) + 2, (int)(WS_MEMN / TS)> P1Order;
        P1Order S{F.G, (int)blockIdx.x};
        pg8::EpiP1 E{ pg8::EpiInProj{(bf16*)(ws + WS_QG), (bf16*)(ws + WS_KG), (bf16*)(ws + WS_SR), (bf16*)(ws + WS_QM), (bf16*)(ws + WS_KM), (bf16*)(ws + WS_SZ), (float*)((unsigned char*)F.out + DO_LA), rstd0, args.in[7]},
                      pg8::EpiVT{(bf16*)(ws + WS_VT), M, rstd0},
                      pg8::EpiRowBf16<0>{(bf16*)(ws + WS_MKV), 512, nullptr, 1.f}, pg8::EpiRowBf16<0>{(bf16*)(ws + WS_MKV) + 1024 * 512, 1024, nullptr, 1.f} };
        pg8::gemm_phase<pg8::EpiP1, P1Order, PG8_ALIGN_EPI, true>(F.lds + RING_OFF, g, S, E);
    } SEAM(1);
    if (IN(2)) { REP(2) gla_a_phase(F); STAMP(30); REP(5) moba_kmean_phase(F); } SEAM(2);
    if (IN(3)) { gla_scan_phase(F); STAMP(31); moba_gate_phase(F, args); } SEAM(3);
    if (IN(4)) { gla_b_phase(F, args); STAMP(32); moba_part_phase(F, args, CW_WQ); } SEAM(4);
    STAMP(6);
    if (IN(6)) { moba_own_phase(F, args, (bf16*)(ws + WS_OGM)); } SEAM(6);
    if (IN(7)) REP(1) { pg8::Gemm g{(const bf16*)(ws + WS_OGM), (const bf16*)(ws + WS_PGMT), M, 1024, 1024}; pg8::StaticOrder S; S.init(M, 1024, F.G, (int)blockIdx.x);
        pg8::EpiMerge2 E{(bf16*)(ws + WS_MG), (const bf16*)(ws + WS_SZ)};
        pg8::gemm_phase<pg8::EpiMerge2, pg8::StaticOrder, PG8_ALIGN_EPI, true>(F.lds + RING_OFF, g, S, E); } SEAM(7);
    if (IN(8)) REP(1) { pg8::Gemm g{(const bf16*)(ws + WS_MG), (const bf16*)(ws + WS_WOUTT), M, 1024, 1024}; pg8::StaticOrder S; S.init(M, 1024, F.G, (int)blockIdx.x);
        pg8::EpiResSplit<true> E{args.in[0], nullptr, nullptr, (bf16*)(ws + WS_X1H), (bf16*)(ws + WS_X1L), (float*)(ws + WS_SS1)};
        pg8::gemm_phase<pg8::EpiResSplit<true>, pg8::StaticOrder, PG8_ALIGN_EPI, true>(F.lds + RING_OFF, g, S, E); } SEAM(8);
    if (IN(10)) REP(1) { pg8::Gemm g{(const bf16*)(ws + WS_X1H), (const bf16*)(ws + WS_WCQT), M, 512, 1024}; pg8::StaticOrder S; S.init(M, 512, F.G, (int)blockIdx.x);
        pg8::EpiRowBf16<0> E{(bf16*)(ws + WS_QC), 512, nullptr, 0.08838834764831845f};
        pg8::gemm_phase<pg8::EpiRowBf16<0>, pg8::StaticOrder, PG8_ALIGN_EPI, true>(F.lds + RING_OFF, g, S, E); } SEAM(10);
    if (IN(11)) { memattn_phase(F, (bf16*)(ws + WS_QC)); } SEAM(11);
    if (IN(12)) { pg8::Gemm g{(const bf16*)(ws + WS_QC), (const bf16*)(ws + WS_WCOT), M, 1024, 512}; pg8::StaticOrder S; S.init(M, 1024, F.G, (int)blockIdx.x);
        pg8::EpiResSplit<false> E{nullptr, (const bf16*)(ws + WS_X1H), (const bf16*)(ws + WS_X1L), (bf16*)(ws + WS_X2H), (bf16*)(ws + WS_X2L), (float*)(ws + WS_SS2)};
        pg8::gemm_phase<pg8::EpiResSplit<false>, pg8::StaticOrder, PG8_ALIGN_EPI, true>(F.lds + RING_OFF, g, S, E);
        expert_weights(F, args); } SEAM(12);
    STAMP(14);
    if (IN(14)) REP(1) {
        { pg8::Gemm g{(const bf16*)(ws + WS_X2H), (const bf16*)(ws + WS_WRT), M, 256, 1024}; pg8::StaticOrder S; S.init(M, 256, F.G, (int)blockIdx.x);
          pg8::EpiLogits E{(float*)(ws + WS_LG), 72, 72};
          pg8::gemm_phase<pg8::EpiLogits, pg8::StaticOrder, PG8_ALIGN_EPI, true>(F.lds + RING_OFF, g, S, E); }
        { pg8::Gemm g{(const bf16*)(ws + WS_X2L), (const bf16*)(ws + WS_WRT) + 256 * 1024, M, 256, 1024}; pg8::StaticOrder S; S.init(M, 256, F.G, (int)((blockIdx.x + F.G / 2) % F.G));
          pg8::EpiLogits E{(float*)(ws + WS_LG2), 36, 36};
          pg8::gemm_phase<pg8::EpiLogits, pg8::StaticOrder, PG8_ALIGN_EPI, true>(F.lds + RING_OFF, g, S, E); }
    } SEAM(14);
    if (IN(15)) { route_phase(F, args); } SEAM(15);
    if (IN(16)) REP(0) { moe_slot_phase(F); } SEAM(16);
    if (IN(17)) REP(1) { const int ntile = moe_bases(F, 0);
        { LAS int* rows = (LAS int*)(F.lds + TBL_ROWS); const int* TOK = (const int*)(ws + WS_TOK);
          for (int i = threadIdx.x; i < 6 * 256; i += NTHR) { const long L = (long)(i >> 8) * F.G + blockIdx.x; rows[i] = (L < (long)ntile * 4) ? TOK[(int)(L >> 2) * 256 + (i & 255)] : 0; }
          __syncthreads(); }
        pg8::Gemm g{(const bf16*)(ws + WS_X2H), (const bf16*)(ws + WS_WGUT), MOE_CAP, 32 * 1024, 1024}; pg8::MoeGatherOrder S{(const LAS int*)(F.lds + TBL_TILE), (const LAS int*)(F.lds + TBL_ROWS), ntile, F.G, (int)blockIdx.x};
        pg8::EpiMoe1 E{(bf16*)(ws + WS_HID), (const float*)(ws + WS_RSTD_SLOT)};
        pg8::gemm_phase<pg8::EpiMoe1, pg8::MoeGatherOrder, PG8_ALIGN_EPI, true>(F.lds + RING_OFF, g, S, E); } SEAM(17);
    if (IN(18)) REP(1) { const int ntile = moe_bases(F, 0);
        pg8::Gemm g{(const bf16*)(ws + WS_HID), (const bf16*)(ws + WS_WDT), MOE_CAP, 32 * 1024, 512}; pg8::MoeOrder S{(const LAS int*)(F.lds + TBL_TILE), ntile, F.G, (int)blockIdx.x};
        pg8::EpiMoe2 E{(bf16*)(ws + WS_XG), (const float*)(ws + WS_W_SLOT)};
        pg8::gemm_phase<pg8::EpiMoe2, pg8::MoeOrder, PG8_ALIGN_EPI, true>(F.lds + RING_OFF, g, S, E); } SEAM(18);
    if (IN(19)) { final_phase(F, args); }
    STAMP(20);
    if ((PROBE_A >= 0 || PROBE_ACC >= 0) && blockIdx.x == PROBE_BLOCK) { const unsigned long long dl = (PROBE_ACC >= 40 ? (unsigned long long)F.MISC[16] : PROBE_ACC >= 0 ? F.pacc : (ts_b - ts_a)) * PROBE_AMP, t0 = __builtin_amdgcn_s_memrealtime(); while (__builtin_amdgcn_s_memrealtime() - t0 < dl) __builtin_amdgcn_s_sleep(8); }
#undef IN
#undef SEAM
}

extern "C" void kernel_launch(void* const* d_in, const int* in_sizes, int n_in, void* d_out, int out_size, void* d_ws, size_t ws_size, hipStream_t stream) {
    static int grid = 0;
    if (grid == 0) {
        if (n_in != 25 || in_sizes[0] != M * D || out_size != M * D || ws_size < WS_END) { fprintf(stderr, "kernel_launch: unexpected shapes (n_in %d in0 %d out %d ws %zu)\n", n_in, n_in > 0 ? in_sizes[0] : -1, out_size, ws_size); grid = -1; return; }
        int dev = 0, cus = 0, per_cu = 0;
        if (hipGetDevice(&dev) != hipSuccess || hipDeviceGetAttribute(&cus, hipDeviceAttributeMultiprocessorCount, dev) != hipSuccess) { grid = -1; return; }
        if (hipFuncSetAttribute((const void*)fwd_kernel, hipFuncAttributeMaxDynamicSharedMemorySize, LDS_BYTES) != hipSuccess) { fprintf(stderr, "kernel_launch: hipFuncSetAttribute failed\n"); grid = -1; return; }
        if (hipOccupancyMaxActiveBlocksPerMultiprocessor(&per_cu, (const void*)fwd_kernel, NWAVES * 64, LDS_BYTES) != hipSuccess || per_cu < 1) fprintf(stderr, "kernel_launch: occupancy query reports %d\n", per_cu);
        (void)hipGetLastError();
        grid = cus;
    }
    if (grid < 0) return;
    if (hipMemsetAsync((char*)d_ws + WS_CTL, 0, CTL_ZERO_BYTES, stream) != hipSuccess) return;
    Args a{};
    for (int i = 0; i < 25; ++i) a.in[i] = (const float*)d_in[i];
    a.out = (float*)d_out; a.ws = (unsigned char*)d_ws;
#if MK_ONE_LAUNCH
    a.ph_lo = 0; a.ph_hi = NPHASE;
    hipLaunchKernelGGL(fwd_kernel, dim3(grid), dim3(NWAVES * 64), LDS_BYTES, stream, a);
#else
    for (int p = 0; p < NPHASE; ++p) { a.ph_lo = p; a.ph_hi = p + 1; hipLaunchKernelGGL(fwd_kernel, dim3(grid), dim3(NWAVES * 64), LDS_BYTES, stream, a); }
#endif
}
```

```cpp
#include <hip/hip_runtime.h>
#include <cstdio>
#include <cstdint>
#define MK_ONE_LAUNCH 1
namespace pg8 {
#define PG8_LAS __attribute__((address_space(3)))
typedef unsigned short bf16_t;
typedef short bf16x8 __attribute__((ext_vector_type(8)));
typedef float f32x4 __attribute__((ext_vector_type(4)));
typedef unsigned u32x4 __attribute__((ext_vector_type(4)));
constexpr int BM = 256, BK = 64, HALF = 128, HTB = HALF * BK * 2  , STAGE_BYTES = 8 * HTB, NXCD = 8, WGM = 8;

__host__ __device__ __forceinline__ int lds_byte(int r, int c) { const int st = (r >> 4) * 2 + (c >> 5), rr = r & 15, cc = c & 31, ob = rr * 64 + cc * 2; return st * 1024 + (ob ^ (((ob >> 9) & 1) << 5)); }
__host__ __device__ __forceinline__ void stage_rc(int b, int& R, int& C) { const int st = b / 1024, sb = b % 1024, swz = sb ^ (((sb >> 9) & 1) << 5); R = (st >> 1) * 16 + swz / 64; C = (st & 1) * 32 + (swz % 64) / 2; }
__host__ __device__ __forceinline__ int perm32(int rho) { const int n = rho >> 4, i = rho & 15; return 8 * (i >> 2) + 4 * n + (i & 3); }

struct Unit { int pm, pn, lm, ln, ty; };
struct Gemm { const bf16_t* A; const bf16_t* Bt; int M, N, K; };

struct StaticOrder {
    static constexpr bool GATHER = false;
    int nM, nN, nwg, G, c;
    __host__ __device__ void init(int M, int N, int G_, int c_) { nM = M / BM; nN = N / BM; nwg = nM * nN; G = G_; c = c_; }
    __host__ __device__ bool next(int i, Unit& u) const {
        const long L = (long)i * G + c; if (L >= nwg) return false;
        int wgid = (int)L; { const int q = nwg / NXCD, r = nwg % NXCD, xcd = wgid % NXCD, off = wgid / NXCD; wgid = (xcd < r ? xcd * (q + 1) : r * (q + 1) + (xcd - r) * q) + off; }
        const int nig = WGM * nN, gid = wgid / nig, fm = gid * WGM, gsz = (nM - fm) < WGM ? (nM - fm) : WGM;
        u.pm = fm + ((wgid % nig) % gsz); u.pn = (wgid % nig) / gsz; u.lm = u.pm; u.ln = u.pn; u.ty = 0; return true;
    }
    __device__ __forceinline__ void a_ready(const Unit&) const {}
    __device__ __forceinline__ void done(const Unit&) const {}
};

__device__ __forceinline__ unsigned cvt_pk_bf16(float lo, float hi) { unsigned r; asm volatile("v_cvt_pk_bf16_f32 %0, %1, %2" : "=v"(r) : "v"(lo), "v"(hi)); return r; }
typedef float f32x2 __attribute__((ext_vector_type(2)));
__device__ __forceinline__ float bf2f(unsigned short h) { return __uint_as_float(((unsigned)h) << 16); }
__device__ __forceinline__ float bflo(unsigned w) { return __uint_as_float(w << 16); }
__device__ __forceinline__ float bfhi(unsigned w) { return __uint_as_float(w & 0xffff0000u); }
__device__ __forceinline__ float sigmoid_f(float x) { return __builtin_amdgcn_rcpf(1.0f + __builtin_amdgcn_exp2f(-1.4426950408889634f * x)); }
__device__ __forceinline__ float silu_f(float x) { return x * __builtin_amdgcn_rcpf(1.0f + __builtin_amdgcn_exp2f(-1.4426950408889634f * x)); }
__device__ __forceinline__ float logsigmoid_f(float x) { return fminf(x, 0.f) - 0.6931471805599453f * __builtin_amdgcn_logf(1.0f + __builtin_amdgcn_exp2f(-1.4426950408889634f * fabsf(x))); }
__device__ __forceinline__ u32x4 pack8(const f32x4 v0, const f32x4 v1) { u32x4 w; w.x = cvt_pk_bf16(v0[0], v0[1]); w.y = cvt_pk_bf16(v0[2], v0[3]); w.z = cvt_pk_bf16(v1[0], v1[1]); w.w = cvt_pk_bf16(v1[2], v1[3]); return w; }

struct EpiInProj {
    static constexpr bool PERM = true, AFTER_DRAIN = false, MIDK = false;
    bf16_t *QG, *KG, *SR, *QM, *KM, *SZ; float* LA; const float* rstd; const float* b_alpha;
    __device__ __forceinline__ void operator()(const f32x4 (&acc)[2][2][4][2], const Unit& u, int wr, int wc, int fr, int fq) const {
        const int pn = u.ln; bf16_t* dst; int ldc, cbase, mode = 0; float sc = 1.f;
        if (pn == 0) { dst = QG; ldc = 256; cbase = 0; sc = 0.125f; }
        else if (pn == 1) { dst = KG; ldc = 256; cbase = 0; }
        else if (pn <= 3) { dst = SR; ldc = 512; cbase = (pn - 2) * 256; mode = 1; }
        else if (pn == 4) { dst = nullptr; ldc = 256; cbase = 0; mode = 3; }
        else if (pn <= 6) { dst = QM; ldc = 512; cbase = (pn - 5) * 256; sc = 0.125f * 1.4426950408889634f; }
        else if (pn <= 8) { dst = KM; ldc = 512; cbase = (pn - 7) * 256; }
        else { dst = SZ; ldc = 2048; cbase = (pn - 9) * 256; mode = 2; }
        const int row0 = u.lm * BM + wr * 64 + fr, col0 = cbase + wc * 32 + 8 * fq;
#pragma unroll
        for (int ai = 0; ai < 2; ++ai)
#pragma unroll
            for (int m = 0; m < 4; ++m) { const int row = row0 + ai * HALF + m * 16; const float rs = sc;
#pragma unroll
                for (int bj = 0; bj < 2; ++bj) { f32x4 v0 = acc[ai][bj][m][0] * rs, v1 = acc[ai][bj][m][1] * rs; const int col = col0 + bj * HALF;
                    if (mode == 3) { const f32x4 b0 = *(const f32x4*)(b_alpha + col), b1 = *(const f32x4*)(b_alpha + col + 4);
#pragma unroll
                        for (int e = 0; e < 4; ++e) { v0[e] = logsigmoid_f(v0[e] + b0[e]) * 0.0625f; v1[e] = logsigmoid_f(v1[e] + b1[e]) * 0.0625f; }
                        float* o = LA + (size_t)row * 256 + col; *(f32x4*)o = v0; *(f32x4*)(o + 4) = v1; }
                    else { if (mode == 1) {
#pragma unroll
                            for (int e = 0; e < 4; ++e) { v0[e] = silu_f(v0[e]); v1[e] = silu_f(v1[e]); } }
                        else if (mode == 2) {
#pragma unroll
                            for (int e = 0; e < 4; ++e) { v0[e] = sigmoid_f(v0[e]); v1[e] = sigmoid_f(v1[e]); } }
                        *(u32x4*)(dst + (size_t)row * ldc + col) = pack8(v0, v1); } } }
    }
};
struct EpiVT {
    static constexpr bool PERM = true, AFTER_DRAIN = false, MIDK = false;
    bf16_t* VT; int ldc; const float* rstd;
    __device__ __forceinline__ void operator()(const f32x4 (&acc)[2][2][4][2], const Unit& u, int wr, int wc, int fr, int fq) const {
        const int row0 = u.lm * BM + wr * 64 + fr, col0 = u.ln * BM + wc * 32 + 8 * fq;
#pragma unroll
        for (int ai = 0; ai < 2; ++ai)
#pragma unroll
            for (int m = 0; m < 4; ++m) { const int row = row0 + ai * HALF + m * 16;
#pragma unroll
                for (int bj = 0; bj < 2; ++bj) *(u32x4*)(VT + (size_t)row * ldc + col0 + bj * HALF) = pack8(acc[ai][bj][m][0], acc[ai][bj][m][1]); }
    }
};
template <int ACT> struct EpiRowBf16 {
    static constexpr bool PERM = true, AFTER_DRAIN = false, MIDK = false;
    bf16_t* O; int ldc; const float* rowscale; float sc;
    __device__ __forceinline__ void operator()(const f32x4 (&acc)[2][2][4][2], const Unit& u, int wr, int wc, int fr, int fq) const {
        const int row0 = u.lm * BM + wr * 64 + fr, col0 = u.ln * BM + wc * 32 + 8 * fq;
#pragma unroll
        for (int ai = 0; ai < 2; ++ai)
#pragma unroll
            for (int m = 0; m < 4; ++m) { const int row = row0 + ai * HALF + m * 16; const float rs = (rowscale ? rowscale[row] : 1.f) * sc;
#pragma unroll
                for (int bj = 0; bj < 2; ++bj) { f32x4 v0 = acc[ai][bj][m][0] * rs, v1 = acc[ai][bj][m][1] * rs;
                    if (ACT == 2) {
#pragma unroll
                        for (int e = 0; e < 4; ++e) { v0[e] = sigmoid_f(v0[e]); v1[e] = sigmoid_f(v1[e]); } }
                    *(u32x4*)(O + (size_t)row * ldc + col0 + bj * HALF) = pack8(v0, v1); } }
    }
};
struct EpiMerge {
    static constexpr bool PERM = true, AFTER_DRAIN = false, MIDK = false;
    bf16_t* O; const bf16_t* SZ; const bf16_t* T1;
    __device__ __forceinline__ void operator()(const f32x4 (&acc)[2][2][4][2], const Unit& u, int wr, int wc, int fr, int fq) const {
        const int row0 = u.lm * BM + wr * 64 + fr, col0 = u.ln * BM + wc * 32 + 8 * fq;
#pragma unroll
        for (int ai = 0; ai < 2; ++ai)
#pragma unroll
            for (int m = 0; m < 4; ++m) { const int row = row0 + ai * HALF + m * 16;
#pragma unroll
                for (int bj = 0; bj < 2; ++bj) { const int col = col0 + bj * HALF;
                    const u32x4 g = *(const u32x4*)(SZ + (size_t)row * 2048 + col), z = *(const u32x4*)(SZ + (size_t)row * 2048 + 1024 + col), t = *(const u32x4*)(T1 + (size_t)row * 1024 + col);
                    const f32x4 a0 = acc[ai][bj][m][0], a1 = acc[ai][bj][m][1]; f32x4 v0, v1;
                    v0[0] = bflo(g.x) * bflo(t.x) + bflo(z.x) * a0[0]; v0[1] = bfhi(g.x) * bfhi(t.x) + bfhi(z.x) * a0[1];
                    v0[2] = bflo(g.y) * bflo(t.y) + bflo(z.y) * a0[2]; v0[3] = bfhi(g.y) * bfhi(t.y) + bfhi(z.y) * a0[3];
                    v1[0] = bflo(g.z) * bflo(t.z) + bflo(z.z) * a1[0]; v1[1] = bfhi(g.z) * bfhi(t.z) + bfhi(z.z) * a1[1];
                    v1[2] = bflo(g.w) * bflo(t.w) + bflo(z.w) * a1[2]; v1[3] = bfhi(g.w) * bfhi(t.w) + bfhi(z.w) * a1[3];
                    *(u32x4*)(O + (size_t)row * 1024 + col) = pack8(v0, v1); } }
    }
};
struct EpiResF32 {
    static constexpr bool PERM = false, AFTER_DRAIN = false, MIDK = false;
    const float* base; float* out;
    __device__ __forceinline__ void operator()(const f32x4 (&acc)[2][2][4][2], const Unit& u, int wr, int wc, int fr, int fq) const {
        const int row0 = u.lm * BM + wr * 64 + fr, col0 = u.ln * BM + wc * 32 + 4 * fq;
#pragma unroll
        for (int ai = 0; ai < 2; ++ai)
#pragma unroll
            for (int m = 0; m < 4; ++m) { const size_t off = (size_t)(row0 + ai * HALF + m * 16) * 1024 + col0;
#pragma unroll
                for (int bj = 0; bj < 2; ++bj)
#pragma unroll
                    for (int n = 0; n < 2; ++n) { const f32x4 b = *(const f32x4*)(base + off + bj * HALF + n * 16); *(f32x4*)(out + off + bj * HALF + n * 16) = b + acc[ai][bj][m][n]; } }
    }
};
template <bool SPLIT> struct EpiResNorm {
    static constexpr bool PERM = true, AFTER_DRAIN = false, MIDK = false;
    const float* base; float* out; bf16_t* H; bf16_t* L; float* SS;
    __device__ __forceinline__ void operator()(const f32x4 (&acc)[2][2][4][2], const Unit& u, int wr, int wc, int fr, int fq) const {
        const int row0 = u.lm * BM + wr * 64 + fr, col0 = u.ln * BM + wc * 32 + 8 * fq;
#pragma unroll
        for (int ai = 0; ai < 2; ++ai)
#pragma unroll
            for (int m = 0; m < 4; ++m) { const int row = row0 + ai * HALF + m * 16; const size_t off = (size_t)row * 1024 + col0; float ss = 0.f;
#pragma unroll
                for (int bj = 0; bj < 2; ++bj) { const f32x4 v0 = *(const f32x4*)(base + off + bj * HALF) + acc[ai][bj][m][0], v1 = *(const f32x4*)(base + off + bj * HALF + 4) + acc[ai][bj][m][1];
                    *(f32x4*)(out + off + bj * HALF) = v0; *(f32x4*)(out + off + bj * HALF + 4) = v1;
                    ss += (v0[0] * v0[0] + v0[1] * v0[1]) + (v0[2] * v0[2] + v0[3] * v0[3]) + (v1[0] * v1[0] + v1[1] * v1[1]) + (v1[2] * v1[2] + v1[3] * v1[3]);
                    const u32x4 h = pack8(v0, v1); *(u32x4*)(H + off + bj * HALF) = h;
                    if (SPLIT) { f32x4 r0, r1; r0[0] = v0[0] - bflo(h.x); r0[1] = v0[1] - bfhi(h.x); r0[2] = v0[2] - bflo(h.y); r0[3] = v0[3] - bfhi(h.y); r1[0] = v1[0] - bflo(h.z); r1[1] = v1[1] - bfhi(h.z); r1[2] = v1[2] - bflo(h.w); r1[3] = v1[3] - bfhi(h.w);
                        *(u32x4*)(L + off + bj * HALF) = pack8(r0, r1); } }
                ss += __shfl_xor(ss, 16); ss += __shfl_xor(ss, 32);
                if (fq == 0) SS[(size_t)row * 16 + u.ln * 4 + wc] = ss; }
    }
};
struct EpiLogits {
    static constexpr bool PERM = false, AFTER_DRAIN = false, MIDK = false;
    float* LG; int ld, ncols;
    __device__ __forceinline__ void operator()(const f32x4 (&acc)[2][2][4][2], const Unit& u, int wr, int wc, int fr, int fq) const {
        const int row0 = u.lm * BM + wr * 64 + fr, col0 = wc * 32 + 4 * fq;
#pragma unroll
        for (int ai = 0; ai < 2; ++ai)
#pragma unroll
            for (int m = 0; m < 4; ++m) { float* o = LG + (size_t)(row0 + ai * HALF + m * 16) * ld;
#pragma unroll
                for (int n = 0; n < 2; ++n) { const int col = col0 + n * 16; if (col < ncols) *(f32x4*)(o + col) = acc[ai][0][m][n]; } }
    }
};
struct EpiMoe1 {
    static constexpr bool PERM = true, AFTER_DRAIN = false, MIDK = false;
    bf16_t* HID; const float* rstd_slot;
    __device__ __forceinline__ void operator()(const f32x4 (&acc)[2][2][4][2], const Unit& u, int wr, int wc, int fr, int fq) const {
        const int row0 = u.lm * BM + wr * 64 + fr, col0 = u.ln * 128 + wc * 32 + 8 * fq;
#pragma unroll
        for (int ai = 0; ai < 2; ++ai)
#pragma unroll
            for (int m = 0; m < 4; ++m) { const int row = row0 + ai * HALF + m * 16; const float rs = rstd_slot[row];
                f32x4 v0, v1;
#pragma unroll
                for (int e = 0; e < 4; ++e) { v0[e] = silu_f(acc[ai][0][m][0][e] * rs) * (acc[ai][1][m][0][e] * rs); v1[e] = silu_f(acc[ai][0][m][1][e] * rs) * (acc[ai][1][m][1][e] * rs); }
                *(u32x4*)(HID + (size_t)row * 512 + col0) = pack8(v0, v1); }
    }
};
struct EpiMoe2 {
    static constexpr bool PERM = true, AFTER_DRAIN = false, MIDK = false;
    bf16_t* Y; const float* w_slot;
    __device__ __forceinline__ void operator()(const f32x4 (&acc)[2][2][4][2], const Unit& u, int wr, int wc, int fr, int fq) const {
        const int row0 = u.lm * BM + wr * 64 + fr, col0 = u.ln * BM + wc * 32 + 8 * fq;
#pragma unroll
        for (int ai = 0; ai < 2; ++ai)
#pragma unroll
            for (int m = 0; m < 4; ++m) { const int row = row0 + ai * HALF + m * 16; const float rs = w_slot[row];
#pragma unroll
                for (int bj = 0; bj < 2; ++bj) *(u32x4*)(Y + (size_t)row * 1024 + col0 + bj * HALF) = pack8(acc[ai][bj][m][0] * rs, acc[ai][bj][m][1] * rs); }
    }
};
struct EpiP1 {
    static constexpr bool PERM = true, AFTER_DRAIN = false, MIDK = false;
    EpiInProj e0; EpiVT e1; EpiRowBf16<0> e2, e3;
    __device__ __forceinline__ void operator()(const f32x4 (&acc)[2][2][4][2], const Unit& u, int wr, int wc, int fr, int fq) const {
        if (u.ty == 0) e0(acc, u, wr, wc, fr, fq); else if (u.ty == 1) e1(acc, u, wr, wc, fr, fq); else if (u.ty == 2) e2(acc, u, wr, wc, fr, fq); else e3(acc, u, wr, wc, fr, fq);
    }
};
struct EpiMerge2 {
    static constexpr bool PERM = true, AFTER_DRAIN = false, MIDK = true;
    bf16_t* O; const bf16_t* SZ;
    __device__ __forceinline__ void mid(f32x4 (&acc)[2][2][4][2], const Unit& u, int wr, int wc, int fr, int fq) const {
        const int row0 = u.lm * BM + wr * 64 + fr, col0 = u.ln * BM + wc * 32 + 8 * fq;
#pragma unroll
        for (int ai = 0; ai < 2; ++ai)
#pragma unroll
            for (int m = 0; m < 4; ++m) { const int row = row0 + ai * HALF + m * 16;
#pragma unroll
                for (int bj = 0; bj < 2; ++bj) { const int col = col0 + bj * HALF; const u32x4 g = *(const u32x4*)(SZ + (size_t)row * 2048 + col), z = *(const u32x4*)(SZ + (size_t)row * 2048 + 1024 + col);
                    f32x4 r0, r1;
                    r0[0] = bflo(g.x) * __builtin_amdgcn_rcpf(fmaxf(bflo(z.x), 1e-30f)); r0[1] = bfhi(g.x) * __builtin_amdgcn_rcpf(fmaxf(bfhi(z.x), 1e-30f)); r0[2] = bflo(g.y) * __builtin_amdgcn_rcpf(fmaxf(bflo(z.y), 1e-30f)); r0[3] = bfhi(g.y) * __builtin_amdgcn_rcpf(fmaxf(bfhi(z.y), 1e-30f));
                    r1[0] = bflo(g.z) * __builtin_amdgcn_rcpf(fmaxf(bflo(z.z), 1e-30f)); r1[1] = bfhi(g.z) * __builtin_amdgcn_rcpf(fmaxf(bfhi(z.z), 1e-30f)); r1[2] = bflo(g.w) * __builtin_amdgcn_rcpf(fmaxf(bflo(z.w), 1e-30f)); r1[3] = bfhi(g.w) * __builtin_amdgcn_rcpf(fmaxf(bfhi(z.w), 1e-30f));
                    acc[ai][bj][m][0] = acc[ai][bj][m][0] * r0; acc[ai][bj][m][1] = acc[ai][bj][m][1] * r1; } }
    }
    __device__ __forceinline__ void operator()(const f32x4 (&acc)[2][2][4][2], const Unit& u, int wr, int wc, int fr, int fq) const {
        const int row0 = u.lm * BM + wr * 64 + fr, col0 = u.ln * BM + wc * 32 + 8 * fq;
#pragma unroll
        for (int ai = 0; ai < 2; ++ai)
#pragma unroll
            for (int m = 0; m < 4; ++m) { const int row = row0 + ai * HALF + m * 16;
#pragma unroll
                for (int bj = 0; bj < 2; ++bj) { const int col = col0 + bj * HALF; const u32x4 z = *(const u32x4*)(SZ + (size_t)row * 2048 + 1024 + col);
                    f32x4 v0 = acc[ai][bj][m][0], v1 = acc[ai][bj][m][1];
                    v0[0] *= bflo(z.x); v0[1] *= bfhi(z.x); v0[2] *= bflo(z.y); v0[3] *= bfhi(z.y); v1[0] *= bflo(z.z); v1[1] *= bfhi(z.z); v1[2] *= bflo(z.w); v1[3] *= bfhi(z.w);
                    *(u32x4*)(O + (size_t)row * 1024 + col) = pack8(v0, v1); } }
    }
};
template <bool BASE_F32> struct EpiResSplit {
    static constexpr bool PERM = true, AFTER_DRAIN = false, MIDK = false;
    const float* basef; const bf16_t* baseH; const bf16_t* baseL; bf16_t* H; bf16_t* L; float* SS;
    __device__ __forceinline__ void operator()(const f32x4 (&acc)[2][2][4][2], const Unit& u, int wr, int wc, int fr, int fq) const {
        const int row0 = u.lm * BM + wr * 64 + fr, col0 = u.ln * BM + wc * 32 + 8 * fq;
#pragma unroll
        for (int ai = 0; ai < 2; ++ai)
#pragma unroll
            for (int m = 0; m < 4; ++m) { const int row = row0 + ai * HALF + m * 16; const size_t off = (size_t)row * 1024 + col0; float ss = 0.f;
#pragma unroll
                for (int bj = 0; bj < 2; ++bj) { f32x4 v0, v1;
                    if (BASE_F32) { v0 = *(const f32x4*)(basef + off + bj * HALF); v1 = *(const f32x4*)(basef + off + bj * HALF + 4); }
                    else { const u32x4 bh = *(const u32x4*)(baseH + off + bj * HALF), bl = *(const u32x4*)(baseL + off + bj * HALF);
                        v0[0] = bflo(bh.x) + bflo(bl.x); v0[1] = bfhi(bh.x) + bfhi(bl.x); v0[2] = bflo(bh.y) + bflo(bl.y); v0[3] = bfhi(bh.y) + bfhi(bl.y); v1[0] = bflo(bh.z) + bflo(bl.z); v1[1] = bfhi(bh.z) + bfhi(bl.z); v1[2] = bflo(bh.w) + bflo(bl.w); v1[3] = bfhi(bh.w) + bfhi(bl.w); }
                    v0 = v0 + acc[ai][bj][m][0]; v1 = v1 + acc[ai][bj][m][1];
                    ss += (v0[0] * v0[0] + v0[1] * v0[1]) + (v0[2] * v0[2] + v0[3] * v0[3]) + (v1[0] * v1[0] + v1[1] * v1[1]) + (v1[2] * v1[2] + v1[3] * v1[3]);
                    const u32x4 h = pack8(v0, v1); *(u32x4*)(H + off + bj * HALF) = h;
                    f32x4 r0, r1; r0[0] = v0[0] - bflo(h.x); r0[1] = v0[1] - bfhi(h.x); r0[2] = v0[2] - bflo(h.y); r0[3] = v0[3] - bfhi(h.y); r1[0] = v1[0] - bflo(h.z); r1[1] = v1[1] - bfhi(h.z); r1[2] = v1[2] - bflo(h.w); r1[3] = v1[3] - bfhi(h.w);
                    *(u32x4*)(L + off + bj * HALF) = pack8(r0, r1); }
                ss += __shfl_xor(ss, 16); ss += __shfl_xor(ss, 32);
                if (fq == 0) SS[(size_t)row * 16 + u.ln * 4 + wc] = ss; }
    }
};
template <int NM0, int NN0, int A00, int B00, int NM1, int NN1, int A01, int B01, int NM2, int NN2, int A02, int B02, int NM3, int NN3, int A03, int B03>
struct MultiOrder {
    static constexpr bool GATHER = false;
    int G, c;
    __device__ __forceinline__ bool next(int i, Unit& u) const {
        constexpr int C0 = NM0 * NN0, C1 = NM1 * NN1, C2 = NM2 * NN2, C3 = NM3 * NN3;
        long L = (long)i * G + c; int s, nwg, nNs, nMs, a0s, b0s;
        if (L < C0) { s = 0; nwg = C0; nNs = NN0; nMs = NM0; a0s = A00; b0s = B00; }
        else if (L < C0 + C1) { L -= C0; s = 1; nwg = C1; nNs = NN1; nMs = NM1; a0s = A01; b0s = B01; }
        else if (L < C0 + C1 + C2) { L -= C0 + C1; s = 2; nwg = C2; nNs = NN2; nMs = NM2; a0s = A02; b0s = B02; }
        else if (L < C0 + C1 + C2 + C3) { L -= C0 + C1 + C2; s = 3; nwg = C3; nNs = NN3; nMs = NM3; a0s = A03; b0s = B03; }
        else return false;
        int wgid = (int)L; { const int q = nwg / NXCD, r = nwg % NXCD, xcd = wgid % NXCD, off = wgid / NXCD; wgid = (xcd < r ? xcd * (q + 1) : r * (q + 1) + (xcd - r) * q) + off; }
        const int nig = WGM * nNs, gid = wgid / nig, fm = gid * WGM, gsz = (nMs - fm) < WGM ? (nMs - fm) : WGM;
        u.lm = fm + ((wgid % nig) % gsz); u.ln = (wgid % nig) / gsz; u.pm = a0s + u.lm; u.pn = b0s + u.ln; u.ty = s; return true;
    }
    __device__ __forceinline__ void a_ready(const Unit&) const {}
    __device__ __forceinline__ void done(const Unit&) const {}
};
struct MoeOrder {
    static constexpr bool GATHER = false;
    const PG8_LAS int* tile_e; int ntile, G, c;
    __device__ __forceinline__ bool next(int i, Unit& u) const {
        const long L = (long)i * G + c; if (L >= (long)ntile * 4) return false;
        const int pm = (int)(L >> 2), j = (int)(L & 3); u.pm = pm; u.pn = __builtin_amdgcn_readfirstlane(tile_e[pm]) * 4 + j; u.lm = pm; u.ln = j; u.ty = 0; return true;
    }
    __device__ __forceinline__ void a_ready(const Unit&) const {}
    __device__ __forceinline__ void done(const Unit&) const {}
};
struct MoeGatherOrder {
    static constexpr bool GATHER = true;
    const PG8_LAS int* tile_e; const PG8_LAS int* rows; int ntile, G, c;
    __device__ __forceinline__ bool next(int i, Unit& u) const {
        const long L = (long)i * G + c; if (L >= (long)ntile * 4) return false;
        const int pm = (int)(L >> 2), j = (int)(L & 3); u.pm = pm; u.pn = __builtin_amdgcn_readfirstlane(tile_e[pm]) * 4 + j; u.lm = pm; u.ln = j; u.ty = 0; return true;
    }
    __device__ __forceinline__ int row(int ui, int r) const { return rows[ui * 256 + r]; }
    __device__ __forceinline__ void a_ready(const Unit&) const {}
    __device__ __forceinline__ void done(const Unit&) const {}
};
#ifndef PROBE_ACC
#define PROBE_ACC -1
#endif
#ifndef PROBE_N
#define PROBE_N 0
#endif
#define PG8_PB(id) do { if ((id) == PROBE_ACC && (PROBE_N == 0 || g.N == PROBE_N)) g_t0 = __builtin_amdgcn_s_memrealtime(); } while (0)
#define PG8_PE(id) do { if ((id) == PROBE_ACC && (PROBE_N == 0 || g.N == PROBE_N) && wid == 0 && lane == 0) { const unsigned d_ = (unsigned)(__builtin_amdgcn_s_memrealtime() - g_t0); __hip_atomic_fetch_add((PG8_LAS unsigned*)(lds + 147776 + 4 * 16), d_, __ATOMIC_RELAXED, __HIP_MEMORY_SCOPE_WORKGROUP); } } while (0)
template <class Epi, class Sched, bool ALIGN_EPI = false, bool SP2 = false>
__device__ __forceinline__ void gemm_phase(PG8_LAS unsigned char* lds, const Gemm g, const Sched& S, const Epi& E) {
    const int tid = threadIdx.x, wid = __builtin_amdgcn_readfirstlane(tid >> 6), lane = tid & 63, wr = wid >> 2, wc = wid & 3, fr = lane & 15, fq = lane >> 4;
    const int K = g.K, nt = K / BK; unsigned long long g_t0 = 0; (void)g_t0; PG8_PB(42);
    unsigned voffA[2], voffB[2];
#pragma unroll
    for (int i = 0; i < 2; ++i) { int R, C; stage_rc(tid * 16 + i * 8192, R, C); const int Rb = Epi::PERM ? ((R & ~31) + perm32(R & 31)) : R;
        voffA[i] = (unsigned)(R * K + C) * 2u; voffB[i] = (unsigned)(Rb * K + C) * 2u; }
    static_assert(!Sched::GATHER || SP2, "gathered A rows: SP2 loop only");
    unsigned gA[2][2], gN[2][2];
#define PG8_GOFF(dst, ui_) do { _Pragma("unroll") for (int _h = 0; _h < 2; ++_h) _Pragma("unroll") for (int _i = 0; _i < 2; ++_i) { int _R, _C; stage_rc(tid * 16 + _i * 8192, _R, _C); dst[_h][_i] = (unsigned)(S.row((ui_), _h * HALF + _R) * K + _C) * 2u; } } while (0)
#define PG8_STAGE_A(bufoff, gbase, hh, un_) do { if constexpr (Sched::GATHER) { unsigned _vo[2] = {(un_) ? gN[hh][0] : gA[hh][0], (un_) ? gN[hh][1] : gA[hh][1]}; PG8_STAGE(bufoff, gbase, _vo); } else { PG8_STAGE(bufoff, (gbase) + ((hh) ? hstep : 0), voffA); } } while (0)
    const size_t kstep = (size_t)(BK * 2);
    const size_t hstep = (size_t)HALF * K * 2;
    const size_t tstep = 2 * hstep;
    const unsigned ldsw = (unsigned)wid * 1024u;
    const int aoff = lds_byte(wr * 64 + fr, fq * 8), boff = lds_byte(wc * 32 + fr, fq * 8);
#define PG8_SA(b, h) (((b) * 2 + (h)) * HTB)
#define PG8_SB(b, h) ((4 + (b) * 2 + (h)) * HTB)
#define PG8_STAGE(bufoff, gbase, voff) do { _Pragma("unroll") for (int _i = 0; _i < 2; ++_i) \
        __builtin_amdgcn_global_load_lds((const unsigned*)((const char*)(gbase) + (voff)[_i]), (PG8_LAS unsigned*)(lds + (bufoff) + ldsw + _i * 8192), 16, 0, 0); } while (0)
#define PG8_LDA(dst, b, h) do { _Pragma("unroll") for (int m = 0; m < 4; ++m) _Pragma("unroll") for (int k = 0; k < 2; ++k) dst[m][k] = *(const PG8_LAS bf16x8*)(lds + PG8_SA(b, h) + aoff + m * 2048 + k * 1024); } while (0)
#define PG8_LDB(dst, b, h) do { _Pragma("unroll") for (int n = 0; n < 2; ++n) _Pragma("unroll") for (int k = 0; k < 2; ++k) dst[n][k] = *(const PG8_LAS bf16x8*)(lds + PG8_SB(b, h) + boff + n * 2048 + k * 1024); } while (0)
#define PG8_MMA(ai, bj, At, Bt) do { __builtin_amdgcn_s_setprio(1); _Pragma("unroll") for (int m = 0; m < 4; ++m) _Pragma("unroll") for (int n = 0; n < 2; ++n) _Pragma("unroll") for (int k = 0; k < 2; ++k) \
        acc[ai][bj][m][n] = __builtin_amdgcn_mfma_f32_16x16x32_bf16(Bt[n][k], At[m][k], acc[ai][bj][m][n], 0, 0, 0); __builtin_amdgcn_s_setprio(0); } while (0)
#define PG8_WAIT_V(n) asm volatile("s_waitcnt vmcnt(" #n ")" ::: "memory")
#define PG8_WAIT_L(n) asm volatile("s_waitcnt lgkmcnt(" #n ")" ::: "memory")
#define PG8_BAR __builtin_amdgcn_s_barrier()
#define PG8_SCHED __builtin_amdgcn_sched_barrier(0)
    Unit cur, nxt; int ui = 0;
    if (!S.next(0, cur)) return;
    f32x4 acc[2][2][4][2];
#pragma unroll
    for (int a = 0; a < 2; ++a)
#pragma unroll
        for (int b = 0; b < 2; ++b)
#pragma unroll
            for (int m = 0; m < 4; ++m)
#pragma unroll
                for (int n = 0; n < 2; ++n) acc[a][b][m][n] = (f32x4){0.f, 0.f, 0.f, 0.f};
    bf16x8 At[4][2], B0[2][2], B1[2][2];
    const char* cA = (const char*)g.A + (Sched::GATHER ? (size_t)0 : (size_t)cur.pm * tstep); const char* cB = (const char*)g.Bt + (size_t)cur.pn * tstep;
    if constexpr (Sched::GATHER) { PG8_GOFF(gA, 0); }
    S.a_ready(cur);
    if constexpr (SP2) {
        PG8_STAGE(PG8_SB(0, 0), cB, voffB); PG8_STAGE(PG8_SB(0, 1), cB + hstep, voffB); PG8_STAGE_A(PG8_SA(0, 0), cA, 0, false); PG8_STAGE_A(PG8_SA(0, 1), cA, 1, false);
        if (wr == 1) PG8_BAR;
        PG8_WAIT_V(2); PG8_BAR;
        PG8_STAGE(PG8_SB(1, 0), cB + kstep, voffB); PG8_STAGE_A(PG8_SA(1, 0), cA + kstep, 0, false); PG8_STAGE(PG8_SB(1, 1), cB + hstep + kstep, voffB);
        PG8_WAIT_V(6); PG8_BAR;
    } else {
        PG8_STAGE(PG8_SB(0, 0), cB, voffB); PG8_STAGE(PG8_SA(0, 0), cA, voffA); PG8_STAGE(PG8_SB(0, 1), cB + hstep, voffB); PG8_STAGE(PG8_SA(0, 1), cA + hstep, voffA);
        if (wr == 1) PG8_BAR;
        PG8_WAIT_V(4); PG8_BAR;
        PG8_STAGE(PG8_SB(1, 0), cB + kstep, voffB); PG8_STAGE(PG8_SA(1, 0), cA + kstep, voffA); PG8_STAGE(PG8_SB(1, 1), cB + hstep + kstep, voffB);
        PG8_WAIT_V(6); PG8_BAR;
    }
    PG8_PE(42);
    for (;;) {
        const bool has_next = S.next(ui + 1, nxt); PG8_PB(40);
        if constexpr (Sched::GATHER) { if (has_next) PG8_GOFF(gN, ui + 1); }
        const char* nA = (has_next && !Sched::GATHER) ? (const char*)g.A + (size_t)nxt.pm * tstep : cA; const char* nB = has_next ? (const char*)g.Bt + (size_t)nxt.pn * tstep : cB;
        for (int t = 0; t < nt; t += 2) {
            if constexpr (Epi::MIDK) { if (t == (nt >> 1)) { int t_ = threadIdx.x; asm volatile("" : "+v"(t_)); const int l_ = t_ & 63, w_ = __builtin_amdgcn_readfirstlane(t_ >> 6); E.mid(acc, cur, w_ >> 2, w_ & 3, l_ & 15, l_ >> 4); } }
            const bool last = (t == nt - 2); const bool un = last && has_next;
            const char* a1 = cA + (size_t)(t + 1) * kstep;
            const char* a2 = last ? nA : cA + (size_t)(t + 2) * kstep; const char* b2 = last ? nB : cB + (size_t)(t + 2) * kstep;
            const char* a3 = a2 + kstep; const char* b3 = b2 + kstep;
            if (last && has_next) S.a_ready(nxt);
            if constexpr (SP2) {
            PG8_LDB(B0, 0, 0); PG8_LDB(B1, 0, 1); PG8_SCHED; PG8_LDA(At, 0, 0); PG8_STAGE_A(PG8_SA(1, 1), a1, 1, false);
            PG8_WAIT_V(8); PG8_WAIT_L(0); PG8_BAR; PG8_MMA(0, 0, At, B0); PG8_MMA(0, 1, At, B1); PG8_BAR; PG8_SCHED;
            PG8_LDA(At, 0, 1); PG8_STAGE(PG8_SB(0, 0), b2, voffB); PG8_STAGE(PG8_SB(0, 1), b2 + hstep, voffB); PG8_STAGE_A(PG8_SA(0, 0), a2, 0, un);
            PG8_WAIT_V(8); PG8_WAIT_L(0); PG8_BAR; PG8_MMA(1, 0, At, B0); PG8_MMA(1, 1, At, B1); PG8_BAR; PG8_SCHED;
            PG8_LDB(B0, 1, 0); PG8_LDB(B1, 1, 1); PG8_SCHED; PG8_LDA(At, 1, 0); PG8_STAGE_A(PG8_SA(0, 1), a2, 1, un);
            PG8_WAIT_V(8); PG8_WAIT_L(0); PG8_BAR; PG8_MMA(0, 0, At, B0); PG8_MMA(0, 1, At, B1); PG8_BAR; PG8_SCHED;
            PG8_LDA(At, 1, 1); PG8_STAGE(PG8_SB(1, 0), b3, voffB); PG8_STAGE(PG8_SB(1, 1), b3 + hstep, voffB); PG8_STAGE_A(PG8_SA(1, 0), a3, 0, un);
            PG8_WAIT_V(8); PG8_WAIT_L(0); PG8_BAR; PG8_MMA(1, 0, At, B0); PG8_MMA(1, 1, At, B1); PG8_BAR; PG8_SCHED;
            } else {
            PG8_LDB(B0, 0, 0); PG8_SCHED; PG8_LDA(At, 0, 0); PG8_STAGE(PG8_SA(1, 1), a1 + hstep, voffA);
            PG8_WAIT_L(8); PG8_BAR; PG8_WAIT_L(0); PG8_MMA(0, 0, At, B0); PG8_BAR; PG8_SCHED;
            PG8_LDB(B1, 0, 1); PG8_STAGE(PG8_SB(0, 0), b2, voffB);
            PG8_BAR; PG8_WAIT_L(0); PG8_MMA(0, 1, At, B1); PG8_BAR;
            PG8_LDA(At, 0, 1); PG8_STAGE(PG8_SA(0, 0), a2, voffA);
            PG8_BAR; PG8_WAIT_L(0); PG8_MMA(1, 0, At, B0); PG8_BAR; PG8_SCHED;
            PG8_STAGE(PG8_SB(0, 1), b2 + hstep, voffB);
            PG8_WAIT_V(6); PG8_BAR; PG8_MMA(1, 1, At, B1); PG8_BAR;
            PG8_LDB(B0, 1, 0); PG8_SCHED; PG8_LDA(At, 1, 0); PG8_STAGE(PG8_SA(0, 1), a2 + hstep, voffA);
            PG8_WAIT_L(8); PG8_BAR; PG8_WAIT_L(0); PG8_MMA(0, 0, At, B0); PG8_BAR; PG8_SCHED;
            PG8_LDB(B1, 1, 1); PG8_STAGE(PG8_SB(1, 0), b3, voffB);
            PG8_BAR; PG8_WAIT_L(0); PG8_MMA(0, 1, At, B1); PG8_BAR;
            PG8_LDA(At, 1, 1); PG8_STAGE(PG8_SA(1, 0), a3, voffA);
            PG8_BAR; PG8_WAIT_L(0); PG8_MMA(1, 0, At, B0); PG8_BAR; PG8_SCHED;
            PG8_STAGE(PG8_SB(1, 1), b3 + hstep, voffB);
            PG8_WAIT_V(6); PG8_BAR; PG8_MMA(1, 1, At, B1); PG8_BAR;
            }
        }
        PG8_PE(40); PG8_PB(41);
        if constexpr (ALIGN_EPI) { if (wr == 0) PG8_BAR; }
        if constexpr (!Epi::AFTER_DRAIN) { int t_ = threadIdx.x; asm volatile("" : "+v"(t_)); const int l_ = t_ & 63, w_ = __builtin_amdgcn_readfirstlane(t_ >> 6); E(acc, cur, w_ >> 2, w_ & 3, l_ & 15, l_ >> 4); S.done(cur); }
        PG8_PE(41);
        if (!has_next) break;
#pragma unroll
        for (int a = 0; a < 2; ++a)
#pragma unroll
            for (int b = 0; b < 2; ++b)
#pragma unroll
                for (int m = 0; m < 4; ++m)
#pragma unroll
                    for (int n = 0; n < 2; ++n) acc[a][b][m][n] = (f32x4){0.f, 0.f, 0.f, 0.f};
        cur = nxt; cA = nA; cB = nB; ++ui;
        if constexpr (Sched::GATHER) { _Pragma("unroll") for (int _h = 0; _h < 2; ++_h) _Pragma("unroll") for (int _i = 0; _i < 2; ++_i) gA[_h][_i] = gN[_h][_i]; }
        if constexpr (ALIGN_EPI) { if (wr == 1) PG8_BAR; }
    }
    PG8_PB(43);
    PG8_WAIT_V(0);
    if constexpr (!ALIGN_EPI) { if (wr == 0) PG8_BAR; }
    PG8_BAR;
    if constexpr (Epi::AFTER_DRAIN) { E.fused(acc, cur, wr, wc, fr, fq, lds, wid, lane); S.done(cur); }
    PG8_PE(43);
#undef PG8_SA
#undef PG8_SB
#undef PG8_STAGE
#undef PG8_STAGE_A
#undef PG8_GOFF
#undef PG8_LDA
#undef PG8_LDB
#undef PG8_MMA
#undef PG8_WAIT_V
#undef PG8_WAIT_L
#undef PG8_BAR
#undef PG8_SCHED
}
}
#define GAS __attribute__((address_space(1)))
#define LAS __attribute__((address_space(3)))
typedef unsigned short bf16;
typedef unsigned v4u __attribute__((ext_vector_type(4)));
typedef float f32x4 __attribute__((ext_vector_type(4)));
typedef short bf16x8 __attribute__((ext_vector_type(8)));
typedef GAS unsigned gu32;
typedef GAS unsigned long long gu64;
#define RLX_AGENT __ATOMIC_RELAXED, __HIP_MEMORY_SCOPE_AGENT
#define LDS_WAIT() asm volatile("s_waitcnt lgkmcnt(0)" ::: "memory")
#define VM_WAIT() asm volatile("s_waitcnt vmcnt(0)" ::: "memory")
__device__ __forceinline__ unsigned long long rt() { return __builtin_amdgcn_s_memrealtime(); }
__device__ __forceinline__ unsigned f2bf(float f) { unsigned u = __builtin_bit_cast(unsigned, f); return (u + 0x7fffu + ((u >> 16) & 1u)) >> 16; }
__device__ __forceinline__ unsigned pk2(float lo, float hi) { return f2bf(lo) | (f2bf(hi) << 16); }
#define XB_TMO      128
#define XB_XCNT(j)  (256  + 64 * (j))
#define XB_XSUB(j)  (1280 + 64 * (j))
#define XB_XGEN(j)  (2304 + 64 * (j))
#define XB_TOP      3328
#define XB_TOPGEN   3392
#define XCD_BAR_WORDS 3456
#define XB_SPIN_CAP (1u << 18)

__device__ __forceinline__ unsigned xb_ld(unsigned* p)              { return __hip_atomic_load(p, __ATOMIC_RELAXED, __HIP_MEMORY_SCOPE_AGENT); }
__device__ __forceinline__ unsigned xb_add(unsigned* p, unsigned v) { return __hip_atomic_fetch_add(p, v, __ATOMIC_RELAXED, __HIP_MEMORY_SCOPE_AGENT); }
__device__ __forceinline__ unsigned xb_xcc_id() { return (unsigned)__builtin_amdgcn_s_getreg((3 << 11) | 20) & 0xFu; }
#define XB_SPIN(cond, bar) do { unsigned _sp = 0; while (cond) { __builtin_amdgcn_s_sleep(1); \
    if ((++_sp & 255u) == 0u) { if (xb_ld(&(bar)[XB_TMO])) break; if (_sp > XB_SPIN_CAP) { atomicAdd(&(bar)[XB_TMO], 1u); break; } } } } while (0)

struct XcdBarrier {
    unsigned* bar; unsigned x;
    volatile LAS unsigned* st;
};

__device__ __forceinline__ XcdBarrier xcd_barrier_post(unsigned* bar, volatile LAS unsigned* st) {
    XcdBarrier b; b.bar = bar; b.x = xb_xcc_id(); b.st = st;
    if (threadIdx.x == 0) (void)xb_add(&bar[XB_XCNT(b.x)], 1u);
    return b;
}
__device__ __forceinline__ void xcd_barrier_complete(unsigned* bar, unsigned x, unsigned& nloc, unsigned& nx) {
    const unsigned G = gridDim.x * gridDim.y * gridDim.z;
    unsigned sum, cnt, mine, sp = 0u;
    for (;;) {
        sum = 0u; cnt = 0u; mine = 0u;
#pragma unroll
        for (unsigned j = 0; j < 16; ++j) { const unsigned c = xb_ld(&bar[XB_XCNT(j)]); sum += c; cnt += (c > 0u) ? 1u : 0u; mine = (j == x) ? c : mine; }
        if (sum == G) break;
        __builtin_amdgcn_s_sleep(1);
        if ((++sp & 255u) == 0u) { if (xb_ld(&bar[XB_TMO])) break; if (sp > XB_SPIN_CAP) { atomicAdd(&bar[XB_TMO], 1u); break; } }
    }
    nloc = mine > 0u ? mine : 1u; nx = cnt > 0u ? cnt : 1u;
}

__device__ __forceinline__ void xcd_barrier(const XcdBarrier& b) {
    asm volatile("s_waitcnt vmcnt(0)" ::: "memory");
    __syncthreads();
    if (threadIdx.x == 0) {
        unsigned* bar = b.bar;
        __builtin_amdgcn_s_waitcnt(0);
        unsigned nloc = b.st[0], nx = b.st[1];
        if (nloc == 0u) { xcd_barrier_complete(bar, b.x, nloc, nx); b.st[0] = nloc; b.st[1] = nx; }
        const unsigned old = xb_add(&bar[XB_XSUB(b.x)], 1u);
        const unsigned gen = old / nloc;
        if (old + 1u == (gen + 1u) * nloc) {
            __builtin_amdgcn_fence(__ATOMIC_RELEASE, "agent");
            asm volatile("s_waitcnt vmcnt(0)" ::: "memory");
            const unsigned og = xb_add(&bar[XB_TOP], 1u);
            const unsigned tg = og / nx;
            if (og + 1u == (tg + 1u) * nx) xb_add(&bar[XB_TOPGEN], 1u);
            else XB_SPIN(xb_ld(&bar[XB_TOPGEN]) == tg, bar);
            __builtin_amdgcn_fence(__ATOMIC_ACQUIRE, "agent");
            xb_add(&bar[XB_XGEN(b.x)], 1u);
            asm volatile("s_waitcnt vmcnt(0)" ::: "memory");
        } else {
            XB_SPIN(xb_ld(&bar[XB_XGEN(b.x)]) == gen, bar);
            __builtin_amdgcn_fence(__ATOMIC_ACQUIRE, "agent");
            asm volatile("s_waitcnt vmcnt(0)" ::: "memory");
        }
    }
    __syncthreads();
}

constexpr int NWAVES = 8, NTHR = 512;
constexpr int M = 32768, D = 1024, SEQ = 8192, NB = 4;
constexpr int DIN = 5136;
constexpr int MOE_CAP_TILES = 288, MOE_CAP = MOE_CAP_TILES * 256;
constexpr int LIST_CAP = 256 * 496;
constexpr float EPS = 1e-6f;
#ifndef MK_ONE_LAUNCH
#define MK_ONE_LAUNCH 0
#endif
constexpr int NPHASE = 20;

constexpr size_t MiB = 1u << 20, KiB = 1u << 10;
constexpr size_t WS_CTL = 0, CTL_ZERO_BYTES = 1 * MiB;
constexpr int CW_TMO = 0, CW_CODE = 1, CW_BAR = 4096, CW_LCNT = 16384, CW_ECNT = 20480, CW_WQ = 24576;
constexpr size_t WS_RSTD0 = 1 * MiB, WS_RSTD1 = WS_RSTD0 + 128 * KiB, WS_RSTD2 = WS_RSTD1 + 128 * KiB;
constexpr size_t WS_DEC = 1 * MiB + 512 * KiB;
constexpr size_t WS_KMEAN = 2 * MiB, WS_KNMAX = 2 * MiB + 256 * KiB;
constexpr size_t WS_MOE_E = 2 * MiB + 512 * KiB, WS_MOE_POS = WS_MOE_E + 256 * KiB, WS_MOE_W = WS_MOE_POS + 256 * KiB, WS_SLOT_OF = WS_MOE_W + 256 * KiB;
constexpr size_t WS_W_SLOT = 4 * MiB, WS_RSTD_SLOT = 4 * MiB + 512 * KiB, WS_TILE_E = 5 * MiB;
constexpr size_t WS_MEMN = 6 * MiB, WS_MKV = 8 * MiB;
constexpr size_t WS_W1T = 10 * MiB  , WS_WVT = WS_W1T + 8704 * KiB, WS_PGMT = WS_WVT + 2 * MiB  , WS_WOUTT = WS_PGMT + 2 * MiB,
                 WS_WCQT = WS_WOUTT + 2 * MiB, WS_WCKVT = WS_WCQT + 1 * MiB, WS_WCOT = WS_WCKVT + 2 * MiB, WS_WRT = WS_WCOT + 1 * MiB;
static_assert(WS_WRT + 1 * MiB <= 30 * MiB, "weights");
constexpr size_t WS_XB = 30 * MiB, WS_QG = 94 * MiB, WS_KG = 110 * MiB, WS_SR = 126 * MiB, WS_QM = 158 * MiB, WS_KM = 190 * MiB, WS_VT = 222 * MiB, WS_OGM = 286 * MiB  , WS_SZ = 350 * MiB;
constexpr size_t WS_LISTS = 478 * MiB, WS_REFS = 494 * MiB, WS_SEL = 495 * MiB, WS_PARTL = 496 * MiB;
constexpr size_t WS_MG = 30 * MiB, WS_X1H = 94 * MiB, WS_X1L = 158 * MiB, WS_QC = 476 * MiB, WS_SS2 = 508 * MiB, WS_SS1 = 510 * MiB;
constexpr size_t WS_X2H = 222 * MiB, WS_X2L = 286 * MiB;
constexpr size_t WS_WGUT = 30 * MiB, WS_WDT = 350 * MiB, WS_LG = 454 * MiB, WS_LG2 = 464 * MiB, WS_HID = 382 * MiB, WS_XG = 30 * MiB  ;
constexpr size_t WS_END = 512 * MiB;
static_assert(WS_XG + 144 * MiB <= WS_X2H && WS_WDT + 32 * MiB <= WS_HID && WS_HID + 72 * MiB <= WS_LG && WS_LG2 + 5 * MiB <= WS_QC && WS_PARTL + 3 * MiB <= WS_END && WS_SS1 + 2 * MiB <= WS_END, "map");
constexpr size_t DO_ST = 0, DO_LA = 64 * MiB, DO_SB = 96 * MiB, DO_PARTO = 0;
constexpr size_t WS_TOK = 5 * MiB + 64 * KiB;
constexpr size_t WS_EMID = 5 * MiB + 512 * KiB;

constexpr int RING_OFF = 0, RING_BYTES = 147456;
constexpr int LDSCTL_OFF = RING_BYTES, MISC_OFF = LDSCTL_OFF + 320;
constexpr int TBL_TILE = RING_BYTES + 1024, TBL_TAB = TBL_TILE + 1280, TBL_BC = TBL_TAB + 512, TBL_EB = TBL_BC + 64;
constexpr int TBL_ROWS = 155648;
constexpr int LDS_BYTES = 163840;
static_assert(TBL_EB + 256 + 1088 * 4 <= TBL_ROWS && TBL_ROWS + 6 * 1024 <= LDS_BYTES, "LDS tables");
static_assert(TBL_EB + 256 + 1088 * 4 <= LDS_BYTES, "LDS map");

struct Args { const float* in[25]; float* out; unsigned char* ws; int ph_lo, ph_hi; };
struct Frame {
    unsigned long long pacc, pt0;
    LAS unsigned char* lds; unsigned char* ldsg;
    volatile LAS unsigned* MISC; gu32* ctl;
    int vcu, G;
    unsigned char* ws; float* out;
};
template <class T> __device__ __forceinline__ T* uniform_ptr(T* p) { const unsigned long long v = (unsigned long long)p; const unsigned lo = __builtin_amdgcn_readfirstlane((unsigned)v), hi = __builtin_amdgcn_readfirstlane((unsigned)(v >> 32)); return (T*)(((unsigned long long)hi << 32) | lo); }
__device__ __forceinline__ float wave_sum(float v) {
#pragma unroll
    for (int o = 1; o < 64; o <<= 1) v += __shfl_xor(v, o);
    return v;
}
__device__ __forceinline__ float wave_max(float v) {
#pragma unroll
    for (int o = 1; o < 64; o <<= 1) v = fmaxf(v, __shfl_xor(v, o));
    return v;
}
__device__ __forceinline__ float bf2f(bf16 h) { return __uint_as_float(((unsigned)h) << 16); }
__device__ __forceinline__ float bflo(unsigned w) { return __uint_as_float(w << 16); }
__device__ __forceinline__ float bfhi(unsigned w) { return __uint_as_float(w & 0xffff0000u); }
__device__ __forceinline__ void unpack8(const v4u w, float* f) { f[0] = bflo(w.x); f[1] = bfhi(w.x); f[2] = bflo(w.y); f[3] = bfhi(w.y); f[4] = bflo(w.z); f[5] = bfhi(w.z); f[6] = bflo(w.w); f[7] = bfhi(w.w); }
__device__ __forceinline__ v4u pack8f(const float* f) { v4u w; w.x = pk2(f[0], f[1]); w.y = pk2(f[2], f[3]); w.z = pk2(f[4], f[5]); w.w = pk2(f[6], f[7]); return w; }
__device__ __forceinline__ int t5_bucket(int n) {
    if (n < 16) return n;
    int b = 16;
    b += (n >= 19) + (n >= 21) + (n >= 24) + (n >= 27) + (n >= 31) + (n >= 35) + (n >= 40) + (n >= 46) + (n >= 52) + (n >= 59) + (n >= 67) + (n >= 77) + (n >= 87) + (n >= 99) + (n >= 113);
    return b;
}

#ifndef PROBE_ACC
#define PROBE_ACC -1
#endif
#define PB(i) do { if ((i) == PROBE_ACC) F.pt0 = __builtin_amdgcn_s_memrealtime(); } while (0)
#define PE(i) do { if ((i) == PROBE_ACC) F.pacc += __builtin_amdgcn_s_memrealtime() - F.pt0; } while (0)
#define PHASE_IDS int tid = threadIdx.x; asm volatile("" : "+v"(tid)); const int lane = tid & 63; const int wave = __builtin_amdgcn_readfirstlane(tid >> 6); (void)lane; (void)wave
struct TrDesc { const float* src; const float* gain; bf16* dst; int ldw, K, k0; };
__device__ __forceinline__ void tr_load(const TrDesc& t, int lane, f32x4 (&v)[8]) {
#pragma unroll
    for (int i = 0; i < 8; ++i) { const int id = i * 64 + lane, kk = id >> 3, c4 = (id & 7) * 4; v[i] = *(const GAS f32x4*)(t.src + (size_t)(t.k0 + kk) * t.ldw + c4); }
}
__device__ __forceinline__ void tr_finish(const TrDesc& t, int lane, const f32x4 (&v)[8], LAS float* scr) {
#pragma unroll
    for (int i = 0; i < 8; ++i) { const int id = i * 64 + lane, kk = id >> 3, c4 = (id & 7) * 4; const float g = t.gain ? t.gain[t.k0 + kk] : 1.f; LAS float* p = scr + kk * 33 + c4; p[0] = v[i][0] * g; p[1] = v[i][1] * g; p[2] = v[i][2] * g; p[3] = v[i][3] * g; }
    LDS_WAIT(); asm volatile("" ::: "memory");
    const int c = lane & 7;
#pragma unroll
    for (int j = 0; j < 4; ++j) { const int n = (lane >> 3) + 8 * j; const LAS float* s2 = scr + (8 * c) * 33 + n;
        v4u o; o.x = pk2(s2[0 * 33], s2[1 * 33]); o.y = pk2(s2[2 * 33], s2[3 * 33]); o.z = pk2(s2[4 * 33], s2[5 * 33]); o.w = pk2(s2[6 * 33], s2[7 * 33]);
        *(GAS v4u*)(t.dst + (size_t)n * t.K + t.k0 + 8 * c) = o; }
    LDS_WAIT(); asm volatile("" ::: "memory");
}
__device__ __forceinline__ void tr_item_alpha(const float* w_in, const float* wau, const float* gain, bf16* dst, int k0, int n0, LAS float* scr, int lane) {
    const float* a = w_in + (size_t)(k0 + lane) * DIN + 1536; const f32x4 a0 = *(const GAS f32x4*)a, a1 = *(const GAS f32x4*)(a + 4), a2 = *(const GAS f32x4*)(a + 8), a3 = *(const GAS f32x4*)(a + 12);
    const float gk = gain[k0 + lane]; const float av[16] = {a0[0], a0[1], a0[2], a0[3], a1[0], a1[1], a1[2], a1[3], a2[0], a2[1], a2[2], a2[3], a3[0], a3[1], a3[2], a3[3]};
#pragma unroll 4
    for (int n = 0; n < 32; ++n) { float v = 0.f;
#pragma unroll
        for (int r = 0; r < 16; ++r) v += av[r] * wau[r * 256 + n0 + n];
        scr[lane * 33 + n] = v * gk; }
    LDS_WAIT(); asm volatile("" ::: "memory");
    const int c = lane & 7;
#pragma unroll
    for (int j = 0; j < 4; ++j) { const int n = (lane >> 3) + 8 * j; const LAS float* s = scr + (8 * c) * 33 + n;
        v4u o; o.x = pk2(s[0 * 33], s[1 * 33]); o.y = pk2(s[2 * 33], s[3 * 33]); o.z = pk2(s[4 * 33], s[5 * 33]); o.w = pk2(s[6 * 33], s[7 * 33]);
        *(GAS v4u*)(dst + (size_t)(n0 + n) * 1024 + k0 + 8 * c) = o; }
    LDS_WAIT(); asm volatile("" ::: "memory");
}
struct TrJob { int src, col0, ldw, gain, K  , ncols, drow; unsigned dst_off_kib; int kdst  , koff  ; };
__constant__ TrJob kJobs[15] = {
    {5, 0, DIN, 4, 1024, 256, 0, (unsigned)(WS_W1T / 1024), 1024, 0},
    {5, 256, DIN, 4, 1024, 256, 256, (unsigned)(WS_W1T / 1024), 1024, 0},
    {5, 1024, DIN, 4, 1024, 512, 512, (unsigned)(WS_W1T / 1024), 1024, 0},
    {5, 1552, DIN, 4, 1024, 512, 1280, (unsigned)(WS_W1T / 1024), 1024, 0},
    {5, 2064, DIN, 4, 1024, 512, 1792, (unsigned)(WS_W1T / 1024), 1024, 0},
    {5, 3088, DIN, 4, 1024, 1024, 2304, (unsigned)(WS_W1T / 1024), 1024, 0},
    {5, 4112, DIN, 4, 1024, 1024, 3328, (unsigned)(WS_W1T / 1024), 1024, 0},
    {5, 512, DIN, 4, 1024, 512, 0, (unsigned)(WS_WVT / 1024), 1024, 0},
    {5, 2576, DIN, 4, 1024, 512, 512, (unsigned)(WS_WVT / 1024), 1024, 0},
    {9, 0, 1024, -1, 512, 1024, 0, (unsigned)(WS_PGMT / 1024), 1024, 0},
    {10, 0, 1024, -1, 512, 1024, 0, (unsigned)(WS_PGMT / 1024), 1024, 512},
    {11, 0, 1024, -1, 1024, 1024, 0, (unsigned)(WS_WOUTT / 1024), 1024, 0},
    {13, 0, 512, 12, 1024, 512, 0, (unsigned)(WS_WCQT / 1024), 1024, 0},
    {14, 0, 1024, -1, 1024, 1024, 0, (unsigned)(WS_WCKVT / 1024), 1024, 0},
    {15, 0, 1024, -1, 512, 1024, 0, (unsigned)(WS_WCOT / 1024), 512, 0},
};

__device__ __forceinline__ void p0_prologue(Frame& F, const Args& A) {
    PHASE_IDS;
    LAS float* scr = (LAS float*)(F.lds + RING_OFF + wave * 16384);
    const int gw = F.vcu * NWAVES + wave, NGW = F.G * NWAVES;
    PB(20);
    int total = 0;
#pragma unroll 1
    for (int j = 0; j < 15; ++j) total += (kJobs[j].K / 64) * (kJobs[j].ncols / 32);
    const int alpha_items = 16 * 8;
#pragma unroll 1
    for (int it = gw; it < total + alpha_items; it += NGW) {
        if (it >= total) { const int r = it - total; tr_item_alpha(A.in[5], A.in[6], A.in[4], (bf16*)(F.ws + WS_W1T) + (size_t)1024 * 1024, (r >> 3) * 64, (r & 7) * 32, scr, lane); continue; }
        int r = it, j = 0;
#pragma unroll 1
        for (; j < 15; ++j) { const int n = (kJobs[j].K / 64) * (kJobs[j].ncols / 32); if (r < n) break; r -= n; }
        const TrJob jb = kJobs[j]; const int nblk = jb.ncols / 32, kb = r / nblk, nb = r % nblk;
        const TrDesc t{A.in[jb.src] + jb.col0 + nb * 32, jb.gain >= 0 ? A.in[jb.gain] : nullptr, (bf16*)(F.ws + (size_t)jb.dst_off_kib * 1024) + (size_t)(jb.drow + nb * 32) * jb.kdst + jb.koff, jb.ldw, jb.kdst, kb * 64};
        f32x4 v[8]; tr_load(t, lane, v); tr_finish(t, lane, v, scr);
    }
    PE(20); PB(21);
    { bf16* wrt = (bf16*)(F.ws + WS_WRT); const float* g = A.in[16]; const float* wg = A.in[17]; const float* we = A.in[19];
        for (int i = blockIdx.x * NTHR + tid; i < 2 * 256 * 1024; i += F.G * NTHR) { const int mat = i >> 18, o = (i >> 10) & 255, kk = i & 1023; unsigned v = 0;
            if (o < (mat ? 36 : 72)) { const int oo = o < 36 ? o : o - 36; const float w = g[kk] * (oo < 4 ? wg[kk * 4 + oo] : we[kk * 32 + oo - 4]); const unsigned hi = f2bf(w);
                v = o < 36 ? hi : f2bf(w - __uint_as_float(hi << 16)); }
            wrt[i] = (bf16)v; } }
    PE(21); PB(22);
    { const float* x = A.in[0]; bf16* xb = (bf16*)(F.ws + WS_XB); float* rstd0 = (float*)(F.ws + WS_RSTD0);
        int m = gw;
        if (m < M) { f32x4 v[4];
#pragma unroll
            for (int j = 0; j < 4; ++j) v[j] = ((const GAS f32x4*)(x + (size_t)m * D))[64 * j + lane];
#pragma unroll 1
            for (;;) { const int mn = m + NGW; const bool more = mn < M; f32x4 w[4];
                if (more) {
#pragma unroll
                    for (int j = 0; j < 4; ++j) w[j] = ((const GAS f32x4*)(x + (size_t)mn * D))[64 * j + lane]; }
                float s = 0.f;
#pragma unroll
                for (int j = 0; j < 4; ++j) s += (v[j].x * v[j].x + v[j].y * v[j].y) + (v[j].z * v[j].z + v[j].w * v[j].w);
                s = wave_sum(s); const float rs = rsqrtf(s * (1.f / D) + EPS);
                GAS unsigned long long* o8 = (GAS unsigned long long*)(xb + (size_t)m * D) + lane;
#pragma unroll
                for (int j = 0; j < 4; ++j) o8[64 * j] = (unsigned long long)pk2(v[j].x * rs, v[j].y * rs) | ((unsigned long long)pk2(v[j].z * rs, v[j].w * rs) << 32);
                if (!more) break;
                m = mn;
#pragma unroll
                for (int j = 0; j < 4; ++j) v[j] = w[j]; } } }
    PE(22); PB(23);
    { const float* mem = A.in[1]; const float* gm = A.in[2]; bf16* mn = (bf16*)(F.ws + WS_MEMN);
        for (int m = gw; m < 1024; m += NGW) { const GAS f32x4* xr = (const GAS f32x4*)(mem + (size_t)m * D) + lane; const GAS f32x4* gr = (const GAS f32x4*)gm + lane; f32x4 v[4]; float s = 0.f;
#pragma unroll
            for (int j = 0; j < 4; ++j) { v[j] = xr[64 * j]; s += (v[j].x * v[j].x + v[j].y * v[j].y) + (v[j].z * v[j].z + v[j].w * v[j].w); }
            s = wave_sum(s); const float rs = rsqrtf(s * (1.f / D) + EPS);
            GAS unsigned long long* o8 = (GAS unsigned long long*)(mn + (size_t)m * D) + lane;
#pragma unroll
            for (int j = 0; j < 4; ++j) { const f32x4 g = gr[64 * j]; o8[64 * j] = (unsigned long long)pk2(v[j].x * rs * g.x, v[j].y * rs * g.y) | ((unsigned long long)pk2(v[j].z * rs * g.z, v[j].w * rs * g.w) << 32); } } }
}
__device__ __forceinline__ TrDesc expert_item(const Args& A, unsigned char* ws, int it) {
    bf16* wgut = (bf16*)(ws + WS_WGUT); bf16* wdt = (bf16*)(ws + WS_WDT); const int e = it / 768, r = it % 768;
    if (r < 512) { const int up = r >> 8, rr = r & 255, kb = rr >> 4, nb = rr & 15, c0 = nb * 32;
        return TrDesc{A.in[up ? 22 : 21] + (size_t)e * 1024 * 512 + c0, A.in[16], wgut + ((size_t)e * 1024 + (c0 >> 7) * 256 + (c0 & 127) + up * 128) * 1024, 512, 1024, kb * 64}; }
    const int rr = r - 512, kb = rr >> 5, nb = rr & 31;
    return TrDesc{A.in[23] + (size_t)e * 512 * 1024 + nb * 32, nullptr, wdt + ((size_t)e * 1024 + nb * 32) * 512, 1024, 512, kb * 64};
}
__device__ __forceinline__ void expert_weights(Frame& F, const Args& A) {
    PHASE_IDS;
    LAS float* scr = (LAS float*)(F.lds + RING_OFF + wave * 16384);
    const int gw = F.vcu * NWAVES + wave, NGW = F.G * NWAVES;
    int it = gw; if (it >= 32 * 768) return;
    TrDesc cur = expert_item(A, F.ws, it); f32x4 v[8]; tr_load(cur, lane, v);
#pragma unroll 1
    for (;;) { const int nx = it + NGW; const bool more = nx < 32 * 768;
        TrDesc nd = cur; f32x4 w[8];
        if (more) { nd = expert_item(A, F.ws, nx); tr_load(nd, lane, w); }
        tr_finish(cur, lane, v, scr);
        if (!more) break;
        cur = nd; it = nx;
#pragma unroll
        for (int i = 0; i < 8; ++i) v[i] = w[i]; }
}

typedef short mb_bf16x8 __attribute__((ext_vector_type(8)));
typedef unsigned mb_u32x2 __attribute__((ext_vector_type(2)));
__device__ __forceinline__ unsigned mb_cvt_pk(float lo, float hi) { unsigned r; asm volatile("v_cvt_pk_bf16_f32 %0, %1, %2" : "=v"(r) : "v"(lo), "v"(hi)); return r; }
constexpr int GS = 65;
__device__ __forceinline__ void gla_load_b(Frame& F, int tid, const float* LA, int m0, int h, float* Bs) {
#pragma unroll 1
    for (int i = tid; i < 4096; i += NTHR) { const int c = i >> 6, d = i & 63; Bs[c * GS + d] = LA[(size_t)(m0 + c) * 256 + h * 64 + d]; }
    __syncthreads();
    if (tid < 64) { float s = 0.f;
#pragma unroll 8
        for (int c = 0; c < 64; ++c) { s += Bs[c * GS + tid]; Bs[c * GS + tid] = s; } }
    __syncthreads();
}
constexpr int GL_STR = 144;
__device__ __forceinline__ void gla_a_phase(Frame& F) {
    PHASE_IDS;
    LAS float* tot = (LAS float*)(F.lds + RING_OFF); LAS unsigned char* Kt = F.lds + RING_OFF + 2048;
    const float* LA = (const float*)((unsigned char*)F.out + DO_LA); float* ST = (float*)((unsigned char*)F.out + DO_ST);
    const bf16* KG = (const bf16*)(F.ws + WS_KG); const bf16* VT = (const bf16*)(F.ws + WS_VT); float* DEC = (float*)(F.ws + WS_DEC); float* EMID = (float*)(F.ws + WS_EMID);
    const int d = tid & 63, seg = wave, lq = lane & 15, g = lane >> 4;
#pragma unroll 1
    for (int u = blockIdx.x; u < 2048; u += F.G) {
        const int bh = u >> 7, n = u & 127, b = bh >> 2, h = bh & 3, m0 = b * SEQ + n * 64;
        float a[8], kk[8];
#pragma unroll
        for (int i = 0; i < 8; ++i) { const size_t gi = (size_t)(m0 + seg * 8 + i) * 256 + h * 64 + d; a[i] = LA[gi]; kk[i] = bf2f(KG[gi]); }
#pragma unroll
        for (int i = 1; i < 8; ++i) a[i] += a[i - 1];
        tot[seg * 64 + d] = a[7];
        __syncthreads();
        float off = 0.f, total = 0.f;
#pragma unroll
        for (int s2 = 0; s2 < 8; ++s2) { const float t = tot[s2 * 64 + d]; if (s2 < seg) off += t; total += t; }
        { v4u w; float e[8];
#pragma unroll
            for (int i = 0; i < 8; ++i) e[i] = kk[i] * __expf(total - (off + a[i]));
            w.x = pk2(e[0], e[1]); w.y = pk2(e[2], e[3]); w.z = pk2(e[4], e[5]); w.w = pk2(e[6], e[7]);
            *(LAS v4u*)(Kt + d * GL_STR + seg * 16) = w; }
        if (seg == 0) { DEC[u * 64 + d] = __expf(total); EMID[u * 64 + d] = __expf((tot[d] + tot[64 + d]) + (tot[128 + d] + tot[192 + d])); }
        __syncthreads();
        { mb_bf16x8 bf[2];
#pragma unroll
            for (int ks = 0; ks < 2; ++ks) bf[ks] = *(const GAS mb_bf16x8*)(VT + (size_t)(h * 128 + wave * 16 + lq) * M + m0 + 32 * ks + 8 * g);
#pragma unroll
            for (int dt = 0; dt < 4; ++dt) { f32x4 acc = (f32x4){0.f, 0.f, 0.f, 0.f};
#pragma unroll
                for (int ks = 0; ks < 2; ++ks) { const mb_bf16x8 af = *(const LAS mb_bf16x8*)(Kt + (dt * 16 + lq) * GL_STR + ks * 64 + g * 16); acc = __builtin_amdgcn_mfma_f32_16x16x32_bf16(af, bf[ks], acc, 0, 0, 0); }
                *(GAS f32x4*)(ST + ((size_t)u * 128 + wave * 16 + lq) * 64 + dt * 16 + 4 * g) = acc; } }
        __syncthreads();
    }
}
__device__ __forceinline__ void gla_scan_phase(Frame& F) {
    PHASE_IDS;
    const float* ST = (const float*)((unsigned char*)F.out + DO_ST); bf16* SB = (bf16*)((unsigned char*)F.out + DO_SB); const float* DEC = (const float*)(F.ws + WS_DEC); const float* EMID = (const float*)(F.ws + WS_EMID);
#pragma unroll 1
    for (int g = blockIdx.x * NTHR + tid; g < 16 * 8192; g += F.G * NTHR) { const int bh = g >> 13, vd = g & 8191, d = vd & 63; float st = 0.f;
        const float* p = ST + (size_t)bh * 128 * 8192 + vd; bf16* q = SB + (size_t)bh * 128 * 8192 + vd; const float* dc = DEC + bh * 128 * 64 + d; const float* em = EMID + bh * 128 * 64 + d;
#pragma unroll 1
        for (int n0 = 0; n0 < 128; n0 += 16) { float kv[16], de[16], ee[16];
#pragma unroll
            for (int i = 0; i < 16; ++i) { kv[i] = p[(size_t)(n0 + i) * 8192]; de[i] = dc[(n0 + i) * 64]; ee[i] = em[(n0 + i) * 64]; }
#pragma unroll
            for (int i = 0; i < 16; ++i) { q[(size_t)(n0 + i) * 8192] = (bf16)f2bf(st * ee[i]); st = de[i] * st + kv[i]; } } }
}
constexpr int GB_TOT = 0, GB_QE = 2048, GB_KE = GB_QE + 64 * GL_STR, GB_VT = GB_KE + 64 * GL_STR, GB_SB = GB_VT + 128 * GL_STR, GB_UNIT = GB_SB + 128 * GL_STR;
static_assert(2 * GB_UNIT <= RING_BYTES && GB_UNIT % 16 == 0, "GLA-B LDS");
typedef float gb_f32x2 __attribute__((ext_vector_type(2)));
__device__ __forceinline__ void gla_b_phase(Frame& F, const Args& A) {
    PHASE_IDS;
    const float* LA = (const float*)((unsigned char*)F.out + DO_LA); const bf16* SB = (const bf16*)((unsigned char*)F.out + DO_SB);
    const bf16* QG = (const bf16*)(F.ws + WS_QG); const bf16* KG = (const bf16*)(F.ws + WS_KG); const bf16* VT = (const bf16*)(F.ws + WS_VT); const bf16* SR = (const bf16*)(F.ws + WS_SR);
    bf16* OG = (bf16*)(F.ws + WS_OGM); const float* gg = A.in[8];
    const int U = wave >> 2, lt = tid & 255, dp = lt & 31, seg = lt >> 5, lq = lane & 15, g = lane >> 4, ct = wave & 3;
    LAS unsigned char* base = F.lds + RING_OFF + U * GB_UNIT;
    LAS float* tot = (LAS float*)(base + GB_TOT); LAS unsigned char* Qe = base + GB_QE; LAS unsigned char* Ke = base + GB_KE; LAS unsigned char* Vt = base + GB_VT; LAS unsigned char* Sb = base + GB_SB;
    gb_f32x2 a[8]; unsigned q2[8], k2[8]; v4u vc[4], sc[4];
#define GB_LOAD(PR_) do { const int u_ = 2 * (PR_) + U, bh_ = u_ >> 7, n_ = u_ & 127, b_ = bh_ >> 2, h_ = bh_ & 3, m0_ = b_ * SEQ + n_ * 64; \
        _Pragma("unroll") for (int i = 0; i < 8; ++i) { const size_t gi = (size_t)(m0_ + seg * 8 + i) * 256 + h_ * 64 + 2 * dp; a[i] = *(const GAS gb_f32x2*)(LA + gi); q2[i] = *(const GAS unsigned*)(QG + gi); k2[i] = *(const GAS unsigned*)(KG + gi); } \
        _Pragma("unroll") for (int i = 0; i < 4; ++i) { const int ch = lt + i * 256, v = ch >> 3, c8 = ch & 7; vc[i] = *(const GAS v4u*)(VT + (size_t)(h_ * 128 + v) * M + m0_ + c8 * 8); sc[i] = *(const GAS v4u*)(SB + ((size_t)u_ * 128 + v) * 64 + c8 * 8); } } while (0)
    int pr = blockIdx.x;
    if (pr < 1024) GB_LOAD(pr);
#pragma unroll 1
    for (; pr < 1024; pr += F.G) {
        const int u = 2 * pr + U, bh = u >> 7, n = u & 127, b = bh >> 2, h = bh & 3, m0 = b * SEQ + n * 64;
#pragma unroll
        for (int i = 1; i < 8; ++i) a[i] += a[i - 1];
        *(LAS gb_f32x2*)(tot + seg * 64 + 2 * dp) = a[7];
#pragma unroll
        for (int i = 0; i < 4; ++i) { const int ch = lt + i * 256, v = ch >> 3, c8 = ch & 7; *(LAS v4u*)(Vt + v * GL_STR + c8 * 16) = vc[i]; *(LAS v4u*)(Sb + v * GL_STR + c8 * 16) = sc[i]; }
        __syncthreads();
        { gb_f32x2 off = (gb_f32x2){0.f, 0.f}, bmid = (gb_f32x2){0.f, 0.f};
#pragma unroll
            for (int s2 = 0; s2 < 7; ++s2) { const gb_f32x2 t = *(const LAS gb_f32x2*)(tot + s2 * 64 + 2 * dp); if (s2 < seg) off += t; if (s2 < 4) bmid += t; }
#pragma unroll
            for (int i = 0; i < 8; ++i) { const int c = seg * 8 + i; const gb_f32x2 bb = off + a[i];
                *(LAS unsigned*)(Qe + c * GL_STR + dp * 4) = mb_cvt_pk(bflo(q2[i]) * __expf(bb.x - bmid.x), bfhi(q2[i]) * __expf(bb.y - bmid.y));
                *(LAS unsigned*)(Ke + c * GL_STR + dp * 4) = mb_cvt_pk(bflo(k2[i]) * __expf(bmid.x - bb.x), bfhi(k2[i]) * __expf(bmid.y - bb.y)); } }
        __syncthreads();
        if (pr + F.G < 1024) GB_LOAD(pr + F.G);
        {
            const size_t mrow = (size_t)(m0 + ct * 16 + lq) * 512 + h * 128;
            mb_u32x2 srv[8];
#pragma unroll
            for (int vt = 0; vt < 8; ++vt) srv[vt] = *(const GAS mb_u32x2*)(SR + mrow + vt * 16 + 4 * g);
            mb_bf16x8 bq[2];
#pragma unroll
            for (int ks = 0; ks < 2; ++ks) bq[ks] = *(const LAS mb_bf16x8*)(Qe + (ct * 16 + lq) * GL_STR + ks * 64 + g * 16);
            f32x4 sa[4];
#pragma unroll
            for (int st = 0; st < 4; ++st) { sa[st] = (f32x4){0.f, 0.f, 0.f, 0.f};
                if (st <= ct) {
#pragma unroll
                    for (int ks = 0; ks < 2; ++ks) { const mb_bf16x8 af = *(const LAS mb_bf16x8*)(Ke + (st * 16 + lq) * GL_STR + ks * 64 + g * 16); sa[st] = __builtin_amdgcn_mfma_f32_16x16x32_bf16(af, bq[ks], sa[st], 0, 0, 0); }
                    if (st == ct) {
#pragma unroll
                        for (int r = 0; r < 4; ++r) if (4 * g + r > lq) sa[st][r] = 0.f; } } }
            mb_bf16x8 pb[2];
#pragma unroll
            for (int kp = 0; kp < 2; ++kp) { v4u pw; pw.x = mb_cvt_pk(sa[2 * kp][0], sa[2 * kp][1]); pw.y = mb_cvt_pk(sa[2 * kp][2], sa[2 * kp][3]); pw.z = mb_cvt_pk(sa[2 * kp + 1][0], sa[2 * kp + 1][1]); pw.w = mb_cvt_pk(sa[2 * kp + 1][2], sa[2 * kp + 1][3]); pb[kp] = __builtin_bit_cast(mb_bf16x8, pw); }
            f32x4 o[8]; float ss = 0.f;
#pragma unroll
            for (int vt = 0; vt < 8; ++vt) { o[vt] = (f32x4){0.f, 0.f, 0.f, 0.f};
#pragma unroll
                for (int kp = 0; kp < 2; ++kp) if (2 * kp <= ct) { const mb_u32x2 a0 = *(const LAS mb_u32x2*)(Vt + (vt * 16 + lq) * GL_STR + kp * 64 + g * 8), a1 = *(const LAS mb_u32x2*)(Vt + (vt * 16 + lq) * GL_STR + kp * 64 + 32 + g * 8);
                    v4u aw; aw.x = a0.x; aw.y = a0.y; aw.z = a1.x; aw.w = a1.y; o[vt] = __builtin_amdgcn_mfma_f32_16x16x32_bf16(__builtin_bit_cast(mb_bf16x8, aw), pb[kp], o[vt], 0, 0, 0); }
#pragma unroll
                for (int ks = 0; ks < 2; ++ks) { const mb_bf16x8 af = *(const LAS mb_bf16x8*)(Sb + (vt * 16 + lq) * GL_STR + ks * 64 + g * 16); o[vt] = __builtin_amdgcn_mfma_f32_16x16x32_bf16(af, bq[ks], o[vt], 0, 0, 0); }
                ss += (o[vt][0] * o[vt][0] + o[vt][1] * o[vt][1]) + (o[vt][2] * o[vt][2] + o[vt][3] * o[vt][3]); }
            ss += __shfl_xor(ss, 16); ss += __shfl_xor(ss, 32);
            const float rs = rsqrtf(ss * (1.f / 128.f) + EPS);
#pragma unroll
            for (int vt = 0; vt < 8; ++vt) { const int v = vt * 16 + 4 * g; const f32x4 gv = *(const GAS f32x4*)(gg + h * 128 + v); const mb_u32x2 sr = srv[vt];
                mb_u32x2 w; w.x = mb_cvt_pk(o[vt][0] * rs * gv[0] * bflo(sr.x), o[vt][1] * rs * gv[1] * bfhi(sr.x)); w.y = mb_cvt_pk(o[vt][2] * rs * gv[2] * bflo(sr.y), o[vt][3] * rs * gv[3] * bfhi(sr.y));
                *(GAS mb_u32x2*)(OG + (size_t)(m0 + ct * 16 + lq) * 1024 + h * 128 + v) = w; } }
        __syncthreads();
    }
#undef GB_LOAD
}

__device__ __forceinline__ int list_off(int j) { return 256 * (31 * j - (j * (j - 1)) / 2); }
__device__ __forceinline__ void moba_kmean_phase(Frame& F) {
    PHASE_IDS;
    float* lf = (float*)(F.ldsg + RING_OFF); float* part = lf; float* pmx = lf + 512;
    const bf16* KM = (const bf16*)(F.ws + WS_KM); float* kmean = (float*)(F.ws + WS_KMEAN); float* knmax = (float*)(F.ws + WS_KNMAX);
    const int c8 = tid & 7, r0 = tid >> 3;
#pragma unroll 1
    for (int u = blockIdx.x; u < 1024; u += F.G) { const int bh = u >> 5, j = u & 31, b = bh >> 3, h = bh & 7; const size_t m0 = (size_t)b * SEQ + j * 256;
        v4u w[4];
#pragma unroll
        for (int i = 0; i < 4; ++i) w[i] = *(const GAS v4u*)(KM + (m0 + r0 + 64 * i) * 512 + h * 64 + c8 * 8);
        float acc[8]; float mx = 0.f;
#pragma unroll
        for (int e = 0; e < 8; ++e) acc[e] = 0.f;
#pragma unroll
        for (int i = 0; i < 4; ++i) { float f[8]; unpack8(w[i], f); float q = 0.f;
#pragma unroll
            for (int e = 0; e < 8; ++e) { acc[e] += f[e]; q += f[e] * f[e]; }
            q += __shfl_xor(q, 1); q += __shfl_xor(q, 2); q += __shfl_xor(q, 4); mx = fmaxf(mx, q); }
#pragma unroll
        for (int e = 0; e < 8; ++e) { acc[e] += __shfl_xor(acc[e], 8); acc[e] += __shfl_xor(acc[e], 16); acc[e] += __shfl_xor(acc[e], 32); }
        mx = wave_max(mx);
        if (lane < 8) {
#pragma unroll
            for (int e = 0; e < 8; ++e) part[wave * 64 + lane * 8 + e] = acc[e]; }
        if (lane == 0) pmx[wave] = mx;
        __syncthreads();
        if (tid < 64) { float t = 0.f;
#pragma unroll
            for (int w2 = 0; w2 < 8; ++w2) t += part[w2 * 64 + tid];
            kmean[u * 64 + tid] = t * (1.f / 256.f); }
        if (tid == 0) { float t = 0.f;
#pragma unroll
            for (int w2 = 0; w2 < 8; ++w2) t = fmaxf(t, pmx[w2]);
            knmax[u] = sqrtf(t); }
        __syncthreads();
    }
}
__device__ __forceinline__ void moba_gate_phase(Frame& F, const Args& A) {
    PHASE_IDS;
    LAS unsigned char* kmh = F.lds + RING_OFF; LAS unsigned char* kml = kmh + 32 * 144;
    float* lf = (float*)(F.ldsg + RING_OFF + 2 * 32 * 144); float* knm = lf; unsigned* hist = (unsigned*)(lf + 32); unsigned* hbase = hist + 32;
    const bf16* QM = (const bf16*)(F.ws + WS_QM); const float* kmean = (const float*)(F.ws + WS_KMEAN); const float* knmax = (const float*)(F.ws + WS_KNMAX);
    unsigned* SEL = (unsigned*)(F.ws + WS_SEL); float* REFS = (float*)(F.ws + WS_REFS); unsigned* LISTS = (unsigned*)(F.ws + WS_LISTS); const float* rb = A.in[3];
    const int lq = lane & 15, g = lane >> 4;
#pragma unroll 1
    for (int u = blockIdx.x, kk = 0; u < 1024; u += F.G, ++kk) { const int bh = u >> 5, qx = (kk & 2) ? ((u & 31) + 16) & 31 : (u & 31), qb = (kk & 1) ? 31 - qx : qx, b = bh >> 3, h = bh & 7;
        { const int j = tid >> 4, c4 = (tid & 15) * 4; const f32x4 v = *(const GAS f32x4*)(kmean + bh * 2048 + j * 64 + c4);
            const unsigned h0 = f2bf(v[0]), h1 = f2bf(v[1]), h2 = f2bf(v[2]), h3 = f2bf(v[3]);
            *(LAS mb_u32x2*)(kmh + j * 144 + c4 * 2) = (mb_u32x2){h0 | (h1 << 16), h2 | (h3 << 16)};
            *(LAS mb_u32x2*)(kml + j * 144 + c4 * 2) = (mb_u32x2){pk2(v[0] - __uint_as_float(h0 << 16), v[1] - __uint_as_float(h1 << 16)), pk2(v[2] - __uint_as_float(h2 << 16), v[3] - __uint_as_float(h3 << 16))}; }
        if (tid < 32) { knm[tid] = knmax[bh * 32 + tid]; hist[tid] = 0u; }
        __syncthreads();
        float bmx = rb[h];
#pragma unroll 1
        for (int k = 1; k < 32; ++k) bmx = fmaxf(bmx, rb[k * 8 + h]);
        const int nsel = qb < 3 ? qb : 3;
        int sel0[2], sel1[2], sel2[2]; unsigned rk0[2], rk1[2], rk2[2];
#pragma unroll
        for (int qt = 0; qt < 2; ++qt) { const int qi = (wave * 2 + qt) * 16 + lq, t = qb * 256 + qi; const size_t m = (size_t)b * SEQ + t;
            mb_bf16x8 qf[2]; qf[0] = *(const GAS mb_bf16x8*)(QM + m * 512 + h * 64 + 8 * g); qf[1] = *(const GAS mb_bf16x8*)(QM + m * 512 + h * 64 + 32 + 8 * g);
            float qn = 0.f;
#pragma unroll
            for (int ks = 0; ks < 2; ++ks) { const v4u w = __builtin_bit_cast(v4u, qf[ks]); float f[8]; unpack8(w, f);
#pragma unroll
                for (int e = 0; e < 8; ++e) qn += f[e] * f[e]; }
            qn += __shfl_xor(qn, 16); qn += __shfl_xor(qn, 32); qn = sqrtf(qn);
            f32x4 sc[2];
#pragma unroll
            for (int jt = 0; jt < 2; ++jt) { sc[jt] = (f32x4){0.f, 0.f, 0.f, 0.f};
#pragma unroll
                for (int ks = 0; ks < 2; ++ks) { const mb_bf16x8 ah = *(const LAS mb_bf16x8*)(kmh + (jt * 16 + lq) * 144 + ks * 64 + g * 16), al = *(const LAS mb_bf16x8*)(kml + (jt * 16 + lq) * 144 + ks * 64 + g * 16);
                    sc[jt] = __builtin_amdgcn_mfma_f32_16x16x32_bf16(ah, qf[ks], sc[jt], 0, 0, 0); sc[jt] = __builtin_amdgcn_mfma_f32_16x16x32_bf16(al, qf[ks], sc[jt], 0, 0, 0); } }
            float v0 = -INFINITY, v1 = -INFINITY, v2 = -INFINITY; int i0 = 0, i1 = 0, i2 = 0;
#define TOP3_INS(G_, J_) do { const float g_ = (G_); const int j_ = (J_); if (g_ > v0) { v2 = v1; i2 = i1; v1 = v0; i1 = i0; v0 = g_; i0 = j_; } else if (g_ > v1) { v2 = v1; i2 = i1; v1 = g_; i1 = j_; } else if (g_ > v2) { v2 = g_; i2 = j_; } } while (0)
#pragma unroll
            for (int jt = 0; jt < 2; ++jt)
#pragma unroll
                for (int r = 0; r < 4; ++r) { const int j = jt * 16 + 4 * g + r; const float gv = j < qb ? sc[jt][r] : -INFINITY; TOP3_INS(gv, j); }
#pragma unroll
            for (int mk = 16; mk <= 32; mk <<= 1) { const float p0 = __shfl_xor(v0, mk), p1 = __shfl_xor(v1, mk), p2 = __shfl_xor(v2, mk); const int j0 = __shfl_xor(i0, mk), j1 = __shfl_xor(i1, mk), j2 = __shfl_xor(i2, mk);
                TOP3_INS(p0, j0); TOP3_INS(p1, j1); TOP3_INS(p2, j2); }
#undef TOP3_INS
            sel0[qt] = i0; sel1[qt] = i1; sel2[qt] = i2; rk0[qt] = 0; rk1[qt] = 0; rk2[qt] = 0;
            if (g == 0) {
                float kx = knm[qb]; if (nsel > 0) kx = fmaxf(kx, knm[i0]); if (nsel > 1) kx = fmaxf(kx, knm[i1]); if (nsel > 2) kx = fmaxf(kx, knm[i2]);
                SEL[m * 8 + h] = (unsigned)i0 | ((unsigned)i1 << 5) | ((unsigned)i2 << 10) | ((unsigned)nsel << 15);
                REFS[m * 8 + h] = qn * kx + bmx * 1.4426950408889634f;
                if (nsel > 0) rk0[qt] = __hip_atomic_fetch_add(hist + i0, 1u, __ATOMIC_RELAXED, __HIP_MEMORY_SCOPE_WORKGROUP);
                if (nsel > 1) rk1[qt] = __hip_atomic_fetch_add(hist + i1, 1u, __ATOMIC_RELAXED, __HIP_MEMORY_SCOPE_WORKGROUP);
                if (nsel > 2) rk2[qt] = __hip_atomic_fetch_add(hist + i2, 1u, __ATOMIC_RELAXED, __HIP_MEMORY_SCOPE_WORKGROUP); } }
        __syncthreads();
        if (tid < qb) { const unsigned c = hist[tid]; hbase[tid] = c ? atomicAdd((unsigned*)(F.ctl + CW_LCNT) + bh * 32 + tid, c) : 0u; }
        __syncthreads();
        if (g == 0) { unsigned* lb = LISTS + (size_t)bh * LIST_CAP;
#pragma unroll
            for (int qt = 0; qt < 2; ++qt) { const unsigned tq = (unsigned)(qb * 256 + (wave * 2 + qt) * 16 + lq);
                if (nsel > 0) lb[list_off(sel0[qt]) + hbase[sel0[qt]] + rk0[qt]] = (tq << 2);
                if (nsel > 1) lb[list_off(sel1[qt]) + hbase[sel1[qt]] + rk1[qt]] = (tq << 2) | 1u;
                if (nsel > 2) lb[list_off(sel2[qt]) + hbase[sel2[qt]] + rk2[qt]] = (tq << 2) | 2u; } }
        __syncthreads();
    }
}
constexpr size_t PARTO_N1 = 524288;
constexpr int MB_KSTR = 144, MB_VSTR = 528, MB_KBYTES = 256 * MB_KSTR, MB_VBYTES = 80 * MB_VSTR, MB_TABX = MB_KBYTES + MB_VBYTES, MB_TABN = 768;
static_assert(MB_TABX + MB_TABN * 4 <= RING_BYTES, "MoBA LDS");
__device__ __forceinline__ void moba_stage_const(int tid, LAS unsigned char* Vl) {
    for (int i = tid; i < 16 * 32; i += NTHR) { const int r = i >> 5, c = i & 31; const unsigned w = r == 0 ? 0x3f803f80u : 0u; *(LAS v4u*)(Vl + (64 + r) * MB_VSTR + c * 16) = (v4u){w, w, w, w}; }
}
struct MobaStage { v4u kv[4], vv[4]; float tb[2]; };
__device__ __forceinline__ void moba_kv_load(Frame& F, int tid, const Args& A, int b, int h, int j, MobaStage& st) {
    const bf16* KM = (const bf16*)(F.ws + WS_KM); const bf16* VT = (const bf16*)(F.ws + WS_VT);
    const size_t mk = (size_t)b * SEQ + j * 256;
#pragma unroll
    for (int i = 0; i < 4; ++i) { const int ch = tid + i * NTHR, key = ch >> 3, c = ch & 7; st.kv[i] = *(const GAS v4u*)(KM + (mk + key) * 512 + h * 64 + c * 8); }
#pragma unroll
    for (int i = 0; i < 4; ++i) { const int ch = tid + i * NTHR, d = ch >> 5, c = ch & 31; st.vv[i] = *(const GAS v4u*)(VT + (size_t)(512 + h * 64 + d) * M + mk + c * 8); }
#pragma unroll
    for (int i = 0; i < 2; ++i) { const int idx = tid + i * NTHR, dist = idx - 255; st.tb[i] = (idx < MB_TABN && dist >= 0) ? A.in[3][t5_bucket(dist < 127 ? dist : 127) * 8 + h] * 1.4426950408889634f : -INFINITY; }
}
__device__ __forceinline__ void moba_kv_store(int tid, const MobaStage& st, LAS unsigned char* Kl, LAS unsigned char* Vl, LAS float* tabx) {
#pragma unroll
    for (int i = 0; i < 4; ++i) { const int ch = tid + i * NTHR, key = ch >> 3, c = ch & 7; *(LAS v4u*)(Kl + key * MB_KSTR + c * 16) = st.kv[i]; }
#pragma unroll
    for (int i = 0; i < 4; ++i) { const int ch = tid + i * NTHR, d = ch >> 5, c = ch & 31; *(LAS v4u*)(Vl + d * MB_VSTR + c * 16) = st.vv[i]; }
#pragma unroll
    for (int i = 0; i < 2; ++i) { const int idx = tid + i * NTHR; if (idx < MB_TABN) tabx[idx] = st.tb[i]; }
}
__device__ __forceinline__ void moba_stage_kv(Frame& F, int tid, const Args& A, int b, int h, int j, LAS unsigned char* Kl, LAS unsigned char* Vl, LAS float* tabx) {
    MobaStage st; moba_kv_load(F, tid, A, b, h, j, st); moba_kv_store(tid, st, Kl, Vl, tabx);
}
template <int NG>
__device__ __forceinline__ void moba_groups(const LAS unsigned char* Kl, const LAS unsigned char* Vl, const LAS float* tabx, const mb_bf16x8 (&qf)[NG][2], const float (&ref)[NG], const int (&qrel)[NG],
                                            const int (&ntile)[NG], const bool (&far)[NG], f32x4 (&o)[NG][5], int lane) {
    const int lq = lane & 15, g = lane >> 4;
    int nmax = ntile[0];
#pragma unroll
    for (int gi = 1; gi < NG; ++gi) nmax = ntile[gi] > nmax ? ntile[gi] : nmax;
    const LAS unsigned char* kp = Kl + lq * MB_KSTR + g * 16;
    const LAS unsigned char* vp = Vl + lq * MB_VSTR + g * 8;
#pragma unroll
    for (int hf = 0; hf < 2; ++hf) { if (8 * hf < nmax) {
        f32x4 sa[NG][8];
#pragma unroll
        for (int gi = 0; gi < NG; ++gi) {
            if (far[gi]) { const float c = tabx[255 + 127] - ref[gi];
#pragma unroll
                for (int t = 0; t < 8; ++t) sa[gi][t] = (f32x4){c, c, c, c}; }
            else { const int qc = qrel[gi] < 511 ? qrel[gi] : 511; const LAS float* lb = tabx + (qc - 4 * g + 12);
#pragma unroll
                for (int t = 0; t < 8; ++t) { sa[gi][t] = (f32x4){0.f, 0.f, 0.f, 0.f};
                    if (8 * hf + t < ntile[gi]) {
#pragma unroll
                        for (int r = 0; r < 4; ++r) sa[gi][t][r] = lb[243 - 16 * (8 * hf + t) - r] - ref[gi]; } } } }
#pragma unroll
        for (int t = 0; t < 8; ++t) { const int T = 8 * hf + t; if (T < nmax) {
                const mb_bf16x8 k0 = *(const LAS mb_bf16x8*)(kp + T * 16 * MB_KSTR), k1 = *(const LAS mb_bf16x8*)(kp + T * 16 * MB_KSTR + 64);
#pragma unroll
                for (int gi = 0; gi < NG; ++gi) if (T < ntile[gi]) { sa[gi][t] = __builtin_amdgcn_mfma_f32_16x16x32_bf16(k0, qf[gi][0], sa[gi][t], 0, 0, 0); sa[gi][t] = __builtin_amdgcn_mfma_f32_16x16x32_bf16(k1, qf[gi][1], sa[gi][t], 0, 0, 0); } } }
#pragma unroll
        for (int gi = 0; gi < NG; ++gi)
#pragma unroll
            for (int t = 0; t < 8; ++t) { if (8 * hf + t < ntile[gi]) {
#pragma unroll
                    for (int r = 0; r < 4; ++r) sa[gi][t][r] = __builtin_amdgcn_exp2f(sa[gi][t][r]); } }
#pragma unroll
        for (int k2 = 0; k2 < 4; ++k2) { const int ks = 4 * hf + k2; if (2 * ks < nmax) {
                mb_bf16x8 pb[NG];
#pragma unroll
                for (int gi = 0; gi < NG; ++gi) { v4u pw; pw.x = mb_cvt_pk(sa[gi][2 * k2][0], sa[gi][2 * k2][1]); pw.y = mb_cvt_pk(sa[gi][2 * k2][2], sa[gi][2 * k2][3]); pw.z = mb_cvt_pk(sa[gi][2 * k2 + 1][0], sa[gi][2 * k2 + 1][1]); pw.w = mb_cvt_pk(sa[gi][2 * k2 + 1][2], sa[gi][2 * k2 + 1][3]); pb[gi] = __builtin_bit_cast(mb_bf16x8, pw); }
#pragma unroll
                for (int dt = 0; dt < 5; ++dt) { const mb_u32x2 a0 = *(const LAS mb_u32x2*)(vp + dt * 16 * MB_VSTR + ks * 64), a1 = *(const LAS mb_u32x2*)(vp + dt * 16 * MB_VSTR + ks * 64 + 32);
                    v4u aw; aw.x = a0.x; aw.y = a0.y; aw.z = a1.x; aw.w = a1.y; const mb_bf16x8 af = __builtin_bit_cast(mb_bf16x8, aw);
#pragma unroll
                    for (int gi = 0; gi < NG; ++gi) if (2 * ks < ntile[gi]) o[gi][dt] = __builtin_amdgcn_mfma_f32_16x16x32_bf16(af, pb[gi], o[gi][dt], 0, 0, 0); } } } } }
}
__device__ __forceinline__ void moba_part_phase(Frame& F, const Args& A, int wq_word) {
    PHASE_IDS;
    LAS unsigned char* Kl = F.lds + RING_OFF; LAS unsigned char* Vl = Kl + MB_KBYTES; LAS float* tabx = (LAS float*)(F.lds + RING_OFF + MB_TABX); volatile LAS int* bc = (volatile LAS int*)(F.lds + TBL_BC);
    const bf16* QM = (const bf16*)(F.ws + WS_QM); const float* REFS = (const float*)(F.ws + WS_REFS); const unsigned* LISTS = (const unsigned*)(F.ws + WS_LISTS);
    bf16* PARTO0 = (bf16*)((unsigned char*)F.out + DO_PARTO); bf16* PARTO1 = (bf16*)(F.ws + WS_XB); float* PARTL = (float*)(F.ws + WS_PARTL);
    const int lq = lane & 15, g = lane >> 4;
    moba_stage_const(tid, Vl);
#pragma unroll 1
    for (;;) {
        PB(5); PB(8);
        if (tid == 0) bc[0] = (int)atomicAdd((unsigned*)(F.ctl + wq_word), 1u);
        __syncthreads();
        const int u = __builtin_amdgcn_readfirstlane(bc[0]);
        __syncthreads();
        if (u >= 31 * 32) break;
        const int j = u >> 5, bh = u & 31, b = bh >> 3, h = bh & 7;
        const int n = __builtin_amdgcn_readfirstlane((int)__hip_atomic_load((unsigned*)(F.ctl + CW_LCNT) + bh * 32 + j, RLX_AGENT));
        moba_stage_kv(F, tid, A, b, h, j, Kl, Vl, tabx);
        __syncthreads(); PE(5); PB(6);
        const unsigned* lst = LISTS + (size_t)bh * LIST_CAP + list_off(j);
#define MB_IDX(G_) (((G_) * 16 + lq < n) ? (G_) * 16 + lq : (((G_) * 16 < n) ? (G_) * 16 : 0))
#define MB_LOADQ(E_, Q_, R_) do { const size_t m_ = (size_t)b * SEQ + ((E_) >> 2); const bf16* qrow_ = QM + m_ * 512 + h * 64; Q_[0] = *(const GAS mb_bf16x8*)(qrow_ + 8 * g); Q_[1] = *(const GAS mb_bf16x8*)(qrow_ + 32 + 8 * g); R_ = REFS[m_ * 8 + h]; } while (0)
        int pr = wave;
        if (pr * 32 < n) {
            unsigned ea[2];
            ea[0] = lst[MB_IDX(2 * pr)]; ea[1] = lst[MB_IDX(2 * pr + 1)];
#pragma unroll 1
            for (;;) {
                unsigned eb[2]; eb[0] = lst[MB_IDX(2 * pr + 2 * NWAVES)]; eb[1] = lst[MB_IDX(2 * pr + 2 * NWAVES + 1)];
                mb_bf16x8 qa[2][2]; float ra[2];
                MB_LOADQ(ea[0], qa[0], ra[0]); MB_LOADQ(ea[1], qa[1], ra[1]);
                int qrel[2], nt[2]; bool far[2];
#pragma unroll
                for (int gi = 0; gi < 2; ++gi) { qrel[gi] = (int)(ea[gi] >> 2) - j * 256; far[gi] = __all(qrel[gi] - 255 >= 113); nt[gi] = ((2 * pr + gi) * 16 < n) ? 16 : 0; }
                f32x4 o[2][5];
#pragma unroll
                for (int gi = 0; gi < 2; ++gi)
#pragma unroll
                    for (int dt = 0; dt < 5; ++dt) o[gi][dt] = (f32x4){0.f, 0.f, 0.f, 0.f};
                if (PROBE_ACC == 9 || PROBE_ACC == 10) asm volatile("s_waitcnt vmcnt(0)" ::: "memory"); PB(9); moba_groups<2>(Kl, Vl, tabx, qa, ra, qrel, nt, far, o, lane); PE(9);
#pragma unroll
                for (int gi = 0; gi < 2; ++gi) { if ((2 * pr + gi) * 16 + lq < n) { const size_t m = (size_t)b * SEQ + (ea[gi] >> 2); const size_t pi = (m * 8 + h) * 3 + (ea[gi] & 3u); if (g == 0) PARTL[pi] = o[gi][4][0];
#pragma unroll
                        for (int dt = 0; dt < 4; ++dt) { mb_u32x2 w; w.x = mb_cvt_pk(o[gi][dt][0], o[gi][dt][1]); w.y = mb_cvt_pk(o[gi][dt][2], o[gi][dt][3]); *(GAS mb_u32x2*)((pi < PARTO_N1 ? PARTO0 + pi * 64 : PARTO1 + (pi - PARTO_N1) * 64) + dt * 16 + g * 4) = w; } } }
                pr += NWAVES; if (pr * 32 >= n) break;
                ea[0] = eb[0]; ea[1] = eb[1];
            }
        }
#undef MB_IDX
        PE(6); PB(7);
        __syncthreads(); PE(7); PE(8);
    }
}
__device__ __forceinline__ void moba_own_phase(Frame& F, const Args& A, bf16* OUT) {
    PHASE_IDS;
    LAS unsigned char* Kl = F.lds + RING_OFF; LAS unsigned char* Vl = Kl + MB_KBYTES; LAS float* tabx = (LAS float*)(F.lds + RING_OFF + MB_TABX);
    const bf16* QM = (const bf16*)(F.ws + WS_QM); const float* REFS = (const float*)(F.ws + WS_REFS);
    const bf16* PARTO0 = (const bf16*)((unsigned char*)F.out + DO_PARTO); const bf16* PARTO1 = (const bf16*)(F.ws + WS_XB); const float* PARTL = (const float*)(F.ws + WS_PARTL);
    const int lq = lane & 15, g = lane >> 4;
    moba_stage_const(tid, Vl);
    MobaStage st;
    if ((int)blockIdx.x < 1024) { const int u0 = blockIdx.x, bh0 = u0 >> 5; moba_kv_load(F, tid, A, bh0 >> 3, bh0 & 7, u0 & 31, st); }
#pragma unroll 1
    for (int u = blockIdx.x; u < 1024; u += F.G) { const int bh = u >> 5, qb = u & 31, b = bh >> 3, h = bh & 7; const int nsel = qb < 3 ? qb : 3;
        PB(1); PB(4); moba_kv_store(tid, st, Kl, Vl, tabx);
        int grp[2] = {wave, 15 - wave}; size_t mq[2]; mb_bf16x8 qa[2][2]; float ra[2];
#pragma unroll
        for (int gi = 0; gi < 2; ++gi) { mq[gi] = (size_t)b * SEQ + qb * 256 + grp[gi] * 16 + lq; MB_LOADQ(((unsigned)(qb * 256 + grp[gi] * 16 + lq)) << 2, qa[gi], ra[gi]); }
        float pl[3]; mb_u32x2 po[3][4];
#pragma unroll
        for (int r = 0; r < 3; ++r) { pl[r] = 0.f;
#pragma unroll
            for (int dt = 0; dt < 4; ++dt) po[r][dt] = (mb_u32x2){0u, 0u};
            if (r < nsel) { const size_t pi = (mq[0] * 8 + h) * 3 + r; pl[r] = PARTL[pi];
#pragma unroll
                for (int dt = 0; dt < 4; ++dt) po[r][dt] = *(const GAS mb_u32x2*)((pi < PARTO_N1 ? PARTO0 + pi * 64 : PARTO1 + (pi - PARTO_N1) * 64) + dt * 16 + g * 4); } }
        __syncthreads(); PE(1); PB(2);
        if (u + F.G < 1024) { const int un = u + F.G, bhn = un >> 5; moba_kv_load(F, tid, A, bhn >> 3, bhn & 7, un & 31, st); }
        { int qrel[2], nt[2]; bool far[2];
#pragma unroll
            for (int gi = 0; gi < 2; ++gi) { qrel[gi] = grp[gi] * 16 + lq; nt[gi] = grp[gi] + 1; far[gi] = false; }
            f32x4 o[2][5];
#pragma unroll
            for (int gi = 0; gi < 2; ++gi)
#pragma unroll
                for (int dt = 0; dt < 5; ++dt) o[gi][dt] = (f32x4){0.f, 0.f, 0.f, 0.f};
            moba_groups<2>(Kl, Vl, tabx, qa, ra, qrel, nt, far, o, lane); PE(2); PB(3);
#pragma unroll
            for (int gi = 0; gi < 2; ++gi) { float l = __shfl(o[gi][4][0], lq);
#pragma unroll
                for (int r = 0; r < 3; ++r) {
                    if (gi == 0) { l += pl[r];
#pragma unroll
                        for (int dt = 0; dt < 4; ++dt) { o[gi][dt][0] += bflo(po[r][dt].x); o[gi][dt][1] += bfhi(po[r][dt].x); o[gi][dt][2] += bflo(po[r][dt].y); o[gi][dt][3] += bfhi(po[r][dt].y); } }
                    else if (r < nsel) { const size_t pi = (mq[gi] * 8 + h) * 3 + r; l += PARTL[pi];
#pragma unroll
                        for (int dt = 0; dt < 4; ++dt) { const mb_u32x2 w = *(const GAS mb_u32x2*)((pi < PARTO_N1 ? PARTO0 + pi * 64 : PARTO1 + (pi - PARTO_N1) * 64) + dt * 16 + g * 4); o[gi][dt][0] += bflo(w.x); o[gi][dt][1] += bfhi(w.x); o[gi][dt][2] += bflo(w.y); o[gi][dt][3] += bfhi(w.y); } } }
                const float il = 1.f / l;
#pragma unroll
                for (int dt = 0; dt < 4; ++dt) { mb_u32x2 w; w.x = mb_cvt_pk(o[gi][dt][0] * il, o[gi][dt][1] * il); w.y = mb_cvt_pk(o[gi][dt][2] * il, o[gi][dt][3] * il); *(GAS mb_u32x2*)(OUT + mq[gi] * 1024 + 512 + h * 64 + dt * 16 + g * 4) = w; } } }
        PE(3);
        __syncthreads(); PE(4);
    }
#undef MB_LOADQ
}
constexpr int MA_KSTR = 272, MA_VSTR = 528, MA_KBYTES = 256 * MA_KSTR, MA_VBYTES = 128 * MA_VSTR;
static_assert(MA_KBYTES + MA_VBYTES <= RING_BYTES, "mem-attn LDS");
__device__ __forceinline__ void memattn_phase(Frame& F, bf16* OUT) {
    PHASE_IDS;
    LAS unsigned char* Kl = F.lds + RING_OFF; LAS unsigned char* Vl = Kl + MA_KBYTES;
    bf16* QC = (bf16*)(F.ws + WS_QC); const float* SS1 = (const float*)(F.ws + WS_SS1); const bf16* MK = (const bf16*)(F.ws + WS_MKV); const bf16* MVT = MK + 1024 * 512;
    const int lq = lane & 15, g = lane >> 4;
    const int per = (512 + F.G - 1) / F.G; int staged = -1;
#pragma unroll 1
    for (int u = blockIdx.x * per; u < blockIdx.x * per + per && u < 512; ++u) { const int qt = u & 31, bhd = u >> 5, b = bhd >> 2, hd = bhd & 3;
        if (bhd != staged) { __syncthreads();
#pragma unroll
            for (int i = 0; i < 8; ++i) { const int ch = tid + i * NTHR, key = ch >> 4, c = ch & 15; *(LAS v4u*)(Kl + key * MA_KSTR + c * 16) = *(const GAS v4u*)(MK + (size_t)(b * 256 + key) * 512 + hd * 128 + c * 8); }
#pragma unroll
            for (int i = 0; i < 8; ++i) { const int ch = tid + i * NTHR, d = ch >> 5, c = ch & 31; *(LAS v4u*)(Vl + d * MA_VSTR + c * 16) = *(const GAS v4u*)(MVT + (size_t)(hd * 128 + d) * 1024 + b * 256 + c * 8); }
            staged = bhd; __syncthreads(); }
#pragma unroll 1
        for (int grp = wave; grp < 16; grp += NWAVES) {
            const size_t m = (size_t)b * SEQ + qt * 256 + grp * 16 + lq; bf16* qrow = QC + m * 512 + hd * 128;
            mb_bf16x8 qf[4];
#pragma unroll
            for (int s = 0; s < 4; ++s) qf[s] = *(const GAS mb_bf16x8*)(qrow + 32 * s + 8 * g);
            f32x4 sa[16]; const LAS unsigned char* kp = Kl + lq * MA_KSTR + g * 16;
#pragma unroll
            for (int t = 0; t < 16; ++t) { sa[t] = (f32x4){0.f, 0.f, 0.f, 0.f};
#pragma unroll
                for (int s = 0; s < 4; ++s) { const mb_bf16x8 kf = *(const LAS mb_bf16x8*)(kp + t * 16 * MA_KSTR + s * 64); sa[t] = __builtin_amdgcn_mfma_f32_16x16x32_bf16(kf, qf[s], sa[t], 0, 0, 0); } }
            { float ssum = 0.f;
#pragma unroll
                for (int i = 0; i < 4; ++i) { const f32x4 p = *(const GAS f32x4*)(SS1 + m * 16 + 4 * i); ssum += (p[0] + p[1]) + (p[2] + p[3]); }
                const float rs1 = rsqrtf(ssum * (1.f / D) + EPS);
#pragma unroll
                for (int t = 0; t < 16; ++t) sa[t] = sa[t] * rs1; }
            float mx = -INFINITY;
#pragma unroll
            for (int t = 0; t < 16; ++t) mx = fmaxf(fmaxf(mx, fmaxf(sa[t][0], sa[t][1])), fmaxf(sa[t][2], sa[t][3]));
            mx = fmaxf(mx, __shfl_xor(mx, 16)); mx = fmaxf(mx, __shfl_xor(mx, 32));
            float l = 0.f;
#pragma unroll
            for (int t = 0; t < 16; ++t)
#pragma unroll
                for (int r = 0; r < 4; ++r) { const float p = __expf(sa[t][r] - mx); sa[t][r] = p; l += p; }
            l += __shfl_xor(l, 16); l += __shfl_xor(l, 32);
            f32x4 o[8];
#pragma unroll
            for (int dt = 0; dt < 8; ++dt) o[dt] = (f32x4){0.f, 0.f, 0.f, 0.f};
            const LAS unsigned char* vp = Vl + lq * MA_VSTR + g * 8;
#pragma unroll
            for (int ks = 0; ks < 8; ++ks) {
                v4u pw; pw.x = mb_cvt_pk(sa[2 * ks][0], sa[2 * ks][1]); pw.y = mb_cvt_pk(sa[2 * ks][2], sa[2 * ks][3]); pw.z = mb_cvt_pk(sa[2 * ks + 1][0], sa[2 * ks + 1][1]); pw.w = mb_cvt_pk(sa[2 * ks + 1][2], sa[2 * ks + 1][3]);
                const mb_bf16x8 pb = __builtin_bit_cast(mb_bf16x8, pw);
#pragma unroll
                for (int dt = 0; dt < 8; ++dt) { const mb_u32x2 a0 = *(const LAS mb_u32x2*)(vp + dt * 16 * MA_VSTR + ks * 64), a1 = *(const LAS mb_u32x2*)(vp + dt * 16 * MA_VSTR + ks * 64 + 32);
                    v4u aw; aw.x = a0.x; aw.y = a0.y; aw.z = a1.x; aw.w = a1.y;
                    o[dt] = __builtin_amdgcn_mfma_f32_16x16x32_bf16(__builtin_bit_cast(mb_bf16x8, aw), pb, o[dt], 0, 0, 0); } }
            const float il = 1.f / l;
#pragma unroll
            for (int dt = 0; dt < 8; ++dt) { mb_u32x2 w; w.x = mb_cvt_pk(o[dt][0] * il, o[dt][1] * il); w.y = mb_cvt_pk(o[dt][2] * il, o[dt][3] * il); *(GAS mb_u32x2*)(OUT + m * 512 + hd * 128 + dt * 16 + g * 4) = w; }
        }
    }
    __syncthreads();
}

template <bool SPLIT> __device__ __forceinline__ void rownorm_phase(Frame& F, bf16* dst, float* rstd) {
    PHASE_IDS;
    const int gw = F.vcu * NWAVES + wave, NGW = F.G * NWAVES; constexpr int LD = SPLIT ? 2048 : 1024;
    for (int m = gw; m < M; m += NGW) { const GAS f32x4* xr = (const GAS f32x4*)(F.out + (size_t)m * D) + lane; f32x4 v[4]; float s = 0.f;
#pragma unroll
        for (int j = 0; j < 4; ++j) { v[j] = xr[64 * j]; s += (v[j].x * v[j].x + v[j].y * v[j].y) + (v[j].z * v[j].z + v[j].w * v[j].w); }
        s = wave_sum(s); if (lane == 0) rstd[m] = rsqrtf(s * (1.f / D) + EPS);
        GAS unsigned long long* o8 = (GAS unsigned long long*)(dst + (size_t)m * LD) + lane;
#pragma unroll
        for (int j = 0; j < 4; ++j) { const unsigned h0 = f2bf(v[j].x), h1 = f2bf(v[j].y), h2 = f2bf(v[j].z), h3 = f2bf(v[j].w);
            o8[64 * j] = (unsigned long long)(h0 | (h1 << 16)) | ((unsigned long long)(h2 | (h3 << 16)) << 32);
            if (SPLIT) o8[256 + 64 * j] = (unsigned long long)pk2(v[j].x - __uint_as_float(h0 << 16), v[j].y - __uint_as_float(h1 << 16)) | ((unsigned long long)pk2(v[j].z - __uint_as_float(h2 << 16), v[j].w - __uint_as_float(h3 << 16)) << 32); } }
}
constexpr int RCH = 128, NCH = M / RCH;
__device__ __forceinline__ void route_phase(Frame& F, const Args& A) {
    PHASE_IDS;
    const float* LG = (const float*)(F.ws + WS_LG); const float* LG2 = (const float*)(F.ws + WS_LG2); const float* SS2 = (const float*)(F.ws + WS_SS2); float* rstd2 = (float*)(F.ws + WS_RSTD2); const float* brg = A.in[18]; const float* bre = A.in[20];
    int* ME = (int*)(F.ws + WS_MOE_E); int* MP = (int*)(F.ws + WS_MOE_POS); float* MW = (float*)(F.ws + WS_MOE_W); unsigned* CNT = (unsigned*)(F.ws + WS_TILE_E);
    unsigned* hist = (unsigned*)(F.ldsg + RING_OFF);
#pragma unroll 1
    for (int ch = blockIdx.x; ch < NCH; ch += F.G) {
        if (tid < 32) hist[tid] = 0u;
        __syncthreads();
        if (tid < RCH) { const int m = ch * RCH + tid; float ssum = 0.f;
#pragma unroll
            for (int i = 0; i < 4; ++i) { const f32x4 p = *(const GAS f32x4*)(SS2 + (size_t)m * 16 + 4 * i); ssum += (p[0] + p[1]) + (p[2] + p[3]); }
            const float rs = rsqrtf(ssum * (1.f / D) + EPS); rstd2[m] = rs; const float* lg = LG + (size_t)m * 72; const float* lg2 = LG2 + (size_t)m * 36;
            float gl[4]; int grp = 0; float gmx = -INFINITY;
#pragma unroll
            for (int o = 0; o < 4; ++o) { gl[o] = (lg[o] + lg[36 + o] + lg2[o]) * rs + brg[o]; if (gl[o] > gmx) { gmx = gl[o]; grp = o; } }
            float gs = 0.f;
#pragma unroll
            for (int o = 0; o < 4; ++o) gs += __expf(gl[o] - gmx);
            const float pg = 1.f / gs;
            float el[8]; float emx = -INFINITY;
#pragma unroll
            for (int i = 0; i < 8; ++i) { el[i] = (lg[4 + grp * 8 + i] + lg[40 + grp * 8 + i] + lg2[4 + grp * 8 + i]) * rs + bre[grp * 8 + i]; emx = fmaxf(emx, el[i]); }
            float p0 = -1.f, p1 = -1.f; int i0 = 0, i1 = 0;
#pragma unroll
            for (int i = 0; i < 8; ++i) { const float p = __expf(el[i] - emx); if (p > p0) { p1 = p0; i1 = i0; p0 = p; i0 = i; } else if (p > p1) { p1 = p; i1 = i; } }
            const float inv = pg / (p0 + p1);
            const int e0 = grp * 8 + i0, e1 = grp * 8 + i1;
            const unsigned q0 = __hip_atomic_fetch_add(hist + e0, 1u, __ATOMIC_RELAXED, __HIP_MEMORY_SCOPE_WORKGROUP), q1 = __hip_atomic_fetch_add(hist + e1, 1u, __ATOMIC_RELAXED, __HIP_MEMORY_SCOPE_WORKGROUP);
            ME[m * 2] = e0; ME[m * 2 + 1] = e1; MP[m * 2] = (int)q0; MP[m * 2 + 1] = (int)q1; MW[m * 2] = p0 * inv; MW[m * 2 + 1] = p1 * inv; }
        __syncthreads();
        if (tid < 32) CNT[ch * 32 + tid] = hist[tid];
        __syncthreads();
    }
}
__device__ __forceinline__ int moe_bases(Frame& F, int mych) {
    PHASE_IDS;
    volatile int* eb = (volatile int*)(F.ldsg + TBL_EB); volatile int* tl = (volatile int*)(F.ldsg + TBL_TILE); volatile int* part = (volatile int*)(F.ldsg + TBL_EB + 256);
    const unsigned* CNT = (const unsigned*)(F.ws + WS_TILE_E);
    { const int e = tid & 31, pt = tid >> 5; int s = 0, sp = 0;
#pragma unroll 1
        for (int c = pt * (NCH / 16); c < (pt + 1) * (NCH / 16); ++c) { const int v = (int)CNT[c * 32 + e]; s += v; if (c < mych) sp += v; }
        part[pt * 32 + e] = s; part[512 + pt * 32 + e] = sp; }
    __syncthreads();
    if (tid < 32) { int s = 0, sp = 0;
#pragma unroll
        for (int p = 0; p < 16; ++p) { s += part[p * 32 + tid]; sp += part[512 + p * 32 + tid]; }
        part[1024 + tid] = s; part[1056 + tid] = sp; }
    __syncthreads();
    if (tid == 0) { int base = 0;
        for (int e = 0; e < 32; ++e) { const int c = part[1024 + e]; eb[e] = base; const int nt = (c + 255) >> 8; for (int t = 0; t < nt; ++t) tl[(base >> 8) + t] = e; base += nt << 8; }
        eb[32] = base; }
    __syncthreads();
    return eb[32] >> 8;
}
__device__ __forceinline__ void moe_slot_phase(Frame& F) {
    PHASE_IDS;
    volatile int* eb = (volatile int*)(F.ldsg + TBL_EB); volatile int* part = (volatile int*)(F.ldsg + TBL_EB + 256);
    const int* ME = (const int*)(F.ws + WS_MOE_E); const int* MP = (const int*)(F.ws + WS_MOE_POS); const float* MW = (const float*)(F.ws + WS_MOE_W); int* SO = (int*)(F.ws + WS_SLOT_OF);
    float* WSL = (float*)(F.ws + WS_W_SLOT); float* RSL = (float*)(F.ws + WS_RSTD_SLOT); const float* rstd2 = (const float*)(F.ws + WS_RSTD2); int* TOK = (int*)(F.ws + WS_TOK);
#pragma unroll 1
    for (int ch = blockIdx.x; ch < NCH; ch += F.G) {
        (void)moe_bases(F, ch);
        if (ch < 32) { const int e = ch; for (int sl = eb[e] + part[1024 + e] + tid; sl < eb[e + 1]; sl += NTHR) { TOK[sl] = 0; WSL[sl] = 0.f; RSL[sl] = 1.f; } }
        if (tid < RCH * 2) { const int a = ch * RCH * 2 + tid, m = a >> 1; const int e = ME[a]; const int slot = eb[e] + part[1056 + e] + MP[a];
            SO[a] = slot; WSL[slot] = MW[a]; RSL[slot] = rstd2[m]; TOK[slot] = m; }
        __syncthreads();
    }
}
__device__ __forceinline__ void final_phase(Frame& F, const Args& A) {
    PHASE_IDS;
    const int gw = F.vcu * NWAVES + wave, NGW = F.G * NWAVES; const int* SO = (const int*)(F.ws + WS_SLOT_OF); const bf16* Y = (const bf16*)(F.ws + WS_XG); const float* gf = A.in[24];
    const bf16* XH = (const bf16*)(F.ws + WS_X2H); const bf16* XL = (const bf16*)(F.ws + WS_X2L);
    f32x4 gv[4];
#pragma unroll
    for (int j = 0; j < 4; ++j) gv[j] = ((const GAS f32x4*)gf)[64 * j + lane];
    typedef unsigned long long u64;
    u64 ya[4], yb[4], xh[4], xl[4];
#define FIN_LOAD(m_) do { const int s0_ = SO[(m_) * 2], s1_ = SO[(m_) * 2 + 1]; const GAS u64* y0_ = (const GAS u64*)(Y + (size_t)s0_ * 1024) + lane; const GAS u64* y1_ = (const GAS u64*)(Y + (size_t)s1_ * 1024) + lane; \
        const GAS u64* h_ = (const GAS u64*)(XH + (size_t)(m_) * 1024) + lane; const GAS u64* l_ = (const GAS u64*)(XL + (size_t)(m_) * 1024) + lane; \
        _Pragma("unroll") for (int j = 0; j < 4; ++j) { ya[j] = y0_[64 * j]; yb[j] = y1_[64 * j]; xh[j] = h_[64 * j]; xl[j] = l_[64 * j]; } } while (0)
    int m = gw; if (m >= M) return;
    FIN_LOAD(m);
#pragma unroll 1
    for (;;) {
        f32x4 v[4]; float s = 0.f;
#pragma unroll
        for (int j = 0; j < 4; ++j) { const u64 a = ya[j], c = yb[j], hh = xh[j], ll = xl[j];
            v[j].x = (bflo((unsigned)hh) + bflo((unsigned)ll)) + (bflo((unsigned)a) + bflo((unsigned)c)); v[j].y = (bfhi((unsigned)hh) + bfhi((unsigned)ll)) + (bfhi((unsigned)a) + bfhi((unsigned)c));
            v[j].z = (bflo((unsigned)(hh >> 32)) + bflo((unsigned)(ll >> 32))) + (bflo((unsigned)(a >> 32)) + bflo((unsigned)(c >> 32))); v[j].w = (bfhi((unsigned)(hh >> 32)) + bfhi((unsigned)(ll >> 32))) + (bfhi((unsigned)(a >> 32)) + bfhi((unsigned)(c >> 32)));
            s += (v[j].x * v[j].x + v[j].y * v[j].y) + (v[j].z * v[j].z + v[j].w * v[j].w); }
        const int mn = m + NGW; const bool more = mn < M;
        if (more) FIN_LOAD(mn);
        s = wave_sum(s); const float rs = rsqrtf(s * (1.f / D) + EPS); GAS f32x4* xr = (GAS f32x4*)(F.out + (size_t)m * D) + lane;
#pragma unroll
        for (int j = 0; j < 4; ++j) xr[64 * j] = (f32x4){v[j].x * rs * gv[j].x, v[j].y * rs * gv[j].y, v[j].z * rs * gv[j].z, v[j].w * rs * gv[j].w};
        if (!more) break;
        m = mn;
    }
#undef FIN_LOAD
}

__global__ void __launch_bounds__(NWAVES * 64, 2) fwd_kernel(Args args) {
    extern __shared__ __attribute__((aligned(16))) unsigned char lds[];
    Frame F; F.pacc = 0; F.pt0 = 0;
    F.lds = (LAS unsigned char*)lds; F.ldsg = lds;
    F.MISC = (volatile LAS unsigned*)(F.lds + MISC_OFF);
    const int tid = threadIdx.x;
    F.G = gridDim.x; { const int bx = blockIdx.x; F.vcu = (F.G % 8 == 0) ? (bx % 8) * (F.G / 8) + bx / 8 : bx; }
    F.ws = uniform_ptr(args.ws); F.out = uniform_ptr(args.out); F.ctl = (gu32*)(F.ws + WS_CTL);
    for (int u = tid; u < (LDS_BYTES - LDSCTL_OFF) / 4; u += NWAVES * 64) ((LAS unsigned*)(F.lds + LDSCTL_OFF))[u] = 0u;
    __syncthreads();
#if MK_ONE_LAUNCH
    XcdBarrier bar = xcd_barrier_post((unsigned*)(F.ctl + CW_BAR), F.MISC + 8);
#define GRID_BAR() xcd_barrier(bar)
#else
#define GRID_BAR() do { if (tid == 0) __hip_atomic_store(F.ctl + CW_TMO, 0xBADBA0u, RLX_AGENT); } while (0)
#endif
    const int lo = args.ph_lo, hi = args.ph_hi;
#define IN(k) (lo <= (k) && (k) < hi)
#ifndef PROBE_MASK
#define PROBE_MASK 0
#endif
#ifndef PG8_ALIGN_EPI
#define PG8_ALIGN_EPI true
#endif
#define REP(k) _Pragma("unroll") for (int rep_ = 0; rep_ < 1 + ((PROBE_MASK >> (k)) & 1); ++rep_)
#ifndef PROBE_A
#define PROBE_A -1
#define PROBE_B -1
#endif
#ifndef PROBE_AMP
#define PROBE_AMP 4
#endif
#ifndef PROBE_BLOCK
#define PROBE_BLOCK 0
#endif
    unsigned long long ts_a = 0, ts_b = 0;
#define STAMP(i) do { if ((i) == PROBE_A) ts_a = __builtin_amdgcn_s_memrealtime(); if ((i) == PROBE_B) ts_b = __builtin_amdgcn_s_memrealtime(); } while (0)
#define SEAM(k) do { if (IN(k) && IN((k) + 1)) { GRID_BAR(); if ((PROBE_MASK >> 6) & 1) GRID_BAR(); } STAMP((k) + 1); } while (0)
    STAMP(0);
    unsigned char* ws = F.ws;
    bf16* XB = (bf16*)(ws + WS_XB);
    const float* rstd0 = (const float*)(ws + WS_RSTD0);

    if (IN(0)) REP(0) { p0_prologue(F, args); } SEAM(0);
    if (IN(1)) REP(1) {
        constexpr int TS = 512 * 1024;
        static_assert(WS_XB % TS == 0 && WS_W1T % TS == 0 && WS_WVT % TS == 0 && WS_MEMN % TS == 0 && WS_WCKVT % TS == 0, "tile-aligned matrices");
        pg8::Gemm g{(const bf16*)ws, (const bf16*)ws, M, 4352, 1024};
        typedef pg8::MultiOrder<128, 17, (int)(WS_XB / TS), (int)(WS_W1T / TS), 4, 128, (int)(WS_WVT / TS), (int)(WS_XB / TS), 4, 2, (int)(WS_MEMN / TS), (int)(WS_WCKVT / TS), 2, 4, (int)(WS_WCKVT / TS) + 2, (int)(WS_MEMN / TS)> P1Order;
        P1Order S{F.G, (int)blockIdx.x};
        pg8::EpiP1 E{ pg8::EpiInProj{(bf16*)(ws + WS_QG), (bf16*)(ws + WS_KG), (bf16*)(ws + WS_SR), (bf16*)(ws + WS_QM), (bf16*)(ws + WS_KM), (bf16*)(ws + WS_SZ), (float*)((unsigned char*)F.out + DO_LA), rstd0, args.in[7]},
                      pg8::EpiVT{(bf16*)(ws + WS_VT), M, rstd0},
                      pg8::EpiRowBf16<0>{(bf16*)(ws + WS_MKV), 512, nullptr, 1.f}, pg8::EpiRowBf16<0>{(bf16*)(ws + WS_MKV) + 1024 * 512, 1024, nullptr, 1.f} };
        pg8::gemm_phase<pg8::EpiP1, P1Order, PG8_ALIGN_EPI, true>(F.lds + RING_OFF, g, S, E);
    } SEAM(1);
    if (IN(2)) { REP(2) gla_a_phase(F); STAMP(30); REP(5) moba_kmean_phase(F); } SEAM(2);
    if (IN(3)) { gla_scan_phase(F); STAMP(31); moba_gate_phase(F, args); } SEAM(3);
    if (IN(4)) { gla_b_phase(F, args); STAMP(32); moba_part_phase(F, args, CW_WQ); } SEAM(4);
    STAMP(6);
    if (IN(6)) { moba_own_phase(F, args, (bf16*)(ws + WS_OGM)); } SEAM(6);
    if (IN(7)) REP(1) { pg8::Gemm g{(const bf16*)(ws + WS_OGM), (const bf16*)(ws + WS_PGMT), M, 1024, 1024}; pg8::StaticOrder S; S.init(M, 1024, F.G, (int)blockIdx.x);
        pg8::EpiMerge2 E{(bf16*)(ws + WS_MG), (const bf16*)(ws + WS_SZ)};
        pg8::gemm_phase<pg8::EpiMerge2, pg8::StaticOrder, PG8_ALIGN_EPI, true>(F.lds + RING_OFF, g, S, E); } SEAM(7);
    if (IN(8)) REP(1) { pg8::Gemm g{(const bf16*)(ws + WS_MG), (const bf16*)(ws + WS_WOUTT), M, 1024, 1024}; pg8::StaticOrder S; S.init(M, 1024, F.G, (int)blockIdx.x);
        pg8::EpiResSplit<true> E{args.in[0], nullptr, nullptr, (bf16*)(ws + WS_X1H), (bf16*)(ws + WS_X1L), (float*)(ws + WS_SS1)};
        pg8::gemm_phase<pg8::EpiResSplit<true>, pg8::StaticOrder, PG8_ALIGN_EPI, true>(F.lds + RING_OFF, g, S, E); } SEAM(8);
    if (IN(10)) REP(1) { pg8::Gemm g{(const bf16*)(ws + WS_X1H), (const bf16*)(ws + WS_WCQT), M, 512, 1024}; pg8::StaticOrder S; S.init(M, 512, F.G, (int)blockIdx.x);
        pg8::EpiRowBf16<0> E{(bf16*)(ws + WS_QC), 512, nullptr, 0.08838834764831845f};
        pg8::gemm_phase<pg8::EpiRowBf16<0>, pg8::StaticOrder, PG8_ALIGN_EPI, true>(F.lds + RING_OFF, g, S, E); } SEAM(10);
    if (IN(11)) { memattn_phase(F, (bf16*)(ws + WS_QC)); } SEAM(11);
    if (IN(12)) { pg8::Gemm g{(const bf16*)(ws + WS_QC), (const bf16*)(ws + WS_WCOT), M, 1024, 512}; pg8::StaticOrder S; S.init(M, 1024, F.G, (int)blockIdx.x);
        pg8::EpiResSplit<false> E{nullptr, (const bf16*)(ws + WS_X1H), (const bf16*)(ws + WS_X1L), (bf16*)(ws + WS_X2H), (bf16*)(ws + WS_X2L), (float*)(ws + WS_SS2)};
        pg8::gemm_phase<pg8::EpiResSplit<false>, pg8::StaticOrder, PG8_ALIGN_EPI, true>(F.lds + RING_OFF, g, S, E);
        expert_weights(F, args); } SEAM(12);
    STAMP(14);
    if (IN(14)) REP(1) {
        { pg8::Gemm g{(const bf16*)(ws + WS_X2H), (const bf16*)(ws + WS_WRT), M, 256, 1024}; pg8::StaticOrder S; S.init(M, 256, F.G, (int)blockIdx.x);
          pg8::EpiLogits E{(float*)(ws + WS_LG), 72, 72};
          pg8::gemm_phase<pg8::EpiLogits, pg8::StaticOrder, PG8_ALIGN_EPI, true>(F.lds + RING_OFF, g, S, E); }
        { pg8::Gemm g{(const bf16*)(ws + WS_X2L), (const bf16*)(ws + WS_WRT) + 256 * 1024, M, 256, 1024}; pg8::StaticOrder S; S.init(M, 256, F.G, (int)((blockIdx.x + F.G / 2) % F.G));
          pg8::EpiLogits E{(float*)(ws + WS_LG2), 36, 36};
          pg8::gemm_phase<pg8::EpiLogits, pg8::StaticOrder, PG8_ALIGN_EPI, true>(F.lds + RING_OFF, g, S, E); }
    } SEAM(14);
    if (IN(15)) { route_phase(F, args); } SEAM(15);
    if (IN(16)) REP(0) { moe_slot_phase(F); } SEAM(16);
    if (IN(17)) REP(1) { const int ntile = moe_bases(F, 0);
        { LAS int* rows = (LAS int*)(F.lds + TBL_ROWS); const int* TOK = (const int*)(ws + WS_TOK);
          for (int i = threadIdx.x; i < 6 * 256; i += NTHR) { const long L = (long)(i >> 8) * F.G + blockIdx.x; rows[i] = (L < (long)ntile * 4) ? TOK[(int)(L >> 2) * 256 + (i & 255)] : 0; }
          __syncthreads(); }
        pg8::Gemm g{(const bf16*)(ws + WS_X2H), (const bf16*)(ws + WS_WGUT), MOE_CAP, 32 * 1024, 1024}; pg8::MoeGatherOrder S{(const LAS int*)(F.lds + TBL_TILE), (const LAS int*)(F.lds + TBL_ROWS), ntile, F.G, (int)blockIdx.x};
        pg8::EpiMoe1 E{(bf16*)(ws + WS_HID), (const float*)(ws + WS_RSTD_SLOT)};
        pg8::gemm_phase<pg8::EpiMoe1, pg8::MoeGatherOrder, PG8_ALIGN_EPI, true>(F.lds + RING_OFF, g, S, E); } SEAM(17);
    if (IN(18)) REP(1) { const int ntile = moe_bases(F, 0);
        pg8::Gemm g{(const bf16*)(ws + WS_HID), (const bf16*)(ws + WS_WDT), MOE_CAP, 32 * 1024, 512}; pg8::MoeOrder S{(const LAS int*)(F.lds + TBL_TILE), ntile, F.G, (int)blockIdx.x};
        pg8::EpiMoe2 E{(bf16*)(ws + WS_XG), (const float*)(ws + WS_W_SLOT)};
        pg8::gemm_phase<pg8::EpiMoe2, pg8::MoeOrder, PG8_ALIGN_EPI, true>(F.lds + RING_OFF, g, S, E); } SEAM(18);
    if (IN(19)) { final_phase(F, args); }
    STAMP(20);
    if ((PROBE_A >= 0 || PROBE_ACC >= 0) && blockIdx.x == PROBE_BLOCK) { const unsigned long long dl = (PROBE_ACC >= 40 ? (unsigned long long)F.MISC[16] : PROBE_ACC >= 0 ? F.pacc : (ts_b - ts_a)) * PROBE_AMP, t0 = __builtin_amdgcn_s_memrealtime(); while (__builtin_amdgcn_s_memrealtime() - t0 < dl) __builtin_amdgcn_s_sleep(8); }
#undef IN
#undef SEAM
}

extern "C" void kernel_launch(void* const* d_in, const int* in_sizes, int n_in, void* d_out, int out_size, void* d_ws, size_t ws_size, hipStream_t stream) {
    static int grid = 0;
    if (grid == 0) {
        if (n_in != 25 || in_sizes[0] != M * D || out_size != M * D || ws_size < WS_END) { fprintf(stderr, "kernel_launch: unexpected shapes (n_in %d in0 %d out %d ws %zu)\n", n_in, n_in > 0 ? in_sizes[0] : -1, out_size, ws_size); grid = -1; return; }
        int dev = 0, cus = 0, per_cu = 0;
        if (hipGetDevice(&dev) != hipSuccess || hipDeviceGetAttribute(&cus, hipDeviceAttributeMultiprocessorCount, dev) != hipSuccess) { grid = -1; return; }
        if (hipFuncSetAttribute((const void*)fwd_kernel, hipFuncAttributeMaxDynamicSharedMemorySize, LDS_BYTES) != hipSuccess) { fprintf(stderr, "kernel_launch: hipFuncSetAttribute failed\n"); grid = -1; return; }
        if (hipOccupancyMaxActiveBlocksPerMultiprocessor(&per_cu, (const void*)fwd_kernel, NWAVES * 64, LDS_BYTES) != hipSuccess || per_cu < 1) fprintf(stderr, "kernel_launch: occupancy query reports %d\n", per_cu);
        (void)hipGetLastError();
        grid = cus;
    }
    if (grid < 0) return;
    if (hipMemsetAsync((char*)d_ws + WS_CTL, 0, CTL_ZERO_BYTES, stream) != hipSuccess) return;
    Args a{};
    for (int i = 0; i < 25; ++i) a.in[i] = (const float*)d_in[i];
    a.out = (float*)d_out; a.ws = (unsigned char*)d_ws;
#if MK_ONE_LAUNCH
    a.ph_lo = 0; a.ph_hi = NPHASE;
    hipLaunchKernelGGL(fwd_kernel, dim3(grid), dim3(NWAVES * 64), LDS_BYTES, stream, a);
#else
    for (int p = 0; p < NPHASE; ++p) { a.ph_lo = p; a.ph_hi = p + 1; hipLaunchKernelGGL(fwd_kernel, dim3(grid), dim3(NWAVES * 64), LDS_BYTES, stream, a); }
#endif
}
```

```cpp
#include <hip/hip_runtime.h>
#include <cstdio>
#include <cstdint>
#define MK_ONE_LAUNCH 1
namespace pg8 {
#define PG8_LAS __attribute__((address_space(3)))
typedef unsigned short bf16_t;
typedef short bf16x8 __attribute__((ext_vector_type(8)));
typedef float f32x4 __attribute__((ext_vector_type(4)));
typedef unsigned u32x4 __attribute__((ext_vector_type(4)));
constexpr int BM = 256, BK = 64, HALF = 128, HTB = HALF * BK * 2  , STAGE_BYTES = 8 * HTB, NXCD = 8, WGM = 8;

__host__ __device__ __forceinline__ int lds_byte(int r, int c) { const int st = (r >> 4) * 2 + (c >> 5), rr = r & 15, cc = c & 31, ob = rr * 64 + cc * 2; return st * 1024 + (ob ^ (((ob >> 9) & 1) << 5)); }
__host__ __device__ __forceinline__ void stage_rc(int b, int& R, int& C) { const int st = b / 1024, sb = b % 1024, swz = sb ^ (((sb >> 9) & 1) << 5); R = (st >> 1) * 16 + swz / 64; C = (st & 1) * 32 + (swz % 64) / 2; }
__host__ __device__ __forceinline__ int perm32(int rho) { const int n = rho >> 4, i = rho & 15; return 8 * (i >> 2) + 4 * n + (i & 3); }

struct Unit { int pm, pn, lm, ln, ty; };
struct Gemm { const bf16_t* A; const bf16_t* Bt; int M, N, K; };

struct StaticOrder {
    static constexpr bool GATHER = false;
    int nM, nN, nwg, G, c;
    __host__ __device__ void init(int M, int N, int G_, int c_) { nM = M / BM; nN = N / BM; nwg = nM * nN; G = G_; c = c_; }
    __host__ __device__ bool next(int i, Unit& u) const {
        const long L = (long)i * G + c; if (L >= nwg) return false;
        int wgid = (int)L; { const int q = nwg / NXCD, r = nwg % NXCD, xcd = wgid % NXCD, off = wgid / NXCD; wgid = (xcd < r ? xcd * (q + 1) : r * (q + 1) + (xcd - r) * q) + off; }
        const int nig = WGM * nN, gid = wgid / nig, fm = gid * WGM, gsz = (nM - fm) < WGM ? (nM - fm) : WGM;
        u.pm = fm + ((wgid % nig) % gsz); u.pn = (wgid % nig) / gsz; u.lm = u.pm; u.ln = u.pn; u.ty = 0; return true;
    }
    __device__ __forceinline__ void a_ready(const Unit&) const {}
    __device__ __forceinline__ void done(const Unit&) const {}
};

__device__ __forceinline__ unsigned cvt_pk_bf16(float lo, float hi) { unsigned r; asm volatile("v_cvt_pk_bf16_f32 %0, %1, %2" : "=v"(r) : "v"(lo), "v"(hi)); return r; }
typedef float f32x2 __attribute__((ext_vector_type(2)));
__device__ __forceinline__ float bf2f(unsigned short h) { return __uint_as_float(((unsigned)h) << 16); }
__device__ __forceinline__ float bflo(unsigned w) { return __uint_as_float(w << 16); }
__device__ __forceinline__ float bfhi(unsigned w) { return __uint_as_float(w & 0xffff0000u); }
__device__ __forceinline__ float sigmoid_f(float x) { return __builtin_amdgcn_rcpf(1.0f + __builtin_amdgcn_exp2f(-1.4426950408889634f * x)); }
__device__ __forceinline__ float silu_f(float x) { return x * __builtin_amdgcn_rcpf(1.0f + __builtin_amdgcn_exp2f(-1.4426950408889634f * x)); }
__device__ __forceinline__ float logsigmoid_f(float x) { return fminf(x, 0.f) - 0.6931471805599453f * __builtin_amdgcn_logf(1.0f + __builtin_amdgcn_exp2f(-1.4426950408889634f * fabsf(x))); }
__device__ __forceinline__ u32x4 pack8(const f32x4 v0, const f32x4 v1) { u32x4 w; w.x = cvt_pk_bf16(v0[0], v0[1]); w.y = cvt_pk_bf16(v0[2], v0[3]); w.z = cvt_pk_bf16(v1[0], v1[1]); w.w = cvt_pk_bf16(v1[2], v1[3]); return w; }

struct EpiInProj {
    static constexpr bool PERM = true, AFTER_DRAIN = false, MIDK = false;
    bf16_t *QG, *KG, *SR, *QM, *KM, *SZ; float* LA; const float* rstd; const float* b_alpha;
    __device__ __forceinline__ void operator()(const f32x4 (&acc)[2][2][4][2], const Unit& u, int wr, int wc, int fr, int fq) const {
        const int pn = u.ln; bf16_t* dst; int ldc, cbase, mode = 0; float sc = 1.f;
        if (pn == 0) { dst = QG; ldc = 256; cbase = 0; sc = 0.125f; }
        else if (pn == 1) { dst = KG; ldc = 256; cbase = 0; }
        else if (pn <= 3) { dst = SR; ldc = 512; cbase = (pn - 2) * 256; mode = 1; }
        else if (pn == 4) { dst = nullptr; ldc = 256; cbase = 0; mode = 3; }
        else if (pn <= 6) { dst = QM; ldc = 512; cbase = (pn - 5) * 256; sc = 0.125f * 1.4426950408889634f; }
        else if (pn <= 8) { dst = KM; ldc = 512; cbase = (pn - 7) * 256; }
        else { dst = SZ; ldc = 2048; cbase = (pn - 9) * 256; mode = 2; }
        const int row0 = u.lm * BM + wr * 64 + fr, col0 = cbase + wc * 32 + 8 * fq;
#pragma unroll
        for (int ai = 0; ai < 2; ++ai)
#pragma unroll
            for (int m = 0; m < 4; ++m) { const int row = row0 + ai * HALF + m * 16; const float rs = sc;
#pragma unroll
                for (int bj = 0; bj < 2; ++bj) { f32x4 v0 = acc[ai][bj][m][0] * rs, v1 = acc[ai][bj][m][1] * rs; const int col = col0 + bj * HALF;
                    if (mode == 3) { const f32x4 b0 = *(const f32x4*)(b_alpha + col), b1 = *(const f32x4*)(b_alpha + col + 4);
#pragma unroll
                        for (int e = 0; e < 4; ++e) { v0[e] = logsigmoid_f(v0[e] + b0[e]) * 0.0625f; v1[e] = logsigmoid_f(v1[e] + b1[e]) * 0.0625f; }
                        float* o = LA + (size_t)row * 256 + col; *(f32x4*)o = v0; *(f32x4*)(o + 4) = v1; }
                    else { if (mode == 1) {
#pragma unroll
                            for (int e = 0; e < 4; ++e) { v0[e] = silu_f(v0[e]); v1[e] = silu_f(v1[e]); } }
                        else if (mode == 2) {
#pragma unroll
                            for (int e = 0; e < 4; ++e) { v0[e] = sigmoid_f(v0[e]); v1[e] = sigmoid_f(v1[e]); } }
                        *(u32x4*)(dst + (size_t)row * ldc + col) = pack8(v0, v1); } } }
    }
};
struct EpiVT {
    static constexpr bool PERM = true, AFTER_DRAIN = false, MIDK = false;
    bf16_t* VT; int ldc; const float* rstd;
    __device__ __forceinline__ void operator()(const f32x4 (&acc)[2][2][4][2], const Unit& u, int wr, int wc, int fr, int fq) const {
        const int row0 = u.lm * BM + wr * 64 + fr, col0 = u.ln * BM + wc * 32 + 8 * fq;
#pragma unroll
        for (int ai = 0; ai < 2; ++ai)
#pragma unroll
            for (int m = 0; m < 4; ++m) { const int row = row0 + ai * HALF + m * 16;
#pragma unroll
                for (int bj = 0; bj < 2; ++bj) *(u32x4*)(VT + (size_t)row * ldc + col0 + bj * HALF) = pack8(acc[ai][bj][m][0], acc[ai][bj][m][1]); }
    }
};
template <int ACT> struct EpiRowBf16 {
    static constexpr bool PERM = true, AFTER_DRAIN = false, MIDK = false;
    bf16_t* O; int ldc; const float* rowscale; float sc;
    __device__ __forceinline__ void operator()(const f32x4 (&acc)[2][2][4][2], const Unit& u, int wr, int wc, int fr, int fq) const {
        const int row0 = u.lm * BM + wr * 64 + fr, col0 = u.ln * BM + wc * 32 + 8 * fq;
#pragma unroll
        for (int ai = 0; ai < 2; ++ai)
#pragma unroll
            for (int m = 0; m < 4; ++m) { const int row = row0 + ai * HALF + m * 16; const float rs = (rowscale ? rowscale[row] : 1.f) * sc;
#pragma unroll
                for (int bj = 0; bj < 2; ++bj) { f32x4 v0 = acc[ai][bj][m][0] * rs, v1 = acc[ai][bj][m][1] * rs;
                    if (ACT == 2) {
#pragma unroll
                        for (int e = 0; e < 4; ++e) { v0[e] = sigmoid_f(v0[e]); v1[e] = sigmoid_f(v1[e]); } }
                    *(u32x4*)(O + (size_t)row * ldc + col0 + bj * HALF) = pack8(v0, v1); } }
    }
};
struct EpiMerge {
    static constexpr bool PERM = true, AFTER_DRAIN = false, MIDK = false;
    bf16_t* O; const bf16_t* SZ; const bf16_t* T1;
    __device__ __forceinline__ void operator()(const f32x4 (&acc)[2][2][4][2], const Unit& u, int wr, int wc, int fr, int fq) const {
        const int row0 = u.lm * BM + wr * 64 + fr, col0 = u.ln * BM + wc * 32 + 8 * fq;
#pragma unroll
        for (int ai = 0; ai < 2; ++ai)
#pragma unroll
            for (int m = 0; m < 4; ++m) { const int row = row0 + ai * HALF + m * 16;
#pragma unroll
                for (int bj = 0; bj < 2; ++bj) { const int col = col0 + bj * HALF;
                    const u32x4 g = *(const u32x4*)(SZ + (size_t)row * 2048 + col), z = *(const u32x4*)(SZ + (size_t)row * 2048 + 1024 + col), t = *(const u32x4*)(T1 + (size_t)row * 1024 + col);
                    const f32x4 a0 = acc[ai][bj][m][0], a1 = acc[ai][bj][m][1]; f32x4 v0, v1;
                    v0[0] = bflo(g.x) * bflo(t.x) + bflo(z.x) * a0[0]; v0[1] = bfhi(g.x) * bfhi(t.x) + bfhi(z.x) * a0[1];
                    v0[2] = bflo(g.y) * bflo(t.y) + bflo(z.y) * a0[2]; v0[3] = bfhi(g.y) * bfhi(t.y) + bfhi(z.y) * a0[3];
                    v1[0] = bflo(g.z) * bflo(t.z) + bflo(z.z) * a1[0]; v1[1] = bfhi(g.z) * bfhi(t.z) + bfhi(z.z) * a1[1];
                    v1[2] = bflo(g.w) * bflo(t.w) + bflo(z.w) * a1[2]; v1[3] = bfhi(g.w) * bfhi(t.w) + bfhi(z.w) * a1[3];
                    *(u32x4*)(O + (size_t)row * 1024 + col) = pack8(v0, v1); } }
    }
};
struct EpiResF32 {
    static constexpr bool PERM = false, AFTER_DRAIN = false, MIDK = false;
    const float* base; float* out;
    __device__ __forceinline__ void operator()(const f32x4 (&acc)[2][2][4][2], const Unit& u, int wr, int wc, int fr, int fq) const {
        const int row0 = u.lm * BM + wr * 64 + fr, col0 = u.ln * BM + wc * 32 + 4 * fq;
#pragma unroll
        for (int ai = 0; ai < 2; ++ai)
#pragma unroll
            for (int m = 0; m < 4; ++m) { const size_t off = (size_t)(row0 + ai * HALF + m * 16) * 1024 + col0;
#pragma unroll
                for (int bj = 0; bj < 2; ++bj)
#pragma unroll
                    for (int n = 0; n < 2; ++n) { const f32x4 b = *(const f32x4*)(base + off + bj * HALF + n * 16); *(f32x4*)(out + off + bj * HALF + n * 16) = b + acc[ai][bj][m][n]; } }
    }
};
template <bool SPLIT> struct EpiResNorm {
    static constexpr bool PERM = true, AFTER_DRAIN = false, MIDK = false;
    const float* base; float* out; bf16_t* H; bf16_t* L; float* SS;
    __device__ __forceinline__ void operator()(const f32x4 (&acc)[2][2][4][2], const Unit& u, int wr, int wc, int fr, int fq) const {
        const int row0 = u.lm * BM + wr * 64 + fr, col0 = u.ln * BM + wc * 32 + 8 * fq;
#pragma unroll
        for (int ai = 0; ai < 2; ++ai)
#pragma unroll
            for (int m = 0; m < 4; ++m) { const int row = row0 + ai * HALF + m * 16; const size_t off = (size_t)row * 1024 + col0; float ss = 0.f;
#pragma unroll
                for (int bj = 0; bj < 2; ++bj) { const f32x4 v0 = *(const f32x4*)(base + off + bj * HALF) + acc[ai][bj][m][0], v1 = *(const f32x4*)(base + off + bj * HALF + 4) + acc[ai][bj][m][1];
                    *(f32x4*)(out + off + bj * HALF) = v0; *(f32x4*)(out + off + bj * HALF + 4) = v1;
                    ss += (v0[0] * v0[0] + v0[1] * v0[1]) + (v0[2] * v0[2] + v0[3] * v0[3]) + (v1[0] * v1[0] + v1[1] * v1[1]) + (v1[2] * v1[2] + v1[3] * v1[3]);
                    const u32x4 h = pack8(v0, v1); *(u32x4*)(H + off + bj * HALF) = h;
                    if (SPLIT) { f32x4 r0, r1; r0[0] = v0[0] - bflo(h.x); r0[1] = v0[1] - bfhi(h.x); r0[2] = v0[2] - bflo(h.y); r0[3] = v0[3] - bfhi(h.y); r1[0] = v1[0] - bflo(h.z); r1[1] = v1[1] - bfhi(h.z); r1[2] = v1[2] - bflo(h.w); r1[3] = v1[3] - bfhi(h.w);
                        *(u32x4*)(L + off + bj * HALF) = pack8(r0, r1); } }
                ss += __shfl_xor(ss, 16); ss += __shfl_xor(ss, 32);
                if (fq == 0) SS[(size_t)row * 16 + u.ln * 4 + wc] = ss; }
    }
};
struct EpiLogits {
    static constexpr bool PERM = false, AFTER_DRAIN = false, MIDK = false;
    float* LG; int ld, ncols;
    __device__ __forceinline__ void operator()(const f32x4 (&acc)[2][2][4][2], const Unit& u, int wr, int wc, int fr, int fq) const {
        const int row0 = u.lm * BM + wr * 64 + fr, col0 = wc * 32 + 4 * fq;
#pragma unroll
        for (int ai = 0; ai < 2; ++ai)
#pragma unroll
            for (int m = 0; m < 4; ++m) { float* o = LG + (size_t)(row0 + ai * HALF + m * 16) * ld;
#pragma unroll
                for (int n = 0; n < 2; ++n) { const int col = col0 + n * 16; if (col < ncols) *(f32x4*)(o + col) = acc[ai][0][m][n]; } }
    }
};
struct EpiMoe1 {
    static constexpr bool PERM = true, AFTER_DRAIN = false, MIDK = false;
    bf16_t* HID; const float* rstd_slot;
    __device__ __forceinline__ void operator()(const f32x4 (&acc)[2][2][4][2], const Unit& u, int wr, int wc, int fr, int fq) const {
        const int row0 = u.lm * BM + wr * 64 + fr, col0 = u.ln * 128 + wc * 32 + 8 * fq;
#pragma unroll
        for (int ai = 0; ai < 2; ++ai)
#pragma unroll
            for (int m = 0; m < 4; ++m) { const int row = row0 + ai * HALF + m * 16; const float rs = rstd_slot[row];
                f32x4 v0, v1;
#pragma unroll
                for (int e = 0; e < 4; ++e) { v0[e] = silu_f(acc[ai][0][m][0][e] * rs) * (acc[ai][1][m][0][e] * rs); v1[e] = silu_f(acc[ai][0][m][1][e] * rs) * (acc[ai][1][m][1][e] * rs); }
                *(u32x4*)(HID + (size_t)row * 512 + col0) = pack8(v0, v1); }
    }
};
struct EpiMoe2 {
    static constexpr bool PERM = true, AFTER_DRAIN = false, MIDK = false;
    bf16_t* Y; const float* w_slot;
    __device__ __forceinline__ void operator()(const f32x4 (&acc)[2][2][4][2], const Unit& u, int wr, int wc, int fr, int fq) const {
        const int row0 = u.lm * BM + wr * 64 + fr, col0 = u.ln * BM + wc * 32 + 8 * fq;
#pragma unroll
        for (int ai = 0; ai < 2; ++ai)
#pragma unroll
            for (int m = 0; m < 4; ++m) { const int row = row0 + ai * HALF + m * 16; const float rs = w_slot[row];
#pragma unroll
                for (int bj = 0; bj < 2; ++bj) *(u32x4*)(Y + (size_t)row * 1024 + col0 + bj * HALF) = pack8(acc[ai][bj][m][0] * rs, acc[ai][bj][m][1] * rs); }
    }
};
struct EpiP1 {
    static constexpr bool PERM = true, AFTER_DRAIN = false, MIDK = false;
    EpiInProj e0; EpiVT e1; EpiRowBf16<0> e2, e3;
    __device__ __forceinline__ void operator()(const f32x4 (&acc)[2][2][4][2], const Unit& u, int wr, int wc, int fr, int fq) const {
        if (u.ty == 0) e0(acc, u, wr, wc, fr, fq); else if (u.ty == 1) e1(acc, u, wr, wc, fr, fq); else if (u.ty == 2) e2(acc, u, wr, wc, fr, fq); else e3(acc, u, wr, wc, fr, fq);
    }
};
struct EpiMerge2 {
    static constexpr bool PERM = true, AFTER_DRAIN = false, MIDK = true;
    bf16_t* O; const bf16_t* SZ;
    __device__ __forceinline__ void mid(f32x4 (&acc)[2][2][4][2], const Unit& u, int wr, int wc, int fr, int fq) const {
        const int row0 = u.lm * BM + wr * 64 + fr, col0 = u.ln * BM + wc * 32 + 8 * fq;
#pragma unroll
        for (int ai = 0; ai < 2; ++ai)
#pragma unroll
            for (int m = 0; m < 4; ++m) { const int row = row0 + ai * HALF + m * 16;
#pragma unroll
                for (int bj = 0; bj < 2; ++bj) { const int col = col0 + bj * HALF; const u32x4 g = *(const u32x4*)(SZ + (size_t)row * 2048 + col), z = *(const u32x4*)(SZ + (size_t)row * 2048 + 1024 + col);
                    f32x4 r0, r1;
                    r0[0] = bflo(g.x) * __builtin_amdgcn_rcpf(fmaxf(bflo(z.x), 1e-30f)); r0[1] = bfhi(g.x) * __builtin_amdgcn_rcpf(fmaxf(bfhi(z.x), 1e-30f)); r0[2] = bflo(g.y) * __builtin_amdgcn_rcpf(fmaxf(bflo(z.y), 1e-30f)); r0[3] = bfhi(g.y) * __builtin_amdgcn_rcpf(fmaxf(bfhi(z.y), 1e-30f));
                    r1[0] = bflo(g.z) * __builtin_amdgcn_rcpf(fmaxf(bflo(z.z), 1e-30f)); r1[1] = bfhi(g.z) * __builtin_amdgcn_rcpf(fmaxf(bfhi(z.z), 1e-30f)); r1[2] = bflo(g.w) * __builtin_amdgcn_rcpf(fmaxf(bflo(z.w), 1e-30f)); r1[3] = bfhi(g.w) * __builtin_amdgcn_rcpf(fmaxf(bfhi(z.w), 1e-30f));
                    acc[ai][bj][m][0] = acc[ai][bj][m][0] * r0; acc[ai][bj][m][1] = acc[ai][bj][m][1] * r1; } }
    }
    __device__ __forceinline__ void operator()(const f32x4 (&acc)[2][2][4][2], const Unit& u, int wr, int wc, int fr, int fq) const {
        const int row0 = u.lm * BM + wr * 64 + fr, col0 = u.ln * BM + wc * 32 + 8 * fq;
#pragma unroll
        for (int ai = 0; ai < 2; ++ai)
#pragma unroll
            for (int m = 0; m < 4; ++m) { const int row = row0 + ai * HALF + m * 16;
#pragma unroll
                for (int bj = 0; bj < 2; ++bj) { const int col = col0 + bj * HALF; const u32x4 z = *(const u32x4*)(SZ + (size_t)row * 2048 + 1024 + col);
                    f32x4 v0 = acc[ai][bj][m][0], v1 = acc[ai][bj][m][1];
                    v0[0] *= bflo(z.x); v0[1] *= bfhi(z.x); v0[2] *= bflo(z.y); v0[3] *= bfhi(z.y); v1[0] *= bflo(z.z); v1[1] *= bfhi(z.z); v1[2] *= bflo(z.w); v1[3] *= bfhi(z.w);
                    *(u32x4*)(O + (size_t)row * 1024 + col) = pack8(v0, v1); } }
    }
};
template <bool BASE_F32> struct EpiResSplit {
    static constexpr bool PERM = true, AFTER_DRAIN = false, MIDK = false;
    const float* basef; const bf16_t* baseH; const bf16_t* baseL; bf16_t* H; bf16_t* L; float* SS;
    __device__ __forceinline__ void operator()(const f32x4 (&acc)[2][2][4][2], const Unit& u, int wr, int wc, int fr, int fq) const {
        const int row0 = u.lm * BM + wr * 64 + fr, col0 = u.ln * BM + wc * 32 + 8 * fq;
#pragma unroll
        for (int ai = 0; ai < 2; ++ai)
#pragma unroll
            for (int m = 0; m < 4; ++m) { const int row = row0 + ai * HALF + m * 16; const size_t off = (size_t)row * 1024 + col0; float ss = 0.f;
#pragma unroll
                for (int bj = 0; bj < 2; ++bj) { f32x4 v0, v1;
                    if (BASE_F32) { v0 = *(const f32x4*)(basef + off + bj * HALF); v1 = *(const f32x4*)(basef + off + bj * HALF + 4); }
                    else { const u32x4 bh = *(const u32x4*)(baseH + off + bj * HALF), bl = *(const u32x4*)(baseL + off + bj * HALF);
                        v0[0] = bflo(bh.x) + bflo(bl.x); v0[1] = bfhi(bh.x) + bfhi(bl.x); v0[2] = bflo(bh.y) + bflo(bl.y); v0[3] = bfhi(bh.y) + bfhi(bl.y); v1[0] = bflo(bh.z) + bflo(bl.z); v1[1] = bfhi(bh.z) + bfhi(bl.z); v1[2] = bflo(bh.w) + bflo(bl.w); v1[3] = bfhi(bh.w) + bfhi(bl.w); }
                    v0 = v0 + acc[ai][bj][m][0]; v1 = v1 + acc[ai][bj][m][1];
                    ss += (v0[0] * v0[0] + v0[1] * v0[1]) + (v0[2] * v0[2] + v0[3] * v0[3]) + (v1[0] * v1[0] + v1[1] * v1[1]) + (v1[2] * v1[2] + v1[3] * v1[3]);
                    const u32x4 h = pack8(v0, v1); *(u32x4*)(H + off + bj * HALF) = h;
                    f32x4 r0, r1; r0[0] = v0[0] - bflo(h.x); r0[1] = v0[1] - bfhi(h.x); r0[2] = v0[2] - bflo(h.y); r0[3] = v0[3] - bfhi(h.y); r1[0] = v1[0] - bflo(h.z); r1[1] = v1[1] - bfhi(h.z); r1[2] = v1[2] - bflo(h.w); r1[3] = v1[3] - bfhi(h.w);
                    *(u32x4*)(L + off + bj * HALF) = pack8(r0, r1); }
                ss += __shfl_xor(ss, 16); ss += __shfl_xor(ss, 32);
                if (fq == 0) SS[(size_t)row * 16 + u.ln * 4 + wc] = ss; }
    }
};
template <int NM0, int NN0, int A00, int B00, int NM1, int NN1, int A01, int B01, int NM2, int NN2, int A02, int B02, int NM3, int NN3, int A03, int B03>
struct MultiOrder {
    static constexpr bool GATHER = false;
    int G, c;
    __device__ __forceinline__ bool next(int i, Unit& u) const {
        constexpr int C0 = NM0 * NN0, C1 = NM1 * NN1, C2 = NM2 * NN2, C3 = NM3 * NN3;
        long L = (long)i * G + c; int s, nwg, nNs, nMs, a0s, b0s;
        if (L < C0) { s = 0; nwg = C0; nNs = NN0; nMs = NM0; a0s = A00; b0s = B00; }
        else if (L < C0 + C1) { L -= C0; s = 1; nwg = C1; nNs = NN1; nMs = NM1; a0s = A01; b0s = B01; }
        else if (L < C0 + C1 + C2) { L -= C0 + C1; s = 2; nwg = C2; nNs = NN2; nMs = NM2; a0s = A02; b0s = B02; }
        else if (L < C0 + C1 + C2 + C3) { L -= C0 + C1 + C2; s = 3; nwg = C3; nNs = NN3; nMs = NM3; a0s = A03; b0s = B03; }
        else return false;
        int wgid = (int)L; { const int q = nwg / NXCD, r = nwg % NXCD, xcd = wgid % NXCD, off = wgid / NXCD; wgid = (xcd < r ? xcd * (q + 1) : r * (q + 1) + (xcd - r) * q) + off; }
        const int nig = WGM * nNs, gid = wgid / nig, fm = gid * WGM, gsz = (nMs - fm) < WGM ? (nMs - fm) : WGM;
        u.lm = fm + ((wgid % nig) % gsz); u.ln = (wgid % nig) / gsz; u.pm = a0s + u.lm; u.pn = b0s + u.ln; u.ty = s; return true;
    }
    __device__ __forceinline__ void a_ready(const Unit&) const {}
    __device__ __forceinline__ void done(const Unit&) const {}
};
struct MoeOrder {
    static constexpr bool GATHER = false;
    const PG8_LAS int* tile_e; int ntile, G, c;
    __device__ __forceinline__ bool next(int i, Unit& u) const {
        const long L = (long)i * G + c; if (L >= (long)ntile * 4) return false;
        const int pm = (int)(L >> 2), j = (int)(L & 3); u.pm = pm; u.pn = __builtin_amdgcn_readfirstlane(tile_e[pm]) * 4 + j; u.lm = pm; u.ln = j; u.ty = 0; return true;
    }
    __device__ __forceinline__ void a_ready(const Unit&) const {}
    __device__ __forceinline__ void done(const Unit&) const {}
};
struct MoeGatherOrder {
    static constexpr bool GATHER = true;
    const PG8_LAS int* tile_e; const PG8_LAS int* rows; int ntile, G, c;
    __device__ __forceinline__ bool next(int i, Unit& u) const {
        const long L = (long)i * G + c; if (L >= (long)ntile * 4) return false;
        const int pm = (int)(L >> 2), j = (int)(L & 3); u.pm = pm; u.pn = __builtin_amdgcn_readfirstlane(tile_e[pm]) * 4 + j; u.lm = pm; u.ln = j; u.ty = 0; return true;
    }
    __device__ __forceinline__ int row(int ui, int r) const { return rows[ui * 256 + r]; }
    __device__ __forceinline__ void a_ready(const Unit&) const {}
    __device__ __forceinline__ void done(const Unit&) const {}
};
#ifndef PROBE_ACC
#define PROBE_ACC -1
#endif
#ifndef PROBE_N
#define PROBE_N 0
#endif
#define PG8_PB(id) do { if ((id) == PROBE_ACC && (PROBE_N == 0 || g.N == PROBE_N)) g_t0 = __builtin_amdgcn_s_memrealtime(); } while (0)
#define PG8_PE(id) do { if ((id) == PROBE_ACC && (PROBE_N == 0 || g.N == PROBE_N) && wid == 0 && lane == 0) { const unsigned d_ = (unsigned)(__builtin_amdgcn_s_memrealtime() - g_t0); __hip_atomic_fetch_add((PG8_LAS unsigned*)(lds + 147776 + 4 * 16), d_, __ATOMIC_RELAXED, __HIP_MEMORY_SCOPE_WORKGROUP); } } while (0)
template <class Epi, class Sched, bool ALIGN_EPI = false, bool SP2 = false>
__device__ __forceinline__ void gemm_phase(PG8_LAS unsigned char* lds, const Gemm g, const Sched& S, const Epi& E) {
    const int tid = threadIdx.x, wid = __builtin_amdgcn_readfirstlane(tid >> 6), lane = tid & 63, wr = wid >> 2, wc = wid & 3, fr = lane & 15, fq = lane >> 4;
    const int K = g.K, nt = K / BK; unsigned long long g_t0 = 0; (void)g_t0; PG8_PB(42);
    unsigned voffA[2], voffB[2];
#pragma unroll
    for (int i = 0; i < 2; ++i) { int R, C; stage_rc(tid * 16 + i * 8192, R, C); const int Rb = Epi::PERM ? ((R & ~31) + perm32(R & 31)) : R;
        voffA[i] = (unsigned)(R * K + C) * 2u; voffB[i] = (unsigned)(Rb * K + C) * 2u; }
    static_assert(!Sched::GATHER || SP2, "gathered A rows: SP2 loop only");
    unsigned gA[2][2], gN[2][2];
#define PG8_GOFF(dst, ui_) do { _Pragma("unroll") for (int _h = 0; _h < 2; ++_h) _Pragma("unroll") for (int _i = 0; _i < 2; ++_i) { int _R, _C; stage_rc(tid * 16 + _i * 8192, _R, _C); dst[_h][_i] = (unsigned)(S.row((ui_), _h * HALF + _R) * K + _C) * 2u; } } while (0)
#define PG8_STAGE_A(bufoff, gbase, hh, un_) do { if constexpr (Sched::GATHER) { unsigned _vo[2] = {(un_) ? gN[hh][0] : gA[hh][0], (un_) ? gN[hh][1] : gA[hh][1]}; PG8_STAGE(bufoff, gbase, _vo); } else { PG8_STAGE(bufoff, (gbase) + ((hh) ? hstep : 0), voffA); } } while (0)
    const size_t kstep = (size_t)(BK * 2);
    const size_t hstep = (size_t)HALF * K * 2;
    const size_t tstep = 2 * hstep;
    const unsigned ldsw = (unsigned)wid * 1024u;
    const int aoff = lds_byte(wr * 64 + fr, fq * 8), boff = lds_byte(wc * 32 + fr, fq * 8);
#define PG8_SA(b, h) (((b) * 2 + (h)) * HTB)
#define PG8_SB(b, h) ((4 + (b) * 2 + (h)) * HTB)
#define PG8_STAGE(bufoff, gbase, voff) do { _Pragma("unroll") for (int _i = 0; _i < 2; ++_i) \
        __builtin_amdgcn_global_load_lds((const unsigned*)((const char*)(gbase) + (voff)[_i]), (PG8_LAS unsigned*)(lds + (bufoff) + ldsw + _i * 8192), 16, 0, 0); } while (0)
#define PG8_LDA(dst, b, h) do { _Pragma("unroll") for (int m = 0; m < 4; ++m) _Pragma("unroll") for (int k = 0; k < 2; ++k) dst[m][k] = *(const PG8_LAS bf16x8*)(lds + PG8_SA(b, h) + aoff + m * 2048 + k * 1024); } while (0)
#define PG8_LDB(dst, b, h) do { _Pragma("unroll") for (int n = 0; n < 2; ++n) _Pragma("unroll") for (int k = 0; k < 2; ++k) dst[n][k] = *(const PG8_LAS bf16x8*)(lds + PG8_SB(b, h) + boff + n * 2048 + k * 1024); } while (0)
#define PG8_MMA(ai, bj, At, Bt) do { __builtin_amdgcn_s_setprio(1); _Pragma("unroll") for (int m = 0; m < 4; ++m) _Pragma("unroll") for (int n = 0; n < 2; ++n) _Pragma("unroll") for (int k = 0; k < 2; ++k) \
        acc[ai][bj][m][n] = __builtin_amdgcn_mfma_f32_16x16x32_bf16(Bt[n][k], At[m][k], acc[ai][bj][m][n], 0, 0, 0); __builtin_amdgcn_s_setprio(0); } while (0)
#define PG8_WAIT_V(n) asm volatile("s_waitcnt vmcnt(" #n ")" ::: "memory")
#define PG8_WAIT_L(n) asm volatile("s_waitcnt lgkmcnt(" #n ")" ::: "memory")
#define PG8_BAR __builtin_amdgcn_s_barrier()
#define PG8_SCHED __builtin_amdgcn_sched_barrier(0)
    Unit cur, nxt; int ui = 0;
    if (!S.next(0, cur)) return;
    f32x4 acc[2][2][4][2];
#pragma unroll
    for (int a = 0; a < 2; ++a)
#pragma unroll
        for (int b = 0; b < 2; ++b)
#pragma unroll
            for (int m = 0; m < 4; ++m)
#pragma unroll
                for (int n = 0; n < 2; ++n) acc[a][b][m][n] = (f32x4){0.f, 0.f, 0.f, 0.f};
    bf16x8 At[4][2], B0[2][2], B1[2][2];
    const char* cA = (const char*)g.A + (Sched::GATHER ? (size_t)0 : (size_t)cur.pm * tstep); const char* cB = (const char*)g.Bt + (size_t)cur.pn * tstep;
    if constexpr (Sched::GATHER) { PG8_GOFF(gA, 0); }
    S.a_ready(cur);
    if constexpr (SP2) {
        PG8_STAGE(PG8_SB(0, 0), cB, voffB); PG8_STAGE(PG8_SB(0, 1), cB + hstep, voffB); PG8_STAGE_A(PG8_SA(0, 0), cA, 0, false); PG8_STAGE_A(PG8_SA(0, 1), cA, 1, false);
        if (wr == 1) PG8_BAR;
        PG8_WAIT_V(2); PG8_BAR;
        PG8_STAGE(PG8_SB(1, 0), cB + kstep, voffB); PG8_STAGE_A(PG8_SA(1, 0), cA + kstep, 0, false); PG8_STAGE(PG8_SB(1, 1), cB + hstep + kstep, voffB);
        PG8_WAIT_V(6); PG8_BAR;
    } else {
        PG8_STAGE(PG8_SB(0, 0), cB, voffB); PG8_STAGE(PG8_SA(0, 0), cA, voffA); PG8_STAGE(PG8_SB(0, 1), cB + hstep, voffB); PG8_STAGE(PG8_SA(0, 1), cA + hstep, voffA);
        if (wr == 1) PG8_BAR;
        PG8_WAIT_V(4); PG8_BAR;
        PG8_STAGE(PG8_SB(1, 0), cB + kstep, voffB); PG8_STAGE(PG8_SA(1, 0), cA + kstep, voffA); PG8_STAGE(PG8_SB(1, 1), cB + hstep + kstep, voffB);
        PG8_WAIT_V(6); PG8_BAR;
    }
    PG8_PE(42);
    for (;;) {
        const bool has_next = S.next(ui + 1, nxt); PG8_PB(40);
        if constexpr (Sched::GATHER) { if (has_next) PG8_GOFF(gN, ui + 1); }
        const char* nA = (has_next && !Sched::GATHER) ? (const char*)g.A + (size_t)nxt.pm * tstep : cA; const char* nB = has_next ? (const char*)g.Bt + (size_t)nxt.pn * tstep : cB;
        for (int t = 0; t < nt; t += 2) {
            if constexpr (Epi::MIDK) { if (t == (nt >> 1)) { int t_ = threadIdx.x; asm volatile("" : "+v"(t_)); const int l_ = t_ & 63, w_ = __builtin_amdgcn_readfirstlane(t_ >> 6); E.mid(acc, cur, w_ >> 2, w_ & 3, l_ & 15, l_ >> 4); } }
            const bool last = (t == nt - 2); const bool un = last && has_next;
            const char* a1 = cA + (size_t)(t + 1) * kstep;
            const char* a2 = last ? nA : cA + (size_t)(t + 2) * kstep; const char* b2 = last ? nB : cB + (size_t)(t + 2) * kstep;
            const char* a3 = a2 + kstep; const char* b3 = b2 + kstep;
            if (last && has_next) S.a_ready(nxt);
            if constexpr (SP2) {
            PG8_LDB(B0, 0, 0); PG8_LDB(B1, 0, 1); PG8_SCHED; PG8_LDA(At, 0, 0); PG8_STAGE_A(PG8_SA(1, 1), a1, 1, false);
            PG8_WAIT_V(8); PG8_WAIT_L(0); PG8_BAR; PG8_MMA(0, 0, At, B0); PG8_MMA(0, 1, At, B1); PG8_BAR; PG8_SCHED;
            PG8_LDA(At, 0, 1); PG8_STAGE(PG8_SB(0, 0), b2, voffB); PG8_STAGE(PG8_SB(0, 1), b2 + hstep, voffB); PG8_STAGE_A(PG8_SA(0, 0), a2, 0, un);
            PG8_WAIT_V(8); PG8_WAIT_L(0); PG8_BAR; PG8_MMA(1, 0, At, B0); PG8_MMA(1, 1, At, B1); PG8_BAR; PG8_SCHED;
            PG8_LDB(B0, 1, 0); PG8_LDB(B1, 1, 1); PG8_SCHED; PG8_LDA(At, 1, 0); PG8_STAGE_A(PG8_SA(0, 1), a2, 1, un);
            PG8_WAIT_V(8); PG8_WAIT_L(0); PG8_BAR; PG8_MMA(0, 0, At, B0); PG8_MMA(0, 1, At, B1); PG8_BAR; PG8_SCHED;
            PG8_LDA(At, 1, 1); PG8_STAGE(PG8_SB(1, 0), b3, voffB); PG8_STAGE(PG8_SB(1, 1), b3 + hstep, voffB); PG8_STAGE_A(PG8_SA(1, 0), a3, 0, un);
            PG8_WAIT_V(8); PG8_WAIT_L(0); PG8_BAR; PG8_MMA(1, 0, At, B0); PG8_MMA(1, 1, At, B1); PG8_BAR; PG8_SCHED;
            } else {
            PG8_LDB(B0, 0, 0); PG8_SCHED; PG8_LDA(At, 0, 0); PG8_STAGE(PG8_SA(1, 1), a1 + hstep, voffA);
            PG8_WAIT_L(8); PG8_BAR; PG8_WAIT_L(0); PG8_MMA(0, 0, At, B0); PG8_BAR; PG8_SCHED;
            PG8_LDB(B1, 0, 1); PG8_STAGE(PG8_SB(0, 0), b2, voffB);
            PG8_BAR; PG8_WAIT_L(0); PG8_MMA(0, 1, At, B1); PG8_BAR;
            PG8_LDA(At, 0, 1); PG8_STAGE(PG8_SA(0, 0), a2, voffA);
            PG8_BAR; PG8_WAIT_L(0); PG8_MMA(1, 0, At, B0); PG8_BAR; PG8_SCHED;
            PG8_STAGE(PG8_SB(0, 1), b2 + hstep, voffB);
            PG8_WAIT_V(6); PG8_BAR; PG8_MMA(1, 1, At, B1); PG8_BAR;
            PG8_LDB(B0, 1, 0); PG8_SCHED; PG8_LDA(At, 1, 0); PG8_STAGE(PG8_SA(0, 1), a2 + hstep, voffA);
            PG8_WAIT_L(8); PG8_BAR; PG8_WAIT_L(0); PG8_MMA(0, 0, At, B0); PG8_BAR; PG8_SCHED;
            PG8_LDB(B1, 1, 1); PG8_STAGE(PG8_SB(1, 0), b3, voffB);
            PG8_BAR; PG8_WAIT_L(0); PG8_MMA(0, 1, At, B1); PG8_BAR;
            PG8_LDA(At, 1, 1); PG8_STAGE(PG8_SA(1, 0), a3, voffA);
            PG8_BAR; PG8_WAIT_L(0); PG8_MMA(1, 0, At, B0); PG8_BAR; PG8_SCHED;
            PG8_STAGE(PG8_SB(1, 1), b3 + hstep, voffB);
            PG8_WAIT_V(6); PG8_BAR; PG8_MMA(1, 1, At, B1); PG8_BAR;
            }
        }
        PG8_PE(40); PG8_PB(41);
        if constexpr (ALIGN_EPI) { if (wr == 0) PG8_BAR; }
        if constexpr (!Epi::AFTER_DRAIN) { int t_ = threadIdx.x; asm volatile("" : "+v"(t_)); const int l_ = t_ & 63, w_ = __builtin_amdgcn_readfirstlane(t_ >> 6); E(acc, cur, w_ >> 2, w_ & 3, l_ & 15, l_ >> 4); S.done(cur); }
        PG8_PE(41);
        if (!has_next) break;
#pragma unroll
        for (int a = 0; a < 2; ++a)
#pragma unroll
            for (int b = 0; b < 2; ++b)
#pragma unroll
                for (int m = 0; m < 4; ++m)
#pragma unroll
                    for (int n = 0; n < 2; ++n) acc[a][b][m][n] = (f32x4){0.f, 0.f, 0.f, 0.f};
        cur = nxt; cA = nA; cB = nB; ++ui;
        if constexpr (Sched::GATHER) { _Pragma("unroll") for (int _h = 0; _h < 2; ++_h) _Pragma("unroll") for (int _i = 0; _i < 2; ++_i) gA[_h][_i] = gN[_h][_i]; }
        if constexpr (ALIGN_EPI) { if (wr == 1) PG8_BAR; }
    }
    PG8_PB(43);
    PG8_WAIT_V(0);
    if constexpr (!ALIGN_EPI) { if (wr == 0) PG8_BAR; }
    PG8_BAR;
    if constexpr (Epi::AFTER_DRAIN) { E.fused(acc, cur, wr, wc, fr, fq, lds, wid, lane); S.done(cur); }
    PG8_PE(43);
#undef PG8_SA
#undef PG8_SB
#undef PG8_STAGE
#undef PG8_STAGE_A
#undef PG8_GOFF
#undef PG8_LDA
#undef PG8_LDB
#undef PG8_MMA
#undef PG8_WAIT_V
#undef PG8_WAIT_L
#undef PG8_BAR
#undef PG8_SCHED
}
}
#define GAS __attribute__((address_space(1)))
#define LAS __attribute__((address_space(3)))
typedef unsigned short bf16;
typedef unsigned v4u __attribute__((ext_vector_type(4)));
typedef float f32x4 __attribute__((ext_vector_type(4)));
typedef short bf16x8 __attribute__((ext_vector_type(8)));
typedef GAS unsigned gu32;
typedef GAS unsigned long long gu64;
#define RLX_AGENT __ATOMIC_RELAXED, __HIP_MEMORY_SCOPE_AGENT
#define LDS_WAIT() asm volatile("s_waitcnt lgkmcnt(0)" ::: "memory")
#define VM_WAIT() asm volatile("s_waitcnt vmcnt(0)" ::: "memory")
__device__ __forceinline__ unsigned long long rt() { return __builtin_amdgcn_s_memrealtime(); }
__device__ __forceinline__ unsigned f2bf(float f) { unsigned u = __builtin_bit_cast(unsigned, f); return (u + 0x7fffu + ((u >> 16) & 1u)) >> 16; }
__device__ __forceinline__ unsigned pk2(float lo, float hi) { return f2bf(lo) | (f2bf(hi) << 16); }
#define XB_TMO      128
#define XB_XCNT(j)  (256  + 64 * (j))
#define XB_XSUB(j)  (1280 + 64 * (j))
#define XB_XGEN(j)  (2304 + 64 * (j))
#define XB_TOP      3328
#define XB_TOPGEN   3392
#define XCD_BAR_WORDS 3456
#define XB_SPIN_CAP (1u << 18)

__device__ __forceinline__ unsigned xb_ld(unsigned* p)              { return __hip_atomic_load(p, __ATOMIC_RELAXED, __HIP_MEMORY_SCOPE_AGENT); }
__device__ __forceinline__ unsigned xb_add(unsigned* p, unsigned v) { return __hip_atomic_fetch_add(p, v, __ATOMIC_RELAXED, __HIP_MEMORY_SCOPE_AGENT); }
__device__ __forceinline__ unsigned xb_xcc_id() { return (unsigned)__builtin_amdgcn_s_getreg((3 << 11) | 20) & 0xFu; }
#define XB_SPIN(cond, bar) do { unsigned _sp = 0; while (cond) { __builtin_amdgcn_s_sleep(1); \
    if ((++_sp & 255u) == 0u) { if (xb_ld(&(bar)[XB_TMO])) break; if (_sp > XB_SPIN_CAP) { atomicAdd(&(bar)[XB_TMO], 1u); break; } } } } while (0)

struct XcdBarrier {
    unsigned* bar; unsigned x;
    volatile LAS unsigned* st;
};

__device__ __forceinline__ XcdBarrier xcd_barrier_post(unsigned* bar, volatile LAS unsigned* st) {
    XcdBarrier b; b.bar = bar; b.x = xb_xcc_id(); b.st = st;
    if (threadIdx.x == 0) (void)xb_add(&bar[XB_XCNT(b.x)], 1u);
    return b;
}
__device__ __forceinline__ void xcd_barrier_complete(unsigned* bar, unsigned x, unsigned& nloc, unsigned& nx) {
    const unsigned G = gridDim.x * gridDim.y * gridDim.z;
    unsigned sum, cnt, mine, sp = 0u;
    for (;;) {
        sum = 0u; cnt = 0u; mine = 0u;
#pragma unroll
        for (unsigned j = 0; j < 16; ++j) { const unsigned c = xb_ld(&bar[XB_XCNT(j)]); sum += c; cnt += (c > 0u) ? 1u : 0u; mine = (j == x) ? c : mine; }
        if (sum == G) break;
        __builtin_amdgcn_s_sleep(1);
        if ((++sp & 255u) == 0u) { if (xb_ld(&bar[XB_TMO])) break; if (sp > XB_SPIN_CAP) { atomicAdd(&bar[XB_TMO], 1u); break; } }
    }
    nloc = mine > 0u ? mine : 1u; nx = cnt > 0u ? cnt : 1u;
}

__device__ __forceinline__ void xcd_barrier(const XcdBarrier& b) {
    asm volatile("s_waitcnt vmcnt(0)" ::: "memory");
    __syncthreads();
    if (threadIdx.x == 0) {
        unsigned* bar = b.bar;
        __builtin_amdgcn_s_waitcnt(0);
        unsigned nloc = b.st[0], nx = b.st[1];
        if (nloc == 0u) { xcd_barrier_complete(bar, b.x, nloc, nx); b.st[0] = nloc; b.st[1] = nx; }
        const unsigned old = xb_add(&bar[XB_XSUB(b.x)], 1u);
        const unsigned gen = old / nloc;
        if (old + 1u == (gen + 1u) * nloc) {
            __builtin_amdgcn_fence(__ATOMIC_RELEASE, "agent");
            asm volatile("s_waitcnt vmcnt(0)" ::: "memory");
            const unsigned og = xb_add(&bar[XB_TOP], 1u);
            const unsigned tg = og / nx;
            if (og + 1u == (tg + 1u) * nx) xb_add(&bar[XB_TOPGEN], 1u);
            else XB_SPIN(xb_ld(&bar[XB_TOPGEN]) == tg, bar);
            __builtin_amdgcn_fence(__ATOMIC_ACQUIRE, "agent");
            xb_add(&bar[XB_XGEN(b.x)], 1u);
            asm volatile("s_waitcnt vmcnt(0)" ::: "memory");
        } else {
            XB_SPIN(xb_ld(&bar[XB_XGEN(b.x)]) == gen, bar);
            __builtin_amdgcn_fence(__ATOMIC_ACQUIRE, "agent");
            asm volatile("s_waitcnt vmcnt(0)" ::: "memory");
        }
    }
    __syncthreads();
}

constexpr int NWAVES = 8, NTHR = 512;
constexpr int M = 32768, D = 1024, SEQ = 8192, NB = 4;
constexpr int DIN = 5136;
constexpr int MOE_CAP_TILES = 288, MOE_CAP = MOE_CAP_TILES * 256;
constexpr int LIST_CAP = 256 * 496;
constexpr float EPS = 1e-6f;
#ifndef MK_ONE_LAUNCH
#define MK_ONE_LAUNCH 0
#endif
constexpr int NPHASE = 20;

constexpr size_t MiB = 1u << 20, KiB = 1u << 10;
constexpr size_t WS_CTL = 0, CTL_ZERO_BYTES = 1 * MiB;
constexpr int CW_TMO = 0, CW_CODE = 1, CW_BAR = 4096, CW_LCNT = 16384, CW_ECNT = 20480, CW_WQ = 24576;
constexpr size_t WS_RSTD0 = 1 * MiB, WS_RSTD1 = WS_RSTD0 + 128 * KiB, WS_RSTD2 = WS_RSTD1 + 128 * KiB;
constexpr size_t WS_DEC = 1 * MiB + 512 * KiB;
constexpr size_t WS_KMEAN = 2 * MiB, WS_KNMAX = 2 * MiB + 256 * KiB;
constexpr size_t WS_MOE_E = 2 * MiB + 512 * KiB, WS_MOE_POS = WS_MOE_E + 256 * KiB, WS_MOE_W = WS_MOE_POS + 256 * KiB, WS_SLOT_OF = WS_MOE_W + 256 * KiB;
constexpr size_t WS_W_SLOT = 4 * MiB, WS_RSTD_SLOT = 4 * MiB + 512 * KiB, WS_TILE_E = 5 * MiB;
constexpr size_t WS_MEMN = 6 * MiB, WS_MKV = 8 * MiB;
constexpr size_t WS_W1T = 10 * MiB  , WS_WVT = WS_W1T + 8704 * KiB, WS_PGMT = WS_WVT + 2 * MiB  , WS_WOUTT = WS_PGMT + 2 * MiB,
                 WS_WCQT = WS_WOUTT + 2 * MiB, WS_WCKVT = WS_WCQT + 1 * MiB, WS_WCOT = WS_WCKVT + 2 * MiB, WS_WRT = WS_WCOT + 1 * MiB;
static_assert(WS_WRT + 1 * MiB <= 30 * MiB, "weights");
constexpr size_t WS_XB = 30 * MiB, WS_QG = 94 * MiB, WS_KG = 110 * MiB, WS_SR = 126 * MiB, WS_QM = 158 * MiB, WS_KM = 190 * MiB, WS_VT = 222 * MiB, WS_OGM = 286 * MiB  , WS_SZ = 350 * MiB;
constexpr size_t WS_LISTS = 478 * MiB, WS_REFS = 494 * MiB, WS_SEL = 495 * MiB, WS_PARTL = 496 * MiB;
constexpr size_t WS_MG = 30 * MiB, WS_X1H = 94 * MiB, WS_X1L = 158 * MiB, WS_QC = 476 * MiB, WS_SS2 = 508 * MiB, WS_SS1 = 510 * MiB;
constexpr size_t WS_X2H = 222 * MiB, WS_X2L = 286 * MiB;
constexpr size_t WS_WGUT = 30 * MiB, WS_WDT = 350 * MiB, WS_LG = 454 * MiB, WS_LG2 = 464 * MiB, WS_HID = 382 * MiB, WS_XG = 30 * MiB  ;
constexpr size_t WS_END = 512 * MiB;
static_assert(WS_XG + 144 * MiB <= WS_X2H && WS_WDT + 32 * MiB <= WS_HID && WS_HID + 72 * MiB <= WS_LG && WS_LG2 + 5 * MiB <= WS_QC && WS_PARTL + 3 * MiB <= WS_END && WS_SS1 + 2 * MiB <= WS_END, "map");
constexpr size_t DO_ST = 0, DO_LA = 64 * MiB, DO_SB = 96 * MiB, DO_PARTO = 0;
constexpr size_t WS_TOK = 5 * MiB + 64 * KiB;
constexpr size_t WS_EMID = 5 * MiB + 512 * KiB;

constexpr int RING_OFF = 0, RING_BYTES = 147456;
constexpr int LDSCTL_OFF = RING_BYTES, MISC_OFF = LDSCTL_OFF + 320;
constexpr int TBL_TILE = RING_BYTES + 1024, TBL_TAB = TBL_TILE + 1280, TBL_BC = TBL_TAB + 512, TBL_EB = TBL_BC + 64;
constexpr int TBL_ROWS = 155648;
constexpr int LDS_BYTES = 163840;
static_assert(TBL_EB + 256 + 1088 * 4 <= TBL_ROWS && TBL_ROWS + 6 * 1024 <= LDS_BYTES, "LDS tables");
static_assert(TBL_EB + 256 + 1088 * 4 <= LDS_BYTES, "LDS map");

struct Args { const float* in[25]; float* out; unsigned char* ws; int ph_lo, ph_hi; };
struct Frame {
    unsigned long long pacc, pt0;
    LAS unsigned char* lds; unsigned char* ldsg;
    volatile LAS unsigned* MISC; gu32* ctl;
    int vcu, G;
    unsigned char* ws; float* out;
};
template <class T> __device__ __forceinline__ T* uniform_ptr(T* p) { const unsigned long long v = (unsigned long long)p; const unsigned lo = __builtin_amdgcn_readfirstlane((unsigned)v), hi = __builtin_amdgcn_readfirstlane((unsigned)(v >> 32)); return (T*)(((unsigned long long)hi << 32) | lo); }
__device__ __forceinline__ float wave_sum(float v) {
#pragma unroll
    for (int o = 1; o < 64; o <<= 1) v += __shfl_xor(v, o);
    return v;
}
__device__ __forceinline__ float wave_max(float v) {
#pragma unroll
    for (int o = 1; o < 64; o <<= 1) v = fmaxf(v, __shfl_xor(v, o));
    return v;
}
__device__ __forceinline__ float bf2f(bf16 h) { return __uint_as_float(((unsigned)h) << 16); }
__device__ __forceinline__ float bflo(unsigned w) { return __uint_as_float(w << 16); }
__device__ __forceinline__ float bfhi(unsigned w) { return __uint_as_float(w & 0xffff0000u); }
__device__ __forceinline__ void unpack8(const v4u w, float* f) { f[0] = bflo(w.x); f[1] = bfhi(w.x); f[2] = bflo(w.y); f[3] = bfhi(w.y); f[4] = bflo(w.z); f[5] = bfhi(w.z); f[6] = bflo(w.w); f[7] = bfhi(w.w); }
__device__ __forceinline__ v4u pack8f(const float* f) { v4u w; w.x = pk2(f[0], f[1]); w.y = pk2(f[2], f[3]); w.z = pk2(f[4], f[5]); w.w = pk2(f[6], f[7]); return w; }
__device__ __forceinline__ int t5_bucket(int n) {
    if (n < 16) return n;
    int b = 16;
    b += (n >= 19) + (n >= 21) + (n >= 24) + (n >= 27) + (n >= 31) + (n >= 35) + (n >= 40) + (n >= 46) + (n >= 52) + (n >= 59) + (n >= 67) + (n >= 77) + (n >= 87) + (n >= 99) + (n >= 113);
    return b;
}

#ifndef PROBE_ACC
#define PROBE_ACC -1
#endif
#define PB(i) do { if ((i) == PROBE_ACC) F.pt0 = __builtin_amdgcn_s_memrealtime(); } while (0)
#define PE(i) do { if ((i) == PROBE_ACC) F.pacc += __builtin_amdgcn_s_memrealtime() - F.pt0; } while (0)
#define PHASE_IDS int tid = threadIdx.x; asm volatile("" : "+v"(tid)); const int lane = tid & 63; const int wave = __builtin_amdgcn_readfirstlane(tid >> 6); (void)lane; (void)wave
struct TrDesc { const float* src; const float* gain; bf16* dst; int ldw, K, k0; };
__device__ __forceinline__ void tr_load(const TrDesc& t, int lane, f32x4 (&v)[8]) {
#pragma unroll
    for (int i = 0; i < 8; ++i) { const int id = i * 64 + lane, kk = id >> 3, c4 = (id & 7) * 4; v[i] = *(const GAS f32x4*)(t.src + (size_t)(t.k0 + kk) * t.ldw + c4); }
}
__device__ __forceinline__ void tr_finish(const TrDesc& t, int lane, const f32x4 (&v)[8], LAS float* scr) {
#pragma unroll
    for (int i = 0; i < 8; ++i) { const int id = i * 64 + lane, kk = id >> 3, c4 = (id & 7) * 4; const float g = t.gain ? t.gain[t.k0 + kk] : 1.f; LAS float* p = scr + kk * 33 + c4; p[0] = v[i][0] * g; p[1] = v[i][1] * g; p[2] = v[i][2] * g; p[3] = v[i][3] * g; }
    LDS_WAIT(); asm volatile("" ::: "memory");
    const int c = lane & 7;
#pragma unroll
    for (int j = 0; j < 4; ++j) { const int n = (lane >> 3) + 8 * j; const LAS float* s2 = scr + (8 * c) * 33 + n;
        v4u o; o.x = pk2(s2[0 * 33], s2[1 * 33]); o.y = pk2(s2[2 * 33], s2[3 * 33]); o.z = pk2(s2[4 * 33], s2[5 * 33]); o.w = pk2(s2[6 * 33], s2[7 * 33]);
        *(GAS v4u*)(t.dst + (size_t)n * t.K + t.k0 + 8 * c) = o; }
    LDS_WAIT(); asm volatile("" ::: "memory");
}
__device__ __forceinline__ void tr_item_alpha(const float* w_in, const float* wau, const float* gain, bf16* dst, int k0, int n0, LAS float* scr, int lane) {
    const float* a = w_in + (size_t)(k0 + lane) * DIN + 1536; const f32x4 a0 = *(const GAS f32x4*)a, a1 = *(const GAS f32x4*)(a + 4), a2 = *(const GAS f32x4*)(a + 8), a3 = *(const GAS f32x4*)(a + 12);
    const float gk = gain[k0 + lane]; const float av[16] = {a0[0], a0[1], a0[2], a0[3], a1[0], a1[1], a1[2], a1[3], a2[0], a2[1], a2[2], a2[3], a3[0], a3[1], a3[2], a3[3]};
#pragma unroll 4
    for (int n = 0; n < 32; ++n) { float v = 0.f;
#pragma unroll
        for (int r = 0; r < 16; ++r) v += av[r] * wau[r * 256 + n0 + n];
        scr[lane * 33 + n] = v * gk; }
    LDS_WAIT(); asm volatile("" ::: "memory");
    const int c = lane & 7;
#pragma unroll
    for (int j = 0; j < 4; ++j) { const int n = (lane >> 3) + 8 * j; const LAS float* s = scr + (8 * c) * 33 + n;
        v4u o; o.x = pk2(s[0 * 33], s[1 * 33]); o.y = pk2(s[2 * 33], s[3 * 33]); o.z = pk2(s[4 * 33], s[5 * 33]); o.w = pk2(s[6 * 33], s[7 * 33]);
        *(GAS v4u*)(dst + (size_t)(n0 + n) * 1024 + k0 + 8 * c) = o; }
    LDS_WAIT(); asm volatile("" ::: "memory");
}
struct TrJob { int src, col0, ldw, gain, K  , ncols, drow; unsigned dst_off_kib; int kdst  , koff  ; };
__constant__ TrJob kJobs[15] = {
    {5, 0, DIN, 4, 1024, 256, 0, (unsigned)(WS_W1T / 1024), 1024, 0},
    {5, 256, DIN, 4, 1024, 256, 256, (unsigned)(WS_W1T / 1024), 1024, 0},
    {5, 1024, DIN, 4, 1024, 512, 512, (unsigned)(WS_W1T / 1024), 1024, 0},
    {5, 1552, DIN, 4, 1024, 512, 1280, (unsigned)(WS_W1T / 1024), 1024, 0},
    {5, 2064, DIN, 4, 1024, 512, 1792, (unsigned)(WS_W1T / 1024), 1024, 0},
    {5, 3088, DIN, 4, 1024, 1024, 2304, (unsigned)(WS_W1T / 1024), 1024, 0},
    {5, 4112, DIN, 4, 1024, 1024, 3328, (unsigned)(WS_W1T / 1024), 1024, 0},
    {5, 512, DIN, 4, 1024, 512, 0, (unsigned)(WS_WVT / 1024), 1024, 0},
    {5, 2576, DIN, 4, 1024, 512, 512, (unsigned)(WS_WVT / 1024), 1024, 0},
    {9, 0, 1024, -1, 512, 1024, 0, (unsigned)(WS_PGMT / 1024), 1024, 0},
    {10, 0, 1024, -1, 512, 1024, 0, (unsigned)(WS_PGMT / 1024), 1024, 512},
    {11, 0, 1024, -1, 1024, 1024, 0, (unsigned)(WS_WOUTT / 1024), 1024, 0},
    {13, 0, 512, 12, 1024, 512, 0, (unsigned)(WS_WCQT / 1024), 1024, 0},
    {14, 0, 1024, -1, 1024, 1024, 0, (unsigned)(WS_WCKVT / 1024), 1024, 0},
    {15, 0, 1024, -1, 512, 1024, 0, (unsigned)(WS_WCOT / 1024), 512, 0},
};

__device__ __forceinline__ void p0_prologue(Frame& F, const Args& A) {
    PHASE_IDS;
    LAS float* scr = (LAS float*)(F.lds + RING_OFF + wave * 16384);
    const int gw = F.vcu * NWAVES + wave, NGW = F.G * NWAVES;
    PB(20);
    int total = 0;
#pragma unroll 1
    for (int j = 0; j < 15; ++j) total += (kJobs[j].K / 64) * (kJobs[j].ncols / 32);
    const int alpha_items = 16 * 8;
#pragma unroll 1
    for (int it = gw; it < total + alpha_items; it += NGW) {
        if (it >= total) { const int r = it - total; tr_item_alpha(A.in[5], A.in[6], A.in[4], (bf16*)(F.ws + WS_W1T) + (size_t)1024 * 1024, (r >> 3) * 64, (r & 7) * 32, scr, lane); continue; }
        int r = it, j = 0;
#pragma unroll 1
        for (; j < 15; ++j) { const int n = (kJobs[j].K / 64) * (kJobs[j].ncols / 32); if (r < n) break; r -= n; }
        const TrJob jb = kJobs[j]; const int nblk = jb.ncols / 32, kb = r / nblk, nb = r % nblk;
        const TrDesc t{A.in[jb.src] + jb.col0 + nb * 32, jb.gain >= 0 ? A.in[jb.gain] : nullptr, (bf16*)(F.ws + (size_t)jb.dst_off_kib * 1024) + (size_t)(jb.drow + nb * 32) * jb.kdst + jb.koff, jb.ldw, jb.kdst, kb * 64};
        f32x4 v[8]; tr_load(t, lane, v); tr_finish(t, lane, v, scr);
    }
    PE(20); PB(21);
    { bf16* wrt = (bf16*)(F.ws + WS_WRT); const float* g = A.in[16]; const float* wg = A.in[17]; const float* we = A.in[19];
        for (int i = blockIdx.x * NTHR + tid; i < 2 * 256 * 1024; i += F.G * NTHR) { const int mat = i >> 18, o = (i >> 10) & 255, kk = i & 1023; unsigned v = 0;
            if (o < (mat ? 36 : 72)) { const int oo = o < 36 ? o : o - 36; const float w = g[kk] * (oo < 4 ? wg[kk * 4 + oo] : we[kk * 32 + oo - 4]); const unsigned hi = f2bf(w);
                v = o < 36 ? hi : f2bf(w - __uint_as_float(hi << 16)); }
            wrt[i] = (bf16)v; } }
    PE(21); PB(22);
    { const float* x = A.in[0]; bf16* xb = (bf16*)(F.ws + WS_XB); float* rstd0 = (float*)(F.ws + WS_RSTD0);
        int m = gw;
        if (m < M) { f32x4 v[4];
#pragma unroll
            for (int j = 0; j < 4; ++j) v[j] = ((const GAS f32x4*)(x + (size_t)m * D))[64 * j + lane];
#pragma unroll 1
            for (;;) { const int mn = m + NGW; const bool more = mn < M; f32x4 w[4];
                if (more) {
#pragma unroll
                    for (int j = 0; j < 4; ++j) w[j] = ((const GAS f32x4*)(x + (size_t)mn * D))[64 * j + lane]; }
                float s = 0.f;
#pragma unroll
                for (int j = 0; j < 4; ++j) s += (v[j].x * v[j].x + v[j].y * v[j].y) + (v[j].z * v[j].z + v[j].w * v[j].w);
                s = wave_sum(s); const float rs = rsqrtf(s * (1.f / D) + EPS);
                GAS unsigned long long* o8 = (GAS unsigned long long*)(xb + (size_t)m * D) + lane;
#pragma unroll
                for (int j = 0; j < 4; ++j) o8[64 * j] = (unsigned long long)pk2(v[j].x * rs, v[j].y * rs) | ((unsigned long long)pk2(v[j].z * rs, v[j].w * rs) << 32);
                if (!more) break;
                m = mn;
#pragma unroll
                for (int j = 0; j < 4; ++j) v[j] = w[j]; } } }
    PE(22); PB(23);
    { const float* mem = A.in[1]; const float* gm = A.in[2]; bf16* mn = (bf16*)(F.ws + WS_MEMN);
        for (int m = gw; m < 1024; m += NGW) { const GAS f32x4* xr = (const GAS f32x4*)(mem + (size_t)m * D) + lane; const GAS f32x4* gr = (const GAS f32x4*)gm + lane; f32x4 v[4]; float s = 0.f;
#pragma unroll
            for (int j = 0; j < 4; ++j) { v[j] = xr[64 * j]; s += (v[j].x * v[j].x + v[j].y * v[j].y) + (v[j].z * v[j].z + v[j].w * v[j].w); }
            s = wave_sum(s); const float rs = rsqrtf(s * (1.f / D) + EPS);
            GAS unsigned long long* o8 = (GAS unsigned long long*)(mn + (size_t)m * D) + lane;
#pragma unroll
            for (int j = 0; j < 4; ++j) { const f32x4 g = gr[64 * j]; o8[64 * j] = (unsigned long long)pk2(v[j].x * rs * g.x, v[j].y * rs * g.y) | ((unsigned long long)pk2(v[j].z * rs * g.z, v[j].w * rs * g.w) << 32); } } }
}
__device__ __forceinline__ TrDesc expert_item(const Args& A, unsigned char* ws, int it) {
    bf16* wgut = (bf16*)(ws + WS_WGUT); bf16* wdt = (bf16*)(ws + WS_WDT); const int e = it / 768, r = it % 768;
    if (r < 512) { const int up = r >> 8, rr = r & 255, kb = rr >> 4, nb = rr & 15, c0 = nb * 32;
        return TrDesc{A.in[up ? 22 : 21] + (size_t)e * 1024 * 512 + c0, A.in[16], wgut + ((size_t)e * 1024 + (c0 >> 7) * 256 + (c0 & 127) + up * 128) * 1024, 512, 1024, kb * 64}; }
    const int rr = r - 512, kb = rr >> 5, nb = rr & 31;
    return TrDesc{A.in[23] + (size_t)e * 512 * 1024 + nb * 32, nullptr, wdt + ((size_t)e * 1024 + nb * 32) * 512, 1024, 512, kb * 64};
}
__device__ __forceinline__ void expert_weights(Frame& F, const Args& A) {
    PHASE_IDS;
    LAS float* scr = (LAS float*)(F.lds + RING_OFF + wave * 16384);
    const int gw = F.vcu * NWAVES + wave, NGW = F.G * NWAVES;
    int it = gw; if (it >= 32 * 768) return;
    TrDesc cur = expert_item(A, F.ws, it); f32x4 v[8]; tr_load(cur, lane, v);
#pragma unroll 1
    for (;;) { const int nx = it + NGW; const bool more = nx < 32 * 768;
        TrDesc nd = cur; f32x4 w[8];
        if (more) { nd = expert_item(A, F.ws, nx); tr_load(nd, lane, w); }
        tr_finish(cur, lane, v, scr);
        if (!more) break;
        cur = nd; it = nx;
#pragma unroll
        for (int i = 0; i < 8; ++i) v[i] = w[i]; }
}

typedef short mb_bf16x8 __attribute__((ext_vector_type(8)));
typedef unsigned mb_u32x2 __attribute__((ext_vector_type(2)));
__device__ __forceinline__ unsigned mb_cvt_pk(float lo, float hi) { unsigned r; asm volatile("v_cvt_pk_bf16_f32 %0, %1, %2" : "=v"(r) : "v"(lo), "v"(hi)); return r; }
constexpr int GS = 65;
__device__ __forceinline__ void gla_load_b(Frame& F, int tid, const float* LA, int m0, int h, float* Bs) {
#pragma unroll 1
    for (int i = tid; i < 4096; i += NTHR) { const int c = i >> 6, d = i & 63; Bs[c * GS + d] = LA[(size_t)(m0 + c) * 256 + h * 64 + d]; }
    __syncthreads();
    if (tid < 64) { float s = 0.f;
#pragma unroll 8
        for (int c = 0; c < 64; ++c) { s += Bs[c * GS + tid]; Bs[c * GS + tid] = s; } }
    __syncthreads();
}
constexpr int GL_STR = 144;
__device__ __forceinline__ void gla_a_phase(Frame& F) {
    PHASE_IDS;
    LAS float* tot = (LAS float*)(F.lds + RING_OFF); LAS unsigned char* Kt = F.lds + RING_OFF + 2048;
    const float* LA = (const float*)((unsigned char*)F.out + DO_LA); float* ST = (float*)((unsigned char*)F.out + DO_ST);
    const bf16* KG = (const bf16*)(F.ws + WS_KG); const bf16* VT = (const bf16*)(F.ws + WS_VT); float* DEC = (float*)(F.ws + WS_DEC); float* EMID = (float*)(F.ws + WS_EMID);
    const int d = tid & 63, seg = wave, lq = lane & 15, g = lane >> 4;
#pragma unroll 1
    for (int u = blockIdx.x; u < 2048; u += F.G) {
        const int bh = u >> 7, n = u & 127, b = bh >> 2, h = bh & 3, m0 = b * SEQ + n * 64;
        float a[8], kk[8];
#pragma unroll
        for (int i = 0; i < 8; ++i) { const size_t gi = (size_t)(m0 + seg * 8 + i) * 256 + h * 64 + d; a[i] = LA[gi]; kk[i] = bf2f(KG[gi]); }
#pragma unroll
        for (int i = 1; i < 8; ++i) a[i] += a[i - 1];
        tot[seg * 64 + d] = a[7];
        __syncthreads();
        float off = 0.f, total = 0.f;
#pragma unroll
        for (int s2 = 0; s2 < 8; ++s2) { const float t = tot[s2 * 64 + d]; if (s2 < seg) off += t; total += t; }
        { v4u w; float e[8];
#pragma unroll
            for (int i = 0; i < 8; ++i) e[i] = kk[i] * __expf(total - (off + a[i]));
            w.x = pk2(e[0], e[1]); w.y = pk2(e[2], e[3]); w.z = pk2(e[4], e[5]); w.w = pk2(e[6], e[7]);
            *(LAS v4u*)(Kt + d * GL_STR + seg * 16) = w; }
        if (seg == 0) { DEC[u * 64 + d] = __expf(total); EMID[u * 64 + d] = __expf((tot[d] + tot[64 + d]) + (tot[128 + d] + tot[192 + d])); }
        __syncthreads();
        { mb_bf16x8 bf[2];
#pragma unroll
            for (int ks = 0; ks < 2; ++ks) bf[ks] = *(const GAS mb_bf16x8*)(VT + (size_t)(h * 128 + wave * 16 + lq) * M + m0 + 32 * ks + 8 * g);
#pragma unroll
            for (int dt = 0; dt < 4; ++dt) { f32x4 acc = (f32x4){0.f, 0.f, 0.f, 0.f};
#pragma unroll
                for (int ks = 0; ks < 2; ++ks) { const mb_bf16x8 af = *(const LAS mb_bf16x8*)(Kt + (dt * 16 + lq) * GL_STR + ks * 64 + g * 16); acc = __builtin_amdgcn_mfma_f32_16x16x32_bf16(af, bf[ks], acc, 0, 0, 0); }
                *(GAS f32x4*)(ST + ((size_t)u * 128 + wave * 16 + lq) * 64 + dt * 16 + 4 * g) = acc; } }
        __syncthreads();
    }
}
__device__ __forceinline__ void gla_scan_phase(Frame& F) {
    PHASE_IDS;
    const float* ST = (const float*)((unsigned char*)F.out + DO_ST); bf16* SB = (bf16*)((unsigned char*)F.out + DO_SB); const float* DEC = (const float*)(F.ws + WS_DEC); const float* EMID = (const float*)(F.ws + WS_EMID);
#pragma unroll 1
    for (int g = blockIdx.x * NTHR + tid; g < 16 * 8192; g += F.G * NTHR) { const int bh = g >> 13, vd = g & 8191, d = vd & 63; float st = 0.f;
        const float* p = ST + (size_t)bh * 128 * 8192 + vd; bf16* q = SB + (size_t)bh * 128 * 8192 + vd; const float* dc = DEC + bh * 128 * 64 + d; const float* em = EMID + bh * 128 * 64 + d;
#pragma unroll 1
        for (int n0 = 0; n0 < 128; n0 += 16) { float kv[16], de[16], ee[16];
#pragma unroll
            for (int i = 0; i < 16; ++i) { kv[i] = p[(size_t)(n0 + i) * 8192]; de[i] = dc[(n0 + i) * 64]; ee[i] = em[(n0 + i) * 64]; }
#pragma unroll
            for (int i = 0; i < 16; ++i) { q[(size_t)(n0 + i) * 8192] = (bf16)f2bf(st * ee[i]); st = de[i] * st + kv[i]; } } }
}
constexpr int GB_TOT = 0, GB_QE = 2048, GB_KE = GB_QE + 64 * GL_STR, GB_VT = GB_KE + 64 * GL_STR, GB_SB = GB_VT + 128 * GL_STR, GB_UNIT = GB_SB + 128 * GL_STR;
static_assert(2 * GB_UNIT <= RING_BYTES && GB_UNIT % 16 == 0, "GLA-B LDS");
typedef float gb_f32x2 __attribute__((ext_vector_type(2)));
__device__ __forceinline__ void gla_b_phase(Frame& F, const Args& A) {
    PHASE_IDS;
    const float* LA = (const float*)((unsigned char*)F.out + DO_LA); const bf16* SB = (const bf16*)((unsigned char*)F.out + DO_SB);
    const bf16* QG = (const bf16*)(F.ws + WS_QG); const bf16* KG = (const bf16*)(F.ws + WS_KG); const bf16* VT = (const bf16*)(F.ws + WS_VT); const bf16* SR = (const bf16*)(F.ws + WS_SR);
    bf16* OG = (bf16*)(F.ws + WS_OGM); const float* gg = A.in[8];
    const int U = wave >> 2, lt = tid & 255, dp = lt & 31, seg = lt >> 5, lq = lane & 15, g = lane >> 4, ct = wave & 3;
    LAS unsigned char* base = F.lds + RING_OFF + U * GB_UNIT;
    LAS float* tot = (LAS float*)(base + GB_TOT); LAS unsigned char* Qe = base + GB_QE; LAS unsigned char* Ke = base + GB_KE; LAS unsigned char* Vt = base + GB_VT; LAS unsigned char* Sb = base + GB_SB;
    gb_f32x2 a[8]; unsigned q2[8], k2[8]; v4u vc[4], sc[4];
#define GB_LOAD(PR_) do { const int u_ = 2 * (PR_) + U, bh_ = u_ >> 7, n_ = u_ & 127, b_ = bh_ >> 2, h_ = bh_ & 3, m0_ = b_ * SEQ + n_ * 64; \
        _Pragma("unroll") for (int i = 0; i < 8; ++i) { const size_t gi = (size_t)(m0_ + seg * 8 + i) * 256 + h_ * 64 + 2 * dp; a[i] = *(const GAS gb_f32x2*)(LA + gi); q2[i] = *(const GAS unsigned*)(QG + gi); k2[i] = *(const GAS unsigned*)(KG + gi); } \
        _Pragma("unroll") for (int i = 0; i < 4; ++i) { const int ch = lt + i * 256, v = ch >> 3, c8 = ch & 7; vc[i] = *(const GAS v4u*)(VT + (size_t)(h_ * 128 + v) * M + m0_ + c8 * 8); sc[i] = *(const GAS v4u*)(SB + ((size_t)u_ * 128 + v) * 64 + c8 * 8); } } while (0)
    int pr = blockIdx.x;
    if (pr < 1024) GB_LOAD(pr);
#pragma unroll 1
    for (; pr < 1024; pr += F.G) {
        const int u = 2 * pr + U, bh = u >> 7, n = u & 127, b = bh >> 2, h = bh & 3, m0 = b * SEQ + n * 64;
#pragma unroll
        for (int i = 1; i < 8; ++i) a[i] += a[i - 1];
        *(LAS gb_f32x2*)(tot + seg * 64 + 2 * dp) = a[7];
#pragma unroll
        for (int i = 0; i < 4; ++i) { const int ch = lt + i * 256, v = ch >> 3, c8 = ch & 7; *(LAS v4u*)(Vt + v * GL_STR + c8 * 16) = vc[i]; *(LAS v4u*)(Sb + v * GL_STR + c8 * 16) = sc[i]; }
        __syncthreads();
        { gb_f32x2 off = (gb_f32x2){0.f, 0.f}, bmid = (gb_f32x2){0.f, 0.f};
#pragma unroll
            for (int s2 = 0; s2 < 7; ++s2) { const gb_f32x2 t = *(const LAS gb_f32x2*)(tot + s2 * 64 + 2 * dp); if (s2 < seg) off += t; if (s2 < 4) bmid += t; }
#pragma unroll
            for (int i = 0; i < 8; ++i) { const int c = seg * 8 + i; const gb_f32x2 bb = off + a[i];
                *(LAS unsigned*)(Qe + c * GL_STR + dp * 4) = mb_cvt_pk(bflo(q2[i]) * __expf(bb.x - bmid.x), bfhi(q2[i]) * __expf(bb.y - bmid.y));
                *(LAS unsigned*)(Ke + c * GL_STR + dp * 4) = mb_cvt_pk(bflo(k2[i]) * __expf(bmid.x - bb.x), bfhi(k2[i]) * __expf(bmid.y - bb.y)); } }
        __syncthreads();
        if (pr + F.G < 1024) GB_LOAD(pr + F.G);
        {
            const size_t mrow = (size_t)(m0 + ct * 16 + lq) * 512 + h * 128;
            mb_u32x2 srv[8];
#pragma unroll
            for (int vt = 0; vt < 8; ++vt) srv[vt] = *(const GAS mb_u32x2*)(SR + mrow + vt * 16 + 4 * g);
            mb_bf16x8 bq[2];
#pragma unroll
            for (int ks = 0; ks < 2; ++ks) bq[ks] = *(const LAS mb_bf16x8*)(Qe + (ct * 16 + lq) * GL_STR + ks * 64 + g * 16);
            f32x4 sa[4];
#pragma unroll
            for (int st = 0; st < 4; ++st) { sa[st] = (f32x4){0.f, 0.f, 0.f, 0.f};
                if (st <= ct) {
#pragma unroll
                    for (int ks = 0; ks < 2; ++ks) { const mb_bf16x8 af = *(const LAS mb_bf16x8*)(Ke + (st * 16 + lq) * GL_STR + ks * 64 + g * 16); sa[st] = __builtin_amdgcn_mfma_f32_16x16x32_bf16(af, bq[ks], sa[st], 0, 0, 0); }
                    if (st == ct) {
#pragma unroll
                        for (int r = 0; r < 4; ++r) if (4 * g + r > lq) sa[st][r] = 0.f; } } }
            mb_bf16x8 pb[2];
#pragma unroll
            for (int kp = 0; kp < 2; ++kp) { v4u pw; pw.x = mb_cvt_pk(sa[2 * kp][0], sa[2 * kp][1]); pw.y = mb_cvt_pk(sa[2 * kp][2], sa[2 * kp][3]); pw.z = mb_cvt_pk(sa[2 * kp + 1][0], sa[2 * kp + 1][1]); pw.w = mb_cvt_pk(sa[2 * kp + 1][2], sa[2 * kp + 1][3]); pb[kp] = __builtin_bit_cast(mb_bf16x8, pw); }
            f32x4 o[8]; float ss = 0.f;
#pragma unroll
            for (int vt = 0; vt < 8; ++vt) { o[vt] = (f32x4){0.f, 0.f, 0.f, 0.f};
#pragma unroll
                for (int kp = 0; kp < 2; ++kp) if (2 * kp <= ct) { const mb_u32x2 a0 = *(const LAS mb_u32x2*)(Vt + (vt * 16 + lq) * GL_STR + kp * 64 + g * 8), a1 = *(const LAS mb_u32x2*)(Vt + (vt * 16 + lq) * GL_STR + kp * 64 + 32 + g * 8);
                    v4u aw; aw.x = a0.x; aw.y = a0.y; aw.z = a1.x; aw.w = a1.y; o[vt] = __builtin_amdgcn_mfma_f32_16x16x32_bf16(__builtin_bit_cast(mb_bf16x8, aw), pb[kp], o[vt], 0, 0, 0); }
#pragma unroll
                for (int ks = 0; ks < 2; ++ks) { const mb_bf16x8 af = *(const LAS mb_bf16x8*)(Sb + (vt * 16 + lq) * GL_STR + ks * 64 + g * 16); o[vt] = __builtin_amdgcn_mfma_f32_16x16x32_bf16(af, bq[ks], o[vt], 0, 0, 0); }
                ss += (o[vt][0] * o[vt][0] + o[vt][1] * o[vt][1]) + (o[vt][2] * o[vt][2] + o[vt][3] * o[vt][3]); }
            ss += __shfl_xor(ss, 16); ss += __shfl_xor(ss, 32);
            const float rs = rsqrtf(ss * (1.f / 128.f) + EPS);
#pragma unroll
            for (int vt = 0; vt < 8; ++vt) { const int v = vt * 16 + 4 * g; const f32x4 gv = *(const GAS f32x4*)(gg + h * 128 + v); const mb_u32x2 sr = srv[vt];
                mb_u32x2 w; w.x = mb_cvt_pk(o[vt][0] * rs * gv[0] * bflo(sr.x), o[vt][1] * rs * gv[1] * bfhi(sr.x)); w.y = mb_cvt_pk(o[vt][2] * rs * gv[2] * bflo(sr.y), o[vt][3] * rs * gv[3] * bfhi(sr.y));
                *(GAS mb_u32x2*)(OG + (size_t)(m0 + ct * 16 + lq) * 1024 + h * 128 + v) = w; } }
        __syncthreads();
    }
#undef GB_LOAD
}

__device__ __forceinline__ int list_off(int j) { return 256 * (31 * j - (j * (j - 1)) / 2); }
__device__ __forceinline__ void moba_kmean_phase(Frame& F) {
    PHASE_IDS;
    float* lf = (float*)(F.ldsg + RING_OFF); float* part = lf; float* pmx = lf + 512;
    const bf16* KM = (const bf16*)(F.ws + WS_KM); float* kmean = (float*)(F.ws + WS_KMEAN); float* knmax = (float*)(F.ws + WS_KNMAX);
    const int c8 = tid & 7, r0 = tid >> 3;
#pragma unroll 1
    for (int u = blockIdx.x; u < 1024; u += F.G) { const int bh = u >> 5, j = u & 31, b = bh >> 3, h = bh & 7; const size_t m0 = (size_t)b * SEQ + j * 256;
        v4u w[4];
#pragma unroll
        for (int i = 0; i < 4; ++i) w[i] = *(const GAS v4u*)(KM + (m0 + r0 + 64 * i) * 512 + h * 64 + c8 * 8);
        float acc[8]; float mx = 0.f;
#pragma unroll
        for (int e = 0; e < 8; ++e) acc[e] = 0.f;
#pragma unroll
        for (int i = 0; i < 4; ++i) { float f[8]; unpack8(w[i], f); float q = 0.f;
#pragma unroll
            for (int e = 0; e < 8; ++e) { acc[e] += f[e]; q += f[e] * f[e]; }
            q += __shfl_xor(q, 1); q += __shfl_xor(q, 2); q += __shfl_xor(q, 4); mx = fmaxf(mx, q); }
#pragma unroll
        for (int e = 0; e < 8; ++e) { acc[e] += __shfl_xor(acc[e], 8); acc[e] += __shfl_xor(acc[e], 16); acc[e] += __shfl_xor(acc[e], 32); }
        mx = wave_max(mx);
        if (lane < 8) {
#pragma unroll
            for (int e = 0; e < 8; ++e) part[wave * 64 + lane * 8 + e] = acc[e]; }
        if (lane == 0) pmx[wave] = mx;
        __syncthreads();
        if (tid < 64) { float t = 0.f;
#pragma unroll
            for (int w2 = 0; w2 < 8; ++w2) t += part[w2 * 64 + tid];
            kmean[u * 64 + tid] = t * (1.f / 256.f); }
        if (tid == 0) { float t = 0.f;
#pragma unroll
            for (int w2 = 0; w2 < 8; ++w2) t = fmaxf(t, pmx[w2]);
            knmax[u] = sqrtf(t); }
        __syncthreads();
    }
}
__device__ __forceinline__ void moba_gate_phase(Frame& F, const Args& A) {
    PHASE_IDS;
    LAS unsigned char* kmh = F.lds + RING_OFF; LAS unsigned char* kml = kmh + 32 * 144;
    float* lf = (float*)(F.ldsg + RING_OFF + 2 * 32 * 144); float* knm = lf; unsigned* hist = (unsigned*)(lf + 32); unsigned* hbase = hist + 32;
    const bf16* QM = (const bf16*)(F.ws + WS_QM); const float* kmean = (const float*)(F.ws + WS_KMEAN); const float* knmax = (const float*)(F.ws + WS_KNMAX);
    unsigned* SEL = (unsigned*)(F.ws + WS_SEL); float* REFS = (float*)(F.ws + WS_REFS); unsigned* LISTS = (unsigned*)(F.ws + WS_LISTS); const float* rb = A.in[3];
    const int lq = lane & 15, g = lane >> 4;
#pragma unroll 1
    for (int u = blockIdx.x, kk = 0; u < 1024; u += F.G, ++kk) { const int bh = u >> 5, qx = (kk & 2) ? ((u & 31) + 16) & 31 : (u & 31), qb = (kk & 1) ? 31 - qx : qx, b = bh >> 3, h = bh & 7;
        { const int j = tid >> 4, c4 = (tid & 15) * 4; const f32x4 v = *(const GAS f32x4*)(kmean + bh * 2048 + j * 64 + c4);
            const unsigned h0 = f2bf(v[0]), h1 = f2bf(v[1]), h2 = f2bf(v[2]), h3 = f2bf(v[3]);
            *(LAS mb_u32x2*)(kmh + j * 144 + c4 * 2) = (mb_u32x2){h0 | (h1 << 16), h2 | (h3 << 16)};
            *(LAS mb_u32x2*)(kml + j * 144 + c4 * 2) = (mb_u32x2){pk2(v[0] - __uint_as_float(h0 << 16), v[1] - __uint_as_float(h1 << 16)), pk2(v[2] - __uint_as_float(h2 << 16), v[3] - __uint_as_float(h3 << 16))}; }
        if (tid < 32) { knm[tid] = knmax[bh * 32 + tid]; hist[tid] = 0u; }
        __syncthreads();
        float bmx = rb[h];
#pragma unroll 1
        for (int k = 1; k < 32; ++k) bmx = fmaxf(bmx, rb[k * 8 + h]);
        const int nsel = qb < 3 ? qb : 3;
        int sel0[2], sel1[2], sel2[2]; unsigned rk0[2], rk1[2], rk2[2];
#pragma unroll
        for (int qt = 0; qt < 2; ++qt) { const int qi = (wave * 2 + qt) * 16 + lq, t = qb * 256 + qi; const size_t m = (size_t)b * SEQ + t;
            mb_bf16x8 qf[2]; qf[0] = *(const GAS mb_bf16x8*)(QM + m * 512 + h * 64 + 8 * g); qf[1] = *(const GAS mb_bf16x8*)(QM + m * 512 + h * 64 + 32 + 8 * g);
            float qn = 0.f;
#pragma unroll
            for (int ks = 0; ks < 2; ++ks) { const v4u w = __builtin_bit_cast(v4u, qf[ks]); float f[8]; unpack8(w, f);
#pragma unroll
                for (int e = 0; e < 8; ++e) qn += f[e] * f[e]; }
            qn += __shfl_xor(qn, 16); qn += __shfl_xor(qn, 32); qn = sqrtf(qn);
            f32x4 sc[2];
#pragma unroll
            for (int jt = 0; jt < 2; ++jt) { sc[jt] = (f32x4){0.f, 0.f, 0.f, 0.f};
#pragma unroll
                for (int ks = 0; ks < 2; ++ks) { const mb_bf16x8 ah = *(const LAS mb_bf16x8*)(kmh + (jt * 16 + lq) * 144 + ks * 64 + g * 16), al = *(const LAS mb_bf16x8*)(kml + (jt * 16 + lq) * 144 + ks * 64 + g * 16);
                    sc[jt] = __builtin_amdgcn_mfma_f32_16x16x32_bf16(ah, qf[ks], sc[jt], 0, 0, 0); sc[jt] = __builtin_amdgcn_mfma_f32_16x16x32_bf16(al, qf[ks], sc[jt], 0, 0, 0); } }
            float v0 = -INFINITY, v1 = -INFINITY, v2 = -INFINITY; int i0 = 0, i1 = 0, i2 = 0;
#define TOP3_INS(G_, J_) do { const float g_ = (G_); const int j_ = (J_); if (g_ > v0) { v2 = v1; i2 = i1; v1 = v0; i1 = i0; v0 = g_; i0 = j_; } else if (g_ > v1) { v2 = v1; i2 = i1; v1 = g_; i1 = j_; } else if (g_ > v2) { v2 = g_; i2 = j_; } } while (0)
#pragma unroll
            for (int jt = 0; jt < 2; ++jt)
#pragma unroll
                for (int r = 0; r < 4; ++r) { const int j = jt * 16 + 4 * g + r; const float gv = j < qb ? sc[jt][r] : -INFINITY; TOP3_INS(gv, j); }
#pragma unroll
            for (int mk = 16; mk <= 32; mk <<= 1) { const float p0 = __shfl_xor(v0, mk), p1 = __shfl_xor(v1, mk), p2 = __shfl_xor(v2, mk); const int j0 = __shfl_xor(i0, mk), j1 = __shfl_xor(i1, mk), j2 = __shfl_xor(i2, mk);
                TOP3_INS(p0, j0); TOP3_INS(p1, j1); TOP3_INS(p2, j2); }
#undef TOP3_INS
            sel0[qt] = i0; sel1[qt] = i1; sel2[qt] = i2; rk0[qt] = 0; rk1[qt] = 0; rk2[qt] = 0;
            if (g == 0) {
                float kx = knm[qb]; if (nsel > 0) kx = fmaxf(kx, knm[i0]); if (nsel > 1) kx = fmaxf(kx, knm[i1]); if (nsel > 2) kx = fmaxf(kx, knm[i2]);
                SEL[m * 8 + h] = (unsigned)i0 | ((unsigned)i1 << 5) | ((unsigned)i2 << 10) | ((unsigned)nsel << 15);
                REFS[m * 8 + h] = qn * kx + bmx * 1.4426950408889634f;
                if (nsel > 0) rk0[qt] = __hip_atomic_fetch_add(hist + i0, 1u, __ATOMIC_RELAXED, __HIP_MEMORY_SCOPE_WORKGROUP);
                if (nsel > 1) rk1[qt] = __hip_atomic_fetch_add(hist + i1, 1u, __ATOMIC_RELAXED, __HIP_MEMORY_SCOPE_WORKGROUP);
                if (nsel > 2) rk2[qt] = __hip_atomic_fetch_add(hist + i2, 1u, __ATOMIC_RELAXED, __HIP_MEMORY_SCOPE_WORKGROUP); } }
        __syncthreads();
        if (tid < qb) { const unsigned c = hist[tid]; hbase[tid] = c ? atomicAdd((unsigned*)(F.ctl + CW_LCNT) + bh * 32 + tid, c) : 0u; }
        __syncthreads();
        if (g == 0) { unsigned* lb = LISTS + (size_t)bh * LIST_CAP;
#pragma unroll
            for (int qt = 0; qt < 2; ++qt) { const unsigned tq = (unsigned)(qb * 256 + (wave * 2 + qt) * 16 + lq);
                if (nsel > 0) lb[list_off(sel0[qt]) + hbase[sel0[qt]] + rk0[qt]] = (tq << 2);
                if (nsel > 1) lb[list_off(sel1[qt]) + hbase[sel1[qt]] + rk1[qt]] = (tq << 2) | 1u;
                if (nsel > 2) lb[list_off(sel2[qt]) + hbase[sel2[qt]] + rk2[qt]] = (tq << 2) | 2u; } }
        __syncthreads();
    }
}
constexpr size_t PARTO_N1 = 524288;
constexpr int MB_KSTR = 144, MB_VSTR = 528, MB_KBYTES = 256 * MB_KSTR, MB_VBYTES = 80 * MB_VSTR, MB_TABX = MB_KBYTES + MB_VBYTES, MB_TABN = 768;
static_assert(MB_TABX + MB_TABN * 4 <= RING_BYTES, "MoBA LDS");
__device__ __forceinline__ void moba_stage_const(int tid, LAS unsigned char* Vl) {
    for (int i = tid; i < 16 * 32; i += NTHR) { const int r = i >> 5, c = i & 31; const unsigned w = r == 0 ? 0x3f803f80u : 0u; *(LAS v4u*)(Vl + (64 + r) * MB_VSTR + c * 16) = (v4u){w, w, w, w}; }
}
struct MobaStage { v4u kv[4], vv[4]; float tb[2]; };
__device__ __forceinline__ void moba_kv_load(Frame& F, int tid, const Args& A, int b, int h, int j, MobaStage& st) {
    const bf16* KM = (const bf16*)(F.ws + WS_KM); const bf16* VT = (const bf16*)(F.ws + WS_VT);
    const size_t mk = (size_t)b * SEQ + j * 256;
#pragma unroll
    for (int i = 0; i < 4; ++i) { const int ch = tid + i * NTHR, key = ch >> 3, c = ch & 7; st.kv[i] = *(const GAS v4u*)(KM + (mk + key) * 512 + h * 64 + c * 8); }
#pragma unroll
    for (int i = 0; i < 4; ++i) { const int ch = tid + i * NTHR, d = ch >> 5, c = ch & 31; st.vv[i] = *(const GAS v4u*)(VT + (size_t)(512 + h * 64 + d) * M + mk + c * 8); }
#pragma unroll
    for (int i = 0; i < 2; ++i) { const int idx = tid + i * NTHR, dist = idx - 255; st.tb[i] = (idx < MB_TABN && dist >= 0) ? A.in[3][t5_bucket(dist < 127 ? dist : 127) * 8 + h] * 1.4426950408889634f : -INFINITY; }
}
__device__ __forceinline__ void moba_kv_store(int tid, const MobaStage& st, LAS unsigned char* Kl, LAS unsigned char* Vl, LAS float* tabx) {
#pragma unroll
    for (int i = 0; i < 4; ++i) { const int ch = tid + i * NTHR, key = ch >> 3, c = ch & 7; *(LAS v4u*)(Kl + key * MB_KSTR + c * 16) = st.kv[i]; }
#pragma unroll
    for (int i = 0; i < 4; ++i) { const int ch = tid + i * NTHR, d = ch >> 5, c = ch & 31; *(LAS v4u*)(Vl + d * MB_VSTR + c * 16) = st.vv[i]; }
#pragma unroll
    for (int i = 0; i < 2; ++i) { const int idx = tid + i * NTHR; if (idx < MB_TABN) tabx[idx] = st.tb[i]; }
}
__device__ __forceinline__ void moba_stage_kv(Frame& F, int tid, const Args& A, int b, int h, int j, LAS unsigned char* Kl, LAS unsigned char* Vl, LAS float* tabx) {
    MobaStage st; moba_kv_load(F, tid, A, b, h, j, st); moba_kv_store(tid, st, Kl, Vl, tabx);
}
template <int NG>
__device__ __forceinline__ void moba_groups(const LAS unsigned char* Kl, const LAS unsigned char* Vl, const LAS float* tabx, const mb_bf16x8 (&qf)[NG][2], const float (&ref)[NG], const int (&qrel)[NG],
                                            const int (&ntile)[NG], const bool (&far)[NG], f32x4 (&o)[NG][5], int lane) {
    const int lq = lane & 15, g = lane >> 4;
    int nmax = ntile[0];
#pragma unroll
    for (int gi = 1; gi < NG; ++gi) nmax = ntile[gi] > nmax ? ntile[gi] : nmax;
    const LAS unsigned char* kp = Kl + lq * MB_KSTR + g * 16;
    const LAS unsigned char* vp = Vl + lq * MB_VSTR + g * 8;
#pragma unroll
    for (int hf = 0; hf < 2; ++hf) { if (8 * hf < nmax) {
        f32x4 sa[NG][8];
#pragma unroll
        for (int gi = 0; gi < NG; ++gi) {
            if (far[gi]) { const float c = tabx[255 + 127] - ref[gi];
#pragma unroll
                for (int t = 0; t < 8; ++t) sa[gi][t] = (f32x4){c, c, c, c}; }
            else { const int qc = qrel[gi] < 511 ? qrel[gi] : 511; const LAS float* lb = tabx + (qc - 4 * g + 12);
#pragma unroll
                for (int t = 0; t < 8; ++t) { sa[gi][t] = (f32x4){0.f, 0.f, 0.f, 0.f};
                    if (8 * hf + t < ntile[gi]) {
#pragma unroll
                        for (int r = 0; r < 4; ++r) sa[gi][t][r] = lb[243 - 16 * (8 * hf + t) - r] - ref[gi]; } } } }
#pragma unroll
        for (int t = 0; t < 8; ++t) { const int T = 8 * hf + t; if (T < nmax) {
                const mb_bf16x8 k0 = *(const LAS mb_bf16x8*)(kp + T * 16 * MB_KSTR), k1 = *(const LAS mb_bf16x8*)(kp + T * 16 * MB_KSTR + 64);
#pragma unroll
                for (int gi = 0; gi < NG; ++gi) if (T < ntile[gi]) { sa[gi][t] = __builtin_amdgcn_mfma_f32_16x16x32_bf16(k0, qf[gi][0], sa[gi][t], 0, 0, 0); sa[gi][t] = __builtin_amdgcn_mfma_f32_16x16x32_bf16(k1, qf[gi][1], sa[gi][t], 0, 0, 0); } } }
#pragma unroll
        for (int gi = 0; gi < NG; ++gi)
#pragma unroll
            for (int t = 0; t < 8; ++t) { if (8 * hf + t < ntile[gi]) {
#pragma unroll
                    for (int r = 0; r < 4; ++r) sa[gi][t][r] = __builtin_amdgcn_exp2f(sa[gi][t][r]); } }
#pragma unroll
        for (int k2 = 0; k2 < 4; ++k2) { const int ks = 4 * hf + k2; if (2 * ks < nmax) {
                mb_bf16x8 pb[NG];
#pragma unroll
                for (int gi = 0; gi < NG; ++gi) { v4u pw; pw.x = mb_cvt_pk(sa[gi][2 * k2][0], sa[gi][2 * k2][1]); pw.y = mb_cvt_pk(sa[gi][2 * k2][2], sa[gi][2 * k2][3]); pw.z = mb_cvt_pk(sa[gi][2 * k2 + 1][0], sa[gi][2 * k2 + 1][1]); pw.w = mb_cvt_pk(sa[gi][2 * k2 + 1][2], sa[gi][2 * k2 + 1][3]); pb[gi] = __builtin_bit_cast(mb_bf16x8, pw); }
#pragma unroll
                for (int dt = 0; dt < 5; ++dt) { const mb_u32x2 a0 = *(const LAS mb_u32x2*)(vp + dt * 16 * MB_VSTR + ks * 64), a1 = *(const LAS mb_u32x2*)(vp + dt * 16 * MB_VSTR + ks * 64 + 32);
                    v4u aw; aw.x = a0.x; aw.y = a0.y; aw.z = a1.x; aw.w = a1.y; const mb_bf16x8 af = __builtin_bit_cast(mb_bf16x8, aw);
#pragma unroll
                    for (int gi = 0; gi < NG; ++gi) if (2 * ks < ntile[gi]) o[gi][dt] = __builtin_amdgcn_mfma_f32_16x16x32_bf16(af, pb[gi], o[gi][dt], 0, 0, 0); } } } } }
}
__device__ __forceinline__ void moba_part_phase(Frame& F, const Args& A, int wq_word) {
    PHASE_IDS;
    LAS unsigned char* Kl = F.lds + RING_OFF; LAS unsigned char* Vl = Kl + MB_KBYTES; LAS float* tabx = (LAS float*)(F.lds + RING_OFF + MB_TABX); volatile LAS int* bc = (volatile LAS int*)(F.lds + TBL_BC);
    const bf16* QM = (const bf16*)(F.ws + WS_QM); const float* REFS = (const float*)(F.ws + WS_REFS); const unsigned* LISTS = (const unsigned*)(F.ws + WS_LISTS);
    bf16* PARTO0 = (bf16*)((unsigned char*)F.out + DO_PARTO); bf16* PARTO1 = (bf16*)(F.ws + WS_XB); float* PARTL = (float*)(F.ws + WS_PARTL);
    const int lq = lane & 15, g = lane >> 4;
    moba_stage_const(tid, Vl);
#pragma unroll 1
    for (;;) {
        PB(5); PB(8);
        if (tid == 0) bc[0] = (int)atomicAdd((unsigned*)(F.ctl + wq_word), 1u);
        __syncthreads();
        const int u = __builtin_amdgcn_readfirstlane(bc[0]);
        __syncthreads();
        if (u >= 31 * 32) break;
        const int j = u >> 5, bh = u & 31, b = bh >> 3, h = bh & 7;
        const int n = __builtin_amdgcn_readfirstlane((int)__hip_atomic_load((unsigned*)(F.ctl + CW_LCNT) + bh * 32 + j, RLX_AGENT));
        moba_stage_kv(F, tid, A, b, h, j, Kl, Vl, tabx);
        __syncthreads(); PE(5); PB(6);
        const unsigned* lst = LISTS + (size_t)bh * LIST_CAP + list_off(j);
#define MB_IDX(G_) (((G_) * 16 + lq < n) ? (G_) * 16 + lq : (((G_) * 16 < n) ? (G_) * 16 : 0))
#define MB_LOADQ(E_, Q_, R_) do { const size_t m_ = (size_t)b * SEQ + ((E_) >> 2); const bf16* qrow_ = QM + m_ * 512 + h * 64; Q_[0] = *(const GAS mb_bf16x8*)(qrow_ + 8 * g); Q_[1] = *(const GAS mb_bf16x8*)(qrow_ + 32 + 8 * g); R_ = REFS[m_ * 8 + h]; } while (0)
        int pr = wave;
        if (pr * 32 < n) {
            unsigned ea[2];
            ea[0] = lst[MB_IDX(2 * pr)]; ea[1] = lst[MB_IDX(2 * pr + 1)];
#pragma unroll 1
            for (;;) {
                unsigned eb[2]; eb[0] = lst[MB_IDX(2 * pr + 2 * NWAVES)]; eb[1] = lst[MB_IDX(2 * pr + 2 * NWAVES + 1)];
                mb_bf16x8 qa[2][2]; float ra[2];
                MB_LOADQ(ea[0], qa[0], ra[0]); MB_LOADQ(ea[1], qa[1], ra[1]);
                int qrel[2], nt[2]; bool far[2];
#pragma unroll
                for (int gi = 0; gi < 2; ++gi) { qrel[gi] = (int)(ea[gi] >> 2) - j * 256; far[gi] = __all(qrel[gi] - 255 >= 113); nt[gi] = ((2 * pr + gi) * 16 < n) ? 16 : 0; }
                f32x4 o[2][5];
#pragma unroll
                for (int gi = 0; gi < 2; ++gi)
#pragma unroll
                    for (int dt = 0; dt < 5; ++dt) o[gi][dt] = (f32x4){0.f, 0.f, 0.f, 0.f};
                if (PROBE_ACC == 9 || PROBE_ACC == 10) asm volatile("s_waitcnt vmcnt(0)" ::: "memory"); PB(9); moba_groups<2>(Kl, Vl, tabx, qa, ra, qrel, nt, far, o, lane); PE(9);
#pragma unroll
                for (int gi = 0; gi < 2; ++gi) { if ((2 * pr + gi) * 16 + lq < n) { const size_t m = (size_t)b * SEQ + (ea[gi] >> 2); const size_t pi = (m * 8 + h) * 3 + (ea[gi] & 3u); if (g == 0) PARTL[pi] = o[gi][4][0];
#pragma unroll
                        for (int dt = 0; dt < 4; ++dt) { mb_u32x2 w; w.x = mb_cvt_pk(o[gi][dt][0], o[gi][dt][1]); w.y = mb_cvt_pk(o[gi][dt][2], o[gi][dt][3]); *(GAS mb_u32x2*)((pi < PARTO_N1 ? PARTO0 + pi * 64 : PARTO1 + (pi - PARTO_N1) * 64) + dt * 16 + g * 4) = w; } } }
                pr += NWAVES; if (pr * 32 >= n) break;
                ea[0] = eb[0]; ea[1] = eb[1];
            }
        }
#undef MB_IDX
        PE(6); PB(7);
        __syncthreads(); PE(7); PE(8);
    }
}
__device__ __forceinline__ void moba_own_phase(Frame& F, const Args& A, bf16* OUT) {
    PHASE_IDS;
    LAS unsigned char* Kl = F.lds + RING_OFF; LAS unsigned char* Vl = Kl + MB_KBYTES; LAS float* tabx = (LAS float*)(F.lds + RING_OFF + MB_TABX);
    const bf16* QM = (const bf16*)(F.ws + WS_QM); const float* REFS = (const float*)(F.ws + WS_REFS);
    const bf16* PARTO0 = (const bf16*)((unsigned char*)F.out + DO_PARTO); const bf16* PARTO1 = (const bf16*)(F.ws + WS_XB); const float* PARTL = (const float*)(F.ws + WS_PARTL);
    const int lq = lane & 15, g = lane >> 4;
    moba_stage_const(tid, Vl);
    MobaStage st;
    if ((int)blockIdx.x < 1024) { const int u0 = blockIdx.x, bh0 = u0 >> 5; moba_kv_load(F, tid, A, bh0 >> 3, bh0 & 7, u0 & 31, st); }
#pragma unroll 1
    for (int u = blockIdx.x; u < 1024; u += F.G) { const int bh = u >> 5, qb = u & 31, b = bh >> 3, h = bh & 7; const int nsel = qb < 3 ? qb : 3;
        PB(1); PB(4); moba_kv_store(tid, st, Kl, Vl, tabx);
        int grp[2] = {wave, 15 - wave}; size_t mq[2]; mb_bf16x8 qa[2][2]; float ra[2];
#pragma unroll
        for (int gi = 0; gi < 2; ++gi) { mq[gi] = (size_t)b * SEQ + qb * 256 + grp[gi] * 16 + lq; MB_LOADQ(((unsigned)(qb * 256 + grp[gi] * 16 + lq)) << 2, qa[gi], ra[gi]); }
        float pl[3]; mb_u32x2 po[3][4];
#pragma unroll
        for (int r = 0; r < 3; ++r) { pl[r] = 0.f;
#pragma unroll
            for (int dt = 0; dt < 4; ++dt) po[r][dt] = (mb_u32x2){0u, 0u};
            if (r < nsel) { const size_t pi = (mq[0] * 8 + h) * 3 + r; pl[r] = PARTL[pi];
#pragma unroll
                for (int dt = 0; dt < 4; ++dt) po[r][dt] = *(const GAS mb_u32x2*)((pi < PARTO_N1 ? PARTO0 + pi * 64 : PARTO1 + (pi - PARTO_N1) * 64) + dt * 16 + g * 4); } }
        __syncthreads(); PE(1); PB(2);
        if (u + F.G < 1024) { const int un = u + F.G, bhn = un >> 5; moba_kv_load(F, tid, A, bhn >> 3, bhn & 7, un & 31, st); }
        { int qrel[2], nt[2]; bool far[2];
#pragma unroll
            for (int gi = 0; gi < 2; ++gi) { qrel[gi] = grp[gi] * 16 + lq; nt[gi] = grp[gi] + 1; far[gi] = false; }
            f32x4 o[2][5];
#pragma unroll
            for (int gi = 0; gi < 2; ++gi)
#pragma unroll
                for (int dt = 0; dt < 5; ++dt) o[gi][dt] = (f32x4){0.f, 0.f, 0.f, 0.f};
            moba_groups<2>(Kl, Vl, tabx, qa, ra, qrel, nt, far, o, lane); PE(2); PB(3);
#pragma unroll
            for (int gi = 0; gi < 2; ++gi) { float l = __shfl(o[gi][4][0], lq);
#pragma unroll
                for (int r = 0; r < 3; ++r) {
                    if (gi == 0) { l += pl[r];
#pragma unroll
                        for (int dt = 0; dt < 4; ++dt) { o[gi][dt][0] += bflo(po[r][dt].x); o[gi][dt][1] += bfhi(po[r][dt].x); o[gi][dt][2] += bflo(po[r][dt].y); o[gi][dt][3] += bfhi(po[r][dt].y); } }
                    else if (r < nsel) { const size_t pi = (mq[gi] * 8 + h) * 3 + r; l += PARTL[pi];
#pragma unroll
                        for (int dt = 0; dt < 4; ++dt) { const mb_u32x2 w = *(const GAS mb_u32x2*)((pi < PARTO_N1 ? PARTO0 + pi * 64 : PARTO1 + (pi - PARTO_N1) * 64) + dt * 16 + g * 4); o[gi][dt][0] += bflo(w.x); o[gi][dt][1] += bfhi(w.x); o[gi][dt][2] += bflo(w.y); o[gi][dt][3] += bfhi(w.y); } } }
                const float il = 1.f / l;
#pragma unroll
                for (int dt = 0; dt < 4; ++dt) { mb_u32x2 w; w.x = mb_cvt_pk(o[gi][dt][0] * il, o[gi][dt][1] * il); w.y = mb_cvt_pk(o[gi][dt][2] * il, o[gi][dt][3] * il); *(GAS mb_u32x2*)(OUT + mq[gi] * 1024 + 512 + h * 64 + dt * 16 + g * 4) = w; } } }
        PE(3);
        __syncthreads(); PE(4);
    }
#undef MB_LOADQ
}
constexpr int MA_KSTR = 272, MA_VSTR = 528, MA_KBYTES = 256 * MA_KSTR, MA_VBYTES = 128 * MA_VSTR;
static_assert(MA_KBYTES + MA_VBYTES <= RING_BYTES, "mem-attn LDS");
__device__ __forceinline__ void memattn_phase(Frame& F, bf16* OUT) {
    PHASE_IDS;
    LAS unsigned char* Kl = F.lds + RING_OFF; LAS unsigned char* Vl = Kl + MA_KBYTES;
    bf16* QC = (bf16*)(F.ws + WS_QC); const float* SS1 = (const float*)(F.ws + WS_SS1); const bf16* MK = (const bf16*)(F.ws + WS_MKV); const bf16* MVT = MK + 1024 * 512;
    const int lq = lane & 15, g = lane >> 4;
    const int per = (512 + F.G - 1) / F.G; int staged = -1;
#pragma unroll 1
    for (int u = blockIdx.x * per; u < blockIdx.x * per + per && u < 512; ++u) { const int qt = u & 31, bhd = u >> 5, b = bhd >> 2, hd = bhd & 3;
        if (bhd != staged) { __syncthreads();
#pragma unroll
            for (int i = 0; i < 8; ++i) { const int ch = tid + i * NTHR, key = ch >> 4, c = ch & 15; *(LAS v4u*)(Kl + key * MA_KSTR + c * 16) = *(const GAS v4u*)(MK + (size_t)(b * 256 + key) * 512 + hd * 128 + c * 8); }
#pragma unroll
            for (int i = 0; i < 8; ++i) { const int ch = tid + i * NTHR, d = ch >> 5, c = ch & 31; *(LAS v4u*)(Vl + d * MA_VSTR + c * 16) = *(const GAS v4u*)(MVT + (size_t)(hd * 128 + d) * 1024 + b * 256 + c * 8); }
            staged = bhd; __syncthreads(); }
#pragma unroll 1
        for (int grp = wave; grp < 16; grp += NWAVES) {
            const size_t m = (size_t)b * SEQ + qt * 256 + grp * 16 + lq; bf16* qrow = QC + m * 512 + hd * 128;
            mb_bf16x8 qf[4];
#pragma unroll
            for (int s = 0; s < 4; ++s) qf[s] = *(const GAS mb_bf16x8*)(qrow + 32 * s + 8 * g);
            f32x4 sa[16]; const LAS unsigned char* kp = Kl + lq * MA_KSTR + g * 16;
#pragma unroll
            for (int t = 0; t < 16; ++t) { sa[t] = (f32x4){0.f, 0.f, 0.f, 0.f};
#pragma unroll
                for (int s = 0; s < 4; ++s) { const mb_bf16x8 kf = *(const LAS mb_bf16x8*)(kp + t * 16 * MA_KSTR + s * 64); sa[t] = __builtin_amdgcn_mfma_f32_16x16x32_bf16(kf, qf[s], sa[t], 0, 0, 0); } }
            { float ssum = 0.f;
#pragma unroll
                for (int i = 0; i < 4; ++i) { const f32x4 p = *(const GAS f32x4*)(SS1 + m * 16 + 4 * i); ssum += (p[0] + p[1]) + (p[2] + p[3]); }
                const float rs1 = rsqrtf(ssum * (1.f / D) + EPS);
#pragma unroll
                for (int t = 0; t < 16; ++t) sa[t] = sa[t] * rs1; }
            float mx = -INFINITY;
#pragma unroll
            for (int t = 0; t < 16; ++t) mx = fmaxf(fmaxf(mx, fmaxf(sa[t][0], sa[t][1])), fmaxf(sa[t][2], sa[t][3]));
            mx = fmaxf(mx, __shfl_xor(mx, 16)); mx = fmaxf(mx, __shfl_xor(mx, 32));
            float l = 0.f;
#pragma unroll
            for (int t = 0; t < 16; ++t)
#pragma unroll
                for (int r = 0; r < 4; ++r) { const float p = __expf(sa[t][r] - mx); sa[t][r] = p; l += p; }
            l += __shfl_xor(l, 16); l += __shfl_xor(l, 32);
            f32x4 o[8];
#pragma unroll
            for (int dt = 0; dt < 8; ++dt) o[dt] = (f32x4){0.f, 0.f, 0.f, 0.f};
            const LAS unsigned char* vp = Vl + lq * MA_VSTR + g * 8;
#pragma unroll
            for (int ks = 0; ks < 8; ++ks) {
                v4u pw; pw.x = mb_cvt_pk(sa[2 * ks][0], sa[2 * ks][1]); pw.y = mb_cvt_pk(sa[2 * ks][2], sa[2 * ks][3]); pw.z = mb_cvt_pk(sa[2 * ks + 1][0], sa[2 * ks + 1][1]); pw.w = mb_cvt_pk(sa[2 * ks + 1][2], sa[2 * ks + 1][3]);
                const mb_bf16x8 pb = __builtin_bit_cast(mb_bf16x8, pw);
#pragma unroll
                for (int dt = 0; dt < 8; ++dt) { const mb_u32x2 a0 = *(const LAS mb_u32x2*)(vp + dt * 16 * MA_VSTR + ks * 64), a1 = *(const LAS mb_u32x2*)(vp + dt * 16 * MA_VSTR + ks * 64 + 32);
                    v4u aw; aw.x = a0.x; aw.y = a0.y; aw.z = a1.x; aw.w = a1.y;
                    o[dt] = __builtin_amdgcn_mfma_f32_16x16x32_bf16(__builtin_bit_cast(mb_bf16x8, aw), pb, o[dt], 0, 0, 0); } }
            const float il = 1.f / l;
#pragma unroll
            for (int dt = 0; dt < 8; ++dt) { mb_u32x2 w; w.x = mb_cvt_pk(o[dt][0] * il, o[dt][1] * il); w.y = mb_cvt_pk(o[dt][2] * il, o[dt][3] * il); *(GAS mb_u32x2*)(OUT + m * 512 + hd * 128 + dt * 16 + g * 4) = w; }
        }
    }
    __syncthreads();
}

template <bool SPLIT> __device__ __forceinline__ void rownorm_phase(Frame& F, bf16* dst, float* rstd) {
    PHASE_IDS;
    const int gw = F.vcu * NWAVES + wave, NGW = F.G * NWAVES; constexpr int LD = SPLIT ? 2048 : 1024;
    for (int m = gw; m < M; m += NGW) { const GAS f32x4* xr = (const GAS f32x4*)(F.out + (size_t)m * D) + lane; f32x4 v[4]; float s = 0.f;
#pragma unroll
        for (int j = 0; j < 4; ++j) { v[j] = xr[64 * j]; s += (v[j].x * v[j].x + v[j].y * v[j].y) + (v[j].z * v[j].z + v[j].w * v[j].w); }
        s = wave_sum(s); if (lane == 0) rstd[m] = rsqrtf(s * (1.f / D) + EPS);
        GAS unsigned long long* o8 = (GAS unsigned long long*)(dst + (size_t)m * LD) + lane;
#pragma unroll
        for (int j = 0; j < 4; ++j) { const unsigned h0 = f2bf(v[j].x), h1 = f2bf(v[j].y), h2 = f2bf(v[j].z), h3 = f2bf(v[j].w);
            o8[64 * j] = (unsigned long long)(h0 | (h1 << 16)) | ((unsigned long long)(h2 | (h3 << 16)) << 32);
            if (SPLIT) o8[256 + 64 * j] = (unsigned long long)pk2(v[j].x - __uint_as_float(h0 << 16), v[j].y - __uint_as_float(h1 << 16)) | ((unsigned long long)pk2(v[j].z - __uint_as_float(h2 << 16), v[j].w - __uint_as_float(h3 << 16)) << 32); } }
}
constexpr int RCH = 128, NCH = M / RCH;
__device__ __forceinline__ void route_phase(Frame& F, const Args& A) {
    PHASE_IDS;
    const float* LG = (const float*)(F.ws + WS_LG); const float* LG2 = (const float*)(F.ws + WS_LG2); const float* SS2 = (const float*)(F.ws + WS_SS2); float* rstd2 = (float*)(F.ws + WS_RSTD2); const float* brg = A.in[18]; const float* bre = A.in[20];
    int* ME = (int*)(F.ws + WS_MOE_E); int* MP = (int*)(F.ws + WS_MOE_POS); float* MW = (float*)(F.ws + WS_MOE_W); unsigned* CNT = (unsigned*)(F.ws + WS_TILE_E);
    unsigned* hist = (unsigned*)(F.ldsg + RING_OFF);
#pragma unroll 1
    for (int ch = blockIdx.x; ch < NCH; ch += F.G) {
        if (tid < 32) hist[tid] = 0u;
        __syncthreads();
        if (tid < RCH) { const int m = ch * RCH + tid; float ssum = 0.f;
#pragma unroll
            for (int i = 0; i < 4; ++i) { const f32x4 p = *(const GAS f32x4*)(SS2 + (size_t)m * 16 + 4 * i); ssum += (p[0] + p[1]) + (p[2] + p[3]); }
            const float rs = rsqrtf(ssum * (1.f / D) + EPS); rstd2[m] = rs; const float* lg = LG + (size_t)m * 72; const float* lg2 = LG2 + (size_t)m * 36;
            float gl[4]; int grp = 0; float gmx = -INFINITY;
#pragma unroll
            for (int o = 0; o < 4; ++o) { gl[o] = (lg[o] + lg[36 + o] + lg2[o]) * rs + brg[o]; if (gl[o] > gmx) { gmx = gl[o]; grp = o; } }
            float gs = 0.f;
#pragma unroll
            for (int o = 0; o < 4; ++o) gs += __expf(gl[o] - gmx);
            const float pg = 1.f / gs;
            float el[8]; float emx = -INFINITY;
#pragma unroll
            for (int i = 0; i < 8; ++i) { el[i] = (lg[4 + grp * 8 + i] + lg[40 + grp * 8 + i] + lg2[4 + grp * 8 + i]) * rs + bre[grp * 8 + i]; emx = fmaxf(emx, el[i]); }
            float p0 = -1.f, p1 = -1.f; int i0 = 0, i1 = 0;
#pragma unroll
            for (int i = 0; i < 8; ++i) { const float p = __expf(el[i] - emx); if (p > p0) { p1 = p0; i1 = i0; p0 = p; i0 = i; } else if (p > p1) { p1 = p; i1 = i; } }
            const float inv = pg / (p0 + p1);
            const int e0 = grp * 8 + i0, e1 = grp * 8 + i1;
            const unsigned q0 = __hip_atomic_fetch_add(hist + e0, 1u, __ATOMIC_RELAXED, __HIP_MEMORY_SCOPE_WORKGROUP), q1 = __hip_atomic_fetch_add(hist + e1, 1u, __ATOMIC_RELAXED, __HIP_MEMORY_SCOPE_WORKGROUP);
            ME[m * 2] = e0; ME[m * 2 + 1] = e1; MP[m * 2] = (int)q0; MP[m * 2 + 1] = (int)q1; MW[m * 2] = p0 * inv; MW[m * 2 + 1] = p1 * inv; }
        __syncthreads();
        if (tid < 32) CNT[ch * 32 + tid] = hist[tid];
        __syncthreads();
    }
}
__device__ __forceinline__ int moe_bases(Frame& F, int mych) {
    PHASE_IDS;
    volatile int* eb = (volatile int*)(F.ldsg + TBL_EB); volatile int* tl = (volatile int*)(F.ldsg + TBL_TILE); volatile int* part = (volatile int*)(F.ldsg + TBL_EB + 256);
    const unsigned* CNT = (const unsigned*)(F.ws + WS_TILE_E);
    { const int e = tid & 31, pt = tid >> 5; int s = 0, sp = 0;
#pragma unroll 1
        for (int c = pt * (NCH / 16); c < (pt + 1) * (NCH / 16); ++c) { const int v = (int)CNT[c * 32 + e]; s += v; if (c < mych) sp += v; }
        part[pt * 32 + e] = s; part[512 + pt * 32 + e] = sp; }
    __syncthreads();
    if (tid < 32) { int s = 0, sp = 0;
#pragma unroll
        for (int p = 0; p < 16; ++p) { s += part[p * 32 + tid]; sp += part[512 + p * 32 + tid]; }
        part[1024 + tid] = s; part[1056 + tid] = sp; }
    __syncthreads();
    if (tid == 0) { int base = 0;
        for (int e = 0; e < 32; ++e) { const int c = part[1024 + e]; eb[e] = base; const int nt = (c + 255) >> 8; for (int t = 0; t < nt; ++t) tl[(base >> 8) + t] = e; base += nt << 8; }
        eb[32] = base; }
    __syncthreads();
    return eb[32] >> 8;
}
__device__ __forceinline__ void moe_slot_phase(Frame& F) {
    PHASE_IDS;
    volatile int* eb = (volatile int*)(F.ldsg + TBL_EB); volatile int* part = (volatile int*)(F.ldsg + TBL_EB + 256);
    const int* ME = (const int*)(F.ws + WS_MOE_E); const int* MP = (const int*)(F.ws + WS_MOE_POS); const float* MW = (const float*)(F.ws + WS_MOE_W); int* SO = (int*)(F.ws + WS_SLOT_OF);
    float* WSL = (float*)(F.ws + WS_W_SLOT); float* RSL = (float*)(F.ws + WS_RSTD_SLOT); const float* rstd2 = (const float*)(F.ws + WS_RSTD2); int* TOK = (int*)(F.ws + WS_TOK);
#pragma unroll 1
    for (int ch = blockIdx.x; ch < NCH; ch += F.G) {
        (void)moe_bases(F, ch);
        if (ch < 32) { const int e = ch; for (int sl = eb[e] + part[1024 + e] + tid; sl < eb[e + 1]; sl += NTHR) { TOK[sl] = 0; WSL[sl] = 0.f; RSL[sl] = 1.f; } }
        if (tid < RCH * 2) { const int a = ch * RCH * 2 + tid, m = a >> 1; const int e = ME[a]; const int slot = eb[e] + part[1056 + e] + MP[a];
            SO[a] = slot; WSL[slot] = MW[a]; RSL[slot] = rstd2[m]; TOK[slot] = m; }
        __syncthreads();
    }
}
__device__ __forceinline__ void final_phase(Frame& F, const Args& A) {
    PHASE_IDS;
    const int gw = F.vcu * NWAVES + wave, NGW = F.G * NWAVES; const int* SO = (const int*)(F.ws + WS_SLOT_OF); const bf16* Y = (const bf16*)(F.ws + WS_XG); const float* gf = A.in[24];
    const bf16* XH = (const bf16*)(F.ws + WS_X2H); const bf16* XL = (const bf16*)(F.ws + WS_X2L);
    f32x4 gv[4];
#pragma unroll
    for (int j = 0; j < 4; ++j) gv[j] = ((const GAS f32x4*)gf)[64 * j + lane];
    typedef unsigned long long u64;
    u64 ya[4], yb[4], xh[4];
#define FIN_LOAD(m_) do { const int s0_ = SO[(m_) * 2], s1_ = SO[(m_) * 2 + 1]; const GAS u64* y0_ = (const GAS u64*)(Y + (size_t)s0_ * 1024) + lane; const GAS u64* y1_ = (const GAS u64*)(Y + (size_t)s1_ * 1024) + lane; \
        const GAS u64* h_ = (const GAS u64*)(XH + (size_t)(m_) * 1024) + lane; \
        _Pragma("unroll") for (int j = 0; j < 4; ++j) { ya[j] = y0_[64 * j]; yb[j] = y1_[64 * j]; xh[j] = h_[64 * j]; } } while (0)
    int m = gw; if (m >= M) return;
    FIN_LOAD(m);
#pragma unroll 1
    for (;;) {
        f32x4 v[4]; float s = 0.f;
#pragma unroll
        for (int j = 0; j < 4; ++j) { const u64 a = ya[j], c = yb[j], hh = xh[j];
            v[j].x = bflo((unsigned)hh) + (bflo((unsigned)a) + bflo((unsigned)c)); v[j].y = bfhi((unsigned)hh) + (bfhi((unsigned)a) + bfhi((unsigned)c));
            v[j].z = bflo((unsigned)(hh >> 32)) + (bflo((unsigned)(a >> 32)) + bflo((unsigned)(c >> 32))); v[j].w = bfhi((unsigned)(hh >> 32)) + (bfhi((unsigned)(a >> 32)) + bfhi((unsigned)(c >> 32)));
            s += (v[j].x * v[j].x + v[j].y * v[j].y) + (v[j].z * v[j].z + v[j].w * v[j].w); }
        const int mn = m + NGW; const bool more = mn < M;
        if (more) FIN_LOAD(mn);
        s = wave_sum(s); const float rs = rsqrtf(s * (1.f / D) + EPS); GAS f32x4* xr = (GAS f32x4*)(F.out + (size_t)m * D) + lane;
#pragma unroll
        for (int j = 0; j < 4; ++j) xr[64 * j] = (f32x4){v[j].x * rs * gv[j].x, v[j].y * rs * gv[j].y, v[j].z * rs * gv[j].z, v[j].w * rs * gv[j].w};
        if (!more) break;
        m = mn;
    }
#undef FIN_LOAD
}

__global__ void __launch_bounds__(NWAVES * 64, 2) fwd_kernel(Args args) {
    extern __shared__ __attribute__((aligned(16))) unsigned char lds[];
    Frame F; F.pacc = 0; F.pt0 = 0;
    F.lds = (LAS unsigned char*)lds; F.ldsg = lds;
    F.MISC = (volatile LAS unsigned*)(F.lds + MISC_OFF);
    const int tid = threadIdx.x;
    F.G = gridDim.x; { const int bx = blockIdx.x; F.vcu = (F.G % 8 == 0) ? (bx % 8) * (F.G / 8) + bx / 8 : bx; }
    F.ws = uniform_ptr(args.ws); F.out = uniform_ptr(args.out); F.ctl = (gu32*)(F.ws + WS_CTL);
    for (int u = tid; u < (LDS_BYTES - LDSCTL_OFF) / 4; u += NWAVES * 64) ((LAS unsigned*)(F.lds + LDSCTL_OFF))[u] = 0u;
    __syncthreads();
#if MK_ONE_LAUNCH
    XcdBarrier bar = xcd_barrier_post((unsigned*)(F.ctl + CW_BAR), F.MISC + 8);
#define GRID_BAR() xcd_barrier(bar)
#else
#define GRID_BAR() do { if (tid == 0) __hip_atomic_store(F.ctl + CW_TMO, 0xBADBA0u, RLX_AGENT); } while (0)
#endif
    const int lo = args.ph_lo, hi = args.ph_hi;
#define IN(k) (lo <= (k) && (k) < hi)
#ifndef PROBE_MASK
#define PROBE_MASK 0
#endif
#ifndef PG8_ALIGN_EPI
#define PG8_ALIGN_EPI true
#endif
#define REP(k) _Pragma("unroll") for (int rep_ = 0; rep_ < 1 + ((PROBE_MASK >> (k)) & 1); ++rep_)
#ifndef PROBE_A
#define PROBE_A -1
#define PROBE_B -1
#endif
#ifndef PROBE_AMP
#define PROBE_AMP 4
#endif
#ifndef PROBE_BLOCK
#define PROBE_BLOCK 0
#endif
    unsigned long long ts_a = 0, ts_b = 0;
#define STAMP(i) do { if ((i) == PROBE_A) ts_a = __builtin_amdgcn_s_memrealtime(); if ((i) == PROBE_B) ts_b = __builtin_amdgcn_s_memrealtime(); } while (0)
#define SEAM(k) do { if (IN(k) && IN((k) + 1)) { GRID_BAR(); if ((PROBE_MASK >> 6) & 1) GRID_BAR(); } STAMP((k) + 1); } while (0)
    STAMP(0);
    unsigned char* ws = F.ws;
    bf16* XB = (bf16*)(ws + WS_XB);
    const float* rstd0 = (const float*)(ws + WS_RSTD0);

    if (IN(0)) REP(0) { p0_prologue(F, args); } SEAM(0);
    if (IN(1)) REP(1) {
        constexpr int TS = 512 * 1024;
        static_assert(WS_XB % TS == 0 && WS_W1T % TS == 0 && WS_WVT % TS == 0 && WS_MEMN % TS == 0 && WS_WCKVT % TS == 0, "tile-aligned matrices");
        pg8::Gemm g{(const bf16*)ws, (const bf16*)ws, M, 4352, 1024};
        typedef pg8::MultiOrder<128, 17, (int)(WS_XB / TS), (int)(WS_W1T / TS), 4, 128, (int)(WS_WVT / TS), (int)(WS_XB / TS), 4, 2, (int)(WS_MEMN / TS), (int)(WS_WCKVT / TS), 2, 4, (int)(WS_WCKVT / TS) + 2, (int)(WS_MEMN / TS)> P1Order;
        P1Order S{F.G, (int)blockIdx.x};
        pg8::EpiP1 E{ pg8::EpiInProj{(bf16*)(ws + WS_QG), (bf16*)(ws + WS_KG), (bf16*)(ws + WS_SR), (bf16*)(ws + WS_QM), (bf16*)(ws + WS_KM), (bf16*)(ws + WS_SZ), (float*)((unsigned char*)F.out + DO_LA), rstd0, args.in[7]},
                      pg8::EpiVT{(bf16*)(ws + WS_VT), M, rstd0},
                      pg8::EpiRowBf16<0>{(bf16*)(ws + WS_MKV), 512, nullptr, 1.f}, pg8::EpiRowBf16<0>{(bf16*)(ws + WS_MKV) + 1024 * 512, 1024, nullptr, 1.f} };
        pg8::gemm_phase<pg8::EpiP1, P1Order, PG8_ALIGN_EPI, true>(F.lds + RING_OFF, g, S, E);
    } SEAM(1);
    if (IN(2)) { REP(2) gla_a_phase(F); STAMP(30); REP(5) moba_kmean_phase(F); } SEAM(2);
    if (IN(3)) { gla_scan_phase(F); STAMP(31); moba_gate_phase(F, args); } SEAM(3);
    if (IN(4)) { gla_b_phase(F, args); STAMP(32); moba_part_phase(F, args, CW_WQ); } SEAM(4);
    STAMP(6);
    if (IN(6)) { moba_own_phase(F, args, (bf16*)(ws + WS_OGM)); } SEAM(6);
    if (IN(7)) REP(1) { pg8::Gemm g{(const bf16*)(ws + WS_OGM), (const bf16*)(ws + WS_PGMT), M, 1024, 1024}; pg8::StaticOrder S; S.init(M, 1024, F.G, (int)blockIdx.x);
        pg8::EpiMerge2 E{(bf16*)(ws + WS_MG), (const bf16*)(ws + WS_SZ)};
        pg8::gemm_phase<pg8::EpiMerge2, pg8::StaticOrder, PG8_ALIGN_EPI, true>(F.lds + RING_OFF, g, S, E); } SEAM(7);
    if (IN(8)) REP(1) { pg8::Gemm g{(const bf16*)(ws + WS_MG), (const bf16*)(ws + WS_WOUTT), M, 1024, 1024}; pg8::StaticOrder S; S.init(M, 1024, F.G, (int)blockIdx.x);
        pg8::EpiResSplit<true> E{args.in[0], nullptr, nullptr, (bf16*)(ws + WS_X1H), (bf16*)(ws + WS_X1L), (float*)(ws + WS_SS1)};
        pg8::gemm_phase<pg8::EpiResSplit<true>, pg8::StaticOrder, PG8_ALIGN_EPI, true>(F.lds + RING_OFF, g, S, E); } SEAM(8);
    if (IN(10)) REP(1) { pg8::Gemm g{(const bf16*)(ws + WS_X1H), (const bf16*)(ws + WS_WCQT), M, 512, 1024}; pg8::StaticOrder S; S.init(M, 512, F.G, (int)blockIdx.x);
        pg8::EpiRowBf16<0> E{(bf16*)(ws + WS_QC), 512, nullptr, 0.08838834764831845f};
        pg8::gemm_phase<pg8::EpiRowBf16<0>, pg8::StaticOrder, PG8_ALIGN_EPI, true>(F.lds + RING_OFF, g, S, E); } SEAM(10);
    if (IN(11)) { memattn_phase(F, (bf16*)(ws + WS_QC)); } SEAM(11);
    if (IN(12)) { pg8::Gemm g{(const bf16*)(ws + WS_QC), (const bf16*)(ws + WS_WCOT), M, 1024, 512}; pg8::StaticOrder S; S.init(M, 1024, F.G, (int)blockIdx.x);
        pg8::EpiResSplit<false> E{nullptr, (const bf16*)(ws + WS_X1H), (const bf16*)(ws + WS_X1L), (bf16*)(ws + WS_X2H), (bf16*)(ws + WS_X2L), (float*)(ws + WS_SS2)};
        pg8::gemm_phase<pg8::EpiResSplit<false>, pg8::StaticOrder, PG8_ALIGN_EPI, true>(F.lds + RING_OFF, g, S, E);
        expert_weights(F, args); } SEAM(12);
    STAMP(14);
    if (IN(14)) REP(1) {
        { pg8::Gemm g{(const bf16*)(ws + WS_X2H), (const bf16*)(ws + WS_WRT), M, 256, 1024}; pg8::StaticOrder S; S.init(M, 256, F.G, (int)blockIdx.x);
          pg8::EpiLogits E{(float*)(ws + WS_LG), 72, 72};
          pg8::gemm_phase<pg8::EpiLogits, pg8::StaticOrder, PG8_ALIGN_EPI, true>(F.lds + RING_OFF, g, S, E); }
        { pg8::Gemm g{(const bf16*)(ws + WS_X2L), (const bf16*)(ws + WS_WRT) + 256 * 1024, M, 256, 1024}; pg8::StaticOrder S; S.init(M, 256, F.G, (int)((blockIdx.x + F.G / 2) % F.G));
          pg8::EpiLogits E{(float*)(ws + WS_LG2), 36, 36};
          pg8::gemm_phase<pg8::EpiLogits, pg8::StaticOrder, PG8_ALIGN_EPI, true>(F.lds + RING_OFF, g, S, E); }
    } SEAM(14);
    if (IN(15)) { route_phase(F, args); } SEAM(15);
    if (IN(16)) REP(0) { moe_slot_phase(F); } SEAM(16);
    if (IN(17)) REP(1) { const int ntile = moe_bases(F, 0);
        { LAS int* rows = (LAS int*)(F.lds + TBL_ROWS); const int* TOK = (const int*)(ws + WS_TOK);
          for (int i = threadIdx.x; i < 6 * 256; i += NTHR) { const long L = (long)(i >> 8) * F.G + blockIdx.x; rows[i] = (L < (long)ntile * 4) ? TOK[(int)(L >> 2) * 256 + (i & 255)] : 0; }
          __syncthreads(); }
        pg8::Gemm g{(const bf16*)(ws + WS_X2H), (const bf16*)(ws + WS_WGUT), MOE_CAP, 32 * 1024, 1024}; pg8::MoeGatherOrder S{(const LAS int*)(F.lds + TBL_TILE), (const LAS int*)(F.lds + TBL_ROWS), ntile, F.G, (int)blockIdx.x};
        pg8::EpiMoe1 E{(bf16*)(ws + WS_HID), (const float*)(ws + WS_RSTD_SLOT)};
        pg8::gemm_phase<pg8::EpiMoe1, pg8::MoeGatherOrder, PG8_ALIGN_EPI, true>(F.lds + RING_OFF, g, S, E); } SEAM(17);
    if (IN(18)) REP(1) { const int ntile = moe_bases(F, 0);
        pg8::Gemm g{(const bf16*)(ws + WS_HID), (const bf16*)(ws + WS_WDT), MOE_CAP, 32 * 1024, 512}; pg8::MoeOrder S{(const LAS int*)(F.lds + TBL_TILE), ntile, F.G, (int)blockIdx.x};
        pg8::EpiMoe2 E{(bf16*)(ws + WS_XG), (const float*)(ws + WS_W_SLOT)};
        pg8::gemm_phase<pg8::EpiMoe2, pg8::MoeOrder, PG8_ALIGN_EPI, true>(F.lds + RING_OFF, g, S, E); } SEAM(18);
    if (IN(19)) { final_phase(F, args); }
    STAMP(20);
    if ((PROBE_A >= 0 || PROBE_ACC >= 0) && blockIdx.x == PROBE_BLOCK) { const unsigned long long dl = (PROBE_ACC >= 40 ? (unsigned long long)F.MISC[16] : PROBE_ACC >= 0 ? F.pacc : (ts_b - ts_a)) * PROBE_AMP, t0 = __builtin_amdgcn_s_memrealtime(); while (__builtin_amdgcn_s_memrealtime() - t0 < dl) __builtin_amdgcn_s_sleep(8); }
#undef IN
#undef SEAM
}

extern "C" void kernel_launch(void* const* d_in, const int* in_sizes, int n_in, void* d_out, int out_size, void* d_ws, size_t ws_size, hipStream_t stream) {
    static int grid = 0;
    if (grid == 0) {
        if (n_in != 25 || in_sizes[0] != M * D || out_size != M * D || ws_size < WS_END) { fprintf(stderr, "kernel_launch: unexpected shapes (n_in %d in0 %d out %d ws %zu)\n", n_in, n_in > 0 ? in_sizes[0] : -1, out_size, ws_size); grid = -1; return; }
        int dev = 0, cus = 0, per_cu = 0;
        if (hipGetDevice(&dev) != hipSuccess || hipDeviceGetAttribute(&cus, hipDeviceAttributeMultiprocessorCount, dev) != hipSuccess) { grid = -1; return; }
        if (hipFuncSetAttribute((const void*)fwd_kernel, hipFuncAttributeMaxDynamicSharedMemorySize, LDS_BYTES) != hipSuccess) { fprintf(stderr, "kernel_launch: hipFuncSetAttribute failed\n"); grid = -1; return; }
        if (hipOccupancyMaxActiveBlocksPerMultiprocessor(&per_cu, (const void*)fwd_kernel, NWAVES * 64, LDS_BYTES) != hipSuccess || per_cu < 1) fprintf(stderr, "kernel_launch: occupancy query reports %d\n", per_cu);
        (void)hipGetLastError();
        grid = cus;
    }
    if (grid < 0) return;
    if (hipMemsetAsync((char*)d_ws + WS_CTL, 0, CTL_ZERO_BYTES, stream) != hipSuccess) return;
    Args a{};
    for (int i = 0; i < 25; ++i) a.in[i] = (const float*)d_in[i];
    a.out = (float*)d_out; a.ws = (unsigned char*)d_ws;
#if MK_ONE_LAUNCH
    a.ph_lo = 0; a.ph_hi = NPHASE;
    hipLaunchKernelGGL(fwd_kernel, dim3(grid), dim3(NWAVES * 64), LDS_BYTES, stream, a);
#else
    for (int p = 0; p < NPHASE; ++p) { a.ph_lo = p; a.ph_hi = p + 1; hipLaunchKernelGGL(fwd_kernel, dim3(grid), dim3(NWAVES * 64), LDS_BYTES, stream, a); }
#endif
}
```

```cpp
#include <hip/hip_runtime.h>
#include <cstdio>
#include <cstdint>
#define MK_ONE_LAUNCH 1
namespace pg8 {
#define PG8_LAS __attribute__((address_space(3)))
typedef unsigned short bf16_t;
typedef short bf16x8 __attribute__((ext_vector_type(8)));
typedef float f32x4 __attribute__((ext_vector_type(4)));
typedef unsigned u32x4 __attribute__((ext_vector_type(4)));
constexpr int BM = 256, BK = 64, HALF = 128, HTB = HALF * BK * 2  , STAGE_BYTES = 8 * HTB, NXCD = 8, WGM = 8;

__host__ __device__ __forceinline__ int lds_byte(int r, int c) { const int st = (r >> 4) * 2 + (c >> 5), rr = r & 15, cc = c & 31, ob = rr * 64 + cc * 2; return st * 1024 + (ob ^ (((ob >> 9) & 1) << 5)); }
__host__ __device__ __forceinline__ void stage_rc(int b, int& R, int& C) { const int st = b / 1024, sb = b % 1024, swz = sb ^ (((sb >> 9) & 1) << 5); R = (st >> 1) * 16 + swz / 64; C = (st & 1) * 32 + (swz % 64) / 2; }
__host__ __device__ __forceinline__ int perm32(int rho) { const int n = rho >> 4, i = rho & 15; return 8 * (i >> 2) + 4 * n + (i & 3); }

struct Unit { int pm, pn, lm, ln, ty; };
struct Gemm { const bf16_t* A; const bf16_t* Bt; int M, N, K; };

struct StaticOrder {
    static constexpr bool GATHER = false;
    int nM, nN, nwg, G, c;
    __host__ __device__ void init(int M, int N, int G_, int c_) { nM = M / BM; nN = N / BM; nwg = nM * nN; G = G_; c = c_; }
    __host__ __device__ bool next(int i, Unit& u) const {
        const long L = (long)i * G + c; if (L >= nwg) return false;
        int wgid = (int)L; { const int q = nwg / NXCD, r = nwg % NXCD, xcd = wgid % NXCD, off = wgid / NXCD; wgid = (xcd < r ? xcd * (q + 1) : r * (q + 1) + (xcd - r) * q) + off; }
        const int nig = WGM * nN, gid = wgid / nig, fm = gid * WGM, gsz = (nM - fm) < WGM ? (nM - fm) : WGM;
        u.pm = fm + ((wgid % nig) % gsz); u.pn = (wgid % nig) / gsz; u.lm = u.pm; u.ln = u.pn; u.ty = 0; return true;
    }
    __device__ __forceinline__ void a_ready(const Unit&) const {}
    __device__ __forceinline__ void done(const Unit&) const {}
};

__device__ __forceinline__ unsigned cvt_pk_bf16(float lo, float hi) { unsigned r; asm volatile("v_cvt_pk_bf16_f32 %0, %1, %2" : "=v"(r) : "v"(lo), "v"(hi)); return r; }
typedef float f32x2 __attribute__((ext_vector_type(2)));
__device__ __forceinline__ float bf2f(unsigned short h) { return __uint_as_float(((unsigned)h) << 16); }
__device__ __forceinline__ float bflo(unsigned w) { return __uint_as_float(w << 16); }
__device__ __forceinline__ float bfhi(unsigned w) { return __uint_as_float(w & 0xffff0000u); }
__device__ __forceinline__ float sigmoid_f(float x) { return __builtin_amdgcn_rcpf(1.0f + __builtin_amdgcn_exp2f(-1.4426950408889634f * x)); }
__device__ __forceinline__ float silu_f(float x) { return x * __builtin_amdgcn_rcpf(1.0f + __builtin_amdgcn_exp2f(-1.4426950408889634f * x)); }
__device__ __forceinline__ float logsigmoid_f(float x) { return fminf(x, 0.f) - 0.6931471805599453f * __builtin_amdgcn_logf(1.0f + __builtin_amdgcn_exp2f(-1.4426950408889634f * fabsf(x))); }
__device__ __forceinline__ u32x4 pack8(const f32x4 v0, const f32x4 v1) { u32x4 w; w.x = cvt_pk_bf16(v0[0], v0[1]); w.y = cvt_pk_bf16(v0[2], v0[3]); w.z = cvt_pk_bf16(v1[0], v1[1]); w.w = cvt_pk_bf16(v1[2], v1[3]); return w; }

struct EpiInProj {
    static constexpr bool PERM = true, AFTER_DRAIN = false, MIDK = false;
    bf16_t *QG, *KG, *SR, *QM, *KM, *SZ; float* LA; const float* rstd; const float* b_alpha;
    __device__ __forceinline__ void operator()(const f32x4 (&acc)[2][2][4][2], const Unit& u, int wr, int wc, int fr, int fq) const {
        const int pn = u.ln; bf16_t* dst; int ldc, cbase, mode = 0; float sc = 1.f;
        if (pn == 0) { dst = QG; ldc = 256; cbase = 0; sc = 0.125f; }
        else if (pn == 1) { dst = KG; ldc = 256; cbase = 0; }
        else if (pn <= 3) { dst = SR; ldc = 512; cbase = (pn - 2) * 256; mode = 1; }
        else if (pn == 4) { dst = nullptr; ldc = 256; cbase = 0; mode = 3; }
        else if (pn <= 6) { dst = QM; ldc = 512; cbase = (pn - 5) * 256; sc = 0.125f * 1.4426950408889634f; }
        else if (pn <= 8) { dst = KM; ldc = 512; cbase = (pn - 7) * 256; }
        else { dst = SZ; ldc = 2048; cbase = (pn - 9) * 256; mode = 2; }
        const int row0 = u.lm * BM + wr * 64 + fr, col0 = cbase + wc * 32 + 8 * fq;
#pragma unroll
        for (int ai = 0; ai < 2; ++ai)
#pragma unroll
            for (int m = 0; m < 4; ++m) { const int row = row0 + ai * HALF + m * 16; const float rs = sc;
#pragma unroll
                for (int bj = 0; bj < 2; ++bj) { f32x4 v0 = acc[ai][bj][m][0] * rs, v1 = acc[ai][bj][m][1] * rs; const int col = col0 + bj * HALF;
                    if (mode == 3) { const f32x4 b0 = *(const f32x4*)(b_alpha + col), b1 = *(const f32x4*)(b_alpha + col + 4);
#pragma unroll
                        for (int e = 0; e < 4; ++e) { v0[e] = logsigmoid_f(v0[e] + b0[e]) * 0.0625f; v1[e] = logsigmoid_f(v1[e] + b1[e]) * 0.0625f; }
                        float* o = LA + (size_t)row * 256 + col; *(f32x4*)o = v0; *(f32x4*)(o + 4) = v1; }
                    else { if (mode == 1) {
#pragma unroll
                            for (int e = 0; e < 4; ++e) { v0[e] = silu_f(v0[e]); v1[e] = silu_f(v1[e]); } }
                        else if (mode == 2) {
#pragma unroll
                            for (int e = 0; e < 4; ++e) { v0[e] = sigmoid_f(v0[e]); v1[e] = sigmoid_f(v1[e]); } }
                        *(u32x4*)(dst + (size_t)row * ldc + col) = pack8(v0, v1); } } }
    }
};
struct EpiVT {
    static constexpr bool PERM = true, AFTER_DRAIN = false, MIDK = false;
    bf16_t* VT; int ldc; const float* rstd;
    __device__ __forceinline__ void operator()(const f32x4 (&acc)[2][2][4][2], const Unit& u, int wr, int wc, int fr, int fq) const {
        const int row0 = u.lm * BM + wr * 64 + fr, col0 = u.ln * BM + wc * 32 + 8 * fq;
#pragma unroll
        for (int ai = 0; ai < 2; ++ai)
#pragma unroll
            for (int m = 0; m < 4; ++m) { const int row = row0 + ai * HALF + m * 16;
#pragma unroll
                for (int bj = 0; bj < 2; ++bj) *(u32x4*)(VT + (size_t)row * ldc + col0 + bj * HALF) = pack8(acc[ai][bj][m][0], acc[ai][bj][m][1]); }
    }
};
template <int ACT> struct EpiRowBf16 {
    static constexpr bool PERM = true, AFTER_DRAIN = false, MIDK = false;
    bf16_t* O; int ldc; const float* rowscale; float sc;
    __device__ __forceinline__ void operator()(const f32x4 (&acc)[2][2][4][2], const Unit& u, int wr, int wc, int fr, int fq) const {
        const int row0 = u.lm * BM + wr * 64 + fr, col0 = u.ln * BM + wc * 32 + 8 * fq;
#pragma unroll
        for (int ai = 0; ai < 2; ++ai)
#pragma unroll
            for (int m = 0; m < 4; ++m) { const int row = row0 + ai * HALF + m * 16; const float rs = (rowscale ? rowscale[row] : 1.f) * sc;
#pragma unroll
                for (int bj = 0; bj < 2; ++bj) { f32x4 v0 = acc[ai][bj][m][0] * rs, v1 = acc[ai][bj][m][1] * rs;
                    if (ACT == 2) {
#pragma unroll
                        for (int e = 0; e < 4; ++e) { v0[e] = sigmoid_f(v0[e]); v1[e] = sigmoid_f(v1[e]); } }
                    *(u32x4*)(O + (size_t)row * ldc + col0 + bj * HALF) = pack8(v0, v1); } }
    }
};
struct EpiMerge {
    static constexpr bool PERM = true, AFTER_DRAIN = false, MIDK = false;
    bf16_t* O; const bf16_t* SZ; const bf16_t* T1;
    __device__ __forceinline__ void operator()(const f32x4 (&acc)[2][2][4][2], const Unit& u, int wr, int wc, int fr, int fq) const {
        const int row0 = u.lm * BM + wr * 64 + fr, col0 = u.ln * BM + wc * 32 + 8 * fq;
#pragma unroll
        for (int ai = 0; ai < 2; ++ai)
#pragma unroll
            for (int m = 0; m < 4; ++m) { const int row = row0 + ai * HALF + m * 16;
#pragma unroll
                for (int bj = 0; bj < 2; ++bj) { const int col = col0 + bj * HALF;
                    const u32x4 g = *(const u32x4*)(SZ + (size_t)row * 2048 + col), z = *(const u32x4*)(SZ + (size_t)row * 2048 + 1024 + col), t = *(const u32x4*)(T1 + (size_t)row * 1024 + col);
                    const f32x4 a0 = acc[ai][bj][m][0], a1 = acc[ai][bj][m][1]; f32x4 v0, v1;
                    v0[0] = bflo(g.x) * bflo(t.x) + bflo(z.x) * a0[0]; v0[1] = bfhi(g.x) * bfhi(t.x) + bfhi(z.x) * a0[1];
                    v0[2] = bflo(g.y) * bflo(t.y) + bflo(z.y) * a0[2]; v0[3] = bfhi(g.y) * bfhi(t.y) + bfhi(z.y) * a0[3];
                    v1[0] = bflo(g.z) * bflo(t.z) + bflo(z.z) * a1[0]; v1[1] = bfhi(g.z) * bfhi(t.z) + bfhi(z.z) * a1[1];
                    v1[2] = bflo(g.w) * bflo(t.w) + bflo(z.w) * a1[2]; v1[3] = bfhi(g.w) * bfhi(t.w) + bfhi(z.w) * a1[3];
                    *(u32x4*)(O + (size_t)row * 1024 + col) = pack8(v0, v1); } }
    }
};
struct EpiResF32 {
    static constexpr bool PERM = false, AFTER_DRAIN = false, MIDK = false;
    const float* base; float* out;
    __device__ __forceinline__ void operator()(const f32x4 (&acc)[2][2][4][2], const Unit& u, int wr, int wc, int fr, int fq) const {
        const int row0 = u.lm * BM + wr * 64 + fr, col0 = u.ln * BM + wc * 32 + 4 * fq;
#pragma unroll
        for (int ai = 0; ai < 2; ++ai)
#pragma unroll
            for (int m = 0; m < 4; ++m) { const size_t off = (size_t)(row0 + ai * HALF + m * 16) * 1024 + col0;
#pragma unroll
                for (int bj = 0; bj < 2; ++bj)
#pragma unroll
                    for (int n = 0; n < 2; ++n) { const f32x4 b = *(const f32x4*)(base + off + bj * HALF + n * 16); *(f32x4*)(out + off + bj * HALF + n * 16) = b + acc[ai][bj][m][n]; } }
    }
};
template <bool SPLIT> struct EpiResNorm {
    static constexpr bool PERM = true, AFTER_DRAIN = false, MIDK = false;
    const float* base; float* out; bf16_t* H; bf16_t* L; float* SS;
    __device__ __forceinline__ void operator()(const f32x4 (&acc)[2][2][4][2], const Unit& u, int wr, int wc, int fr, int fq) const {
        const int row0 = u.lm * BM + wr * 64 + fr, col0 = u.ln * BM + wc * 32 + 8 * fq;
#pragma unroll
        for (int ai = 0; ai < 2; ++ai)
#pragma unroll
            for (int m = 0; m < 4; ++m) { const int row = row0 + ai * HALF + m * 16; const size_t off = (size_t)row * 1024 + col0; float ss = 0.f;
#pragma unroll
                for (int bj = 0; bj < 2; ++bj) { const f32x4 v0 = *(const f32x4*)(base + off + bj * HALF) + acc[ai][bj][m][0], v1 = *(const f32x4*)(base + off + bj * HALF + 4) + acc[ai][bj][m][1];
                    *(f32x4*)(out + off + bj * HALF) = v0; *(f32x4*)(out + off + bj * HALF + 4) = v1;
                    ss += (v0[0] * v0[0] + v0[1] * v0[1]) + (v0[2] * v0[2] + v0[3] * v0[3]) + (v1[0] * v1[0] + v1[1] * v1[1]) + (v1[2] * v1[2] + v1[3] * v1[3]);
                    const u32x4 h = pack8(v0, v1); *(u32x4*)(H + off + bj * HALF) = h;
                    if (SPLIT) { f32x4 r0, r1; r0[0] = v0[0] - bflo(h.x); r0[1] = v0[1] - bfhi(h.x); r0[2] = v0[2] - bflo(h.y); r0[3] = v0[3] - bfhi(h.y); r1[0] = v1[0] - bflo(h.z); r1[1] = v1[1] - bfhi(h.z); r1[2] = v1[2] - bflo(h.w); r1[3] = v1[3] - bfhi(h.w);
                        *(u32x4*)(L + off + bj * HALF) = pack8(r0, r1); } }
                ss += __shfl_xor(ss, 16); ss += __shfl_xor(ss, 32);
                if (fq == 0) SS[(size_t)row * 16 + u.ln * 4 + wc] = ss; }
    }
};
struct EpiLogits {
    static constexpr bool PERM = false, AFTER_DRAIN = false, MIDK = false;
    float* LG; int ld, ncols;
    __device__ __forceinline__ void operator()(const f32x4 (&acc)[2][2][4][2], const Unit& u, int wr, int wc, int fr, int fq) const {
        const int row0 = u.lm * BM + wr * 64 + fr, col0 = wc * 32 + 4 * fq;
#pragma unroll
        for (int ai = 0; ai < 2; ++ai)
#pragma unroll
            for (int m = 0; m < 4; ++m) { float* o = LG + (size_t)(row0 + ai * HALF + m * 16) * ld;
#pragma unroll
                for (int n = 0; n < 2; ++n) { const int col = col0 + n * 16; if (col < ncols) *(f32x4*)(o + col) = acc[ai][0][m][n]; } }
    }
};
struct EpiMoe1 {
    static constexpr bool PERM = true, AFTER_DRAIN = false, MIDK = false;
    bf16_t* HID; const float* rstd_slot;
    __device__ __forceinline__ void operator()(const f32x4 (&acc)[2][2][4][2], const Unit& u, int wr, int wc, int fr, int fq) const {
        const int row0 = u.lm * BM + wr * 64 + fr, col0 = u.ln * 128 + wc * 32 + 8 * fq;
#pragma unroll
        for (int ai = 0; ai < 2; ++ai)
#pragma unroll
            for (int m = 0; m < 4; ++m) { const int row = row0 + ai * HALF + m * 16; const float rs = rstd_slot[row];
                f32x4 v0, v1;
#pragma unroll
                for (int e = 0; e < 4; ++e) { v0[e] = silu_f(acc[ai][0][m][0][e] * rs) * (acc[ai][1][m][0][e] * rs); v1[e] = silu_f(acc[ai][0][m][1][e] * rs) * (acc[ai][1][m][1][e] * rs); }
                *(u32x4*)(HID + (size_t)row * 512 + col0) = pack8(v0, v1); }
    }
};
struct EpiMoe2 {
    static constexpr bool PERM = true, AFTER_DRAIN = false, MIDK = false;
    bf16_t* Y; const float* w_slot;
    __device__ __forceinline__ void operator()(const f32x4 (&acc)[2][2][4][2], const Unit& u, int wr, int wc, int fr, int fq) const {
        const int row0 = u.lm * BM + wr * 64 + fr, col0 = u.ln * BM + wc * 32 + 8 * fq;
#pragma unroll
        for (int ai = 0; ai < 2; ++ai)
#pragma unroll
            for (int m = 0; m < 4; ++m) { const int row = row0 + ai * HALF + m * 16; const float rs = w_slot[row];
#pragma unroll
                for (int bj = 0; bj < 2; ++bj) *(u32x4*)(Y + (size_t)row * 1024 + col0 + bj * HALF) = pack8(acc[ai][bj][m][0] * rs, acc[ai][bj][m][1] * rs); }
    }
};
struct EpiP1 {
    static constexpr bool PERM = true, AFTER_DRAIN = false, MIDK = false;
    EpiInProj e0; EpiVT e1; EpiRowBf16<0> e2, e3;
    __device__ __forceinline__ void operator()(const f32x4 (&acc)[2][2][4][2], const Unit& u, int wr, int wc, int fr, int fq) const {
        if (u.ty == 0) e0(acc, u, wr, wc, fr, fq); else if (u.ty == 1) e1(acc, u, wr, wc, fr, fq); else if (u.ty == 2) e2(acc, u, wr, wc, fr, fq); else e3(acc, u, wr, wc, fr, fq);
    }
};
struct EpiMerge2 {
    static constexpr bool PERM = true, AFTER_DRAIN = false, MIDK = true;
    bf16_t* O; const bf16_t* SZ;
    __device__ __forceinline__ void mid(f32x4 (&acc)[2][2][4][2], const Unit& u, int wr, int wc, int fr, int fq) const {
        const int row0 = u.lm * BM + wr * 64 + fr, col0 = u.ln * BM + wc * 32 + 8 * fq;
#pragma unroll
        for (int ai = 0; ai < 2; ++ai)
#pragma unroll
            for (int m = 0; m < 4; ++m) { const int row = row0 + ai * HALF + m * 16;
#pragma unroll
                for (int bj = 0; bj < 2; ++bj) { const int col = col0 + bj * HALF; const u32x4 g = *(const u32x4*)(SZ + (size_t)row * 2048 + col), z = *(const u32x4*)(SZ + (size_t)row * 2048 + 1024 + col);
                    f32x4 r0, r1;
                    r0[0] = bflo(g.x) * __builtin_amdgcn_rcpf(fmaxf(bflo(z.x), 1e-30f)); r0[1] = bfhi(g.x) * __builtin_amdgcn_rcpf(fmaxf(bfhi(z.x), 1e-30f)); r0[2] = bflo(g.y) * __builtin_amdgcn_rcpf(fmaxf(bflo(z.y), 1e-30f)); r0[3] = bfhi(g.y) * __builtin_amdgcn_rcpf(fmaxf(bfhi(z.y), 1e-30f));
                    r1[0] = bflo(g.z) * __builtin_amdgcn_rcpf(fmaxf(bflo(z.z), 1e-30f)); r1[1] = bfhi(g.z) * __builtin_amdgcn_rcpf(fmaxf(bfhi(z.z), 1e-30f)); r1[2] = bflo(g.w) * __builtin_amdgcn_rcpf(fmaxf(bflo(z.w), 1e-30f)); r1[3] = bfhi(g.w) * __builtin_amdgcn_rcpf(fmaxf(bfhi(z.w), 1e-30f));
                    acc[ai][bj][m][0] = acc[ai][bj][m][0] * r0; acc[ai][bj][m][1] = acc[ai][bj][m][1] * r1; } }
    }
    __device__ __forceinline__ void operator()(const f32x4 (&acc)[2][2][4][2], const Unit& u, int wr, int wc, int fr, int fq) const {
        const int row0 = u.lm * BM + wr * 64 + fr, col0 = u.ln * BM + wc * 32 + 8 * fq;
#pragma unroll
        for (int ai = 0; ai < 2; ++ai)
#pragma unroll
            for (int m = 0; m < 4; ++m) { const int row = row0 + ai * HALF + m * 16;
#pragma unroll
                for (int bj = 0; bj < 2; ++bj) { const int col = col0 + bj * HALF; const u32x4 z = *(const u32x4*)(SZ + (size_t)row * 2048 + 1024 + col);
                    f32x4 v0 = acc[ai][bj][m][0], v1 = acc[ai][bj][m][1];
                    v0[0] *= bflo(z.x); v0[1] *= bfhi(z.x); v0[2] *= bflo(z.y); v0[3] *= bfhi(z.y); v1[0] *= bflo(z.z); v1[1] *= bfhi(z.z); v1[2] *= bflo(z.w); v1[3] *= bfhi(z.w);
                    *(u32x4*)(O + (size_t)row * 1024 + col) = pack8(v0, v1); } }
    }
};
template <bool BASE_F32> struct EpiResSplit {
    static constexpr bool PERM = true, AFTER_DRAIN = false, MIDK = false;
    const float* basef; const bf16_t* baseH; const bf16_t* baseL; bf16_t* H; bf16_t* L; float* SS;
    __device__ __forceinline__ void operator()(const f32x4 (&acc)[2][2][4][2], const Unit& u, int wr, int wc, int fr, int fq) const {
        const int row0 = u.lm * BM + wr * 64 + fr, col0 = u.ln * BM + wc * 32 + 8 * fq;
#pragma unroll
        for (int ai = 0; ai < 2; ++ai)
#pragma unroll
            for (int m = 0; m < 4; ++m) { const int row = row0 + ai * HALF + m * 16; const size_t off = (size_t)row * 1024 + col0; float ss = 0.f;
#pragma unroll
                for (int bj = 0; bj < 2; ++bj) { f32x4 v0, v1;
                    if (BASE_F32) { v0 = *(const f32x4*)(basef + off + bj * HALF); v1 = *(const f32x4*)(basef + off + bj * HALF + 4); }
                    else { const u32x4 bh = *(const u32x4*)(baseH + off + bj * HALF), bl = *(const u32x4*)(baseL + off + bj * HALF);
                        v0[0] = bflo(bh.x) + bflo(bl.x); v0[1] = bfhi(bh.x) + bfhi(bl.x); v0[2] = bflo(bh.y) + bflo(bl.y); v0[3] = bfhi(bh.y) + bfhi(bl.y); v1[0] = bflo(bh.z) + bflo(bl.z); v1[1] = bfhi(bh.z) + bfhi(bl.z); v1[2] = bflo(bh.w) + bflo(bl.w); v1[3] = bfhi(bh.w) + bfhi(bl.w); }
                    v0 = v0 + acc[ai][bj][m][0]; v1 = v1 + acc[ai][bj][m][1];
                    ss += (v0[0] * v0[0] + v0[1] * v0[1]) + (v0[2] * v0[2] + v0[3] * v0[3]) + (v1[0] * v1[0] + v1[1] * v1[1]) + (v1[2] * v1[2] + v1[3] * v1[3]);
                    const u32x4 h = pack8(v0, v1); *(u32x4*)(H + off + bj * HALF) = h;
                    f32x4 r0, r1; r0[0] = v0[0] - bflo(h.x); r0[1] = v0[1] - bfhi(h.x); r0[2] = v0[2] - bflo(h.y); r0[3] = v0[3] - bfhi(h.y); r1[0] = v1[0] - bflo(h.z); r1[1] = v1[1] - bfhi(h.z); r1[2] = v1[2] - bflo(h.w); r1[3] = v1[3] - bfhi(h.w);
                    *(u32x4*)(L + off + bj * HALF) = pack8(r0, r1); }
                ss += __shfl_xor(ss, 16); ss += __shfl_xor(ss, 32);
                if (fq == 0) SS[(size_t)row * 16 + u.ln * 4 + wc] = ss; }
    }
};
template <int NM0, int NN0, int A00, int B00, int NM1, int NN1, int A01, int B01, int NM2, int NN2, int A02, int B02, int NM3, int NN3, int A03, int B03>
struct MultiOrder {
    static constexpr bool GATHER = false;
    int G, c;
    __device__ __forceinline__ bool next(int i, Unit& u) const {
        constexpr int C0 = NM0 * NN0, C1 = NM1 * NN1, C2 = NM2 * NN2, C3 = NM3 * NN3;
        long L = (long)i * G + c; int s, nwg, nNs, nMs, a0s, b0s;
        if (L < C0) { s = 0; nwg = C0; nNs = NN0; nMs = NM0; a0s = A00; b0s = B00; }
        else if (L < C0 + C1) { L -= C0; s = 1; nwg = C1; nNs = NN1; nMs = NM1; a0s = A01; b0s = B01; }
        else if (L < C0 + C1 + C2) { L -= C0 + C1; s = 2; nwg = C2; nNs = NN2; nMs = NM2; a0s = A02; b0s = B02; }
        else if (L < C0 + C1 + C2 + C3) { L -= C0 + C1 + C2; s = 3; nwg = C3; nNs = NN3; nMs = NM3; a0s = A03; b0s = B03; }
        else return false;
        int wgid = (int)L; { const int q = nwg / NXCD, r = nwg % NXCD, xcd = wgid % NXCD, off = wgid / NXCD; wgid = (xcd < r ? xcd * (q + 1) : r * (q + 1) + (xcd - r) * q) + off; }
        const int nig = WGM * nNs, gid = wgid / nig, fm = gid * WGM, gsz = (nMs - fm) < WGM ? (nMs - fm) : WGM;
        u.lm = fm + ((wgid % nig) % gsz); u.ln = (wgid % nig) / gsz; u.pm = a0s + u.lm; u.pn = b0s + u.ln; u.ty = s; return true;
    }
    __device__ __forceinline__ void a_ready(const Unit&) const {}
    __device__ __forceinline__ void done(const Unit&) const {}
};
struct MoeOrder {
    static constexpr bool GATHER = false;
    const PG8_LAS int* tile_e; int ntile, G, c;
    __device__ __forceinline__ bool next(int i, Unit& u) const {
        const long L = (long)i * G + c; if (L >= (long)ntile * 4) return false;
        const int pm = (int)(L >> 2), j = (int)(L & 3); u.pm = pm; u.pn = __builtin_amdgcn_readfirstlane(tile_e[pm]) * 4 + j; u.lm = pm; u.ln = j; u.ty = 0; return true;
    }
    __device__ __forceinline__ void a_ready(const Unit&) const {}
    __device__ __forceinline__ void done(const Unit&) const {}
};
struct MoeGatherOrder {
    static constexpr bool GATHER = true;
    const PG8_LAS int* tile_e; const PG8_LAS int* rows; int ntile, G, c;
    __device__ __forceinline__ bool next(int i, Unit& u) const {
        const long L = (long)i * G + c; if (L >= (long)ntile * 4) return false;
        const int pm = (int)(L >> 2), j = (int)(L & 3); u.pm = pm; u.pn = __builtin_amdgcn_readfirstlane(tile_e[pm]) * 4 + j; u.lm = pm; u.ln = j; u.ty = 0; return true;
    }
    __device__ __forceinline__ int row(int ui, int r) const { return rows[ui * 256 + r]; }
    __device__ __forceinline__ void a_ready(const Unit&) const {}
    __device__ __forceinline__ void done(const Unit&) const {}
};
#ifndef PROBE_ACC
#define PROBE_ACC -1
#endif
#ifndef PROBE_N
#define PROBE_N 0
#endif
#define PG8_PB(id) do { if ((id) == PROBE_ACC && (PROBE_N == 0 || g.N == PROBE_N)) g_t0 = __builtin_amdgcn_s_memrealtime(); } while (0)
#define PG8_PE(id) do { if ((id) == PROBE_ACC && (PROBE_N == 0 || g.N == PROBE_N) && wid == 0 && lane == 0) { const unsigned d_ = (unsigned)(__builtin_amdgcn_s_memrealtime() - g_t0); __hip_atomic_fetch_add((PG8_LAS unsigned*)(lds + 147776 + 4 * 16), d_, __ATOMIC_RELAXED, __HIP_MEMORY_SCOPE_WORKGROUP); } } while (0)
template <class Epi, class Sched, bool ALIGN_EPI = false, bool SP2 = false>
__device__ __forceinline__ void gemm_phase(PG8_LAS unsigned char* lds, const Gemm g, const Sched& S, const Epi& E) {
    const int tid = threadIdx.x, wid = __builtin_amdgcn_readfirstlane(tid >> 6), lane = tid & 63, wr = wid >> 2, wc = wid & 3, fr = lane & 15, fq = lane >> 4;
    const int K = g.K, nt = K / BK; unsigned long long g_t0 = 0; (void)g_t0; PG8_PB(42);
    unsigned voffA[2], voffB[2];
#pragma unroll
    for (int i = 0; i < 2; ++i) { int R, C; stage_rc(tid * 16 + i * 8192, R, C); const int Rb = Epi::PERM ? ((R & ~31) + perm32(R & 31)) : R;
        voffA[i] = (unsigned)(R * K + C) * 2u; voffB[i] = (unsigned)(Rb * K + C) * 2u; }
    static_assert(!Sched::GATHER || SP2, "gathered A rows: SP2 loop only");
    unsigned gA[2][2], gN[2][2];
#define PG8_GOFF(dst, ui_) do { _Pragma("unroll") for (int _h = 0; _h < 2; ++_h) _Pragma("unroll") for (int _i = 0; _i < 2; ++_i) { int _R, _C; stage_rc(tid * 16 + _i * 8192, _R, _C); dst[_h][_i] = (unsigned)(S.row((ui_), _h * HALF + _R) * K + _C) * 2u; } } while (0)
#define PG8_STAGE_A(bufoff, gbase, hh, un_) do { if constexpr (Sched::GATHER) { unsigned _vo[2] = {(un_) ? gN[hh][0] : gA[hh][0], (un_) ? gN[hh][1] : gA[hh][1]}; PG8_STAGE(bufoff, gbase, _vo); } else { PG8_STAGE(bufoff, (gbase) + ((hh) ? hstep : 0), voffA); } } while (0)
    const size_t kstep = (size_t)(BK * 2);
    const size_t hstep = (size_t)HALF * K * 2;
    const size_t tstep = 2 * hstep;
    const unsigned ldsw = (unsigned)wid * 1024u;
    const int aoff = lds_byte(wr * 64 + fr, fq * 8), boff = lds_byte(wc * 32 + fr, fq * 8);
#define PG8_SA(b, h) (((b) * 2 + (h)) * HTB)
#define PG8_SB(b, h) ((4 + (b) * 2 + (h)) * HTB)
#define PG8_STAGE(bufoff, gbase, voff) do { _Pragma("unroll") for (int _i = 0; _i < 2; ++_i) \
        __builtin_amdgcn_global_load_lds((const unsigned*)((const char*)(gbase) + (voff)[_i]), (PG8_LAS unsigned*)(lds + (bufoff) + ldsw + _i * 8192), 16, 0, 0); } while (0)
#define PG8_LDA(dst, b, h) do { _Pragma("unroll") for (int m = 0; m < 4; ++m) _Pragma("unroll") for (int k = 0; k < 2; ++k) dst[m][k] = *(const PG8_LAS bf16x8*)(lds + PG8_SA(b, h) + aoff + m * 2048 + k * 1024); } while (0)
#define PG8_LDB(dst, b, h) do { _Pragma("unroll") for (int n = 0; n < 2; ++n) _Pragma("unroll") for (int k = 0; k < 2; ++k) dst[n][k] = *(const PG8_LAS bf16x8*)(lds + PG8_SB(b, h) + boff + n * 2048 + k * 1024); } while (0)
#define PG8_MMA(ai, bj, At, Bt) do { __builtin_amdgcn_s_setprio(1); _Pragma("unroll") for (int m = 0; m < 4; ++m) _Pragma("unroll") for (int n = 0; n < 2; ++n) _Pragma("unroll") for (int k = 0; k < 2; ++k) \
        acc[ai][bj][m][n] = __builtin_amdgcn_mfma_f32_16x16x32_bf16(Bt[n][k], At[m][k], acc[ai][bj][m][n], 0, 0, 0); __builtin_amdgcn_s_setprio(0); } while (0)
#define PG8_WAIT_V(n) asm volatile("s_waitcnt vmcnt(" #n ")" ::: "memory")
#define PG8_WAIT_L(n) asm volatile("s_waitcnt lgkmcnt(" #n ")" ::: "memory")
#define PG8_BAR __builtin_amdgcn_s_barrier()
#define PG8_SCHED __builtin_amdgcn_sched_barrier(0)
    Unit cur, nxt; int ui = 0;
    if (!S.next(0, cur)) return;
    f32x4 acc[2][2][4][2];
#pragma unroll
    for (int a = 0; a < 2; ++a)
#pragma unroll
        for (int b = 0; b < 2; ++b)
#pragma unroll
            for (int m = 0; m < 4; ++m)
#pragma unroll
                for (int n = 0; n < 2; ++n) acc[a][b][m][n] = (f32x4){0.f, 0.f, 0.f, 0.f};
    bf16x8 At[4][2], B0[2][2], B1[2][2];
    const char* cA = (const char*)g.A + (Sched::GATHER ? (size_t)0 : (size_t)cur.pm * tstep); const char* cB = (const char*)g.Bt + (size_t)cur.pn * tstep;
    if constexpr (Sched::GATHER) { PG8_GOFF(gA, 0); }
    S.a_ready(cur);
    if constexpr (SP2) {
        PG8_STAGE(PG8_SB(0, 0), cB, voffB); PG8_STAGE(PG8_SB(0, 1), cB + hstep, voffB); PG8_STAGE_A(PG8_SA(0, 0), cA, 0, false); PG8_STAGE_A(PG8_SA(0, 1), cA, 1, false);
        if (wr == 1) PG8_BAR;
        PG8_WAIT_V(2); PG8_BAR;
        PG8_STAGE(PG8_SB(1, 0), cB + kstep, voffB); PG8_STAGE_A(PG8_SA(1, 0), cA + kstep, 0, false); PG8_STAGE(PG8_SB(1, 1), cB + hstep + kstep, voffB);
        PG8_WAIT_V(6); PG8_BAR;
    } else {
        PG8_STAGE(PG8_SB(0, 0), cB, voffB); PG8_STAGE(PG8_SA(0, 0), cA, voffA); PG8_STAGE(PG8_SB(0, 1), cB + hstep, voffB); PG8_STAGE(PG8_SA(0, 1), cA + hstep, voffA);
        if (wr == 1) PG8_BAR;
        PG8_WAIT_V(4); PG8_BAR;
        PG8_STAGE(PG8_SB(1, 0), cB + kstep, voffB); PG8_STAGE(PG8_SA(1, 0), cA + kstep, voffA); PG8_STAGE(PG8_SB(1, 1), cB + hstep + kstep, voffB);
        PG8_WAIT_V(6); PG8_BAR;
    }
    PG8_PE(42);
    for (;;) {
        const bool has_next = S.next(ui + 1, nxt); PG8_PB(40);
        if constexpr (Sched::GATHER) { if (has_next) PG8_GOFF(gN, ui + 1); }
        const char* nA = (has_next && !Sched::GATHER) ? (const char*)g.A + (size_t)nxt.pm * tstep : cA; const char* nB = has_next ? (const char*)g.Bt + (size_t)nxt.pn * tstep : cB;
        for (int t = 0; t < nt; t += 2) {
            if constexpr (Epi::MIDK) { if (t == (nt >> 1)) { int t_ = threadIdx.x; asm volatile("" : "+v"(t_)); const int l_ = t_ & 63, w_ = __builtin_amdgcn_readfirstlane(t_ >> 6); E.mid(acc, cur, w_ >> 2, w_ & 3, l_ & 15, l_ >> 4); } }
            const bool last = (t == nt - 2); const bool un = last && has_next;
            const char* a1 = cA + (size_t)(t + 1) * kstep;
            const char* a2 = last ? nA : cA + (size_t)(t + 2) * kstep; const char* b2 = last ? nB : cB + (size_t)(t + 2) * kstep;
            const char* a3 = a2 + kstep; const char* b3 = b2 + kstep;
            if (last && has_next) S.a_ready(nxt);
            if constexpr (SP2) {
            PG8_LDB(B0, 0, 0); PG8_LDB(B1, 0, 1); PG8_SCHED; PG8_LDA(At, 0, 0); PG8_STAGE_A(PG8_SA(1, 1), a1, 1, false);
            PG8_WAIT_V(8); PG8_WAIT_L(0); PG8_BAR; PG8_MMA(0, 0, At, B0); PG8_MMA(0, 1, At, B1); PG8_BAR; PG8_SCHED;
            PG8_LDA(At, 0, 1); PG8_STAGE(PG8_SB(0, 0), b2, voffB); PG8_STAGE(PG8_SB(0, 1), b2 + hstep, voffB); PG8_STAGE_A(PG8_SA(0, 0), a2, 0, un);
            PG8_WAIT_V(8); PG8_WAIT_L(0); PG8_BAR; PG8_MMA(1, 0, At, B0); PG8_MMA(1, 1, At, B1); PG8_BAR; PG8_SCHED;
            PG8_LDB(B0, 1, 0); PG8_LDB(B1, 1, 1); PG8_SCHED; PG8_LDA(At, 1, 0); PG8_STAGE_A(PG8_SA(0, 1), a2, 1, un);
            PG8_WAIT_V(8); PG8_WAIT_L(0); PG8_BAR; PG8_MMA(0, 0, At, B0); PG8_MMA(0, 1, At, B1); PG8_BAR; PG8_SCHED;
            PG8_LDA(At, 1, 1); PG8_STAGE(PG8_SB(1, 0), b3, voffB); PG8_STAGE(PG8_SB(1, 1), b3 + hstep, voffB); PG8_STAGE_A(PG8_SA(1, 0), a3, 0, un);
            PG8_WAIT_V(8); PG8_WAIT_L(0); PG8_BAR; PG8_MMA(1, 0, At, B0); PG8_MMA(1, 1, At, B1); PG8_BAR; PG8_SCHED;
            } else {
            PG8_LDB(B0, 0, 0); PG8_SCHED; PG8_LDA(At, 0, 0); PG8_STAGE(PG8_SA(1, 1), a1 + hstep, voffA);
            PG8_WAIT_L(8); PG8_BAR; PG8_WAIT_L(0); PG8_MMA(0, 0, At, B0); PG8_BAR; PG8_SCHED;
            PG8_LDB(B1, 0, 1); PG8_STAGE(PG8_SB(0, 0), b2, voffB);
            PG8_BAR; PG8_WAIT_L(0); PG8_MMA(0, 1, At, B1); PG8_BAR;
            PG8_LDA(At, 0, 1); PG8_STAGE(PG8_SA(0, 0), a2, voffA);
            PG8_BAR; PG8_WAIT_L(0); PG8_MMA(1, 0, At, B0); PG8_BAR; PG8_SCHED;
            PG8_STAGE(PG8_SB(0, 1), b2 + hstep, voffB);
            PG8_WAIT_V(6); PG8_BAR; PG8_MMA(1, 1, At, B1); PG8_BAR;
            PG8_LDB(B0, 1, 0); PG8_SCHED; PG8_LDA(At, 1, 0); PG8_STAGE(PG8_SA(0, 1), a2 + hstep, voffA);
            PG8_WAIT_L(8); PG8_BAR; PG8_WAIT_L(0); PG8_MMA(0, 0, At, B0); PG8_BAR; PG8_SCHED;
            PG8_LDB(B1, 1, 1); PG8_STAGE(PG8_SB(1, 0), b3, voffB);
            PG8_BAR; PG8_WAIT_L(0); PG8_MMA(0, 1, At, B1); PG8_BAR;
            PG8_LDA(At, 1, 1); PG8_STAGE(PG8_SA(1, 0), a3, voffA);
            PG8_BAR; PG8_WAIT_L(0); PG8_MMA(1, 0, At, B0); PG8_BAR; PG8_SCHED;
            PG8_STAGE(PG8_SB(1, 1), b3 + hstep, voffB);
            PG8_WAIT_V(6); PG8_BAR; PG8_MMA(1, 1, At, B1); PG8_BAR;
            }
        }
        PG8_PE(40); PG8_PB(41);
        if constexpr (ALIGN_EPI) { if (wr == 0) PG8_BAR; }
        if constexpr (!Epi::AFTER_DRAIN) { int t_ = threadIdx.x; asm volatile("" : "+v"(t_)); const int l_ = t_ & 63, w_ = __builtin_amdgcn_readfirstlane(t_ >> 6); E(acc, cur, w_ >> 2, w_ & 3, l_ & 15, l_ >> 4); S.done(cur); }
        PG8_PE(41);
        if (!has_next) break;
#pragma unroll
        for (int a = 0; a < 2; ++a)
#pragma unroll
            for (int b = 0; b < 2; ++b)
#pragma unroll
                for (int m = 0; m < 4; ++m)
#pragma unroll
                    for (int n = 0; n < 2; ++n) acc[a][b][m][n] = (f32x4){0.f, 0.f, 0.f, 0.f};
        cur = nxt; cA = nA; cB = nB; ++ui;
        if constexpr (Sched::GATHER) { _Pragma("unroll") for (int _h = 0; _h < 2; ++_h) _Pragma("unroll") for (int _i = 0; _i < 2; ++_i) gA[_h][_i] = gN[_h][_i]; }
        if constexpr (ALIGN_EPI) { if (wr == 1) PG8_BAR; }
    }
    PG8_PB(43);
    PG8_WAIT_V(0);
    if constexpr (!ALIGN_EPI) { if (wr == 0) PG8_BAR; }
    PG8_BAR;
    if constexpr (Epi::AFTER_DRAIN) { E.fused(acc, cur, wr, wc, fr, fq, lds, wid, lane); S.done(cur); }
    PG8_PE(43);
#undef PG8_SA
#undef PG8_SB
#undef PG8_STAGE
#undef PG8_STAGE_A
#undef PG8_GOFF
#undef PG8_LDA
#undef PG8_LDB
#undef PG8_MMA
#undef PG8_WAIT_V
#undef PG8_WAIT_L
#undef PG8_BAR
#undef PG8_SCHED
}
}
#define GAS __attribute__((address_space(1)))
#define LAS __attribute__((address_space(3)))
typedef unsigned short bf16;
typedef unsigned v4u __attribute__((ext_vector_type(4)));
typedef float f32x4 __attribute__((ext_vector_type(4)));
typedef short bf16x8 __attribute__((ext_vector_type(8)));
typedef GAS unsigned gu32;
typedef GAS unsigned long long gu64;
#define RLX_AGENT __ATOMIC_RELAXED, __HIP_MEMORY_SCOPE_AGENT
#define LDS_WAIT() asm volatile("s_waitcnt lgkmcnt(0)" ::: "memory")
#define VM_WAIT() asm volatile("s_waitcnt vmcnt(0)" ::: "memory")
__device__ __forceinline__ unsigned long long rt() { return __builtin_amdgcn_s_memrealtime(); }
__device__ __forceinline__ unsigned f2bf(float f) { unsigned u = __builtin_bit_cast(unsigned, f); return (u + 0x7fffu + ((u >> 16) & 1u)) >> 16; }
__device__ __forceinline__ unsigned pk2(float lo, float hi) { return f2bf(lo) | (f2bf(hi) << 16); }
#define XB_TMO      128
#define XB_XCNT(j)  (256  + 64 * (j))
#define XB_XSUB(j)  (1280 + 64 * (j))
#define XB_XGEN(j)  (2304 + 64 * (j))
#define XB_TOP      3328
#define XB_TOPGEN   3392
#define XCD_BAR_WORDS 3456
#define XB_SPIN_CAP (1u << 18)

__device__ __forceinline__ unsigned xb_ld(unsigned* p)              { return __hip_atomic_load(p, __ATOMIC_RELAXED, __HIP_MEMORY_SCOPE_AGENT); }
__device__ __forceinline__ unsigned xb_add(unsigned* p, unsigned v) { return __hip_atomic_fetch_add(p, v, __ATOMIC_RELAXED, __HIP_MEMORY_SCOPE_AGENT); }
__device__ __forceinline__ unsigned xb_xcc_id() { return (unsigned)__builtin_amdgcn_s_getreg((3 << 11) | 20) & 0xFu; }
#define XB_SPIN(cond, bar) do { unsigned _sp = 0; while (cond) { __builtin_amdgcn_s_sleep(1); \
    if ((++_sp & 255u) == 0u) { if (xb_ld(&(bar)[XB_TMO])) break; if (_sp > XB_SPIN_CAP) { atomicAdd(&(bar)[XB_TMO], 1u); break; } } } } while (0)

struct XcdBarrier {
    unsigned* bar; unsigned x;
    volatile LAS unsigned* st;
};

__device__ __forceinline__ XcdBarrier xcd_barrier_post(unsigned* bar, volatile LAS unsigned* st) {
    XcdBarrier b; b.bar = bar; b.x = xb_xcc_id(); b.st = st;
    if (threadIdx.x == 0) (void)xb_add(&bar[XB_XCNT(b.x)], 1u);
    return b;
}
__device__ __forceinline__ void xcd_barrier_complete(unsigned* bar, unsigned x, unsigned& nloc, unsigned& nx) {
    const unsigned G = gridDim.x * gridDim.y * gridDim.z;
    unsigned sum, cnt, mine, sp = 0u;
    for (;;) {
        sum = 0u; cnt = 0u; mine = 0u;
#pragma unroll
        for (unsigned j = 0; j < 16; ++j) { const unsigned c = xb_ld(&bar[XB_XCNT(j)]); sum += c; cnt += (c > 0u) ? 1u : 0u; mine = (j == x) ? c : mine; }
        if (sum == G) break;
        __builtin_amdgcn_s_sleep(1);
        if ((++sp & 255u) == 0u) { if (xb_ld(&bar[XB_TMO])) break; if (sp > XB_SPIN_CAP) { atomicAdd(&bar[XB_TMO], 1u); break; } }
    }
    nloc = mine > 0u ? mine : 1u; nx = cnt > 0u ? cnt : 1u;
}

__device__ __forceinline__ void xcd_barrier(const XcdBarrier& b) {
    asm volatile("s_waitcnt vmcnt(0)" ::: "memory");
    __syncthreads();
    if (threadIdx.x == 0) {
        unsigned* bar = b.bar;
        __builtin_amdgcn_s_waitcnt(0);
        unsigned nloc = b.st[0], nx = b.st[1];
        if (nloc == 0u) { xcd_barrier_complete(bar, b.x, nloc, nx); b.st[0] = nloc; b.st[1] = nx; }
        const unsigned old = xb_add(&bar[XB_XSUB(b.x)], 1u);
        const unsigned gen = old / nloc;
        if (old + 1u == (gen + 1u) * nloc) {
            __builtin_amdgcn_fence(__ATOMIC_RELEASE, "agent");
            asm volatile("s_waitcnt vmcnt(0)" ::: "memory");
            const unsigned og = xb_add(&bar[XB_TOP], 1u);
            const unsigned tg = og / nx;
            if (og + 1u == (tg + 1u) * nx) xb_add(&bar[XB_TOPGEN], 1u);
            else XB_SPIN(xb_ld(&bar[XB_TOPGEN]) == tg, bar);
            __builtin_amdgcn_fence(__ATOMIC_ACQUIRE, "agent");
            xb_add(&bar[XB_XGEN(b.x)], 1u);
            asm volatile("s_waitcnt vmcnt(0)" ::: "memory");
        } else {
            XB_SPIN(xb_ld(&bar[XB_XGEN(b.x)]) == gen, bar);
            __builtin_amdgcn_fence(__ATOMIC_ACQUIRE, "agent");
            asm volatile("s_waitcnt vmcnt(0)" ::: "memory");
        }
    }
    __syncthreads();
}

constexpr int NWAVES = 8, NTHR = 512;
constexpr int M = 32768, D = 1024, SEQ = 8192, NB = 4;
constexpr int DIN = 5136;
constexpr int MOE_CAP_TILES = 288, MOE_CAP = MOE_CAP_TILES * 256;
constexpr int LIST_CAP = 256 * 496;
constexpr float EPS = 1e-6f;
#ifndef MK_ONE_LAUNCH
#define MK_ONE_LAUNCH 0
#endif
constexpr int NPHASE = 20;

constexpr size_t MiB = 1u << 20, KiB = 1u << 10;
constexpr size_t WS_CTL = 0, CTL_ZERO_BYTES = 1 * MiB;
constexpr int CW_TMO = 0, CW_CODE = 1, CW_BAR = 4096, CW_LCNT = 16384, CW_ECNT = 20480, CW_WQ = 24576;
constexpr size_t WS_RSTD0 = 1 * MiB, WS_RSTD1 = WS_RSTD0 + 128 * KiB, WS_RSTD2 = WS_RSTD1 + 128 * KiB;
constexpr size_t WS_DEC = 1 * MiB + 512 * KiB;
constexpr size_t WS_KMEAN = 2 * MiB, WS_KNMAX = 2 * MiB + 256 * KiB;
constexpr size_t WS_MOE_E = 2 * MiB + 512 * KiB, WS_MOE_POS = WS_MOE_E + 256 * KiB, WS_MOE_W = WS_MOE_POS + 256 * KiB, WS_SLOT_OF = WS_MOE_W + 256 * KiB;
constexpr size_t WS_W_SLOT = 4 * MiB, WS_RSTD_SLOT = 4 * MiB + 512 * KiB, WS_TILE_E = 5 * MiB;
constexpr size_t WS_MEMN = 6 * MiB, WS_MKV = 8 * MiB;
constexpr size_t WS_W1T = 10 * MiB  , WS_WVT = WS_W1T + 8704 * KiB, WS_PGMT = WS_WVT + 2 * MiB  , WS_WOUTT = WS_PGMT + 2 * MiB,
                 WS_WCQT = WS_WOUTT + 2 * MiB, WS_WCKVT = WS_WCQT + 1 * MiB, WS_WCOT = WS_WCKVT + 2 * MiB, WS_WRT = WS_WCOT + 1 * MiB;
static_assert(WS_WRT + 1 * MiB <= 30 * MiB, "weights");
constexpr size_t WS_XB = 30 * MiB, WS_QG = 94 * MiB, WS_KG = 110 * MiB, WS_SR = 126 * MiB, WS_QM = 158 * MiB, WS_KM = 190 * MiB, WS_VT = 222 * MiB, WS_OGM = 286 * MiB  , WS_SZ = 350 * MiB;
constexpr size_t WS_LISTS = 478 * MiB, WS_REFS = 494 * MiB, WS_SEL = 495 * MiB, WS_PARTL = 496 * MiB;
constexpr size_t WS_MG = 30 * MiB, WS_X1H = 94 * MiB, WS_X1L = 158 * MiB, WS_QC = 476 * MiB, WS_SS2 = 508 * MiB, WS_SS1 = 510 * MiB;
constexpr size_t WS_X2H = 222 * MiB, WS_X2L = 286 * MiB;
constexpr size_t WS_WGUT = 30 * MiB, WS_WDT = 350 * MiB, WS_LG = 454 * MiB, WS_LG2 = 464 * MiB, WS_HID = 382 * MiB, WS_XG = 30 * MiB  ;
constexpr size_t WS_END = 512 * MiB;
static_assert(WS_XG + 144 * MiB <= WS_X2H && WS_WDT + 32 * MiB <= WS_HID && WS_HID + 72 * MiB <= WS_LG && WS_LG2 + 5 * MiB <= WS_QC && WS_PARTL + 3 * MiB <= WS_END && WS_SS1 + 2 * MiB <= WS_END, "map");
constexpr size_t DO_ST = 0, DO_LA = 64 * MiB, DO_SB = 96 * MiB, DO_PARTO = 0;
constexpr size_t WS_TOK = 5 * MiB + 64 * KiB;
constexpr size_t WS_EMID = 5 * MiB + 512 * KiB;

constexpr int RING_OFF = 0, RING_BYTES = 147456;
constexpr int LDSCTL_OFF = RING_BYTES, MISC_OFF = LDSCTL_OFF + 320;
constexpr int TBL_TILE = RING_BYTES + 1024, TBL_TAB = TBL_TILE + 1280, TBL_BC = TBL_TAB + 512, TBL_EB = TBL_BC + 64;
constexpr int TBL_ROWS = 155648;
constexpr int LDS_BYTES = 163840;
static_assert(TBL_EB + 256 + 1088 * 4 <= TBL_ROWS && TBL_ROWS + 6 * 1024 <= LDS_BYTES, "LDS tables");
static_assert(TBL_EB + 256 + 1088 * 4 <= LDS_BYTES, "LDS map");

struct Args { const float* in[25]; float* out; unsigned char* ws; int ph_lo, ph_hi; };
struct Frame {
    unsigned long long pacc, pt0;
    LAS unsigned char* lds; unsigned char* ldsg;
    volatile LAS unsigned* MISC; gu32* ctl;
    int vcu, G;
    unsigned char* ws; float* out;
};
template <class T> __device__ __forceinline__ T* uniform_ptr(T* p) { const unsigned long long v = (unsigned long long)p; const unsigned lo = __builtin_amdgcn_readfirstlane((unsigned)v), hi = __builtin_amdgcn_readfirstlane((unsigned)(v >> 32)); return (T*)(((unsigned long long)hi << 32) | lo); }
__device__ __forceinline__ float wave_sum(float v) {
#pragma unroll
    for (int o = 1; o < 64; o <<= 1) v += __shfl_xor(v, o);
    return v;
}
__device__ __forceinline__ float wave_max(float v) {
#pragma unroll
    for (int o = 1; o < 64; o <<= 1) v = fmaxf(v, __shfl_xor(v, o));
    return v;
}
__device__ __forceinline__ float bf2f(bf16 h) { return __uint_as_float(((unsigned)h) << 16); }
__device__ __forceinline__ float bflo(unsigned w) { return __uint_as_float(w << 16); }
__device__ __forceinline__ float bfhi(unsigned w) { return __uint_as_float(w & 0xffff0000u); }
__device__ __forceinline__ void unpack8(const v4u w, float* f) { f[0] = bflo(w.x); f[1] = bfhi(w.x); f[2] = bflo(w.y); f[3] = bfhi(w.y); f[4] = bflo(w.z); f[5] = bfhi(w.z); f[6] = bflo(w.w); f[7] = bfhi(w.w); }
__device__ __forceinline__ v4u pack8f(const float* f) { v4u w; w.x = pk2(f[0], f[1]); w.y = pk2(f[2], f[3]); w.z = pk2(f[4], f[5]); w.w = pk2(f[6], f[7]); return w; }
__device__ __forceinline__ int t5_bucket(int n) {
    if (n < 16) return n;
    int b = 16;
    b += (n >= 19) + (n >= 21) + (n >= 24) + (n >= 27) + (n >= 31) + (n >= 35) + (n >= 40) + (n >= 46) + (n >= 52) + (n >= 59) + (n >= 67) + (n >= 77) + (n >= 87) + (n >= 99) + (n >= 113);
    return b;
}

#ifndef PROBE_ACC
#define PROBE_ACC -1
#endif
#define PB(i) do { if ((i) == PROBE_ACC) F.pt0 = __builtin_amdgcn_s_memrealtime(); } while (0)
#define PE(i) do { if ((i) == PROBE_ACC) F.pacc += __builtin_amdgcn_s_memrealtime() - F.pt0; } while (0)
#define PHASE_IDS int tid = threadIdx.x; asm volatile("" : "+v"(tid)); const int lane = tid & 63; const int wave = __builtin_amdgcn_readfirstlane(tid >> 6); (void)lane; (void)wave
struct TrDesc { const float* src; const float* gain; bf16* dst; int ldw, K, k0; };
__device__ __forceinline__ void tr_load(const TrDesc& t, int lane, f32x4 (&v)[8]) {
#pragma unroll
    for (int i = 0; i < 8; ++i) { const int id = i * 64 + lane, kk = id >> 3, c4 = (id & 7) * 4; v[i] = *(const GAS f32x4*)(t.src + (size_t)(t.k0 + kk) * t.ldw + c4); }
}
__device__ __forceinline__ void tr_finish(const TrDesc& t, int lane, const f32x4 (&v)[8], LAS float* scr) {
#pragma unroll
    for (int i = 0; i < 8; ++i) { const int id = i * 64 + lane, kk = id >> 3, c4 = (id & 7) * 4; const float g = t.gain ? t.gain[t.k0 + kk] : 1.f; LAS float* p = scr + kk * 33 + c4; p[0] = v[i][0] * g; p[1] = v[i][1] * g; p[2] = v[i][2] * g; p[3] = v[i][3] * g; }
    LDS_WAIT(); asm volatile("" ::: "memory");
    const int c = lane & 7;
#pragma unroll
    for (int j = 0; j < 4; ++j) { const int n = (lane >> 3) + 8 * j; const LAS float* s2 = scr + (8 * c) * 33 + n;
        v4u o; o.x = pk2(s2[0 * 33], s2[1 * 33]); o.y = pk2(s2[2 * 33], s2[3 * 33]); o.z = pk2(s2[4 * 33], s2[5 * 33]); o.w = pk2(s2[6 * 33], s2[7 * 33]);
        *(GAS v4u*)(t.dst + (size_t)n * t.K + t.k0 + 8 * c) = o; }
    LDS_WAIT(); asm volatile("" ::: "memory");
}
__device__ __forceinline__ void tr_item_alpha(const float* w_in, const float* wau, const float* gain, bf16* dst, int k0, int n0, LAS float* scr, int lane) {
    const float* a = w_in + (size_t)(k0 + lane) * DIN + 1536; const f32x4 a0 = *(const GAS f32x4*)a, a1 = *(const GAS f32x4*)(a + 4), a2 = *(const GAS f32x4*)(a + 8), a3 = *(const GAS f32x4*)(a + 12);
    const float gk = gain[k0 + lane]; const float av[16] = {a0[0], a0[1], a0[2], a0[3], a1[0], a1[1], a1[2], a1[3], a2[0], a2[1], a2[2], a2[3], a3[0], a3[1], a3[2], a3[3]};
#pragma unroll 4
    for (int n = 0; n < 32; ++n) { float v = 0.f;
#pragma unroll
        for (int r = 0; r < 16; ++r) v += av[r] * wau[r * 256 + n0 + n];
        scr[lane * 33 + n] = v * gk; }
    LDS_WAIT(); asm volatile("" ::: "memory");
    const int c = lane & 7;
#pragma unroll
    for (int j = 0; j < 4; ++j) { const int n = (lane >> 3) + 8 * j; const LAS float* s = scr + (8 * c) * 33 + n;
        v4u o; o.x = pk2(s[0 * 33], s[1 * 33]); o.y = pk2(s[2 * 33], s[3 * 33]); o.z = pk2(s[4 * 33], s[5 * 33]); o.w = pk2(s[6 * 33], s[7 * 33]);
        *(GAS v4u*)(dst + (size_t)(n0 + n) * 1024 + k0 + 8 * c) = o; }
    LDS_WAIT(); asm volatile("" ::: "memory");
}
struct TrJob { int src, col0, ldw, gain, K  , ncols, drow; unsigned dst_off_kib; int kdst  , koff  ; };
__constant__ TrJob kJobs[15] = {
    {5, 0, DIN, 4, 1024, 256, 0, (unsigned)(WS_W1T / 1024), 1024, 0},
    {5, 256, DIN, 4, 1024, 256, 256, (unsigned)(WS_W1T / 1024), 1024, 0},
    {5, 1024, DIN, 4, 1024, 512, 512, (unsigned)(WS_W1T / 1024), 1024, 0},
    {5, 1552, DIN, 4, 1024, 512, 1280, (unsigned)(WS_W1T / 1024), 1024, 0},
    {5, 2064, DIN, 4, 1024, 512, 1792, (unsigned)(WS_W1T / 1024), 1024, 0},
    {5, 3088, DIN, 4, 1024, 1024, 2304, (unsigned)(WS_W1T / 1024), 1024, 0},
    {5, 4112, DIN, 4, 1024, 1024, 3328, (unsigned)(WS_W1T / 1024), 1024, 0},
    {5, 512, DIN, 4, 1024, 512, 0, (unsigned)(WS_WVT / 1024), 1024, 0},
    {5, 2576, DIN, 4, 1024, 512, 512, (unsigned)(WS_WVT / 1024), 1024, 0},
    {9, 0, 1024, -1, 512, 1024, 0, (unsigned)(WS_PGMT / 1024), 1024, 0},
    {10, 0, 1024, -1, 512, 1024, 0, (unsigned)(WS_PGMT / 1024), 1024, 512},
    {11, 0, 1024, -1, 1024, 1024, 0, (unsigned)(WS_WOUTT / 1024), 1024, 0},
    {13, 0, 512, 12, 1024, 512, 0, (unsigned)(WS_WCQT / 1024), 1024, 0},
    {14, 0, 1024, -1, 1024, 1024, 0, (unsigned)(WS_WCKVT / 1024), 1024, 0},
    {15, 0, 1024, -1, 512, 1024, 0, (unsigned)(WS_WCOT / 1024), 512, 0},
};

__device__ __forceinline__ void p0_prologue(Frame& F, const Args& A) {
    PHASE_IDS;
    LAS float* scr = (LAS float*)(F.lds + RING_OFF + wave * 16384);
    const int gw = F.vcu * NWAVES + wave, NGW = F.G * NWAVES;
    PB(20);
    int total = 0;
#pragma unroll 1
    for (int j = 0; j < 15; ++j) total += (kJobs[j].K / 64) * (kJobs[j].ncols / 32);
    const int alpha_items = 16 * 8;
#pragma unroll 1
    for (int it = gw; it < total + alpha_items; it += NGW) {
        if (it >= total) { const int r = it - total; tr_item_alpha(A.in[5], A.in[6], A.in[4], (bf16*)(F.ws + WS_W1T) + (size_t)1024 * 1024, (r >> 3) * 64, (r & 7) * 32, scr, lane); continue; }
        int r = it, j = 0;
#pragma unroll 1
        for (; j < 15; ++j) { const int n = (kJobs[j].K / 64) * (kJobs[j].ncols / 32); if (r < n) break; r -= n; }
        const TrJob jb = kJobs[j]; const int nblk = jb.ncols / 32, kb = r / nblk, nb = r % nblk;
        const TrDesc t{A.in[jb.src] + jb.col0 + nb * 32, jb.gain >= 0 ? A.in[jb.gain] : nullptr, (bf16*)(F.ws + (size_t)jb.dst_off_kib * 1024) + (size_t)(jb.drow + nb * 32) * jb.kdst + jb.koff, jb.ldw, jb.kdst, kb * 64};
        f32x4 v[8]; tr_load(t, lane, v); tr_finish(t, lane, v, scr);
    }
    PE(20); PB(21);
    { bf16* wrt = (bf16*)(F.ws + WS_WRT); const float* g = A.in[16]; const float* wg = A.in[17]; const float* we = A.in[19];
        for (int i = blockIdx.x * NTHR + tid; i < 2 * 256 * 1024; i += F.G * NTHR) { const int mat = i >> 18, o = (i >> 10) & 255, kk = i & 1023; unsigned v = 0;
            if (o < (mat ? 36 : 72)) { const int oo = o < 36 ? o : o - 36; const float w = g[kk] * (oo < 4 ? wg[kk * 4 + oo] : we[kk * 32 + oo - 4]); const unsigned hi = f2bf(w);
                v = o < 36 ? hi : f2bf(w - __uint_as_float(hi << 16)); }
            wrt[i] = (bf16)v; } }
    PE(21); PB(22);
    { const float* x = A.in[0]; bf16* xb = (bf16*)(F.ws + WS_XB); float* rstd0 = (float*)(F.ws + WS_RSTD0);
        int m = gw;
        if (m < M) { f32x4 v[4];
#pragma unroll
            for (int j = 0; j < 4; ++j) v[j] = ((const GAS f32x4*)(x + (size_t)m * D))[64 * j + lane];
#pragma unroll 1
            for (;;) { const int mn = m + NGW; const bool more = mn < M; f32x4 w[4];
                if (more) {
#pragma unroll
                    for (int j = 0; j < 4; ++j) w[j] = ((const GAS f32x4*)(x + (size_t)mn * D))[64 * j + lane]; }
                float s = 0.f;
#pragma unroll
                for (int j = 0; j < 4; ++j) s += (v[j].x * v[j].x + v[j].y * v[j].y) + (v[j].z * v[j].z + v[j].w * v[j].w);
                s = wave_sum(s); const float rs = rsqrtf(s * (1.f / D) + EPS);
                GAS unsigned long long* o8 = (GAS unsigned long long*)(xb + (size_t)m * D) + lane;
#pragma unroll
                for (int j = 0; j < 4; ++j) o8[64 * j] = (unsigned long long)pk2(v[j].x * rs, v[j].y * rs) | ((unsigned long long)pk2(v[j].z * rs, v[j].w * rs) << 32);
                if (!more) break;
                m = mn;
#pragma unroll
                for (int j = 0; j < 4; ++j) v[j] = w[j]; } } }
    PE(22); PB(23);
    { const float* mem = A.in[1]; const float* gm = A.in[2]; bf16* mn = (bf16*)(F.ws + WS_MEMN);
        for (int m = gw; m < 1024; m += NGW) { const GAS f32x4* xr = (const GAS f32x4*)(mem + (size_t)m * D) + lane; const GAS f32x4* gr = (const GAS f32x4*)gm + lane; f32x4 v[4]; float s = 0.f;
#pragma unroll
            for (int j = 0; j < 4; ++j) { v[j] = xr[64 * j]; s += (v[j].x * v[j].x + v[j].y * v[j].y) + (v[j].z * v[j].z + v[j].w * v[j].w); }
            s = wave_sum(s); const float rs = rsqrtf(s * (1.f / D) + EPS);
            GAS unsigned long long* o8 = (GAS unsigned long long*)(mn + (size_t)m * D) + lane;
#pragma unroll
            for (int j = 0; j < 4; ++j) { const f32x4 g = gr[64 * j]; o8[64 * j] = (unsigned long long)pk2(v[j].x * rs * g.x, v[j].y * rs * g.y) | ((unsigned long long)pk2(v[j].z * rs * g.z, v[j].w * rs * g.w) << 32); } } }
}
__device__ __forceinline__ TrDesc gu_item(const Args& A, unsigned char* ws, int it) {
    bf16* wgut = (bf16*)(ws + WS_WGUT); const int e = it >> 9, r = it & 511, up = r >> 8, rr = r & 255, kb = rr >> 4, nb = rr & 15, c0 = nb * 32;
    return TrDesc{A.in[up ? 22 : 21] + (size_t)e * 1024 * 512 + c0, A.in[16], wgut + ((size_t)e * 1024 + (c0 >> 7) * 256 + (c0 & 127) + up * 128) * 1024, 512, 1024, kb * 64};
}
__device__ __forceinline__ TrDesc dn_item(const Args& A, unsigned char* ws, int it) {
    bf16* wdt = (bf16*)(ws + WS_WDT); const int e = it >> 8, rr = it & 255, kb = rr >> 5, nb = rr & 31;
    return TrDesc{A.in[23] + (size_t)e * 512 * 1024 + nb * 32, nullptr, wdt + ((size_t)e * 1024 + nb * 32) * 512, 1024, 512, kb * 64};
}
__device__ __forceinline__ void expert_weights_gu(Frame& F, const Args& A) {
    PHASE_IDS;
    LAS float* scr = (LAS float*)(F.lds + RING_OFF + wave * 16384);
    const int gw = F.vcu * NWAVES + wave, NGW = F.G * NWAVES;
    int it = gw; if (it >= 16384) return;
    TrDesc cur = gu_item(A, F.ws, it); f32x4 v[8]; tr_load(cur, lane, v);
#pragma unroll 1
    for (;;) { const int nx = it + NGW; const bool more = nx < 16384;
        TrDesc nd = cur; f32x4 w[8];
        if (more) { nd = gu_item(A, F.ws, nx); tr_load(nd, lane, w); }
        tr_finish(cur, lane, v, scr);
        if (!more) break;
        cur = nd; it = nx;
#pragma unroll
        for (int i = 0; i < 8; ++i) v[i] = w[i]; }
}
__device__ __forceinline__ void expert_weights_dn(Frame& F, const Args& A, int li, int nl) {
    PHASE_IDS;
    if (li < 0) return;
    LAS float* scr = (LAS float*)(F.lds + RING_OFF + wave * 16384);
    const int gw = li * NWAVES + wave, NGW = nl * NWAVES;
    int it = gw; if (it >= 8192) return;
    TrDesc cur = dn_item(A, F.ws, it); f32x4 v[8]; tr_load(cur, lane, v);
#pragma unroll 1
    for (;;) { const int nx = it + NGW; const bool more = nx < 8192;
        TrDesc nd = cur; f32x4 w[8];
        if (more) { nd = dn_item(A, F.ws, nx); tr_load(nd, lane, w); }
        tr_finish(cur, lane, v, scr);
        if (!more) break;
        cur = nd; it = nx;
#pragma unroll
        for (int i = 0; i < 8; ++i) v[i] = w[i]; }
}

typedef short mb_bf16x8 __attribute__((ext_vector_type(8)));
typedef unsigned mb_u32x2 __attribute__((ext_vector_type(2)));
__device__ __forceinline__ unsigned mb_cvt_pk(float lo, float hi) { unsigned r; asm volatile("v_cvt_pk_bf16_f32 %0, %1, %2" : "=v"(r) : "v"(lo), "v"(hi)); return r; }
constexpr int GS = 65;
__device__ __forceinline__ void gla_load_b(Frame& F, int tid, const float* LA, int m0, int h, float* Bs) {
#pragma unroll 1
    for (int i = tid; i < 4096; i += NTHR) { const int c = i >> 6, d = i & 63; Bs[c * GS + d] = LA[(size_t)(m0 + c) * 256 + h * 64 + d]; }
    __syncthreads();
    if (tid < 64) { float s = 0.f;
#pragma unroll 8
        for (int c = 0; c < 64; ++c) { s += Bs[c * GS + tid]; Bs[c * GS + tid] = s; } }
    __syncthreads();
}
constexpr int GL_STR = 144;
__device__ __forceinline__ void gla_a_phase(Frame& F) {
    PHASE_IDS;
    LAS float* tot = (LAS float*)(F.lds + RING_OFF); LAS unsigned char* Kt = F.lds + RING_OFF + 2048;
    const float* LA = (const float*)((unsigned char*)F.out + DO_LA); float* ST = (float*)((unsigned char*)F.out + DO_ST);
    const bf16* KG = (const bf16*)(F.ws + WS_KG); const bf16* VT = (const bf16*)(F.ws + WS_VT); float* DEC = (float*)(F.ws + WS_DEC); float* EMID = (float*)(F.ws + WS_EMID);
    const int d = tid & 63, seg = wave, lq = lane & 15, g = lane >> 4;
#pragma unroll 1
    for (int u = blockIdx.x; u < 2048; u += F.G) {
        const int bh = u >> 7, n = u & 127, b = bh >> 2, h = bh & 3, m0 = b * SEQ + n * 64;
        float a[8], kk[8];
#pragma unroll
        for (int i = 0; i < 8; ++i) { const size_t gi = (size_t)(m0 + seg * 8 + i) * 256 + h * 64 + d; a[i] = LA[gi]; kk[i] = bf2f(KG[gi]); }
#pragma unroll
        for (int i = 1; i < 8; ++i) a[i] += a[i - 1];
        tot[seg * 64 + d] = a[7];
        __syncthreads();
        float off = 0.f, total = 0.f;
#pragma unroll
        for (int s2 = 0; s2 < 8; ++s2) { const float t = tot[s2 * 64 + d]; if (s2 < seg) off += t; total += t; }
        { v4u w; float e[8];
#pragma unroll
            for (int i = 0; i < 8; ++i) e[i] = kk[i] * __expf(total - (off + a[i]));
            w.x = pk2(e[0], e[1]); w.y = pk2(e[2], e[3]); w.z = pk2(e[4], e[5]); w.w = pk2(e[6], e[7]);
            *(LAS v4u*)(Kt + d * GL_STR + seg * 16) = w; }
        if (seg == 0) { DEC[u * 64 + d] = __expf(total); EMID[u * 64 + d] = __expf((tot[d] + tot[64 + d]) + (tot[128 + d] + tot[192 + d])); }
        __syncthreads();
        { mb_bf16x8 bf[2];
#pragma unroll
            for (int ks = 0; ks < 2; ++ks) bf[ks] = *(const GAS mb_bf16x8*)(VT + (size_t)(h * 128 + wave * 16 + lq) * M + m0 + 32 * ks + 8 * g);
#pragma unroll
            for (int dt = 0; dt < 4; ++dt) { f32x4 acc = (f32x4){0.f, 0.f, 0.f, 0.f};
#pragma unroll
                for (int ks = 0; ks < 2; ++ks) { const mb_bf16x8 af = *(const LAS mb_bf16x8*)(Kt + (dt * 16 + lq) * GL_STR + ks * 64 + g * 16); acc = __builtin_amdgcn_mfma_f32_16x16x32_bf16(af, bf[ks], acc, 0, 0, 0); }
                *(GAS f32x4*)(ST + ((size_t)u * 128 + wave * 16 + lq) * 64 + dt * 16 + 4 * g) = acc; } }
        __syncthreads();
    }
}
__device__ __forceinline__ void gla_scan_phase(Frame& F) {
    PHASE_IDS;
    const float* ST = (const float*)((unsigned char*)F.out + DO_ST); bf16* SB = (bf16*)((unsigned char*)F.out + DO_SB); const float* DEC = (const float*)(F.ws + WS_DEC); const float* EMID = (const float*)(F.ws + WS_EMID);
#pragma unroll 1
    for (int g = blockIdx.x * NTHR + tid; g < 16 * 8192; g += F.G * NTHR) { const int bh = g >> 13, vd = g & 8191, d = vd & 63; float st = 0.f;
        const float* p = ST + (size_t)bh * 128 * 8192 + vd; bf16* q = SB + (size_t)bh * 128 * 8192 + vd; const float* dc = DEC + bh * 128 * 64 + d; const float* em = EMID + bh * 128 * 64 + d;
#pragma unroll 1
        for (int n0 = 0; n0 < 128; n0 += 16) { float kv[16], de[16], ee[16];
#pragma unroll
            for (int i = 0; i < 16; ++i) { kv[i] = p[(size_t)(n0 + i) * 8192]; de[i] = dc[(n0 + i) * 64]; ee[i] = em[(n0 + i) * 64]; }
#pragma unroll
            for (int i = 0; i < 16; ++i) { q[(size_t)(n0 + i) * 8192] = (bf16)f2bf(st * ee[i]); st = de[i] * st + kv[i]; } } }
}
constexpr int GB_TOT = 0, GB_QE = 2048, GB_KE = GB_QE + 64 * GL_STR, GB_VT = GB_KE + 64 * GL_STR, GB_SB = GB_VT + 128 * GL_STR, GB_UNIT = GB_SB + 128 * GL_STR;
static_assert(2 * GB_UNIT <= RING_BYTES && GB_UNIT % 16 == 0, "GLA-B LDS");
typedef float gb_f32x2 __attribute__((ext_vector_type(2)));
__device__ __forceinline__ void gla_b_phase(Frame& F, const Args& A) {
    PHASE_IDS;
    const float* LA = (const float*)((unsigned char*)F.out + DO_LA); const bf16* SB = (const bf16*)((unsigned char*)F.out + DO_SB);
    const bf16* QG = (const bf16*)(F.ws + WS_QG); const bf16* KG = (const bf16*)(F.ws + WS_KG); const bf16* VT = (const bf16*)(F.ws + WS_VT); const bf16* SR = (const bf16*)(F.ws + WS_SR);
    bf16* OG = (bf16*)(F.ws + WS_OGM); const float* gg = A.in[8];
    const int U = wave >> 2, lt = tid & 255, dp = lt & 31, seg = lt >> 5, lq = lane & 15, g = lane >> 4, ct = wave & 3;
    LAS unsigned char* base = F.lds + RING_OFF + U * GB_UNIT;
    LAS float* tot = (LAS float*)(base + GB_TOT); LAS unsigned char* Qe = base + GB_QE; LAS unsigned char* Ke = base + GB_KE; LAS unsigned char* Vt = base + GB_VT; LAS unsigned char* Sb = base + GB_SB;
    gb_f32x2 a[8]; unsigned q2[8], k2[8]; v4u vc[4], sc[4];
#define GB_LOAD(PR_) do { const int u_ = 2 * (PR_) + U, bh_ = u_ >> 7, n_ = u_ & 127, b_ = bh_ >> 2, h_ = bh_ & 3, m0_ = b_ * SEQ + n_ * 64; \
        _Pragma("unroll") for (int i = 0; i < 8; ++i) { const size_t gi = (size_t)(m0_ + seg * 8 + i) * 256 + h_ * 64 + 2 * dp; a[i] = *(const GAS gb_f32x2*)(LA + gi); q2[i] = *(const GAS unsigned*)(QG + gi); k2[i] = *(const GAS unsigned*)(KG + gi); } \
        _Pragma("unroll") for (int i = 0; i < 4; ++i) { const int ch = lt + i * 256, v = ch >> 3, c8 = ch & 7; vc[i] = *(const GAS v4u*)(VT + (size_t)(h_ * 128 + v) * M + m0_ + c8 * 8); sc[i] = *(const GAS v4u*)(SB + ((size_t)u_ * 128 + v) * 64 + c8 * 8); } } while (0)
    int pr = blockIdx.x;
    if (pr < 1024) GB_LOAD(pr);
#pragma unroll 1
    for (; pr < 1024; pr += F.G) {
        const int u = 2 * pr + U, bh = u >> 7, n = u & 127, b = bh >> 2, h = bh & 3, m0 = b * SEQ + n * 64;
#pragma unroll
        for (int i = 1; i < 8; ++i) a[i] += a[i - 1];
        *(LAS gb_f32x2*)(tot + seg * 64 + 2 * dp) = a[7];
#pragma unroll
        for (int i = 0; i < 4; ++i) { const int ch = lt + i * 256, v = ch >> 3, c8 = ch & 7; *(LAS v4u*)(Vt + v * GL_STR + c8 * 16) = vc[i]; *(LAS v4u*)(Sb + v * GL_STR + c8 * 16) = sc[i]; }
        __syncthreads();
        { gb_f32x2 off = (gb_f32x2){0.f, 0.f}, bmid = (gb_f32x2){0.f, 0.f};
#pragma unroll
            for (int s2 = 0; s2 < 7; ++s2) { const gb_f32x2 t = *(const LAS gb_f32x2*)(tot + s2 * 64 + 2 * dp); if (s2 < seg) off += t; if (s2 < 4) bmid += t; }
#pragma unroll
            for (int i = 0; i < 8; ++i) { const int c = seg * 8 + i; const gb_f32x2 bb = off + a[i];
                *(LAS unsigned*)(Qe + c * GL_STR + dp * 4) = mb_cvt_pk(bflo(q2[i]) * __expf(bb.x - bmid.x), bfhi(q2[i]) * __expf(bb.y - bmid.y));
                *(LAS unsigned*)(Ke + c * GL_STR + dp * 4) = mb_cvt_pk(bflo(k2[i]) * __expf(bmid.x - bb.x), bfhi(k2[i]) * __expf(bmid.y - bb.y)); } }
        __syncthreads();
        if (pr + F.G < 1024) GB_LOAD(pr + F.G);
        {
            const size_t mrow = (size_t)(m0 + ct * 16 + lq) * 512 + h * 128;
            mb_u32x2 srv[8];
#pragma unroll
            for (int vt = 0; vt < 8; ++vt) srv[vt] = *(const GAS mb_u32x2*)(SR + mrow + vt * 16 + 4 * g);
            mb_bf16x8 bq[2];
#pragma unroll
            for (int ks = 0; ks < 2; ++ks) bq[ks] = *(const LAS mb_bf16x8*)(Qe + (ct * 16 + lq) * GL_STR + ks * 64 + g * 16);
            f32x4 sa[4];
#pragma unroll
            for (int st = 0; st < 4; ++st) { sa[st] = (f32x4){0.f, 0.f, 0.f, 0.f};
                if (st <= ct) {
#pragma unroll
                    for (int ks = 0; ks < 2; ++ks) { const mb_bf16x8 af = *(const LAS mb_bf16x8*)(Ke + (st * 16 + lq) * GL_STR + ks * 64 + g * 16); sa[st] = __builtin_amdgcn_mfma_f32_16x16x32_bf16(af, bq[ks], sa[st], 0, 0, 0); }
                    if (st == ct) {
#pragma unroll
                        for (int r = 0; r < 4; ++r) if (4 * g + r > lq) sa[st][r] = 0.f; } } }
            mb_bf16x8 pb[2];
#pragma unroll
            for (int kp = 0; kp < 2; ++kp) { v4u pw; pw.x = mb_cvt_pk(sa[2 * kp][0], sa[2 * kp][1]); pw.y = mb_cvt_pk(sa[2 * kp][2], sa[2 * kp][3]); pw.z = mb_cvt_pk(sa[2 * kp + 1][0], sa[2 * kp + 1][1]); pw.w = mb_cvt_pk(sa[2 * kp + 1][2], sa[2 * kp + 1][3]); pb[kp] = __builtin_bit_cast(mb_bf16x8, pw); }
            f32x4 o[8]; float ss = 0.f;
#pragma unroll
            for (int vt = 0; vt < 8; ++vt) { o[vt] = (f32x4){0.f, 0.f, 0.f, 0.f};
#pragma unroll
                for (int kp = 0; kp < 2; ++kp) if (2 * kp <= ct) { const mb_u32x2 a0 = *(const LAS mb_u32x2*)(Vt + (vt * 16 + lq) * GL_STR + kp * 64 + g * 8), a1 = *(const LAS mb_u32x2*)(Vt + (vt * 16 + lq) * GL_STR + kp * 64 + 32 + g * 8);
                    v4u aw; aw.x = a0.x; aw.y = a0.y; aw.z = a1.x; aw.w = a1.y; o[vt] = __builtin_amdgcn_mfma_f32_16x16x32_bf16(__builtin_bit_cast(mb_bf16x8, aw), pb[kp], o[vt], 0, 0, 0); }
#pragma unroll
                for (int ks = 0; ks < 2; ++ks) { const mb_bf16x8 af = *(const LAS mb_bf16x8*)(Sb + (vt * 16 + lq) * GL_STR + ks * 64 + g * 16); o[vt] = __builtin_amdgcn_mfma_f32_16x16x32_bf16(af, bq[ks], o[vt], 0, 0, 0); }
                ss += (o[vt][0] * o[vt][0] + o[vt][1] * o[vt][1]) + (o[vt][2] * o[vt][2] + o[vt][3] * o[vt][3]); }
            ss += __shfl_xor(ss, 16); ss += __shfl_xor(ss, 32);
            const float rs = rsqrtf(ss * (1.f / 128.f) + EPS);
#pragma unroll
            for (int vt = 0; vt < 8; ++vt) { const int v = vt * 16 + 4 * g; const f32x4 gv = *(const GAS f32x4*)(gg + h * 128 + v); const mb_u32x2 sr = srv[vt];
                mb_u32x2 w; w.x = mb_cvt_pk(o[vt][0] * rs * gv[0] * bflo(sr.x), o[vt][1] * rs * gv[1] * bfhi(sr.x)); w.y = mb_cvt_pk(o[vt][2] * rs * gv[2] * bflo(sr.y), o[vt][3] * rs * gv[3] * bfhi(sr.y));
                *(GAS mb_u32x2*)(OG + (size_t)(m0 + ct * 16 + lq) * 1024 + h * 128 + v) = w; } }
        __syncthreads();
    }
#undef GB_LOAD
}

__device__ __forceinline__ int list_off(int j) { return 256 * (31 * j - (j * (j - 1)) / 2); }
__device__ __forceinline__ void moba_kmean_phase(Frame& F) {
    PHASE_IDS;
    float* lf = (float*)(F.ldsg + RING_OFF); float* part = lf; float* pmx = lf + 512;
    const bf16* KM = (const bf16*)(F.ws + WS_KM); float* kmean = (float*)(F.ws + WS_KMEAN); float* knmax = (float*)(F.ws + WS_KNMAX);
    const int c8 = tid & 7, r0 = tid >> 3;
#pragma unroll 1
    for (int u = blockIdx.x; u < 1024; u += F.G) { const int bh = u >> 5, j = u & 31, b = bh >> 3, h = bh & 7; const size_t m0 = (size_t)b * SEQ + j * 256;
        v4u w[4];
#pragma unroll
        for (int i = 0; i < 4; ++i) w[i] = *(const GAS v4u*)(KM + (m0 + r0 + 64 * i) * 512 + h * 64 + c8 * 8);
        float acc[8]; float mx = 0.f;
#pragma unroll
        for (int e = 0; e < 8; ++e) acc[e] = 0.f;
#pragma unroll
        for (int i = 0; i < 4; ++i) { float f[8]; unpack8(w[i], f); float q = 0.f;
#pragma unroll
            for (int e = 0; e < 8; ++e) { acc[e] += f[e]; q += f[e] * f[e]; }
            q += __shfl_xor(q, 1); q += __shfl_xor(q, 2); q += __shfl_xor(q, 4); mx = fmaxf(mx, q); }
#pragma unroll
        for (int e = 0; e < 8; ++e) { acc[e] += __shfl_xor(acc[e], 8); acc[e] += __shfl_xor(acc[e], 16); acc[e] += __shfl_xor(acc[e], 32); }
        mx = wave_max(mx);
        if (lane < 8) {
#pragma unroll
            for (int e = 0; e < 8; ++e) part[wave * 64 + lane * 8 + e] = acc[e]; }
        if (lane == 0) pmx[wave] = mx;
        __syncthreads();
        if (tid < 64) { float t = 0.f;
#pragma unroll
            for (int w2 = 0; w2 < 8; ++w2) t += part[w2 * 64 + tid];
            kmean[u * 64 + tid] = t * (1.f / 256.f); }
        if (tid == 0) { float t = 0.f;
#pragma unroll
            for (int w2 = 0; w2 < 8; ++w2) t = fmaxf(t, pmx[w2]);
            knmax[u] = sqrtf(t); }
        __syncthreads();
    }
}
__device__ __forceinline__ void moba_gate_phase(Frame& F, const Args& A) {
    PHASE_IDS;
    LAS unsigned char* kmh = F.lds + RING_OFF; LAS unsigned char* kml = kmh + 32 * 144;
    float* lf = (float*)(F.ldsg + RING_OFF + 2 * 32 * 144); float* knm = lf; unsigned* hist = (unsigned*)(lf + 32); unsigned* hbase = hist + 32;
    const bf16* QM = (const bf16*)(F.ws + WS_QM); const float* kmean = (const float*)(F.ws + WS_KMEAN); const float* knmax = (const float*)(F.ws + WS_KNMAX);
    unsigned* SEL = (unsigned*)(F.ws + WS_SEL); float* REFS = (float*)(F.ws + WS_REFS); unsigned* LISTS = (unsigned*)(F.ws + WS_LISTS); const float* rb = A.in[3];
    const int lq = lane & 15, g = lane >> 4;
#pragma unroll 1
    for (int u = blockIdx.x, kk = 0; u < 1024; u += F.G, ++kk) { const int bh = u >> 5, qx = (kk & 2) ? ((u & 31) + 16) & 31 : (u & 31), qb = (kk & 1) ? 31 - qx : qx, b = bh >> 3, h = bh & 7;
        { const int j = tid >> 4, c4 = (tid & 15) * 4; const f32x4 v = *(const GAS f32x4*)(kmean + bh * 2048 + j * 64 + c4);
            const unsigned h0 = f2bf(v[0]), h1 = f2bf(v[1]), h2 = f2bf(v[2]), h3 = f2bf(v[3]);
            *(LAS mb_u32x2*)(kmh + j * 144 + c4 * 2) = (mb_u32x2){h0 | (h1 << 16), h2 | (h3 << 16)};
            *(LAS mb_u32x2*)(kml + j * 144 + c4 * 2) = (mb_u32x2){pk2(v[0] - __uint_as_float(h0 << 16), v[1] - __uint_as_float(h1 << 16)), pk2(v[2] - __uint_as_float(h2 << 16), v[3] - __uint_as_float(h3 << 16))}; }
        if (tid < 32) { knm[tid] = knmax[bh * 32 + tid]; hist[tid] = 0u; }
        __syncthreads();
        float bmx = rb[h];
#pragma unroll 1
        for (int k = 1; k < 32; ++k) bmx = fmaxf(bmx, rb[k * 8 + h]);
        const int nsel = qb < 3 ? qb : 3;
        int sel0[2], sel1[2], sel2[2]; unsigned rk0[2], rk1[2], rk2[2];
#pragma unroll
        for (int qt = 0; qt < 2; ++qt) { const int qi = (wave * 2 + qt) * 16 + lq, t = qb * 256 + qi; const size_t m = (size_t)b * SEQ + t;
            mb_bf16x8 qf[2]; qf[0] = *(const GAS mb_bf16x8*)(QM + m * 512 + h * 64 + 8 * g); qf[1] = *(const GAS mb_bf16x8*)(QM + m * 512 + h * 64 + 32 + 8 * g);
            float qn = 0.f;
#pragma unroll
            for (int ks = 0; ks < 2; ++ks) { const v4u w = __builtin_bit_cast(v4u, qf[ks]); float f[8]; unpack8(w, f);
#pragma unroll
                for (int e = 0; e < 8; ++e) qn += f[e] * f[e]; }
            qn += __shfl_xor(qn, 16); qn += __shfl_xor(qn, 32); qn = sqrtf(qn);
            f32x4 sc[2];
#pragma unroll
            for (int jt = 0; jt < 2; ++jt) { sc[jt] = (f32x4){0.f, 0.f, 0.f, 0.f};
#pragma unroll
                for (int ks = 0; ks < 2; ++ks) { const mb_bf16x8 ah = *(const LAS mb_bf16x8*)(kmh + (jt * 16 + lq) * 144 + ks * 64 + g * 16), al = *(const LAS mb_bf16x8*)(kml + (jt * 16 + lq) * 144 + ks * 64 + g * 16);
                    sc[jt] = __builtin_amdgcn_mfma_f32_16x16x32_bf16(ah, qf[ks], sc[jt], 0, 0, 0); sc[jt] = __builtin_amdgcn_mfma_f32_16x16x32_bf16(al, qf[ks], sc[jt], 0, 0, 0); } }
            float v0 = -INFINITY, v1 = -INFINITY, v2 = -INFINITY; int i0 = 0, i1 = 0, i2 = 0;
#define TOP3_INS(G_, J_) do { const float g_ = (G_); const int j_ = (J_); if (g_ > v0) { v2 = v1; i2 = i1; v1 = v0; i1 = i0; v0 = g_; i0 = j_; } else if (g_ > v1) { v2 = v1; i2 = i1; v1 = g_; i1 = j_; } else if (g_ > v2) { v2 = g_; i2 = j_; } } while (0)
#pragma unroll
            for (int jt = 0; jt < 2; ++jt)
#pragma unroll
                for (int r = 0; r < 4; ++r) { const int j = jt * 16 + 4 * g + r; const float gv = j < qb ? sc[jt][r] : -INFINITY; TOP3_INS(gv, j); }
#pragma unroll
            for (int mk = 16; mk <= 32; mk <<= 1) { const float p0 = __shfl_xor(v0, mk), p1 = __shfl_xor(v1, mk), p2 = __shfl_xor(v2, mk); const int j0 = __shfl_xor(i0, mk), j1 = __shfl_xor(i1, mk), j2 = __shfl_xor(i2, mk);
                TOP3_INS(p0, j0); TOP3_INS(p1, j1); TOP3_INS(p2, j2); }
#undef TOP3_INS
            sel0[qt] = i0; sel1[qt] = i1; sel2[qt] = i2; rk0[qt] = 0; rk1[qt] = 0; rk2[qt] = 0;
            if (g == 0) {
                float kx = knm[qb]; if (nsel > 0) kx = fmaxf(kx, knm[i0]); if (nsel > 1) kx = fmaxf(kx, knm[i1]); if (nsel > 2) kx = fmaxf(kx, knm[i2]);
                SEL[m * 8 + h] = (unsigned)i0 | ((unsigned)i1 << 5) | ((unsigned)i2 << 10) | ((unsigned)nsel << 15);
                REFS[m * 8 + h] = qn * kx + bmx * 1.4426950408889634f;
                if (nsel > 0) rk0[qt] = __hip_atomic_fetch_add(hist + i0, 1u, __ATOMIC_RELAXED, __HIP_MEMORY_SCOPE_WORKGROUP);
                if (nsel > 1) rk1[qt] = __hip_atomic_fetch_add(hist + i1, 1u, __ATOMIC_RELAXED, __HIP_MEMORY_SCOPE_WORKGROUP);
                if (nsel > 2) rk2[qt] = __hip_atomic_fetch_add(hist + i2, 1u, __ATOMIC_RELAXED, __HIP_MEMORY_SCOPE_WORKGROUP); } }
        __syncthreads();
        if (tid < qb) { const unsigned c = hist[tid]; hbase[tid] = c ? atomicAdd((unsigned*)(F.ctl + CW_LCNT) + bh * 32 + tid, c) : 0u; }
        __syncthreads();
        if (g == 0) { unsigned* lb = LISTS + (size_t)bh * LIST_CAP;
#pragma unroll
            for (int qt = 0; qt < 2; ++qt) { const unsigned tq = (unsigned)(qb * 256 + (wave * 2 + qt) * 16 + lq);
                if (nsel > 0) lb[list_off(sel0[qt]) + hbase[sel0[qt]] + rk0[qt]] = (tq << 2);
                if (nsel > 1) lb[list_off(sel1[qt]) + hbase[sel1[qt]] + rk1[qt]] = (tq << 2) | 1u;
                if (nsel > 2) lb[list_off(sel2[qt]) + hbase[sel2[qt]] + rk2[qt]] = (tq << 2) | 2u; } }
        __syncthreads();
    }
}
constexpr size_t PARTO_N1 = 524288;
constexpr int MB_KSTR = 144, MB_VSTR = 528, MB_KBYTES = 256 * MB_KSTR, MB_VBYTES = 80 * MB_VSTR, MB_TABX = MB_KBYTES + MB_VBYTES, MB_TABN = 768;
static_assert(MB_TABX + MB_TABN * 4 <= RING_BYTES, "MoBA LDS");
__device__ __forceinline__ void moba_stage_const(int tid, LAS unsigned char* Vl) {
    for (int i = tid; i < 16 * 32; i += NTHR) { const int r = i >> 5, c = i & 31; const unsigned w = r == 0 ? 0x3f803f80u : 0u; *(LAS v4u*)(Vl + (64 + r) * MB_VSTR + c * 16) = (v4u){w, w, w, w}; }
}
struct MobaStage { v4u kv[4], vv[4]; float tb[2]; };
__device__ __forceinline__ void moba_kv_load(Frame& F, int tid, const Args& A, int b, int h, int j, MobaStage& st) {
    const bf16* KM = (const bf16*)(F.ws + WS_KM); const bf16* VT = (const bf16*)(F.ws + WS_VT);
    const size_t mk = (size_t)b * SEQ + j * 256;
#pragma unroll
    for (int i = 0; i < 4; ++i) { const int ch = tid + i * NTHR, key = ch >> 3, c = ch & 7; st.kv[i] = *(const GAS v4u*)(KM + (mk + key) * 512 + h * 64 + c * 8); }
#pragma unroll
    for (int i = 0; i < 4; ++i) { const int ch = tid + i * NTHR, d = ch >> 5, c = ch & 31; st.vv[i] = *(const GAS v4u*)(VT + (size_t)(512 + h * 64 + d) * M + mk + c * 8); }
#pragma unroll
    for (int i = 0; i < 2; ++i) { const int idx = tid + i * NTHR, dist = idx - 255; st.tb[i] = (idx < MB_TABN && dist >= 0) ? A.in[3][t5_bucket(dist < 127 ? dist : 127) * 8 + h] * 1.4426950408889634f : -INFINITY; }
}
__device__ __forceinline__ void moba_kv_store(int tid, const MobaStage& st, LAS unsigned char* Kl, LAS unsigned char* Vl, LAS float* tabx) {
#pragma unroll
    for (int i = 0; i < 4; ++i) { const int ch = tid + i * NTHR, key = ch >> 3, c = ch & 7; *(LAS v4u*)(Kl + key * MB_KSTR + c * 16) = st.kv[i]; }
#pragma unroll
    for (int i = 0; i < 4; ++i) { const int ch = tid + i * NTHR, d = ch >> 5, c = ch & 31; *(LAS v4u*)(Vl + d * MB_VSTR + c * 16) = st.vv[i]; }
#pragma unroll
    for (int i = 0; i < 2; ++i) { const int idx = tid + i * NTHR; if (idx < MB_TABN) tabx[idx] = st.tb[i]; }
}
__device__ __forceinline__ void moba_stage_kv(Frame& F, int tid, const Args& A, int b, int h, int j, LAS unsigned char* Kl, LAS unsigned char* Vl, LAS float* tabx) {
    MobaStage st; moba_kv_load(F, tid, A, b, h, j, st); moba_kv_store(tid, st, Kl, Vl, tabx);
}
template <int NG>
__device__ __forceinline__ void moba_groups(const LAS unsigned char* Kl, const LAS unsigned char* Vl, const LAS float* tabx, const mb_bf16x8 (&qf)[NG][2], const float (&ref)[NG], const int (&qrel)[NG],
                                            const int (&ntile)[NG], const bool (&far)[NG], f32x4 (&o)[NG][5], int lane) {
    const int lq = lane & 15, g = lane >> 4;
    int nmax = ntile[0];
#pragma unroll
    for (int gi = 1; gi < NG; ++gi) nmax = ntile[gi] > nmax ? ntile[gi] : nmax;
    const LAS unsigned char* kp = Kl + lq * MB_KSTR + g * 16;
    const LAS unsigned char* vp = Vl + lq * MB_VSTR + g * 8;
#pragma unroll
    for (int hf = 0; hf < 2; ++hf) { if (8 * hf < nmax) {
        f32x4 sa[NG][8];
#pragma unroll
        for (int gi = 0; gi < NG; ++gi) {
            if (far[gi]) { const float c = tabx[255 + 127] - ref[gi];
#pragma unroll
                for (int t = 0; t < 8; ++t) sa[gi][t] = (f32x4){c, c, c, c}; }
            else { const int qc = qrel[gi] < 511 ? qrel[gi] : 511; const LAS float* lb = tabx + (qc - 4 * g + 12);
#pragma unroll
                for (int t = 0; t < 8; ++t) { sa[gi][t] = (f32x4){0.f, 0.f, 0.f, 0.f};
                    if (8 * hf + t < ntile[gi]) {
#pragma unroll
                        for (int r = 0; r < 4; ++r) sa[gi][t][r] = lb[243 - 16 * (8 * hf + t) - r] - ref[gi]; } } } }
#pragma unroll
        for (int t = 0; t < 8; ++t) { const int T = 8 * hf + t; if (T < nmax) {
                const mb_bf16x8 k0 = *(const LAS mb_bf16x8*)(kp + T * 16 * MB_KSTR), k1 = *(const LAS mb_bf16x8*)(kp + T * 16 * MB_KSTR + 64);
#pragma unroll
                for (int gi = 0; gi < NG; ++gi) if (T < ntile[gi]) { sa[gi][t] = __builtin_amdgcn_mfma_f32_16x16x32_bf16(k0, qf[gi][0], sa[gi][t], 0, 0, 0); sa[gi][t] = __builtin_amdgcn_mfma_f32_16x16x32_bf16(k1, qf[gi][1], sa[gi][t], 0, 0, 0); } } }
#pragma unroll
        for (int gi = 0; gi < NG; ++gi)
#pragma unroll
            for (int t = 0; t < 8; ++t) { if (8 * hf + t < ntile[gi]) {
#pragma unroll
                    for (int r = 0; r < 4; ++r) sa[gi][t][r] = __builtin_amdgcn_exp2f(sa[gi][t][r]); } }
#pragma unroll
        for (int k2 = 0; k2 < 4; ++k2) { const int ks = 4 * hf + k2; if (2 * ks < nmax) {
                mb_bf16x8 pb[NG];
#pragma unroll
                for (int gi = 0; gi < NG; ++gi) { v4u pw; pw.x = mb_cvt_pk(sa[gi][2 * k2][0], sa[gi][2 * k2][1]); pw.y = mb_cvt_pk(sa[gi][2 * k2][2], sa[gi][2 * k2][3]); pw.z = mb_cvt_pk(sa[gi][2 * k2 + 1][0], sa[gi][2 * k2 + 1][1]); pw.w = mb_cvt_pk(sa[gi][2 * k2 + 1][2], sa[gi][2 * k2 + 1][3]); pb[gi] = __builtin_bit_cast(mb_bf16x8, pw); }
#pragma unroll
                for (int dt = 0; dt < 5; ++dt) { const mb_u32x2 a0 = *(const LAS mb_u32x2*)(vp + dt * 16 * MB_VSTR + ks * 64), a1 = *(const LAS mb_u32x2*)(vp + dt * 16 * MB_VSTR + ks * 64 + 32);
                    v4u aw; aw.x = a0.x; aw.y = a0.y; aw.z = a1.x; aw.w = a1.y; const mb_bf16x8 af = __builtin_bit_cast(mb_bf16x8, aw);
#pragma unroll
                    for (int gi = 0; gi < NG; ++gi) if (2 * ks < ntile[gi]) o[gi][dt] = __builtin_amdgcn_mfma_f32_16x16x32_bf16(af, pb[gi], o[gi][dt], 0, 0, 0); } } } } }
}
__device__ __forceinline__ void moba_part_phase(Frame& F, const Args& A, int wq_word) {
    PHASE_IDS;
    LAS unsigned char* Kl = F.lds + RING_OFF; LAS unsigned char* Vl = Kl + MB_KBYTES; LAS float* tabx = (LAS float*)(F.lds + RING_OFF + MB_TABX); volatile LAS int* bc = (volatile LAS int*)(F.lds + TBL_BC);
    const bf16* QM = (const bf16*)(F.ws + WS_QM); const float* REFS = (const float*)(F.ws + WS_REFS); const unsigned* LISTS = (const unsigned*)(F.ws + WS_LISTS);
    bf16* PARTO0 = (bf16*)((unsigned char*)F.out + DO_PARTO); bf16* PARTO1 = (bf16*)(F.ws + WS_XB); float* PARTL = (float*)(F.ws + WS_PARTL);
    const int lq = lane & 15, g = lane >> 4;
    moba_stage_const(tid, Vl);
#pragma unroll 1
    for (;;) {
        PB(5); PB(8);
        if (tid == 0) bc[0] = (int)atomicAdd((unsigned*)(F.ctl + wq_word), 1u);
        __syncthreads();
        const int u = __builtin_amdgcn_readfirstlane(bc[0]);
        __syncthreads();
        if (u >= 31 * 32) break;
        const int j = u >> 5, bh = u & 31, b = bh >> 3, h = bh & 7;
        const int n = __builtin_amdgcn_readfirstlane((int)__hip_atomic_load((unsigned*)(F.ctl + CW_LCNT) + bh * 32 + j, RLX_AGENT));
        moba_stage_kv(F, tid, A, b, h, j, Kl, Vl, tabx);
        __syncthreads(); PE(5); PB(6);
        const unsigned* lst = LISTS + (size_t)bh * LIST_CAP + list_off(j);
#define MB_IDX(G_) (((G_) * 16 + lq < n) ? (G_) * 16 + lq : (((G_) * 16 < n) ? (G_) * 16 : 0))
#define MB_LOADQ(E_, Q_, R_) do { const size_t m_ = (size_t)b * SEQ + ((E_) >> 2); const bf16* qrow_ = QM + m_ * 512 + h * 64; Q_[0] = *(const GAS mb_bf16x8*)(qrow_ + 8 * g); Q_[1] = *(const GAS mb_bf16x8*)(qrow_ + 32 + 8 * g); R_ = REFS[m_ * 8 + h]; } while (0)
        int pr = wave;
        if (pr * 32 < n) {
            unsigned ea[2];
            ea[0] = lst[MB_IDX(2 * pr)]; ea[1] = lst[MB_IDX(2 * pr + 1)];
#pragma unroll 1
            for (;;) {
                unsigned eb[2]; eb[0] = lst[MB_IDX(2 * pr + 2 * NWAVES)]; eb[1] = lst[MB_IDX(2 * pr + 2 * NWAVES + 1)];
                mb_bf16x8 qa[2][2]; float ra[2];
                MB_LOADQ(ea[0], qa[0], ra[0]); MB_LOADQ(ea[1], qa[1], ra[1]);
                int qrel[2], nt[2]; bool far[2];
#pragma unroll
                for (int gi = 0; gi < 2; ++gi) { qrel[gi] = (int)(ea[gi] >> 2) - j * 256; far[gi] = __all(qrel[gi] - 255 >= 113); nt[gi] = ((2 * pr + gi) * 16 < n) ? 16 : 0; }
                f32x4 o[2][5];
#pragma unroll
                for (int gi = 0; gi < 2; ++gi)
#pragma unroll
                    for (int dt = 0; dt < 5; ++dt) o[gi][dt] = (f32x4){0.f, 0.f, 0.f, 0.f};
                if (PROBE_ACC == 9 || PROBE_ACC == 10) asm volatile("s_waitcnt vmcnt(0)" ::: "memory"); PB(9); moba_groups<2>(Kl, Vl, tabx, qa, ra, qrel, nt, far, o, lane); PE(9);
#pragma unroll
                for (int gi = 0; gi < 2; ++gi) { if ((2 * pr + gi) * 16 + lq < n) { const size_t m = (size_t)b * SEQ + (ea[gi] >> 2); const size_t pi = (m * 8 + h) * 3 + (ea[gi] & 3u); if (g == 0) PARTL[pi] = o[gi][4][0];
#pragma unroll
                        for (int dt = 0; dt < 4; ++dt) { mb_u32x2 w; w.x = mb_cvt_pk(o[gi][dt][0], o[gi][dt][1]); w.y = mb_cvt_pk(o[gi][dt][2], o[gi][dt][3]); *(GAS mb_u32x2*)((pi < PARTO_N1 ? PARTO0 + pi * 64 : PARTO1 + (pi - PARTO_N1) * 64) + dt * 16 + g * 4) = w; } } }
                pr += NWAVES; if (pr * 32 >= n) break;
                ea[0] = eb[0]; ea[1] = eb[1];
            }
        }
#undef MB_IDX
        PE(6); PB(7);
        __syncthreads(); PE(7); PE(8);
    }
}
__device__ __forceinline__ void moba_own_phase(Frame& F, const Args& A, bf16* OUT) {
    PHASE_IDS;
    LAS unsigned char* Kl = F.lds + RING_OFF; LAS unsigned char* Vl = Kl + MB_KBYTES; LAS float* tabx = (LAS float*)(F.lds + RING_OFF + MB_TABX);
    const bf16* QM = (const bf16*)(F.ws + WS_QM); const float* REFS = (const float*)(F.ws + WS_REFS);
    const bf16* PARTO0 = (const bf16*)((unsigned char*)F.out + DO_PARTO); const bf16* PARTO1 = (const bf16*)(F.ws + WS_XB); const float* PARTL = (const float*)(F.ws + WS_PARTL);
    const int lq = lane & 15, g = lane >> 4;
    moba_stage_const(tid, Vl);
    MobaStage st;
    if ((int)blockIdx.x < 1024) { const int u0 = blockIdx.x, bh0 = u0 >> 5; moba_kv_load(F, tid, A, bh0 >> 3, bh0 & 7, u0 & 31, st); }
#pragma unroll 1
    for (int u = blockIdx.x; u < 1024; u += F.G) { const int bh = u >> 5, qb = u & 31, b = bh >> 3, h = bh & 7; const int nsel = qb < 3 ? qb : 3;
        PB(1); PB(4); moba_kv_store(tid, st, Kl, Vl, tabx);
        int grp[2] = {wave, 15 - wave}; size_t mq[2]; mb_bf16x8 qa[2][2]; float ra[2];
#pragma unroll
        for (int gi = 0; gi < 2; ++gi) { mq[gi] = (size_t)b * SEQ + qb * 256 + grp[gi] * 16 + lq; MB_LOADQ(((unsigned)(qb * 256 + grp[gi] * 16 + lq)) << 2, qa[gi], ra[gi]); }
        float pl[3]; mb_u32x2 po[3][4];
#pragma unroll
        for (int r = 0; r < 3; ++r) { pl[r] = 0.f;
#pragma unroll
            for (int dt = 0; dt < 4; ++dt) po[r][dt] = (mb_u32x2){0u, 0u};
            if (r < nsel) { const size_t pi = (mq[0] * 8 + h) * 3 + r; pl[r] = PARTL[pi];
#pragma unroll
                for (int dt = 0; dt < 4; ++dt) po[r][dt] = *(const GAS mb_u32x2*)((pi < PARTO_N1 ? PARTO0 + pi * 64 : PARTO1 + (pi - PARTO_N1) * 64) + dt * 16 + g * 4); } }
        __syncthreads(); PE(1); PB(2);
        if (u + F.G < 1024) { const int un = u + F.G, bhn = un >> 5; moba_kv_load(F, tid, A, bhn >> 3, bhn & 7, un & 31, st); }
        { int qrel[2], nt[2]; bool far[2];
#pragma unroll
            for (int gi = 0; gi < 2; ++gi) { qrel[gi] = grp[gi] * 16 + lq; nt[gi] = grp[gi] + 1; far[gi] = false; }
            f32x4 o[2][5];
#pragma unroll
            for (int gi = 0; gi < 2; ++gi)
#pragma unroll
                for (int dt = 0; dt < 5; ++dt) o[gi][dt] = (f32x4){0.f, 0.f, 0.f, 0.f};
            moba_groups<2>(Kl, Vl, tabx, qa, ra, qrel, nt, far, o, lane); PE(2); PB(3);
#pragma unroll
            for (int gi = 0; gi < 2; ++gi) { float l = __shfl(o[gi][4][0], lq);
#pragma unroll
                for (int r = 0; r < 3; ++r) {
                    if (gi == 0) { l += pl[r];
#pragma unroll
                        for (int dt = 0; dt < 4; ++dt) { o[gi][dt][0] += bflo(po[r][dt].x); o[gi][dt][1] += bfhi(po[r][dt].x); o[gi][dt][2] += bflo(po[r][dt].y); o[gi][dt][3] += bfhi(po[r][dt].y); } }
                    else if (r < nsel) { const size_t pi = (mq[gi] * 8 + h) * 3 + r; l += PARTL[pi];
#pragma unroll
                        for (int dt = 0; dt < 4; ++dt) { const mb_u32x2 w = *(const GAS mb_u32x2*)((pi < PARTO_N1 ? PARTO0 + pi * 64 : PARTO1 + (pi - PARTO_N1) * 64) + dt * 16 + g * 4); o[gi][dt][0] += bflo(w.x); o[gi][dt][1] += bfhi(w.x); o[gi][dt][2] += bflo(w.y); o[gi][dt][3] += bfhi(w.y); } } }
                const float il = 1.f / l;
#pragma unroll
                for (int dt = 0; dt < 4; ++dt) { mb_u32x2 w; w.x = mb_cvt_pk(o[gi][dt][0] * il, o[gi][dt][1] * il); w.y = mb_cvt_pk(o[gi][dt][2] * il, o[gi][dt][3] * il); *(GAS mb_u32x2*)(OUT + mq[gi] * 1024 + 512 + h * 64 + dt * 16 + g * 4) = w; } } }
        PE(3);
        __syncthreads(); PE(4);
    }
#undef MB_LOADQ
}
constexpr int MA_KSTR = 272, MA_VSTR = 528, MA_KBYTES = 256 * MA_KSTR, MA_VBYTES = 128 * MA_VSTR;
static_assert(MA_KBYTES + MA_VBYTES <= RING_BYTES, "mem-attn LDS");
__device__ __forceinline__ void memattn_phase(Frame& F, bf16* OUT) {
    PHASE_IDS;
    LAS unsigned char* Kl = F.lds + RING_OFF; LAS unsigned char* Vl = Kl + MA_KBYTES;
    bf16* QC = (bf16*)(F.ws + WS_QC); const float* SS1 = (const float*)(F.ws + WS_SS1); const bf16* MK = (const bf16*)(F.ws + WS_MKV); const bf16* MVT = MK + 1024 * 512;
    const int lq = lane & 15, g = lane >> 4;
    const int per = (512 + F.G - 1) / F.G; int staged = -1;
#pragma unroll 1
    for (int u = blockIdx.x * per; u < blockIdx.x * per + per && u < 512; ++u) { const int qt = u & 31, bhd = u >> 5, b = bhd >> 2, hd = bhd & 3;
        if (bhd != staged) { __syncthreads();
#pragma unroll
            for (int i = 0; i < 8; ++i) { const int ch = tid + i * NTHR, key = ch >> 4, c = ch & 15; *(LAS v4u*)(Kl + key * MA_KSTR + c * 16) = *(const GAS v4u*)(MK + (size_t)(b * 256 + key) * 512 + hd * 128 + c * 8); }
#pragma unroll
            for (int i = 0; i < 8; ++i) { const int ch = tid + i * NTHR, d = ch >> 5, c = ch & 31; *(LAS v4u*)(Vl + d * MA_VSTR + c * 16) = *(const GAS v4u*)(MVT + (size_t)(hd * 128 + d) * 1024 + b * 256 + c * 8); }
            staged = bhd; __syncthreads(); }
#pragma unroll 1
        for (int grp = wave; grp < 16; grp += NWAVES) {
            const size_t m = (size_t)b * SEQ + qt * 256 + grp * 16 + lq; bf16* qrow = QC + m * 512 + hd * 128;
            mb_bf16x8 qf[4];
#pragma unroll
            for (int s = 0; s < 4; ++s) qf[s] = *(const GAS mb_bf16x8*)(qrow + 32 * s + 8 * g);
            f32x4 sa[16]; const LAS unsigned char* kp = Kl + lq * MA_KSTR + g * 16;
#pragma unroll
            for (int t = 0; t < 16; ++t) { sa[t] = (f32x4){0.f, 0.f, 0.f, 0.f};
#pragma unroll
                for (int s = 0; s < 4; ++s) { const mb_bf16x8 kf = *(const LAS mb_bf16x8*)(kp + t * 16 * MA_KSTR + s * 64); sa[t] = __builtin_amdgcn_mfma_f32_16x16x32_bf16(kf, qf[s], sa[t], 0, 0, 0); } }
            { float ssum = 0.f;
#pragma unroll
                for (int i = 0; i < 4; ++i) { const f32x4 p = *(const GAS f32x4*)(SS1 + m * 16 + 4 * i); ssum += (p[0] + p[1]) + (p[2] + p[3]); }
                const float rs1 = rsqrtf(ssum * (1.f / D) + EPS);
#pragma unroll
                for (int t = 0; t < 16; ++t) sa[t] = sa[t] * rs1; }
            float mx = -INFINITY;
#pragma unroll
            for (int t = 0; t < 16; ++t) mx = fmaxf(fmaxf(mx, fmaxf(sa[t][0], sa[t][1])), fmaxf(sa[t][2], sa[t][3]));
            mx = fmaxf(mx, __shfl_xor(mx, 16)); mx = fmaxf(mx, __shfl_xor(mx, 32));
            float l = 0.f;
#pragma unroll
            for (int t = 0; t < 16; ++t)
#pragma unroll
                for (int r = 0; r < 4; ++r) { const float p = __expf(sa[t][r] - mx); sa[t][r] = p; l += p; }
            l += __shfl_xor(l, 16); l += __shfl_xor(l, 32);
            f32x4 o[8];
#pragma unroll
            for (int dt = 0; dt < 8; ++dt) o[dt] = (f32x4){0.f, 0.f, 0.f, 0.f};
            const LAS unsigned char* vp = Vl + lq * MA_VSTR + g * 8;
#pragma unroll
            for (int ks = 0; ks < 8; ++ks) {
                v4u pw; pw.x = mb_cvt_pk(sa[2 * ks][0], sa[2 * ks][1]); pw.y = mb_cvt_pk(sa[2 * ks][2], sa[2 * ks][3]); pw.z = mb_cvt_pk(sa[2 * ks + 1][0], sa[2 * ks + 1][1]); pw.w = mb_cvt_pk(sa[2 * ks + 1][2], sa[2 * ks + 1][3]);
                const mb_bf16x8 pb = __builtin_bit_cast(mb_bf16x8, pw);
#pragma unroll
                for (int dt = 0; dt < 8; ++dt) { const mb_u32x2 a0 = *(const LAS mb_u32x2*)(vp + dt * 16 * MA_VSTR + ks * 64), a1 = *(const LAS mb_u32x2*)(vp + dt * 16 * MA_VSTR + ks * 64 + 32);
                    v4u aw; aw.x = a0.x; aw.y = a0.y; aw.z = a1.x; aw.w = a1.y;
                    o[dt] = __builtin_amdgcn_mfma_f32_16x16x32_bf16(__builtin_bit_cast(mb_bf16x8, aw), pb, o[dt], 0, 0, 0); } }
            const float il = 1.f / l;
#pragma unroll
            for (int dt = 0; dt < 8; ++dt) { mb_u32x2 w; w.x = mb_cvt_pk(o[dt][0] * il, o[dt][1] * il); w.y = mb_cvt_pk(o[dt][2] * il, o[dt][3] * il); *(GAS mb_u32x2*)(OUT + m * 512 + hd * 128 + dt * 16 + g * 4) = w; }
        }
    }
    __syncthreads();
}

template <bool SPLIT> __device__ __forceinline__ void rownorm_phase(Frame& F, bf16* dst, float* rstd) {
    PHASE_IDS;
    const int gw = F.vcu * NWAVES + wave, NGW = F.G * NWAVES; constexpr int LD = SPLIT ? 2048 : 1024;
    for (int m = gw; m < M; m += NGW) { const GAS f32x4* xr = (const GAS f32x4*)(F.out + (size_t)m * D) + lane; f32x4 v[4]; float s = 0.f;
#pragma unroll
        for (int j = 0; j < 4; ++j) { v[j] = xr[64 * j]; s += (v[j].x * v[j].x + v[j].y * v[j].y) + (v[j].z * v[j].z + v[j].w * v[j].w); }
        s = wave_sum(s); if (lane == 0) rstd[m] = rsqrtf(s * (1.f / D) + EPS);
        GAS unsigned long long* o8 = (GAS unsigned long long*)(dst + (size_t)m * LD) + lane;
#pragma unroll
        for (int j = 0; j < 4; ++j) { const unsigned h0 = f2bf(v[j].x), h1 = f2bf(v[j].y), h2 = f2bf(v[j].z), h3 = f2bf(v[j].w);
            o8[64 * j] = (unsigned long long)(h0 | (h1 << 16)) | ((unsigned long long)(h2 | (h3 << 16)) << 32);
            if (SPLIT) o8[256 + 64 * j] = (unsigned long long)pk2(v[j].x - __uint_as_float(h0 << 16), v[j].y - __uint_as_float(h1 << 16)) | ((unsigned long long)pk2(v[j].z - __uint_as_float(h2 << 16), v[j].w - __uint_as_float(h3 << 16)) << 32); } }
}
constexpr int RCH = 128, NCH = M / RCH;
__device__ __forceinline__ void route_phase(Frame& F, const Args& A) {
    PHASE_IDS;
    const float* LG = (const float*)(F.ws + WS_LG); const float* LG2 = (const float*)(F.ws + WS_LG2); const float* SS2 = (const float*)(F.ws + WS_SS2); float* rstd2 = (float*)(F.ws + WS_RSTD2); const float* brg = A.in[18]; const float* bre = A.in[20];
    int* ME = (int*)(F.ws + WS_MOE_E); int* MP = (int*)(F.ws + WS_MOE_POS); float* MW = (float*)(F.ws + WS_MOE_W); unsigned* CNT = (unsigned*)(F.ws + WS_TILE_E);
    unsigned* hist = (unsigned*)(F.ldsg + RING_OFF);
#pragma unroll 1
    for (int ch = blockIdx.x; ch < NCH; ch += F.G) {
        if (tid < 32) hist[tid] = 0u;
        __syncthreads();
        if (tid < RCH) { const int m = ch * RCH + tid; float ssum = 0.f;
#pragma unroll
            for (int i = 0; i < 4; ++i) { const f32x4 p = *(const GAS f32x4*)(SS2 + (size_t)m * 16 + 4 * i); ssum += (p[0] + p[1]) + (p[2] + p[3]); }
            const float rs = rsqrtf(ssum * (1.f / D) + EPS); rstd2[m] = rs; const float* lg = LG + (size_t)m * 72; const float* lg2 = LG2 + (size_t)m * 36;
            float gl[4]; int grp = 0; float gmx = -INFINITY;
#pragma unroll
            for (int o = 0; o < 4; ++o) { gl[o] = (lg[o] + lg[36 + o] + lg2[o]) * rs + brg[o]; if (gl[o] > gmx) { gmx = gl[o]; grp = o; } }
            float gs = 0.f;
#pragma unroll
            for (int o = 0; o < 4; ++o) gs += __expf(gl[o] - gmx);
            const float pg = 1.f / gs;
            float el[8]; float emx = -INFINITY;
#pragma unroll
            for (int i = 0; i < 8; ++i) { el[i] = (lg[4 + grp * 8 + i] + lg[40 + grp * 8 + i] + lg2[4 + grp * 8 + i]) * rs + bre[grp * 8 + i]; emx = fmaxf(emx, el[i]); }
            float p0 = -1.f, p1 = -1.f; int i0 = 0, i1 = 0;
#pragma unroll
            for (int i = 0; i < 8; ++i) { const float p = __expf(el[i] - emx); if (p > p0) { p1 = p0; i1 = i0; p0 = p; i0 = i; } else if (p > p1) { p1 = p; i1 = i; } }
            const float inv = pg / (p0 + p1);
            const int e0 = grp * 8 + i0, e1 = grp * 8 + i1;
            const unsigned q0 = __hip_atomic_fetch_add(hist + e0, 1u, __ATOMIC_RELAXED, __HIP_MEMORY_SCOPE_WORKGROUP), q1 = __hip_atomic_fetch_add(hist + e1, 1u, __ATOMIC_RELAXED, __HIP_MEMORY_SCOPE_WORKGROUP);
            ME[m * 2] = e0; ME[m * 2 + 1] = e1; MP[m * 2] = (int)q0; MP[m * 2 + 1] = (int)q1; MW[m * 2] = p0 * inv; MW[m * 2 + 1] = p1 * inv; }
        __syncthreads();
        if (tid < 32) CNT[ch * 32 + tid] = hist[tid];
        __syncthreads();
    }
}
__device__ __forceinline__ int moe_bases(Frame& F, int mych) {
    PHASE_IDS;
    volatile int* eb = (volatile int*)(F.ldsg + TBL_EB); volatile int* tl = (volatile int*)(F.ldsg + TBL_TILE); volatile int* part = (volatile int*)(F.ldsg + TBL_EB + 256);
    const unsigned* CNT = (const unsigned*)(F.ws + WS_TILE_E);
    { const int e = tid & 31, pt = tid >> 5; int s = 0, sp = 0;
#pragma unroll 1
        for (int c = pt * (NCH / 16); c < (pt + 1) * (NCH / 16); ++c) { const int v = (int)CNT[c * 32 + e]; s += v; if (c < mych) sp += v; }
        part[pt * 32 + e] = s; part[512 + pt * 32 + e] = sp; }
    __syncthreads();
    if (tid < 32) { int s = 0, sp = 0;
#pragma unroll
        for (int p = 0; p < 16; ++p) { s += part[p * 32 + tid]; sp += part[512 + p * 32 + tid]; }
        part[1024 + tid] = s; part[1056 + tid] = sp; }
    __syncthreads();
    if (tid == 0) { int base = 0;
        for (int e = 0; e < 32; ++e) { const int c = part[1024 + e]; eb[e] = base; const int nt = (c + 255) >> 8; for (int t = 0; t < nt; ++t) tl[(base >> 8) + t] = e; base += nt << 8; }
        eb[32] = base; }
    __syncthreads();
    return eb[32] >> 8;
}
__device__ __forceinline__ void moe_slot_phase(Frame& F) {
    PHASE_IDS;
    volatile int* eb = (volatile int*)(F.ldsg + TBL_EB); volatile int* part = (volatile int*)(F.ldsg + TBL_EB + 256);
    const int* ME = (const int*)(F.ws + WS_MOE_E); const int* MP = (const int*)(F.ws + WS_MOE_POS); const float* MW = (const float*)(F.ws + WS_MOE_W); int* SO = (int*)(F.ws + WS_SLOT_OF);
    float* WSL = (float*)(F.ws + WS_W_SLOT); float* RSL = (float*)(F.ws + WS_RSTD_SLOT); const float* rstd2 = (const float*)(F.ws + WS_RSTD2); int* TOK = (int*)(F.ws + WS_TOK);
#pragma unroll 1
    for (int ch = blockIdx.x; ch < NCH; ch += F.G) {
        (void)moe_bases(F, ch);
        if (ch < 32) { const int e = ch; for (int sl = eb[e] + part[1024 + e] + tid; sl < eb[e + 1]; sl += NTHR) { TOK[sl] = 0; WSL[sl] = 0.f; RSL[sl] = 1.f; } }
        if (tid < RCH * 2) { const int a = ch * RCH * 2 + tid, m = a >> 1; const int e = ME[a]; const int slot = eb[e] + part[1056 + e] + MP[a];
            SO[a] = slot; WSL[slot] = MW[a]; RSL[slot] = rstd2[m]; TOK[slot] = m; }
        __syncthreads();
    }
}
__device__ __forceinline__ void final_phase(Frame& F, const Args& A) {
    PHASE_IDS;
    const int gw = F.vcu * NWAVES + wave, NGW = F.G * NWAVES; const int* SO = (const int*)(F.ws + WS_SLOT_OF); const bf16* Y = (const bf16*)(F.ws + WS_XG); const float* gf = A.in[24];
    const bf16* XH = (const bf16*)(F.ws + WS_X2H); const bf16* XL = (const bf16*)(F.ws + WS_X2L);
    f32x4 gv[4];
#pragma unroll
    for (int j = 0; j < 4; ++j) gv[j] = ((const GAS f32x4*)gf)[64 * j + lane];
    typedef unsigned long long u64;
    u64 ya[4], yb[4], xh[4];
#define FIN_LOAD(m_) do { const int s0_ = SO[(m_) * 2], s1_ = SO[(m_) * 2 + 1]; const GAS u64* y0_ = (const GAS u64*)(Y + (size_t)s0_ * 1024) + lane; const GAS u64* y1_ = (const GAS u64*)(Y + (size_t)s1_ * 1024) + lane; \
        const GAS u64* h_ = (const GAS u64*)(XH + (size_t)(m_) * 1024) + lane; \
        _Pragma("unroll") for (int j = 0; j < 4; ++j) { ya[j] = y0_[64 * j]; yb[j] = y1_[64 * j]; xh[j] = h_[64 * j]; } } while (0)
    int m = gw; if (m >= M) return;
    FIN_LOAD(m);
#pragma unroll 1
    for (;;) {
        f32x4 v[4]; float s = 0.f;
#pragma unroll
        for (int j = 0; j < 4; ++j) { const u64 a = ya[j], c = yb[j], hh = xh[j];
            v[j].x = bflo((unsigned)hh) + (bflo((unsigned)a) + bflo((unsigned)c)); v[j].y = bfhi((unsigned)hh) + (bfhi((unsigned)a) + bfhi((unsigned)c));
            v[j].z = bflo((unsigned)(hh >> 32)) + (bflo((unsigned)(a >> 32)) + bflo((unsigned)(c >> 32))); v[j].w = bfhi((unsigned)(hh >> 32)) + (bfhi((unsigned)(a >> 32)) + bfhi((unsigned)(c >> 32)));
            s += (v[j].x * v[j].x + v[j].y * v[j].y) + (v[j].z * v[j].z + v[j].w * v[j].w); }
        const int mn = m + NGW; const bool more = mn < M;
        if (more) FIN_LOAD(mn);
        s = wave_sum(s); const float rs = rsqrtf(s * (1.f / D) + EPS); GAS f32x4* xr = (GAS f32x4*)(F.out + (size_t)m * D) + lane;
#pragma unroll
        for (int j = 0; j < 4; ++j) xr[64 * j] = (f32x4){v[j].x * rs * gv[j].x, v[j].y * rs * gv[j].y, v[j].z * rs * gv[j].z, v[j].w * rs * gv[j].w};
        if (!more) break;
        m = mn;
    }
#undef FIN_LOAD
}

__global__ void __launch_bounds__(NWAVES * 64, 2) fwd_kernel(Args args) {
    extern __shared__ __attribute__((aligned(16))) unsigned char lds[];
    Frame F; F.pacc = 0; F.pt0 = 0;
    F.lds = (LAS unsigned char*)lds; F.ldsg = lds;
    F.MISC = (volatile LAS unsigned*)(F.lds + MISC_OFF);
    const int tid = threadIdx.x;
    F.G = gridDim.x; { const int bx = blockIdx.x; F.vcu = (F.G % 8 == 0) ? (bx % 8) * (F.G / 8) + bx / 8 : bx; }
    F.ws = uniform_ptr(args.ws); F.out = uniform_ptr(args.out); F.ctl = (gu32*)(F.ws + WS_CTL);
    for (int u = tid; u < (LDS_BYTES - LDSCTL_OFF) / 4; u += NWAVES * 64) ((LAS unsigned*)(F.lds + LDSCTL_OFF))[u] = 0u;
    __syncthreads();
#if MK_ONE_LAUNCH
    XcdBarrier bar = xcd_barrier_post((unsigned*)(F.ctl + CW_BAR), F.MISC + 8);
#define GRID_BAR() xcd_barrier(bar)
#else
#define GRID_BAR() do { if (tid == 0) __hip_atomic_store(F.ctl + CW_TMO, 0xBADBA0u, RLX_AGENT); } while (0)
#endif
    const int lo = args.ph_lo, hi = args.ph_hi;
#define IN(k) (lo <= (k) && (k) < hi)
#ifndef PROBE_MASK
#define PROBE_MASK 0
#endif
#ifndef PG8_ALIGN_EPI
#define PG8_ALIGN_EPI true
#endif
#define REP(k) _Pragma("unroll") for (int rep_ = 0; rep_ < 1 + ((PROBE_MASK >> (k)) & 1); ++rep_)
#ifndef PROBE_A
#define PROBE_A -1
#define PROBE_B -1
#endif
#ifndef PROBE_AMP
#define PROBE_AMP 4
#endif
#ifndef PROBE_BLOCK
#define PROBE_BLOCK 0
#endif
    unsigned long long ts_a = 0, ts_b = 0;
#define STAMP(i) do { if ((i) == PROBE_A) ts_a = __builtin_amdgcn_s_memrealtime(); if ((i) == PROBE_B) ts_b = __builtin_amdgcn_s_memrealtime(); } while (0)
#define SEAM(k) do { if (IN(k) && IN((k) + 1)) { GRID_BAR(); if ((PROBE_MASK >> 6) & 1) GRID_BAR(); } STAMP((k) + 1); } while (0)
    STAMP(0);
    unsigned char* ws = F.ws;
    bf16* XB = (bf16*)(ws + WS_XB);
    const float* rstd0 = (const float*)(ws + WS_RSTD0);

    if (IN(0)) REP(0) { p0_prologue(F, args); } SEAM(0);
    if (IN(1)) REP(1) {
        constexpr int TS = 512 * 1024;
        static_assert(WS_XB % TS == 0 && WS_W1T % TS == 0 && WS_WVT % TS == 0 && WS_MEMN % TS == 0 && WS_WCKVT % TS == 0, "tile-aligned matrices");
        pg8::Gemm g{(const bf16*)ws, (const bf16*)ws, M, 4352, 1024};
        typedef pg8::MultiOrder<128, 17, (int)(WS_XB / TS), (int)(WS_W1T / TS), 4, 128, (int)(WS_WVT / TS), (int)(WS_XB / TS), 4, 2, (int)(WS_MEMN / TS), (int)(WS_WCKVT / TS), 2, 4, (int)(WS_WCKVT / TS) + 2, (int)(WS_MEMN / TS)> P1Order;
        P1Order S{F.G, (int)blockIdx.x};
        pg8::EpiP1 E{ pg8::EpiInProj{(bf16*)(ws + WS_QG), (bf16*)(ws + WS_KG), (bf16*)(ws + WS_SR), (bf16*)(ws + WS_QM), (bf16*)(ws + WS_KM), (bf16*)(ws + WS_SZ), (float*)((unsigned char*)F.out + DO_LA), rstd0, args.in[7]},
                      pg8::EpiVT{(bf16*)(ws + WS_VT), M, rstd0},
                      pg8::EpiRowBf16<0>{(bf16*)(ws + WS_MKV), 512, nullptr, 1.f}, pg8::EpiRowBf16<0>{(bf16*)(ws + WS_MKV) + 1024 * 512, 1024, nullptr, 1.f} };
        pg8::gemm_phase<pg8::EpiP1, P1Order, PG8_ALIGN_EPI, true>(F.lds + RING_OFF, g, S, E);
    } SEAM(1);
    if (IN(2)) { REP(2) gla_a_phase(F); STAMP(30); REP(5) moba_kmean_phase(F); } SEAM(2);
    if (IN(3)) { gla_scan_phase(F); STAMP(31); moba_gate_phase(F, args); } SEAM(3);
    if (IN(4)) { gla_b_phase(F, args); STAMP(32); moba_part_phase(F, args, CW_WQ); } SEAM(4);
    STAMP(6);
    if (IN(6)) { moba_own_phase(F, args, (bf16*)(ws + WS_OGM)); } SEAM(6);
    if (IN(7)) REP(1) { pg8::Gemm g{(const bf16*)(ws + WS_OGM), (const bf16*)(ws + WS_PGMT), M, 1024, 1024}; pg8::StaticOrder S; S.init(M, 1024, F.G, (int)blockIdx.x);
        pg8::EpiMerge2 E{(bf16*)(ws + WS_MG), (const bf16*)(ws + WS_SZ)};
        pg8::gemm_phase<pg8::EpiMerge2, pg8::StaticOrder, PG8_ALIGN_EPI, true>(F.lds + RING_OFF, g, S, E); } SEAM(7);
    if (IN(8)) REP(1) { pg8::Gemm g{(const bf16*)(ws + WS_MG), (const bf16*)(ws + WS_WOUTT), M, 1024, 1024}; pg8::StaticOrder S; S.init(M, 1024, F.G, (int)blockIdx.x);
        pg8::EpiResSplit<true> E{args.in[0], nullptr, nullptr, (bf16*)(ws + WS_X1H), (bf16*)(ws + WS_X1L), (float*)(ws + WS_SS1)};
        pg8::gemm_phase<pg8::EpiResSplit<true>, pg8::StaticOrder, PG8_ALIGN_EPI, true>(F.lds + RING_OFF, g, S, E); } SEAM(8);
    if (IN(10)) REP(1) { pg8::Gemm g{(const bf16*)(ws + WS_X1H), (const bf16*)(ws + WS_WCQT), M, 512, 1024}; pg8::StaticOrder S; S.init(M, 512, F.G, (int)blockIdx.x);
        pg8::EpiRowBf16<0> E{(bf16*)(ws + WS_QC), 512, nullptr, 0.08838834764831845f};
        pg8::gemm_phase<pg8::EpiRowBf16<0>, pg8::StaticOrder, PG8_ALIGN_EPI, true>(F.lds + RING_OFF, g, S, E); } SEAM(10);
    if (IN(11)) { memattn_phase(F, (bf16*)(ws + WS_QC)); } SEAM(11);
    if (IN(12)) { pg8::Gemm g{(const bf16*)(ws + WS_QC), (const bf16*)(ws + WS_WCOT), M, 1024, 512}; pg8::StaticOrder S; S.init(M, 1024, F.G, (int)blockIdx.x);
        pg8::EpiResSplit<false> E{nullptr, (const bf16*)(ws + WS_X1H), (const bf16*)(ws + WS_X1L), (bf16*)(ws + WS_X2H), (bf16*)(ws + WS_X2L), (float*)(ws + WS_SS2)};
        pg8::gemm_phase<pg8::EpiResSplit<false>, pg8::StaticOrder, PG8_ALIGN_EPI, true>(F.lds + RING_OFF, g, S, E);
        expert_weights_gu(F, args); } SEAM(12);
    STAMP(14);
    if (IN(14)) REP(1) {
        { pg8::Gemm g{(const bf16*)(ws + WS_X2H), (const bf16*)(ws + WS_WRT), M, 256, 1024}; pg8::StaticOrder S; S.init(M, 256, F.G, (int)blockIdx.x);
          pg8::EpiLogits E{(float*)(ws + WS_LG), 72, 72};
          pg8::gemm_phase<pg8::EpiLogits, pg8::StaticOrder, PG8_ALIGN_EPI, true>(F.lds + RING_OFF, g, S, E); }
        { pg8::Gemm g{(const bf16*)(ws + WS_X2L), (const bf16*)(ws + WS_WRT) + 256 * 1024, M, 256, 1024}; pg8::StaticOrder S; S.init(M, 256, F.G, (int)((blockIdx.x + F.G / 2) % F.G));
          pg8::EpiLogits E{(float*)(ws + WS_LG2), 36, 36};
          pg8::gemm_phase<pg8::EpiLogits, pg8::StaticOrder, PG8_ALIGN_EPI, true>(F.lds + RING_OFF, g, S, E); }
    } SEAM(14);
    if (IN(15)) { route_phase(F, args); } SEAM(15);
    if (IN(16)) REP(0) { moe_slot_phase(F); } SEAM(16);
    if (IN(17)) REP(1) { const int ntile = moe_bases(F, 0);
        { LAS int* rows = (LAS int*)(F.lds + TBL_ROWS); const int* TOK = (const int*)(ws + WS_TOK);
          for (int i = threadIdx.x; i < 6 * 256; i += NTHR) { const long L = (long)(i >> 8) * F.G + blockIdx.x; rows[i] = (L < (long)ntile * 4) ? TOK[(int)(L >> 2) * 256 + (i & 255)] : 0; }
          __syncthreads(); }
        pg8::Gemm g{(const bf16*)(ws + WS_X2H), (const bf16*)(ws + WS_WGUT), MOE_CAP, 32 * 1024, 1024}; pg8::MoeGatherOrder S{(const LAS int*)(F.lds + TBL_TILE), (const LAS int*)(F.lds + TBL_ROWS), ntile, F.G, (int)blockIdx.x};
        pg8::EpiMoe1 E{(bf16*)(ws + WS_HID), (const float*)(ws + WS_RSTD_SLOT)};
        pg8::gemm_phase<pg8::EpiMoe1, pg8::MoeGatherOrder, PG8_ALIGN_EPI, true>(F.lds + RING_OFF, g, S, E);
        { const int total = ntile * 4, maxun = (total + F.G - 1) / F.G, rem = total - (maxun - 1) * F.G;
          const bool even = rem == F.G; expert_weights_dn(F, args, even ? (int)blockIdx.x : (int)blockIdx.x - rem, even ? F.G : F.G - rem); } } SEAM(17);
    if (IN(18)) REP(1) { const int ntile = moe_bases(F, 0);
        pg8::Gemm g{(const bf16*)(ws + WS_HID), (const bf16*)(ws + WS_WDT), MOE_CAP, 32 * 1024, 512}; pg8::MoeOrder S{(const LAS int*)(F.lds + TBL_TILE), ntile, F.G, (int)blockIdx.x};
        pg8::EpiMoe2 E{(bf16*)(ws + WS_XG), (const float*)(ws + WS_W_SLOT)};
        pg8::gemm_phase<pg8::EpiMoe2, pg8::MoeOrder, PG8_ALIGN_EPI, true>(F.lds + RING_OFF, g, S, E); } SEAM(18);
    if (IN(19)) { final_phase(F, args); }
    STAMP(20);
    if ((PROBE_A >= 0 || PROBE_ACC >= 0) && blockIdx.x == PROBE_BLOCK) { const unsigned long long dl = (PROBE_ACC >= 40 ? (unsigned long long)F.MISC[16] : PROBE_ACC >= 0 ? F.pacc : (ts_b - ts_a)) * PROBE_AMP, t0 = __builtin_amdgcn_s_memrealtime(); while (__builtin_amdgcn_s_memrealtime() - t0 < dl) __builtin_amdgcn_s_sleep(8); }
#undef IN
#undef SEAM
}

extern "C" void kernel_launch(void* const* d_in, const int* in_sizes, int n_in, void* d_out, int out_size, void* d_ws, size_t ws_size, hipStream_t stream) {
    static int grid = 0;
    if (grid == 0) {
        if (n_in != 25 || in_sizes[0] != M * D || out_size != M * D || ws_size < WS_END) { fprintf(stderr, "kernel_launch: unexpected shapes (n_in %d in0 %d out %d ws %zu)\n", n_in, n_in > 0 ? in_sizes[0] : -1, out_size, ws_size); grid = -1; return; }
        int dev = 0, cus = 0, per_cu = 0;
        if (hipGetDevice(&dev) != hipSuccess || hipDeviceGetAttribute(&cus, hipDeviceAttributeMultiprocessorCount, dev) != hipSuccess) { grid = -1; return; }
        if (hipFuncSetAttribute((const void*)fwd_kernel, hipFuncAttributeMaxDynamicSharedMemorySize, LDS_BYTES) != hipSuccess) { fprintf(stderr, "kernel_launch: hipFuncSetAttribute failed\n"); grid = -1; return; }
        if (hipOccupancyMaxActiveBlocksPerMultiprocessor(&per_cu, (const void*)fwd_kernel, NWAVES * 64, LDS_BYTES) != hipSuccess || per_cu < 1) fprintf(stderr, "kernel_launch: occupancy query reports %d\n", per_cu);
        (void)hipGetLastError();
        grid = cus;
    }
    if (grid < 0) return;
    if (hipMemsetAsync((char*)d_ws + WS_CTL, 0, CTL_ZERO_BYTES, stream) != hipSuccess) return;
    Args a{};
    for (int i = 0; i < 25; ++i) a.in[i] = (const float*)d_in[i];
    a.out = (float*)d_out; a.ws = (unsigned char*)d_ws;
#if MK_ONE_LAUNCH
    a.ph_lo = 0; a.ph_hi = NPHASE;
    hipLaunchKernelGGL(fwd_kernel, dim3(grid), dim3(NWAVES * 64), LDS_BYTES, stream, a);
#else
    for (int p = 0; p < NPHASE; ++p) { a.ph_lo = p; a.ph_hi = p + 1; hipLaunchKernelGGL(fwd_kernel, dim3(grid), dim3(NWAVES * 64), LDS_BYTES, stream, a); }
#endif
}
```

```cpp
#include <hip/hip_runtime.h>
#include <cstdio>
#include <cstdint>
#define MK_ONE_LAUNCH 1
namespace pg8 {
#define PG8_LAS __attribute__((address_space(3)))
typedef unsigned short bf16_t;
typedef short bf16x8 __attribute__((ext_vector_type(8)));
typedef float f32x4 __attribute__((ext_vector_type(4)));
typedef unsigned u32x4 __attribute__((ext_vector_type(4)));
constexpr int BM = 256, BK = 64, HALF = 128, HTB = HALF * BK * 2  , STAGE_BYTES = 8 * HTB, NXCD = 8, WGM = 8;

__host__ __device__ __forceinline__ int lds_byte(int r, int c) { const int st = (r >> 4) * 2 + (c >> 5), rr = r & 15, cc = c & 31, ob = rr * 64 + cc * 2; return st * 1024 + (ob ^ (((ob >> 9) & 1) << 5)); }
__host__ __device__ __forceinline__ void stage_rc(int b, int& R, int& C) { const int st = b / 1024, sb = b % 1024, swz = sb ^ (((sb >> 9) & 1) << 5); R = (st >> 1) * 16 + swz / 64; C = (st & 1) * 32 + (swz % 64) / 2; }
__host__ __device__ __forceinline__ int perm32(int rho) { const int n = rho >> 4, i = rho & 15; return 8 * (i >> 2) + 4 * n + (i & 3); }

struct Unit { int pm, pn, lm, ln, ty; };
struct Gemm { const bf16_t* A; const bf16_t* Bt; int M, N, K; };

struct StaticOrder {
    static constexpr bool GATHER = false;
    int nM, nN, nwg, G, c;
    __host__ __device__ void init(int M, int N, int G_, int c_) { nM = M / BM; nN = N / BM; nwg = nM * nN; G = G_; c = c_; }
    __host__ __device__ bool next(int i, Unit& u) const {
        const long L = (long)i * G + c; if (L >= nwg) return false;
        int wgid = (int)L; { const int q = nwg / NXCD, r = nwg % NXCD, xcd = wgid % NXCD, off = wgid / NXCD; wgid = (xcd < r ? xcd * (q + 1) : r * (q + 1) + (xcd - r) * q) + off; }
        const int nig = WGM * nN, gid = wgid / nig, fm = gid * WGM, gsz = (nM - fm) < WGM ? (nM - fm) : WGM;
        u.pm = fm + ((wgid % nig) % gsz); u.pn = (wgid % nig) / gsz; u.lm = u.pm; u.ln = u.pn; u.ty = 0; return true;
    }
    __device__ __forceinline__ void a_ready(const Unit&) const {}
    __device__ __forceinline__ void done(const Unit&) const {}
};

__device__ __forceinline__ unsigned cvt_pk_bf16(float lo, float hi) { unsigned r; asm volatile("v_cvt_pk_bf16_f32 %0, %1, %2" : "=v"(r) : "v"(lo), "v"(hi)); return r; }
typedef float f32x2 __attribute__((ext_vector_type(2)));
__device__ __forceinline__ float bf2f(unsigned short h) { return __uint_as_float(((unsigned)h) << 16); }
__device__ __forceinline__ float bflo(unsigned w) { return __uint_as_float(w << 16); }
__device__ __forceinline__ float bfhi(unsigned w) { return __uint_as_float(w & 0xffff0000u); }
__device__ __forceinline__ float sigmoid_f(float x) { return __builtin_amdgcn_rcpf(1.0f + __builtin_amdgcn_exp2f(-1.4426950408889634f * x)); }
__device__ __forceinline__ float silu_f(float x) { return x * __builtin_amdgcn_rcpf(1.0f + __builtin_amdgcn_exp2f(-1.4426950408889634f * x)); }
__device__ __forceinline__ float logsigmoid_f(float x) { return fminf(x, 0.f) - 0.6931471805599453f * __builtin_amdgcn_logf(1.0f + __builtin_amdgcn_exp2f(-1.4426950408889634f * fabsf(x))); }
__device__ __forceinline__ u32x4 pack8(const f32x4 v0, const f32x4 v1) { u32x4 w; w.x = cvt_pk_bf16(v0[0], v0[1]); w.y = cvt_pk_bf16(v0[2], v0[3]); w.z = cvt_pk_bf16(v1[0], v1[1]); w.w = cvt_pk_bf16(v1[2], v1[3]); return w; }

struct EpiInProj {
    static constexpr bool PERM = true, AFTER_DRAIN = false, MIDK = false;
    bf16_t *QG, *KG, *SR, *QM, *KM, *SZ; float* LA; const float* rstd; const float* b_alpha;
    __device__ __forceinline__ void operator()(const f32x4 (&acc)[2][2][4][2], const Unit& u, int wr, int wc, int fr, int fq) const {
        const int pn = u.ln; bf16_t* dst; int ldc, cbase, mode = 0; float sc = 1.f;
        if (pn == 0) { dst = QG; ldc = 256; cbase = 0; sc = 0.125f; }
        else if (pn == 1) { dst = KG; ldc = 256; cbase = 0; }
        else if (pn <= 3) { dst = SR; ldc = 512; cbase = (pn - 2) * 256; mode = 1; }
        else if (pn == 4) { dst = nullptr; ldc = 256; cbase = 0; mode = 3; }
        else if (pn <= 6) { dst = QM; ldc = 512; cbase = (pn - 5) * 256; sc = 0.125f * 1.4426950408889634f; }
        else if (pn <= 8) { dst = KM; ldc = 512; cbase = (pn - 7) * 256; }
        else { dst = SZ; ldc = 2048; cbase = (pn - 9) * 256; mode = 2; }
        const int row0 = u.lm * BM + wr * 64 + fr, col0 = cbase + wc * 32 + 8 * fq;
#pragma unroll
        for (int ai = 0; ai < 2; ++ai)
#pragma unroll
            for (int m = 0; m < 4; ++m) { const int row = row0 + ai * HALF + m * 16; const float rs = sc;
#pragma unroll
                for (int bj = 0; bj < 2; ++bj) { f32x4 v0 = acc[ai][bj][m][0] * rs, v1 = acc[ai][bj][m][1] * rs; const int col = col0 + bj * HALF;
                    if (mode == 3) { const f32x4 b0 = *(const f32x4*)(b_alpha + col), b1 = *(const f32x4*)(b_alpha + col + 4);
#pragma unroll
                        for (int e = 0; e < 4; ++e) { v0[e] = logsigmoid_f(v0[e] + b0[e]) * 0.0625f; v1[e] = logsigmoid_f(v1[e] + b1[e]) * 0.0625f; }
                        float* o = LA + (size_t)row * 256 + col; *(f32x4*)o = v0; *(f32x4*)(o + 4) = v1; }
                    else { if (mode == 1) {
#pragma unroll
                            for (int e = 0; e < 4; ++e) { v0[e] = silu_f(v0[e]); v1[e] = silu_f(v1[e]); } }
                        else if (mode == 2) {
#pragma unroll
                            for (int e = 0; e < 4; ++e) { v0[e] = sigmoid_f(v0[e]); v1[e] = sigmoid_f(v1[e]); } }
                        *(u32x4*)(dst + (size_t)row * ldc + col) = pack8(v0, v1); } } }
    }
};
struct EpiVT {
    static constexpr bool PERM = true, AFTER_DRAIN = false, MIDK = false;
    bf16_t* VT; int ldc; const float* rstd;
    __device__ __forceinline__ void operator()(const f32x4 (&acc)[2][2][4][2], const Unit& u, int wr, int wc, int fr, int fq) const {
        const int row0 = u.lm * BM + wr * 64 + fr, col0 = u.ln * BM + wc * 32 + 8 * fq;
#pragma unroll
        for (int ai = 0; ai < 2; ++ai)
#pragma unroll
            for (int m = 0; m < 4; ++m) { const int row = row0 + ai * HALF + m * 16;
#pragma unroll
                for (int bj = 0; bj < 2; ++bj) *(u32x4*)(VT + (size_t)row * ldc + col0 + bj * HALF) = pack8(acc[ai][bj][m][0], acc[ai][bj][m][1]); }
    }
};
template <int ACT> struct EpiRowBf16 {
    static constexpr bool PERM = true, AFTER_DRAIN = false, MIDK = false;
    bf16_t* O; int ldc; const float* rowscale; float sc;
    __device__ __forceinline__ void operator()(const f32x4 (&acc)[2][2][4][2], const Unit& u, int wr, int wc, int fr, int fq) const {
        const int row0 = u.lm * BM + wr * 64 + fr, col0 = u.ln * BM + wc * 32 + 8 * fq;
#pragma unroll
        for (int ai = 0; ai < 2; ++ai)
#pragma unroll
            for (int m = 0; m < 4; ++m) { const int row = row0 + ai * HALF + m * 16; const float rs = (rowscale ? rowscale[row] : 1.f) * sc;
#pragma unroll
                for (int bj = 0; bj < 2; ++bj) { f32x4 v0 = acc[ai][bj][m][0] * rs, v1 = acc[ai][bj][m][1] * rs;
                    if (ACT == 2) {
#pragma unroll
                        for (int e = 0; e < 4; ++e) { v0[e] = sigmoid_f(v0[e]); v1[e] = sigmoid_f(v1[e]); } }
                    *(u32x4*)(O + (size_t)row * ldc + col0 + bj * HALF) = pack8(v0, v1); } }
    }
};
struct EpiMerge {
    static constexpr bool PERM = true, AFTER_DRAIN = false, MIDK = false;
    bf16_t* O; const bf16_t* SZ; const bf16_t* T1;
    __device__ __forceinline__ void operator()(const f32x4 (&acc)[2][2][4][2], const Unit& u, int wr, int wc, int fr, int fq) const {
        const int row0 = u.lm * BM + wr * 64 + fr, col0 = u.ln * BM + wc * 32 + 8 * fq;
#pragma unroll
        for (int ai = 0; ai < 2; ++ai)
#pragma unroll
            for (int m = 0; m < 4; ++m) { const int row = row0 + ai * HALF + m * 16;
#pragma unroll
                for (int bj = 0; bj < 2; ++bj) { const int col = col0 + bj * HALF;
                    const u32x4 g = *(const u32x4*)(SZ + (size_t)row * 2048 + col), z = *(const u32x4*)(SZ + (size_t)row * 2048 + 1024 + col), t = *(const u32x4*)(T1 + (size_t)row * 1024 + col);
                    const f32x4 a0 = acc[ai][bj][m][0], a1 = acc[ai][bj][m][1]; f32x4 v0, v1;
                    v0[0] = bflo(g.x) * bflo(t.x) + bflo(z.x) * a0[0]; v0[1] = bfhi(g.x) * bfhi(t.x) + bfhi(z.x) * a0[1];
                    v0[2] = bflo(g.y) * bflo(t.y) + bflo(z.y) * a0[2]; v0[3] = bfhi(g.y) * bfhi(t.y) + bfhi(z.y) * a0[3];
                    v1[0] = bflo(g.z) * bflo(t.z) + bflo(z.z) * a1[0]; v1[1] = bfhi(g.z) * bfhi(t.z) + bfhi(z.z) * a1[1];
                    v1[2] = bflo(g.w) * bflo(t.w) + bflo(z.w) * a1[2]; v1[3] = bfhi(g.w) * bfhi(t.w) + bfhi(z.w) * a1[3];
                    *(u32x4*)(O + (size_t)row * 1024 + col) = pack8(v0, v1); } }
    }
};
struct EpiResF32 {
    static constexpr bool PERM = false, AFTER_DRAIN = false, MIDK = false;
    const float* base; float* out;
    __device__ __forceinline__ void operator()(const f32x4 (&acc)[2][2][4][2], const Unit& u, int wr, int wc, int fr, int fq) const {
        const int row0 = u.lm * BM + wr * 64 + fr, col0 = u.ln * BM + wc * 32 + 4 * fq;
#pragma unroll
        for (int ai = 0; ai < 2; ++ai)
#pragma unroll
            for (int m = 0; m < 4; ++m) { const size_t off = (size_t)(row0 + ai * HALF + m * 16) * 1024 + col0;
#pragma unroll
                for (int bj = 0; bj < 2; ++bj)
#pragma unroll
                    for (int n = 0; n < 2; ++n) { const f32x4 b = *(const f32x4*)(base + off + bj * HALF + n * 16); *(f32x4*)(out + off + bj * HALF + n * 16) = b + acc[ai][bj][m][n]; } }
    }
};
template <bool SPLIT> struct EpiResNorm {
    static constexpr bool PERM = true, AFTER_DRAIN = false, MIDK = false;
    const float* base; float* out; bf16_t* H; bf16_t* L; float* SS;
    __device__ __forceinline__ void operator()(const f32x4 (&acc)[2][2][4][2], const Unit& u, int wr, int wc, int fr, int fq) const {
        const int row0 = u.lm * BM + wr * 64 + fr, col0 = u.ln * BM + wc * 32 + 8 * fq;
#pragma unroll
        for (int ai = 0; ai < 2; ++ai)
#pragma unroll
            for (int m = 0; m < 4; ++m) { const int row = row0 + ai * HALF + m * 16; const size_t off = (size_t)row * 1024 + col0; float ss = 0.f;
#pragma unroll
                for (int bj = 0; bj < 2; ++bj) { const f32x4 v0 = *(const f32x4*)(base + off + bj * HALF) + acc[ai][bj][m][0], v1 = *(const f32x4*)(base + off + bj * HALF + 4) + acc[ai][bj][m][1];
                    *(f32x4*)(out + off + bj * HALF) = v0; *(f32x4*)(out + off + bj * HALF + 4) = v1;
                    ss += (v0[0] * v0[0] + v0[1] * v0[1]) + (v0[2] * v0[2] + v0[3] * v0[3]) + (v1[0] * v1[0] + v1[1] * v1[1]) + (v1[2] * v1[2] + v1[3] * v1[3]);
                    const u32x4 h = pack8(v0, v1); *(u32x4*)(H + off + bj * HALF) = h;
                    if (SPLIT) { f32x4 r0, r1; r0[0] = v0[0] - bflo(h.x); r0[1] = v0[1] - bfhi(h.x); r0[2] = v0[2] - bflo(h.y); r0[3] = v0[3] - bfhi(h.y); r1[0] = v1[0] - bflo(h.z); r1[1] = v1[1] - bfhi(h.z); r1[2] = v1[2] - bflo(h.w); r1[3] = v1[3] - bfhi(h.w);
                        *(u32x4*)(L + off + bj * HALF) = pack8(r0, r1); } }
                ss += __shfl_xor(ss, 16); ss += __shfl_xor(ss, 32);
                if (fq == 0) SS[(size_t)row * 16 + u.ln * 4 + wc] = ss; }
    }
};
struct EpiLogits {
    static constexpr bool PERM = false, AFTER_DRAIN = false, MIDK = false;
    float* LG; int ld, ncols;
    __device__ __forceinline__ void operator()(const f32x4 (&acc)[2][2][4][2], const Unit& u, int wr, int wc, int fr, int fq) const {
        const int row0 = u.lm * BM + wr * 64 + fr, col0 = wc * 32 + 4 * fq;
#pragma unroll
        for (int ai = 0; ai < 2; ++ai)
#pragma unroll
            for (int m = 0; m < 4; ++m) { float* o = LG + (size_t)(row0 + ai * HALF + m * 16) * ld;
#pragma unroll
                for (int n = 0; n < 2; ++n) { const int col = col0 + n * 16; if (col < ncols) *(f32x4*)(o + col) = acc[ai][0][m][n]; } }
    }
};
struct EpiMoe1 {
    static constexpr bool PERM = true, AFTER_DRAIN = false, MIDK = false;
    bf16_t* HID; const float* rstd_slot;
    __device__ __forceinline__ void operator()(const f32x4 (&acc)[2][2][4][2], const Unit& u, int wr, int wc, int fr, int fq) const {
        const int row0 = u.lm * BM + wr * 64 + fr, col0 = u.ln * 128 + wc * 32 + 8 * fq;
#pragma unroll
        for (int ai = 0; ai < 2; ++ai)
#pragma unroll
            for (int m = 0; m < 4; ++m) { const int row = row0 + ai * HALF + m * 16; const float rs = rstd_slot[row];
                f32x4 v0, v1;
#pragma unroll
                for (int e = 0; e < 4; ++e) { v0[e] = silu_f(acc[ai][0][m][0][e] * rs) * (acc[ai][1][m][0][e] * rs); v1[e] = silu_f(acc[ai][0][m][1][e] * rs) * (acc[ai][1][m][1][e] * rs); }
                *(u32x4*)(HID + (size_t)row * 512 + col0) = pack8(v0, v1); }
    }
};
struct EpiMoe2 {
    static constexpr bool PERM = true, AFTER_DRAIN = false, MIDK = false;
    bf16_t* Y; const float* w_slot;
    __device__ __forceinline__ void operator()(const f32x4 (&acc)[2][2][4][2], const Unit& u, int wr, int wc, int fr, int fq) const {
        const int row0 = u.lm * BM + wr * 64 + fr, col0 = u.ln * BM + wc * 32 + 8 * fq;
#pragma unroll
        for (int ai = 0; ai < 2; ++ai)
#pragma unroll
            for (int m = 0; m < 4; ++m) { const int row = row0 + ai * HALF + m * 16; const float rs = w_slot[row];
#pragma unroll
                for (int bj = 0; bj < 2; ++bj) *(u32x4*)(Y + (size_t)row * 1024 + col0 + bj * HALF) = pack8(acc[ai][bj][m][0] * rs, acc[ai][bj][m][1] * rs); }
    }
};
struct EpiP1 {
    static constexpr bool PERM = true, AFTER_DRAIN = false, MIDK = false;
    EpiInProj e0; EpiVT e1; EpiRowBf16<0> e2, e3;
    __device__ __forceinline__ void operator()(const f32x4 (&acc)[2][2][4][2], const Unit& u, int wr, int wc, int fr, int fq) const {
        if (u.ty == 0) e0(acc, u, wr, wc, fr, fq); else if (u.ty == 1) e1(acc, u, wr, wc, fr, fq); else if (u.ty == 2) e2(acc, u, wr, wc, fr, fq); else e3(acc, u, wr, wc, fr, fq);
    }
};
struct EpiMerge2 {
    static constexpr bool PERM = true, AFTER_DRAIN = false, MIDK = true;
    bf16_t* O; const bf16_t* SZ;
    __device__ __forceinline__ void mid(f32x4 (&acc)[2][2][4][2], const Unit& u, int wr, int wc, int fr, int fq) const {
        const int row0 = u.lm * BM + wr * 64 + fr, col0 = u.ln * BM + wc * 32 + 8 * fq;
#pragma unroll
        for (int ai = 0; ai < 2; ++ai)
#pragma unroll
            for (int m = 0; m < 4; ++m) { const int row = row0 + ai * HALF + m * 16;
#pragma unroll
                for (int bj = 0; bj < 2; ++bj) { const int col = col0 + bj * HALF; const u32x4 g = *(const u32x4*)(SZ + (size_t)row * 2048 + col), z = *(const u32x4*)(SZ + (size_t)row * 2048 + 1024 + col);
                    f32x4 r0, r1;
                    r0[0] = bflo(g.x) * __builtin_amdgcn_rcpf(fmaxf(bflo(z.x), 1e-30f)); r0[1] = bfhi(g.x) * __builtin_amdgcn_rcpf(fmaxf(bfhi(z.x), 1e-30f)); r0[2] = bflo(g.y) * __builtin_amdgcn_rcpf(fmaxf(bflo(z.y), 1e-30f)); r0[3] = bfhi(g.y) * __builtin_amdgcn_rcpf(fmaxf(bfhi(z.y), 1e-30f));
                    r1[0] = bflo(g.z) * __builtin_amdgcn_rcpf(fmaxf(bflo(z.z), 1e-30f)); r1[1] = bfhi(g.z) * __builtin_amdgcn_rcpf(fmaxf(bfhi(z.z), 1e-30f)); r1[2] = bflo(g.w) * __builtin_amdgcn_rcpf(fmaxf(bflo(z.w), 1e-30f)); r1[3] = bfhi(g.w) * __builtin_amdgcn_rcpf(fmaxf(bfhi(z.w), 1e-30f));
                    acc[ai][bj][m][0] = acc[ai][bj][m][0] * r0; acc[ai][bj][m][1] = acc[ai][bj][m][1] * r1; } }
    }
    __device__ __forceinline__ void operator()(const f32x4 (&acc)[2][2][4][2], const Unit& u, int wr, int wc, int fr, int fq) const {
        const int row0 = u.lm * BM + wr * 64 + fr, col0 = u.ln * BM + wc * 32 + 8 * fq;
#pragma unroll
        for (int ai = 0; ai < 2; ++ai)
#pragma unroll
            for (int m = 0; m < 4; ++m) { const int row = row0 + ai * HALF + m * 16;
#pragma unroll
                for (int bj = 0; bj < 2; ++bj) { const int col = col0 + bj * HALF; const u32x4 z = *(const u32x4*)(SZ + (size_t)row * 2048 + 1024 + col);
                    f32x4 v0 = acc[ai][bj][m][0], v1 = acc[ai][bj][m][1];
                    v0[0] *= bflo(z.x); v0[1] *= bfhi(z.x); v0[2] *= bflo(z.y); v0[3] *= bfhi(z.y); v1[0] *= bflo(z.z); v1[1] *= bfhi(z.z); v1[2] *= bflo(z.w); v1[3] *= bfhi(z.w);
                    *(u32x4*)(O + (size_t)row * 1024 + col) = pack8(v0, v1); } }
    }
};
template <bool BASE_F32, bool WRITE_L> struct EpiResSplit {
    static constexpr bool PERM = true, AFTER_DRAIN = false, MIDK = false;
    const float* basef; const bf16_t* baseH; const bf16_t* baseL; bf16_t* H; bf16_t* L; float* SS;
    __device__ __forceinline__ void operator()(const f32x4 (&acc)[2][2][4][2], const Unit& u, int wr, int wc, int fr, int fq) const {
        const int row0 = u.lm * BM + wr * 64 + fr, col0 = u.ln * BM + wc * 32 + 8 * fq;
#pragma unroll
        for (int ai = 0; ai < 2; ++ai)
#pragma unroll
            for (int m = 0; m < 4; ++m) { const int row = row0 + ai * HALF + m * 16; const size_t off = (size_t)row * 1024 + col0; float ss = 0.f;
#pragma unroll
                for (int bj = 0; bj < 2; ++bj) { f32x4 v0, v1;
                    if (BASE_F32) { v0 = *(const f32x4*)(basef + off + bj * HALF); v1 = *(const f32x4*)(basef + off + bj * HALF + 4); }
                    else { const u32x4 bh = *(const u32x4*)(baseH + off + bj * HALF);
                        v0[0] = bflo(bh.x); v0[1] = bfhi(bh.x); v0[2] = bflo(bh.y); v0[3] = bfhi(bh.y); v1[0] = bflo(bh.z); v1[1] = bfhi(bh.z); v1[2] = bflo(bh.w); v1[3] = bfhi(bh.w); }
                    v0 = v0 + acc[ai][bj][m][0]; v1 = v1 + acc[ai][bj][m][1];
                    ss += (v0[0] * v0[0] + v0[1] * v0[1]) + (v0[2] * v0[2] + v0[3] * v0[3]) + (v1[0] * v1[0] + v1[1] * v1[1]) + (v1[2] * v1[2] + v1[3] * v1[3]);
                    const u32x4 h = pack8(v0, v1); *(u32x4*)(H + off + bj * HALF) = h;
                    if (WRITE_L) { f32x4 r0, r1; r0[0] = v0[0] - bflo(h.x); r0[1] = v0[1] - bfhi(h.x); r0[2] = v0[2] - bflo(h.y); r0[3] = v0[3] - bfhi(h.y); r1[0] = v1[0] - bflo(h.z); r1[1] = v1[1] - bfhi(h.z); r1[2] = v1[2] - bflo(h.w); r1[3] = v1[3] - bfhi(h.w);
                        *(u32x4*)(L + off + bj * HALF) = pack8(r0, r1); } }
                ss += __shfl_xor(ss, 16); ss += __shfl_xor(ss, 32);
                if (fq == 0) SS[(size_t)row * 16 + u.ln * 4 + wc] = ss; }
    }
};
template <int NM0, int NN0, int A00, int B00, int NM1, int NN1, int A01, int B01, int NM2, int NN2, int A02, int B02, int NM3, int NN3, int A03, int B03>
struct MultiOrder {
    static constexpr bool GATHER = false;
    int G, c;
    __device__ __forceinline__ bool next(int i, Unit& u) const {
        constexpr int C0 = NM0 * NN0, C1 = NM1 * NN1, C2 = NM2 * NN2, C3 = NM3 * NN3;
        long L = (long)i * G + c; int s, nwg, nNs, nMs, a0s, b0s;
        if (L < C0) { s = 0; nwg = C0; nNs = NN0; nMs = NM0; a0s = A00; b0s = B00; }
        else if (L < C0 + C1) { L -= C0; s = 1; nwg = C1; nNs = NN1; nMs = NM1; a0s = A01; b0s = B01; }
        else if (L < C0 + C1 + C2) { L -= C0 + C1; s = 2; nwg = C2; nNs = NN2; nMs = NM2; a0s = A02; b0s = B02; }
        else if (L < C0 + C1 + C2 + C3) { L -= C0 + C1 + C2; s = 3; nwg = C3; nNs = NN3; nMs = NM3; a0s = A03; b0s = B03; }
        else return false;
        int wgid = (int)L; { const int q = nwg / NXCD, r = nwg % NXCD, xcd = wgid % NXCD, off = wgid / NXCD; wgid = (xcd < r ? xcd * (q + 1) : r * (q + 1) + (xcd - r) * q) + off; }
        const int nig = WGM * nNs, gid = wgid / nig, fm = gid * WGM, gsz = (nMs - fm) < WGM ? (nMs - fm) : WGM;
        u.lm = fm + ((wgid % nig) % gsz); u.ln = (wgid % nig) / gsz; u.pm = a0s + u.lm; u.pn = b0s + u.ln; u.ty = s; return true;
    }
    __device__ __forceinline__ void a_ready(const Unit&) const {}
    __device__ __forceinline__ void done(const Unit&) const {}
};
struct MoeOrder {
    static constexpr bool GATHER = false;
    const PG8_LAS int* tile_e; int ntile, G, c;
    __device__ __forceinline__ bool next(int i, Unit& u) const {
        const long L = (long)i * G + c; if (L >= (long)ntile * 4) return false;
        const int pm = (int)(L >> 2), j = (int)(L & 3); u.pm = pm; u.pn = __builtin_amdgcn_readfirstlane(tile_e[pm]) * 4 + j; u.lm = pm; u.ln = j; u.ty = 0; return true;
    }
    __device__ __forceinline__ void a_ready(const Unit&) const {}
    __device__ __forceinline__ void done(const Unit&) const {}
};
struct MoeGatherOrder {
    static constexpr bool GATHER = true;
    const PG8_LAS int* tile_e; const PG8_LAS int* rows; int ntile, G, c;
    __device__ __forceinline__ bool next(int i, Unit& u) const {
        const long L = (long)i * G + c; if (L >= (long)ntile * 4) return false;
        const int pm = (int)(L >> 2), j = (int)(L & 3); u.pm = pm; u.pn = __builtin_amdgcn_readfirstlane(tile_e[pm]) * 4 + j; u.lm = pm; u.ln = j; u.ty = 0; return true;
    }
    __device__ __forceinline__ int row(int ui, int r) const { return rows[ui * 256 + r]; }
    __device__ __forceinline__ void a_ready(const Unit&) const {}
    __device__ __forceinline__ void done(const Unit&) const {}
};
#ifndef PROBE_ACC
#define PROBE_ACC -1
#endif
#ifndef PROBE_N
#define PROBE_N 0
#endif
#define PG8_PB(id) do { if ((id) == PROBE_ACC && (PROBE_N == 0 || g.N == PROBE_N)) g_t0 = __builtin_amdgcn_s_memrealtime(); } while (0)
#define PG8_PE(id) do { if ((id) == PROBE_ACC && (PROBE_N == 0 || g.N == PROBE_N) && wid == 0 && lane == 0) { const unsigned d_ = (unsigned)(__builtin_amdgcn_s_memrealtime() - g_t0); __hip_atomic_fetch_add((PG8_LAS unsigned*)(lds + 147776 + 4 * 16), d_, __ATOMIC_RELAXED, __HIP_MEMORY_SCOPE_WORKGROUP); } } while (0)
template <class Epi, class Sched, bool ALIGN_EPI = false, bool SP2 = false>
__device__ __forceinline__ void gemm_phase(PG8_LAS unsigned char* lds, const Gemm g, const Sched& S, const Epi& E) {
    const int tid = threadIdx.x, wid = __builtin_amdgcn_readfirstlane(tid >> 6), lane = tid & 63, wr = wid >> 2, wc = wid & 3, fr = lane & 15, fq = lane >> 4;
    const int K = g.K, nt = K / BK; unsigned long long g_t0 = 0; (void)g_t0; PG8_PB(42);
    unsigned voffA[2], voffB[2];
#pragma unroll
    for (int i = 0; i < 2; ++i) { int R, C; stage_rc(tid * 16 + i * 8192, R, C); const int Rb = Epi::PERM ? ((R & ~31) + perm32(R & 31)) : R;
        voffA[i] = (unsigned)(R * K + C) * 2u; voffB[i] = (unsigned)(Rb * K + C) * 2u; }
    static_assert(!Sched::GATHER || SP2, "gathered A rows: SP2 loop only");
    unsigned gA[2][2], gN[2][2];
#define PG8_GOFF(dst, ui_) do { _Pragma("unroll") for (int _h = 0; _h < 2; ++_h) _Pragma("unroll") for (int _i = 0; _i < 2; ++_i) { int _R, _C; stage_rc(tid * 16 + _i * 8192, _R, _C); dst[_h][_i] = (unsigned)(S.row((ui_), _h * HALF + _R) * K + _C) * 2u; } } while (0)
#define PG8_STAGE_A(bufoff, gbase, hh, un_) do { if constexpr (Sched::GATHER) { unsigned _vo[2] = {(un_) ? gN[hh][0] : gA[hh][0], (un_) ? gN[hh][1] : gA[hh][1]}; PG8_STAGE(bufoff, gbase, _vo); } else { PG8_STAGE(bufoff, (gbase) + ((hh) ? hstep : 0), voffA); } } while (0)
    const size_t kstep = (size_t)(BK * 2);
    const size_t hstep = (size_t)HALF * K * 2;
    const size_t tstep = 2 * hstep;
    const unsigned ldsw = (unsigned)wid * 1024u;
    const int aoff = lds_byte(wr * 64 + fr, fq * 8), boff = lds_byte(wc * 32 + fr, fq * 8);
#define PG8_SA(b, h) (((b) * 2 + (h)) * HTB)
#define PG8_SB(b, h) ((4 + (b) * 2 + (h)) * HTB)
#define PG8_STAGE(bufoff, gbase, voff) do { _Pragma("unroll") for (int _i = 0; _i < 2; ++_i) \
        __builtin_amdgcn_global_load_lds((const unsigned*)((const char*)(gbase) + (voff)[_i]), (PG8_LAS unsigned*)(lds + (bufoff) + ldsw + _i * 8192), 16, 0, 0); } while (0)
#define PG8_LDA(dst, b, h) do { _Pragma("unroll") for (int m = 0; m < 4; ++m) _Pragma("unroll") for (int k = 0; k < 2; ++k) dst[m][k] = *(const PG8_LAS bf16x8*)(lds + PG8_SA(b, h) + aoff + m * 2048 + k * 1024); } while (0)
#define PG8_LDB(dst, b, h) do { _Pragma("unroll") for (int n = 0; n < 2; ++n) _Pragma("unroll") for (int k = 0; k < 2; ++k) dst[n][k] = *(const PG8_LAS bf16x8*)(lds + PG8_SB(b, h) + boff + n * 2048 + k * 1024); } while (0)
#define PG8_MMA(ai, bj, At, Bt) do { __builtin_amdgcn_s_setprio(1); _Pragma("unroll") for (int m = 0; m < 4; ++m) _Pragma("unroll") for (int n = 0; n < 2; ++n) _Pragma("unroll") for (int k = 0; k < 2; ++k) \
        acc[ai][bj][m][n] = __builtin_amdgcn_mfma_f32_16x16x32_bf16(Bt[n][k], At[m][k], acc[ai][bj][m][n], 0, 0, 0); __builtin_amdgcn_s_setprio(0); } while (0)
#define PG8_WAIT_V(n) asm volatile("s_waitcnt vmcnt(" #n ")" ::: "memory")
#define PG8_WAIT_L(n) asm volatile("s_waitcnt lgkmcnt(" #n ")" ::: "memory")
#define PG8_BAR __builtin_amdgcn_s_barrier()
#define PG8_SCHED __builtin_amdgcn_sched_barrier(0)
    Unit cur, nxt; int ui = 0;
    if (!S.next(0, cur)) return;
    f32x4 acc[2][2][4][2];
#pragma unroll
    for (int a = 0; a < 2; ++a)
#pragma unroll
        for (int b = 0; b < 2; ++b)
#pragma unroll
            for (int m = 0; m < 4; ++m)
#pragma unroll
                for (int n = 0; n < 2; ++n) acc[a][b][m][n] = (f32x4){0.f, 0.f, 0.f, 0.f};
    bf16x8 At[4][2], B0[2][2], B1[2][2];
    const char* cA = (const char*)g.A + (Sched::GATHER ? (size_t)0 : (size_t)cur.pm * tstep); const char* cB = (const char*)g.Bt + (size_t)cur.pn * tstep;
    if constexpr (Sched::GATHER) { PG8_GOFF(gA, 0); }
    S.a_ready(cur);
    if constexpr (SP2) {
        PG8_STAGE(PG8_SB(0, 0), cB, voffB); PG8_STAGE(PG8_SB(0, 1), cB + hstep, voffB); PG8_STAGE_A(PG8_SA(0, 0), cA, 0, false); PG8_STAGE_A(PG8_SA(0, 1), cA, 1, false);
        if (wr == 1) PG8_BAR;
        PG8_WAIT_V(2); PG8_BAR;
        PG8_STAGE(PG8_SB(1, 0), cB + kstep, voffB); PG8_STAGE_A(PG8_SA(1, 0), cA + kstep, 0, false); PG8_STAGE(PG8_SB(1, 1), cB + hstep + kstep, voffB);
        PG8_WAIT_V(6); PG8_BAR;
    } else {
        PG8_STAGE(PG8_SB(0, 0), cB, voffB); PG8_STAGE(PG8_SA(0, 0), cA, voffA); PG8_STAGE(PG8_SB(0, 1), cB + hstep, voffB); PG8_STAGE(PG8_SA(0, 1), cA + hstep, voffA);
        if (wr == 1) PG8_BAR;
        PG8_WAIT_V(4); PG8_BAR;
        PG8_STAGE(PG8_SB(1, 0), cB + kstep, voffB); PG8_STAGE(PG8_SA(1, 0), cA + kstep, voffA); PG8_STAGE(PG8_SB(1, 1), cB + hstep + kstep, voffB);
        PG8_WAIT_V(6); PG8_BAR;
    }
    PG8_PE(42);
    for (;;) {
        const bool has_next = S.next(ui + 1, nxt); PG8_PB(40);
        if constexpr (Sched::GATHER) { if (has_next) PG8_GOFF(gN, ui + 1); }
        const char* nA = (has_next && !Sched::GATHER) ? (const char*)g.A + (size_t)nxt.pm * tstep : cA; const char* nB = has_next ? (const char*)g.Bt + (size_t)nxt.pn * tstep : cB;
        for (int t = 0; t < nt; t += 2) {
            if constexpr (Epi::MIDK) { if (t == (nt >> 1)) { int t_ = threadIdx.x; asm volatile("" : "+v"(t_)); const int l_ = t_ & 63, w_ = __builtin_amdgcn_readfirstlane(t_ >> 6); E.mid(acc, cur, w_ >> 2, w_ & 3, l_ & 15, l_ >> 4); } }
            const bool last = (t == nt - 2); const bool un = last && has_next;
            const char* a1 = cA + (size_t)(t + 1) * kstep;
            const char* a2 = last ? nA : cA + (size_t)(t + 2) * kstep; const char* b2 = last ? nB : cB + (size_t)(t + 2) * kstep;
            const char* a3 = a2 + kstep; const char* b3 = b2 + kstep;
            if (last && has_next) S.a_ready(nxt);
            if constexpr (SP2) {
            PG8_LDB(B0, 0, 0); PG8_LDB(B1, 0, 1); PG8_SCHED; PG8_LDA(At, 0, 0); PG8_STAGE_A(PG8_SA(1, 1), a1, 1, false);
            PG8_WAIT_V(8); PG8_WAIT_L(0); PG8_BAR; PG8_MMA(0, 0, At, B0); PG8_MMA(0, 1, At, B1); PG8_BAR; PG8_SCHED;
            PG8_LDA(At, 0, 1); PG8_STAGE(PG8_SB(0, 0), b2, voffB); PG8_STAGE(PG8_SB(0, 1), b2 + hstep, voffB); PG8_STAGE_A(PG8_SA(0, 0), a2, 0, un);
            PG8_WAIT_V(8); PG8_WAIT_L(0); PG8_BAR; PG8_MMA(1, 0, At, B0); PG8_MMA(1, 1, At, B1); PG8_BAR; PG8_SCHED;
            PG8_LDB(B0, 1, 0); PG8_LDB(B1, 1, 1); PG8_SCHED; PG8_LDA(At, 1, 0); PG8_STAGE_A(PG8_SA(0, 1), a2, 1, un);
            PG8_WAIT_V(8); PG8_WAIT_L(0); PG8_BAR; PG8_MMA(0, 0, At, B0); PG8_MMA(0, 1, At, B1); PG8_BAR; PG8_SCHED;
            PG8_LDA(At, 1, 1); PG8_STAGE(PG8_SB(1, 0), b3, voffB); PG8_STAGE(PG8_SB(1, 1), b3 + hstep, voffB); PG8_STAGE_A(PG8_SA(1, 0), a3, 0, un);
            PG8_WAIT_V(8); PG8_WAIT_L(0); PG8_BAR; PG8_MMA(1, 0, At, B0); PG8_MMA(1, 1, At, B1); PG8_BAR; PG8_SCHED;
            } else {
            PG8_LDB(B0, 0, 0); PG8_SCHED; PG8_LDA(At, 0, 0); PG8_STAGE(PG8_SA(1, 1), a1 + hstep, voffA);
            PG8_WAIT_L(8); PG8_BAR; PG8_WAIT_L(0); PG8_MMA(0, 0, At, B0); PG8_BAR; PG8_SCHED;
            PG8_LDB(B1, 0, 1); PG8_STAGE(PG8_SB(0, 0), b2, voffB);
            PG8_BAR; PG8_WAIT_L(0); PG8_MMA(0, 1, At, B1); PG8_BAR;
            PG8_LDA(At, 0, 1); PG8_STAGE(PG8_SA(0, 0), a2, voffA);
            PG8_BAR; PG8_WAIT_L(0); PG8_MMA(1, 0, At, B0); PG8_BAR; PG8_SCHED;
            PG8_STAGE(PG8_SB(0, 1), b2 + hstep, voffB);
            PG8_WAIT_V(6); PG8_BAR; PG8_MMA(1, 1, At, B1); PG8_BAR;
            PG8_LDB(B0, 1, 0); PG8_SCHED; PG8_LDA(At, 1, 0); PG8_STAGE(PG8_SA(0, 1), a2 + hstep, voffA);
            PG8_WAIT_L(8); PG8_BAR; PG8_WAIT_L(0); PG8_MMA(0, 0, At, B0); PG8_BAR; PG8_SCHED;
            PG8_LDB(B1, 1, 1); PG8_STAGE(PG8_SB(1, 0), b3, voffB);
            PG8_BAR; PG8_WAIT_L(0); PG8_MMA(0, 1, At, B1); PG8_BAR;
            PG8_LDA(At, 1, 1); PG8_STAGE(PG8_SA(1, 0), a3, voffA);
            PG8_BAR; PG8_WAIT_L(0); PG8_MMA(1, 0, At, B0); PG8_BAR; PG8_SCHED;
            PG8_STAGE(PG8_SB(1, 1), b3 + hstep, voffB);
            PG8_WAIT_V(6); PG8_BAR; PG8_MMA(1, 1, At, B1); PG8_BAR;
            }
        }
        PG8_PE(40); PG8_PB(41);
        if constexpr (ALIGN_EPI) { if (wr == 0) PG8_BAR; }
        if constexpr (!Epi::AFTER_DRAIN) { int t_ = threadIdx.x; asm volatile("" : "+v"(t_)); const int l_ = t_ & 63, w_ = __builtin_amdgcn_readfirstlane(t_ >> 6); E(acc, cur, w_ >> 2, w_ & 3, l_ & 15, l_ >> 4); S.done(cur); }
        PG8_PE(41);
        if (!has_next) break;
#pragma unroll
        for (int a = 0; a < 2; ++a)
#pragma unroll
            for (int b = 0; b < 2; ++b)
#pragma unroll
                for (int m = 0; m < 4; ++m)
#pragma unroll
                    for (int n = 0; n < 2; ++n) acc[a][b][m][n] = (f32x4){0.f, 0.f, 0.f, 0.f};
        cur = nxt; cA = nA; cB = nB; ++ui;
        if constexpr (Sched::GATHER) { _Pragma("unroll") for (int _h = 0; _h < 2; ++_h) _Pragma("unroll") for (int _i = 0; _i < 2; ++_i) gA[_h][_i] = gN[_h][_i]; }
        if constexpr (ALIGN_EPI) { if (wr == 1) PG8_BAR; }
    }
    PG8_PB(43);
    PG8_WAIT_V(0);
    if constexpr (!ALIGN_EPI) { if (wr == 0) PG8_BAR; }
    PG8_BAR;
    if constexpr (Epi::AFTER_DRAIN) { E.fused(acc, cur, wr, wc, fr, fq, lds, wid, lane); S.done(cur); }
    PG8_PE(43);
#undef PG8_SA
#undef PG8_SB
#undef PG8_STAGE
#undef PG8_STAGE_A
#undef PG8_GOFF
#undef PG8_LDA
#undef PG8_LDB
#undef PG8_MMA
#undef PG8_WAIT_V
#undef PG8_WAIT_L
#undef PG8_BAR
#undef PG8_SCHED
}
}
#define GAS __attribute__((address_space(1)))
#define LAS __attribute__((address_space(3)))
typedef unsigned short bf16;
typedef unsigned v4u __attribute__((ext_vector_type(4)));
typedef float f32x4 __attribute__((ext_vector_type(4)));
typedef short bf16x8 __attribute__((ext_vector_type(8)));
typedef GAS unsigned gu32;
typedef GAS unsigned long long gu64;
#define RLX_AGENT __ATOMIC_RELAXED, __HIP_MEMORY_SCOPE_AGENT
#define LDS_WAIT() asm volatile("s_waitcnt lgkmcnt(0)" ::: "memory")
#define VM_WAIT() asm volatile("s_waitcnt vmcnt(0)" ::: "memory")
__device__ __forceinline__ unsigned long long rt() { return __builtin_amdgcn_s_memrealtime(); }
__device__ __forceinline__ unsigned f2bf(float f) { unsigned u = __builtin_bit_cast(unsigned, f); return (u + 0x7fffu + ((u >> 16) & 1u)) >> 16; }
__device__ __forceinline__ unsigned pk2(float lo, float hi) { return f2bf(lo) | (f2bf(hi) << 16); }
#define XB_TMO      128
#define XB_XCNT(j)  (256  + 64 * (j))
#define XB_XSUB(j)  (1280 + 64 * (j))
#define XB_XGEN(j)  (2304 + 64 * (j))
#define XB_TOP      3328
#define XB_TOPGEN   3392
#define XCD_BAR_WORDS 3456
#define XB_SPIN_CAP (1u << 18)

__device__ __forceinline__ unsigned xb_ld(unsigned* p)              { return __hip_atomic_load(p, __ATOMIC_RELAXED, __HIP_MEMORY_SCOPE_AGENT); }
__device__ __forceinline__ unsigned xb_add(unsigned* p, unsigned v) { return __hip_atomic_fetch_add(p, v, __ATOMIC_RELAXED, __HIP_MEMORY_SCOPE_AGENT); }
__device__ __forceinline__ unsigned xb_xcc_id() { return (unsigned)__builtin_amdgcn_s_getreg((3 << 11) | 20) & 0xFu; }
#define XB_SPIN(cond, bar) do { unsigned _sp = 0; while (cond) { __builtin_amdgcn_s_sleep(1); \
    if ((++_sp & 255u) == 0u) { if (xb_ld(&(bar)[XB_TMO])) break; if (_sp > XB_SPIN_CAP) { atomicAdd(&(bar)[XB_TMO], 1u); break; } } } } while (0)

struct XcdBarrier {
    unsigned* bar; unsigned x;
    volatile LAS unsigned* st;
};

__device__ __forceinline__ XcdBarrier xcd_barrier_post(unsigned* bar, volatile LAS unsigned* st) {
    XcdBarrier b; b.bar = bar; b.x = xb_xcc_id(); b.st = st;
    if (threadIdx.x == 0) (void)xb_add(&bar[XB_XCNT(b.x)], 1u);
    return b;
}
__device__ __forceinline__ void xcd_barrier_complete(unsigned* bar, unsigned x, unsigned& nloc, unsigned& nx) {
    const unsigned G = gridDim.x * gridDim.y * gridDim.z;
    unsigned sum, cnt, mine, sp = 0u;
    for (;;) {
        sum = 0u; cnt = 0u; mine = 0u;
#pragma unroll
        for (unsigned j = 0; j < 16; ++j) { const unsigned c = xb_ld(&bar[XB_XCNT(j)]); sum += c; cnt += (c > 0u) ? 1u : 0u; mine = (j == x) ? c : mine; }
        if (sum == G) break;
        __builtin_amdgcn_s_sleep(1);
        if ((++sp & 255u) == 0u) { if (xb_ld(&bar[XB_TMO])) break; if (sp > XB_SPIN_CAP) { atomicAdd(&bar[XB_TMO], 1u); break; } }
    }
    nloc = mine > 0u ? mine : 1u; nx = cnt > 0u ? cnt : 1u;
}

__device__ __forceinline__ void xcd_barrier(const XcdBarrier& b) {
    asm volatile("s_waitcnt vmcnt(0)" ::: "memory");
    __syncthreads();
    if (threadIdx.x == 0) {
        unsigned* bar = b.bar;
        __builtin_amdgcn_s_waitcnt(0);
        unsigned nloc = b.st[0], nx = b.st[1];
        if (nloc == 0u) { xcd_barrier_complete(bar, b.x, nloc, nx); b.st[0] = nloc; b.st[1] = nx; }
        const unsigned old = xb_add(&bar[XB_XSUB(b.x)], 1u);
        const unsigned gen = old / nloc;
        if (old + 1u == (gen + 1u) * nloc) {
            __builtin_amdgcn_fence(__ATOMIC_RELEASE, "agent");
            asm volatile("s_waitcnt vmcnt(0)" ::: "memory");
            const unsigned og = xb_add(&bar[XB_TOP], 1u);
            const unsigned tg = og / nx;
            if (og + 1u == (tg + 1u) * nx) xb_add(&bar[XB_TOPGEN], 1u);
            else XB_SPIN(xb_ld(&bar[XB_TOPGEN]) == tg, bar);
            __builtin_amdgcn_fence(__ATOMIC_ACQUIRE, "agent");
            xb_add(&bar[XB_XGEN(b.x)], 1u);
            asm volatile("s_waitcnt vmcnt(0)" ::: "memory");
        } else {
            XB_SPIN(xb_ld(&bar[XB_XGEN(b.x)]) == gen, bar);
            __builtin_amdgcn_fence(__ATOMIC_ACQUIRE, "agent");
            asm volatile("s_waitcnt vmcnt(0)" ::: "memory");
        }
    }
    __syncthreads();
}

constexpr int NWAVES = 8, NTHR = 512;
constexpr int M = 32768, D = 1024, SEQ = 8192, NB = 4;
constexpr int DIN = 5136;
constexpr int MOE_CAP_TILES = 288, MOE_CAP = MOE_CAP_TILES * 256;
constexpr int LIST_CAP = 256 * 496;
constexpr float EPS = 1e-6f;
#ifndef MK_ONE_LAUNCH
#define MK_ONE_LAUNCH 0
#endif
constexpr int NPHASE = 20;

constexpr size_t MiB = 1u << 20, KiB = 1u << 10;
constexpr size_t WS_CTL = 0, CTL_ZERO_BYTES = 1 * MiB;
constexpr int CW_TMO = 0, CW_CODE = 1, CW_BAR = 4096, CW_LCNT = 16384, CW_ECNT = 20480, CW_WQ = 24576;
constexpr size_t WS_RSTD0 = 1 * MiB, WS_RSTD1 = WS_RSTD0 + 128 * KiB, WS_RSTD2 = WS_RSTD1 + 128 * KiB;
constexpr size_t WS_DEC = 1 * MiB + 512 * KiB;
constexpr size_t WS_KMEAN = 2 * MiB, WS_KNMAX = 2 * MiB + 256 * KiB;
constexpr size_t WS_MOE_E = 2 * MiB + 512 * KiB, WS_MOE_POS = WS_MOE_E + 256 * KiB, WS_MOE_W = WS_MOE_POS + 256 * KiB, WS_SLOT_OF = WS_MOE_W + 256 * KiB;
constexpr size_t WS_W_SLOT = 4 * MiB, WS_RSTD_SLOT = 4 * MiB + 512 * KiB, WS_TILE_E = 5 * MiB;
constexpr size_t WS_MEMN = 6 * MiB, WS_MKV = 8 * MiB;
constexpr size_t WS_W1T = 10 * MiB  , WS_WVT = WS_W1T + 8704 * KiB, WS_PGMT = WS_WVT + 2 * MiB  , WS_WOUTT = WS_PGMT + 2 * MiB,
                 WS_WCQT = WS_WOUTT + 2 * MiB, WS_WCKVT = WS_WCQT + 1 * MiB, WS_WCOT = WS_WCKVT + 2 * MiB, WS_WRT = WS_WCOT + 1 * MiB;
static_assert(WS_WRT + 1 * MiB <= 30 * MiB, "weights");
constexpr size_t WS_XB = 30 * MiB, WS_QG = 94 * MiB, WS_KG = 110 * MiB, WS_SR = 126 * MiB, WS_QM = 158 * MiB, WS_KM = 190 * MiB, WS_VT = 222 * MiB, WS_OGM = 286 * MiB  , WS_SZ = 350 * MiB;
constexpr size_t WS_LISTS = 478 * MiB, WS_REFS = 494 * MiB, WS_SEL = 495 * MiB, WS_PARTL = 496 * MiB;
constexpr size_t WS_MG = 30 * MiB, WS_X1H = 94 * MiB, WS_X1L = 158 * MiB, WS_QC = 476 * MiB, WS_SS2 = 508 * MiB, WS_SS1 = 510 * MiB;
constexpr size_t WS_X2H = 222 * MiB, WS_X2L = 286 * MiB;
constexpr size_t WS_WGUT = 30 * MiB, WS_WDT = 350 * MiB, WS_LG = 454 * MiB, WS_LG2 = 464 * MiB, WS_HID = 382 * MiB, WS_XG = 30 * MiB  ;
constexpr size_t WS_END = 512 * MiB;
static_assert(WS_XG + 144 * MiB <= WS_X2H && WS_WDT + 32 * MiB <= WS_HID && WS_HID + 72 * MiB <= WS_LG && WS_LG2 + 5 * MiB <= WS_QC && WS_PARTL + 3 * MiB <= WS_END && WS_SS1 + 2 * MiB <= WS_END, "map");
constexpr size_t DO_ST = 0, DO_LA = 64 * MiB, DO_SB = 96 * MiB, DO_PARTO = 0;
constexpr size_t WS_TOK = 5 * MiB + 64 * KiB;
constexpr size_t WS_EMID = 5 * MiB + 512 * KiB;

constexpr int RING_OFF = 0, RING_BYTES = 147456;
constexpr int LDSCTL_OFF = RING_BYTES, MISC_OFF = LDSCTL_OFF + 320;
constexpr int TBL_TILE = RING_BYTES + 1024, TBL_TAB = TBL_TILE + 1280, TBL_BC = TBL_TAB + 512, TBL_EB = TBL_BC + 64;
constexpr int TBL_ROWS = 155648;
constexpr int LDS_BYTES = 163840;
static_assert(TBL_EB + 256 + 1088 * 4 <= TBL_ROWS && TBL_ROWS + 6 * 1024 <= LDS_BYTES, "LDS tables");
static_assert(TBL_EB + 256 + 1088 * 4 <= LDS_BYTES, "LDS map");

struct Args { const float* in[25]; float* out; unsigned char* ws; int ph_lo, ph_hi; };
struct Frame {
    unsigned long long pacc, pt0;
    LAS unsigned char* lds; unsigned char* ldsg;
    volatile LAS unsigned* MISC; gu32* ctl;
    int vcu, G;
    unsigned char* ws; float* out;
};
template <class T> __device__ __forceinline__ T* uniform_ptr(T* p) { const unsigned long long v = (unsigned long long)p; const unsigned lo = __builtin_amdgcn_readfirstlane((unsigned)v), hi = __builtin_amdgcn_readfirstlane((unsigned)(v >> 32)); return (T*)(((unsigned long long)hi << 32) | lo); }
__device__ __forceinline__ float wave_sum(float v) {
#pragma unroll
    for (int o = 1; o < 64; o <<= 1) v += __shfl_xor(v, o);
    return v;
}
__device__ __forceinline__ float wave_max(float v) {
#pragma unroll
    for (int o = 1; o < 64; o <<= 1) v = fmaxf(v, __shfl_xor(v, o));
    return v;
}
__device__ __forceinline__ float bf2f(bf16 h) { return __uint_as_float(((unsigned)h) << 16); }
__device__ __forceinline__ float bflo(unsigned w) { return __uint_as_float(w << 16); }
__device__ __forceinline__ float bfhi(unsigned w) { return __uint_as_float(w & 0xffff0000u); }
__device__ __forceinline__ void unpack8(const v4u w, float* f) { f[0] = bflo(w.x); f[1] = bfhi(w.x); f[2] = bflo(w.y); f[3] = bfhi(w.y); f[4] = bflo(w.z); f[5] = bfhi(w.z); f[6] = bflo(w.w); f[7] = bfhi(w.w); }
__device__ __forceinline__ v4u pack8f(const float* f) { v4u w; w.x = pk2(f[0], f[1]); w.y = pk2(f[2], f[3]); w.z = pk2(f[4], f[5]); w.w = pk2(f[6], f[7]); return w; }
__device__ __forceinline__ int t5_bucket(int n) {
    if (n < 16) return n;
    int b = 16;
    b += (n >= 19) + (n >= 21) + (n >= 24) + (n >= 27) + (n >= 31) + (n >= 35) + (n >= 40) + (n >= 46) + (n >= 52) + (n >= 59) + (n >= 67) + (n >= 77) + (n >= 87) + (n >= 99) + (n >= 113);
    return b;
}

#ifndef PROBE_ACC
#define PROBE_ACC -1
#endif
#define PB(i) do { if ((i) == PROBE_ACC) F.pt0 = __builtin_amdgcn_s_memrealtime(); } while (0)
#define PE(i) do { if ((i) == PROBE_ACC) F.pacc += __builtin_amdgcn_s_memrealtime() - F.pt0; } while (0)
#define PHASE_IDS int tid = threadIdx.x; asm volatile("" : "+v"(tid)); const int lane = tid & 63; const int wave = __builtin_amdgcn_readfirstlane(tid >> 6); (void)lane; (void)wave
struct TrDesc { const float* src; const float* gain; bf16* dst; int ldw, K, k0; };
__device__ __forceinline__ void tr_load(const TrDesc& t, int lane, f32x4 (&v)[8]) {
#pragma unroll
    for (int i = 0; i < 8; ++i) { const int id = i * 64 + lane, kk = id >> 3, c4 = (id & 7) * 4; v[i] = *(const GAS f32x4*)(t.src + (size_t)(t.k0 + kk) * t.ldw + c4); }
}
__device__ __forceinline__ void tr_finish(const TrDesc& t, int lane, const f32x4 (&v)[8], LAS float* scr) {
#pragma unroll
    for (int i = 0; i < 8; ++i) { const int id = i * 64 + lane, kk = id >> 3, c4 = (id & 7) * 4; const float g = t.gain ? t.gain[t.k0 + kk] : 1.f; LAS float* p = scr + kk * 33 + c4; p[0] = v[i][0] * g; p[1] = v[i][1] * g; p[2] = v[i][2] * g; p[3] = v[i][3] * g; }
    LDS_WAIT(); asm volatile("" ::: "memory");
    const int c = lane & 7;
#pragma unroll
    for (int j = 0; j < 4; ++j) { const int n = (lane >> 3) + 8 * j; const LAS float* s2 = scr + (8 * c) * 33 + n;
        v4u o; o.x = pk2(s2[0 * 33], s2[1 * 33]); o.y = pk2(s2[2 * 33], s2[3 * 33]); o.z = pk2(s2[4 * 33], s2[5 * 33]); o.w = pk2(s2[6 * 33], s2[7 * 33]);
        *(GAS v4u*)(t.dst + (size_t)n * t.K + t.k0 + 8 * c) = o; }
    LDS_WAIT(); asm volatile("" ::: "memory");
}
__device__ __forceinline__ void tr_item_alpha(const float* w_in, const float* wau, const float* gain, bf16* dst, int k0, int n0, LAS float* scr, int lane) {
    const float* a = w_in + (size_t)(k0 + lane) * DIN + 1536; const f32x4 a0 = *(const GAS f32x4*)a, a1 = *(const GAS f32x4*)(a + 4), a2 = *(const GAS f32x4*)(a + 8), a3 = *(const GAS f32x4*)(a + 12);
    const float gk = gain[k0 + lane]; const float av[16] = {a0[0], a0[1], a0[2], a0[3], a1[0], a1[1], a1[2], a1[3], a2[0], a2[1], a2[2], a2[3], a3[0], a3[1], a3[2], a3[3]};
#pragma unroll 4
    for (int n = 0; n < 32; ++n) { float v = 0.f;
#pragma unroll
        for (int r = 0; r < 16; ++r) v += av[r] * wau[r * 256 + n0 + n];
        scr[lane * 33 + n] = v * gk; }
    LDS_WAIT(); asm volatile("" ::: "memory");
    const int c = lane & 7;
#pragma unroll
    for (int j = 0; j < 4; ++j) { const int n = (lane >> 3) + 8 * j; const LAS float* s = scr + (8 * c) * 33 + n;
        v4u o; o.x = pk2(s[0 * 33], s[1 * 33]); o.y = pk2(s[2 * 33], s[3 * 33]); o.z = pk2(s[4 * 33], s[5 * 33]); o.w = pk2(s[6 * 33], s[7 * 33]);
        *(GAS v4u*)(dst + (size_t)(n0 + n) * 1024 + k0 + 8 * c) = o; }
    LDS_WAIT(); asm volatile("" ::: "memory");
}
struct TrJob { int src, col0, ldw, gain, K  , ncols, drow; unsigned dst_off_kib; int kdst  , koff  ; };
__constant__ TrJob kJobs[15] = {
    {5, 0, DIN, 4, 1024, 256, 0, (unsigned)(WS_W1T / 1024), 1024, 0},
    {5, 256, DIN, 4, 1024, 256, 256, (unsigned)(WS_W1T / 1024), 1024, 0},
    {5, 1024, DIN, 4, 1024, 512, 512, (unsigned)(WS_W1T / 1024), 1024, 0},
    {5, 1552, DIN, 4, 1024, 512, 1280, (unsigned)(WS_W1T / 1024), 1024, 0},
    {5, 2064, DIN, 4, 1024, 512, 1792, (unsigned)(WS_W1T / 1024), 1024, 0},
    {5, 3088, DIN, 4, 1024, 1024, 2304, (unsigned)(WS_W1T / 1024), 1024, 0},
    {5, 4112, DIN, 4, 1024, 1024, 3328, (unsigned)(WS_W1T / 1024), 1024, 0},
    {5, 512, DIN, 4, 1024, 512, 0, (unsigned)(WS_WVT / 1024), 1024, 0},
    {5, 2576, DIN, 4, 1024, 512, 512, (unsigned)(WS_WVT / 1024), 1024, 0},
    {9, 0, 1024, -1, 512, 1024, 0, (unsigned)(WS_PGMT / 1024), 1024, 0},
    {10, 0, 1024, -1, 512, 1024, 0, (unsigned)(WS_PGMT / 1024), 1024, 512},
    {11, 0, 1024, -1, 1024, 1024, 0, (unsigned)(WS_WOUTT / 1024), 1024, 0},
    {13, 0, 512, 12, 1024, 512, 0, (unsigned)(WS_WCQT / 1024), 1024, 0},
    {14, 0, 1024, -1, 1024, 1024, 0, (unsigned)(WS_WCKVT / 1024), 1024, 0},
    {15, 0, 1024, -1, 512, 1024, 0, (unsigned)(WS_WCOT / 1024), 512, 0},
};

__device__ __forceinline__ void p0_prologue(Frame& F, const Args& A) {
    PHASE_IDS;
    LAS float* scr = (LAS float*)(F.lds + RING_OFF + wave * 16384);
    const int gw = F.vcu * NWAVES + wave, NGW = F.G * NWAVES;
    PB(20);
    int total = 0;
#pragma unroll 1
    for (int j = 0; j < 15; ++j) total += (kJobs[j].K / 64) * (kJobs[j].ncols / 32);
    const int alpha_items = 16 * 8;
#pragma unroll 1
    for (int it = gw; it < total + alpha_items; it += NGW) {
        if (it >= total) { const int r = it - total; tr_item_alpha(A.in[5], A.in[6], A.in[4], (bf16*)(F.ws + WS_W1T) + (size_t)1024 * 1024, (r >> 3) * 64, (r & 7) * 32, scr, lane); continue; }
        int r = it, j = 0;
#pragma unroll 1
        for (; j < 15; ++j) { const int n = (kJobs[j].K / 64) * (kJobs[j].ncols / 32); if (r < n) break; r -= n; }
        const TrJob jb = kJobs[j]; const int nblk = jb.ncols / 32, kb = r / nblk, nb = r % nblk;
        const TrDesc t{A.in[jb.src] + jb.col0 + nb * 32, jb.gain >= 0 ? A.in[jb.gain] : nullptr, (bf16*)(F.ws + (size_t)jb.dst_off_kib * 1024) + (size_t)(jb.drow + nb * 32) * jb.kdst + jb.koff, jb.ldw, jb.kdst, kb * 64};
        f32x4 v[8]; tr_load(t, lane, v); tr_finish(t, lane, v, scr);
    }
    PE(20); PB(21);
    { bf16* wrt = (bf16*)(F.ws + WS_WRT); const float* g = A.in[16]; const float* wg = A.in[17]; const float* we = A.in[19];
        for (int i = blockIdx.x * NTHR + tid; i < 2 * 256 * 1024; i += F.G * NTHR) { const int mat = i >> 18, o = (i >> 10) & 255, kk = i & 1023; unsigned v = 0;
            if (o < (mat ? 36 : 72)) { const int oo = o < 36 ? o : o - 36; const float w = g[kk] * (oo < 4 ? wg[kk * 4 + oo] : we[kk * 32 + oo - 4]); const unsigned hi = f2bf(w);
                v = o < 36 ? hi : f2bf(w - __uint_as_float(hi << 16)); }
            wrt[i] = (bf16)v; } }
    PE(21); PB(22);
    { const float* x = A.in[0]; bf16* xb = (bf16*)(F.ws + WS_XB); float* rstd0 = (float*)(F.ws + WS_RSTD0);
        int m = gw;
        if (m < M) { f32x4 v[4];
#pragma unroll
            for (int j = 0; j < 4; ++j) v[j] = ((const GAS f32x4*)(x + (size_t)m * D))[64 * j + lane];
#pragma unroll 1
            for (;;) { const int mn = m + NGW; const bool more = mn < M; f32x4 w[4];
                if (more) {
#pragma unroll
                    for (int j = 0; j < 4; ++j) w[j] = ((const GAS f32x4*)(x + (size_t)mn * D))[64 * j + lane]; }
                float s = 0.f;
#pragma unroll
                for (int j = 0; j < 4; ++j) s += (v[j].x * v[j].x + v[j].y * v[j].y) + (v[j].z * v[j].z + v[j].w * v[j].w);
                s = wave_sum(s); const float rs = rsqrtf(s * (1.f / D) + EPS);
                GAS unsigned long long* o8 = (GAS unsigned long long*)(xb + (size_t)m * D) + lane;
#pragma unroll
                for (int j = 0; j < 4; ++j) o8[64 * j] = (unsigned long long)pk2(v[j].x * rs, v[j].y * rs) | ((unsigned long long)pk2(v[j].z * rs, v[j].w * rs) << 32);
                if (!more) break;
                m = mn;
#pragma unroll
                for (int j = 0; j < 4; ++j) v[j] = w[j]; } } }
    PE(22); PB(23);
    { const float* mem = A.in[1]; const float* gm = A.in[2]; bf16* mn = (bf16*)(F.ws + WS_MEMN);
        for (int m = gw; m < 1024; m += NGW) { const GAS f32x4* xr = (const GAS f32x4*)(mem + (size_t)m * D) + lane; const GAS f32x4* gr = (const GAS f32x4*)gm + lane; f32x4 v[4]; float s = 0.f;
#pragma unroll
            for (int j = 0; j < 4; ++j) { v[j] = xr[64 * j]; s += (v[j].x * v[j].x + v[j].y * v[j].y) + (v[j].z * v[j].z + v[j].w * v[j].w); }
            s = wave_sum(s); const float rs = rsqrtf(s * (1.f / D) + EPS);
            GAS unsigned long long* o8 = (GAS unsigned long long*)(mn + (size_t)m * D) + lane;
#pragma unroll
            for (int j = 0; j < 4; ++j) { const f32x4 g = gr[64 * j]; o8[64 * j] = (unsigned long long)pk2(v[j].x * rs * g.x, v[j].y * rs * g.y) | ((unsigned long long)pk2(v[j].z * rs * g.z, v[j].w * rs * g.w) << 32); } } }
}
__device__ __forceinline__ TrDesc gu_item(const Args& A, unsigned char* ws, int it) {
    bf16* wgut = (bf16*)(ws + WS_WGUT); const int e = it >> 9, r = it & 511, up = r >> 8, rr = r & 255, kb = rr >> 4, nb = rr & 15, c0 = nb * 32;
    return TrDesc{A.in[up ? 22 : 21] + (size_t)e * 1024 * 512 + c0, A.in[16], wgut + ((size_t)e * 1024 + (c0 >> 7) * 256 + (c0 & 127) + up * 128) * 1024, 512, 1024, kb * 64};
}
__device__ __forceinline__ TrDesc dn_item(const Args& A, unsigned char* ws, int it) {
    bf16* wdt = (bf16*)(ws + WS_WDT); const int e = it >> 8, rr = it & 255, kb = rr >> 5, nb = rr & 31;
    return TrDesc{A.in[23] + (size_t)e * 512 * 1024 + nb * 32, nullptr, wdt + ((size_t)e * 1024 + nb * 32) * 512, 1024, 512, kb * 64};
}
__device__ __forceinline__ void expert_weights_gu(Frame& F, const Args& A) {
    PHASE_IDS;
    LAS float* scr = (LAS float*)(F.lds + RING_OFF + wave * 16384);
    const int gw = F.vcu * NWAVES + wave, NGW = F.G * NWAVES;
    int it = gw; if (it >= 16384) return;
    TrDesc cur = gu_item(A, F.ws, it); f32x4 v[8]; tr_load(cur, lane, v);
#pragma unroll 1
    for (;;) { const int nx = it + NGW; const bool more = nx < 16384;
        TrDesc nd = cur; f32x4 w[8];
        if (more) { nd = gu_item(A, F.ws, nx); tr_load(nd, lane, w); }
        tr_finish(cur, lane, v, scr);
        if (!more) break;
        cur = nd; it = nx;
#pragma unroll
        for (int i = 0; i < 8; ++i) v[i] = w[i]; }
}
__device__ __forceinline__ void expert_weights_dn(Frame& F, const Args& A, int li, int nl) {
    PHASE_IDS;
    if (li < 0) return;
    LAS float* scr = (LAS float*)(F.lds + RING_OFF + wave * 16384);
    const int gw = li * NWAVES + wave, NGW = nl * NWAVES;
    int it = gw; if (it >= 8192) return;
    TrDesc cur = dn_item(A, F.ws, it); f32x4 v[8]; tr_load(cur, lane, v);
#pragma unroll 1
    for (;;) { const int nx = it + NGW; const bool more = nx < 8192;
        TrDesc nd = cur; f32x4 w[8];
        if (more) { nd = dn_item(A, F.ws, nx); tr_load(nd, lane, w); }
        tr_finish(cur, lane, v, scr);
        if (!more) break;
        cur = nd; it = nx;
#pragma unroll
        for (int i = 0; i < 8; ++i) v[i] = w[i]; }
}

typedef short mb_bf16x8 __attribute__((ext_vector_type(8)));
typedef unsigned mb_u32x2 __attribute__((ext_vector_type(2)));
__device__ __forceinline__ unsigned mb_cvt_pk(float lo, float hi) { unsigned r; asm volatile("v_cvt_pk_bf16_f32 %0, %1, %2" : "=v"(r) : "v"(lo), "v"(hi)); return r; }
constexpr int GS = 65;
__device__ __forceinline__ void gla_load_b(Frame& F, int tid, const float* LA, int m0, int h, float* Bs) {
#pragma unroll 1
    for (int i = tid; i < 4096; i += NTHR) { const int c = i >> 6, d = i & 63; Bs[c * GS + d] = LA[(size_t)(m0 + c) * 256 + h * 64 + d]; }
    __syncthreads();
    if (tid < 64) { float s = 0.f;
#pragma unroll 8
        for (int c = 0; c < 64; ++c) { s += Bs[c * GS + tid]; Bs[c * GS + tid] = s; } }
    __syncthreads();
}
constexpr int GL_STR = 144;
__device__ __forceinline__ void gla_a_phase(Frame& F) {
    PHASE_IDS;
    LAS float* tot = (LAS float*)(F.lds + RING_OFF); LAS unsigned char* Kt = F.lds + RING_OFF + 2048;
    const float* LA = (const float*)((unsigned char*)F.out + DO_LA); float* ST = (float*)((unsigned char*)F.out + DO_ST);
    const bf16* KG = (const bf16*)(F.ws + WS_KG); const bf16* VT = (const bf16*)(F.ws + WS_VT); float* DEC = (float*)(F.ws + WS_DEC); float* EMID = (float*)(F.ws + WS_EMID);
    const int d = tid & 63, seg = wave, lq = lane & 15, g = lane >> 4;
#pragma unroll 1
    for (int u = blockIdx.x; u < 2048; u += F.G) {
        const int bh = u >> 7, n = u & 127, b = bh >> 2, h = bh & 3, m0 = b * SEQ + n * 64;
        float a[8], kk[8];
#pragma unroll
        for (int i = 0; i < 8; ++i) { const size_t gi = (size_t)(m0 + seg * 8 + i) * 256 + h * 64 + d; a[i] = LA[gi]; kk[i] = bf2f(KG[gi]); }
#pragma unroll
        for (int i = 1; i < 8; ++i) a[i] += a[i - 1];
        tot[seg * 64 + d] = a[7];
        __syncthreads();
        float off = 0.f, total = 0.f;
#pragma unroll
        for (int s2 = 0; s2 < 8; ++s2) { const float t = tot[s2 * 64 + d]; if (s2 < seg) off += t; total += t; }
        { v4u w; float e[8];
#pragma unroll
            for (int i = 0; i < 8; ++i) e[i] = kk[i] * __expf(total - (off + a[i]));
            w.x = pk2(e[0], e[1]); w.y = pk2(e[2], e[3]); w.z = pk2(e[4], e[5]); w.w = pk2(e[6], e[7]);
            *(LAS v4u*)(Kt + d * GL_STR + seg * 16) = w; }
        if (seg == 0) { DEC[u * 64 + d] = __expf(total); EMID[u * 64 + d] = __expf((tot[d] + tot[64 + d]) + (tot[128 + d] + tot[192 + d])); }
        __syncthreads();
        { mb_bf16x8 bf[2];
#pragma unroll
            for (int ks = 0; ks < 2; ++ks) bf[ks] = *(const GAS mb_bf16x8*)(VT + (size_t)(h * 128 + wave * 16 + lq) * M + m0 + 32 * ks + 8 * g);
#pragma unroll
            for (int dt = 0; dt < 4; ++dt) { f32x4 acc = (f32x4){0.f, 0.f, 0.f, 0.f};
#pragma unroll
                for (int ks = 0; ks < 2; ++ks) { const mb_bf16x8 af = *(const LAS mb_bf16x8*)(Kt + (dt * 16 + lq) * GL_STR + ks * 64 + g * 16); acc = __builtin_amdgcn_mfma_f32_16x16x32_bf16(af, bf[ks], acc, 0, 0, 0); }
                *(GAS f32x4*)(ST + ((size_t)u * 128 + wave * 16 + lq) * 64 + dt * 16 + 4 * g) = acc; } }
        __syncthreads();
    }
}
__device__ __forceinline__ void gla_scan_phase(Frame& F) {
    PHASE_IDS;
    const float* ST = (const float*)((unsigned char*)F.out + DO_ST); bf16* SB = (bf16*)((unsigned char*)F.out + DO_SB); const float* DEC = (const float*)(F.ws + WS_DEC); const float* EMID = (const float*)(F.ws + WS_EMID);
#pragma unroll 1
    for (int g = blockIdx.x * NTHR + tid; g < 16 * 8192; g += F.G * NTHR) { const int bh = g >> 13, vd = g & 8191, d = vd & 63; float st = 0.f;
        const float* p = ST + (size_t)bh * 128 * 8192 + vd; bf16* q = SB + (size_t)bh * 128 * 8192 + vd; const float* dc = DEC + bh * 128 * 64 + d; const float* em = EMID + bh * 128 * 64 + d;
#pragma unroll 1
        for (int n0 = 0; n0 < 128; n0 += 16) { float kv[16], de[16], ee[16];
#pragma unroll
            for (int i = 0; i < 16; ++i) { kv[i] = p[(size_t)(n0 + i) * 8192]; de[i] = dc[(n0 + i) * 64]; ee[i] = em[(n0 + i) * 64]; }
#pragma unroll
            for (int i = 0; i < 16; ++i) { q[(size_t)(n0 + i) * 8192] = (bf16)f2bf(st * ee[i]); st = de[i] * st + kv[i]; } } }
}
constexpr int GB_TOT = 0, GB_QE = 2048, GB_KE = GB_QE + 64 * GL_STR, GB_VT = GB_KE + 64 * GL_STR, GB_SB = GB_VT + 128 * GL_STR, GB_UNIT = GB_SB + 128 * GL_STR;
static_assert(2 * GB_UNIT <= RING_BYTES && GB_UNIT % 16 == 0, "GLA-B LDS");
typedef float gb_f32x2 __attribute__((ext_vector_type(2)));
__device__ __forceinline__ void gla_b_phase(Frame& F, const Args& A) {
    PHASE_IDS;
    const float* LA = (const float*)((unsigned char*)F.out + DO_LA); const bf16* SB = (const bf16*)((unsigned char*)F.out + DO_SB);
    const bf16* QG = (const bf16*)(F.ws + WS_QG); const bf16* KG = (const bf16*)(F.ws + WS_KG); const bf16* VT = (const bf16*)(F.ws + WS_VT); const bf16* SR = (const bf16*)(F.ws + WS_SR);
    bf16* OG = (bf16*)(F.ws + WS_OGM); const float* gg = A.in[8];
    const int U = wave >> 2, lt = tid & 255, dp = lt & 31, seg = lt >> 5, lq = lane & 15, g = lane >> 4, ct = wave & 3;
    LAS unsigned char* base = F.lds + RING_OFF + U * GB_UNIT;
    LAS float* tot = (LAS float*)(base + GB_TOT); LAS unsigned char* Qe = base + GB_QE; LAS unsigned char* Ke = base + GB_KE; LAS unsigned char* Vt = base + GB_VT; LAS unsigned char* Sb = base + GB_SB;
    gb_f32x2 a[8]; unsigned q2[8], k2[8]; v4u vc[4], sc[4];
#define GB_LOAD(PR_) do { const int u_ = 2 * (PR_) + U, bh_ = u_ >> 7, n_ = u_ & 127, b_ = bh_ >> 2, h_ = bh_ & 3, m0_ = b_ * SEQ + n_ * 64; \
        _Pragma("unroll") for (int i = 0; i < 8; ++i) { const size_t gi = (size_t)(m0_ + seg * 8 + i) * 256 + h_ * 64 + 2 * dp; a[i] = *(const GAS gb_f32x2*)(LA + gi); q2[i] = *(const GAS unsigned*)(QG + gi); k2[i] = *(const GAS unsigned*)(KG + gi); } \
        _Pragma("unroll") for (int i = 0; i < 4; ++i) { const int ch = lt + i * 256, v = ch >> 3, c8 = ch & 7; vc[i] = *(const GAS v4u*)(VT + (size_t)(h_ * 128 + v) * M + m0_ + c8 * 8); sc[i] = *(const GAS v4u*)(SB + ((size_t)u_ * 128 + v) * 64 + c8 * 8); } } while (0)
    int pr = blockIdx.x;
    if (pr < 1024) GB_LOAD(pr);
#pragma unroll 1
    for (; pr < 1024; pr += F.G) {
        const int u = 2 * pr + U, bh = u >> 7, n = u & 127, b = bh >> 2, h = bh & 3, m0 = b * SEQ + n * 64;
#pragma unroll
        for (int i = 1; i < 8; ++i) a[i] += a[i - 1];
        *(LAS gb_f32x2*)(tot + seg * 64 + 2 * dp) = a[7];
#pragma unroll
        for (int i = 0; i < 4; ++i) { const int ch = lt + i * 256, v = ch >> 3, c8 = ch & 7; *(LAS v4u*)(Vt + v * GL_STR + c8 * 16) = vc[i]; *(LAS v4u*)(Sb + v * GL_STR + c8 * 16) = sc[i]; }
        __syncthreads();
        { gb_f32x2 off = (gb_f32x2){0.f, 0.f}, bmid = (gb_f32x2){0.f, 0.f};
#pragma unroll
            for (int s2 = 0; s2 < 7; ++s2) { const gb_f32x2 t = *(const LAS gb_f32x2*)(tot + s2 * 64 + 2 * dp); if (s2 < seg) off += t; if (s2 < 4) bmid += t; }
#pragma unroll
            for (int i = 0; i < 8; ++i) { const int c = seg * 8 + i; const gb_f32x2 bb = off + a[i];
                *(LAS unsigned*)(Qe + c * GL_STR + dp * 4) = mb_cvt_pk(bflo(q2[i]) * __expf(bb.x - bmid.x), bfhi(q2[i]) * __expf(bb.y - bmid.y));
                *(LAS unsigned*)(Ke + c * GL_STR + dp * 4) = mb_cvt_pk(bflo(k2[i]) * __expf(bmid.x - bb.x), bfhi(k2[i]) * __expf(bmid.y - bb.y)); } }
        __syncthreads();
        if (pr + F.G < 1024) GB_LOAD(pr + F.G);
        {
            const size_t mrow = (size_t)(m0 + ct * 16 + lq) * 512 + h * 128;
            mb_u32x2 srv[8];
#pragma unroll
            for (int vt = 0; vt < 8; ++vt) srv[vt] = *(const GAS mb_u32x2*)(SR + mrow + vt * 16 + 4 * g);
            mb_bf16x8 bq[2];
#pragma unroll
            for (int ks = 0; ks < 2; ++ks) bq[ks] = *(const LAS mb_bf16x8*)(Qe + (ct * 16 + lq) * GL_STR + ks * 64 + g * 16);
            f32x4 sa[4];
#pragma unroll
            for (int st = 0; st < 4; ++st) { sa[st] = (f32x4){0.f, 0.f, 0.f, 0.f};
                if (st <= ct) {
#pragma unroll
                    for (int ks = 0; ks < 2; ++ks) { const mb_bf16x8 af = *(const LAS mb_bf16x8*)(Ke + (st * 16 + lq) * GL_STR + ks * 64 + g * 16); sa[st] = __builtin_amdgcn_mfma_f32_16x16x32_bf16(af, bq[ks], sa[st], 0, 0, 0); }
                    if (st == ct) {
#pragma unroll
                        for (int r = 0; r < 4; ++r) if (4 * g + r > lq) sa[st][r] = 0.f; } } }
            mb_bf16x8 pb[2];
#pragma unroll
            for (int kp = 0; kp < 2; ++kp) { v4u pw; pw.x = mb_cvt_pk(sa[2 * kp][0], sa[2 * kp][1]); pw.y = mb_cvt_pk(sa[2 * kp][2], sa[2 * kp][3]); pw.z = mb_cvt_pk(sa[2 * kp + 1][0], sa[2 * kp + 1][1]); pw.w = mb_cvt_pk(sa[2 * kp + 1][2], sa[2 * kp + 1][3]); pb[kp] = __builtin_bit_cast(mb_bf16x8, pw); }
            f32x4 o[8]; float ss = 0.f;
#pragma unroll
            for (int vt = 0; vt < 8; ++vt) { o[vt] = (f32x4){0.f, 0.f, 0.f, 0.f};
#pragma unroll
                for (int kp = 0; kp < 2; ++kp) if (2 * kp <= ct) { const mb_u32x2 a0 = *(const LAS mb_u32x2*)(Vt + (vt * 16 + lq) * GL_STR + kp * 64 + g * 8), a1 = *(const LAS mb_u32x2*)(Vt + (vt * 16 + lq) * GL_STR + kp * 64 + 32 + g * 8);
                    v4u aw; aw.x = a0.x; aw.y = a0.y; aw.z = a1.x; aw.w = a1.y; o[vt] = __builtin_amdgcn_mfma_f32_16x16x32_bf16(__builtin_bit_cast(mb_bf16x8, aw), pb[kp], o[vt], 0, 0, 0); }
#pragma unroll
                for (int ks = 0; ks < 2; ++ks) { const mb_bf16x8 af = *(const LAS mb_bf16x8*)(Sb + (vt * 16 + lq) * GL_STR + ks * 64 + g * 16); o[vt] = __builtin_amdgcn_mfma_f32_16x16x32_bf16(af, bq[ks], o[vt], 0, 0, 0); }
                ss += (o[vt][0] * o[vt][0] + o[vt][1] * o[vt][1]) + (o[vt][2] * o[vt][2] + o[vt][3] * o[vt][3]); }
            ss += __shfl_xor(ss, 16); ss += __shfl_xor(ss, 32);
            const float rs = rsqrtf(ss * (1.f / 128.f) + EPS);
#pragma unroll
            for (int vt = 0; vt < 8; ++vt) { const int v = vt * 16 + 4 * g; const f32x4 gv = *(const GAS f32x4*)(gg + h * 128 + v); const mb_u32x2 sr = srv[vt];
                mb_u32x2 w; w.x = mb_cvt_pk(o[vt][0] * rs * gv[0] * bflo(sr.x), o[vt][1] * rs * gv[1] * bfhi(sr.x)); w.y = mb_cvt_pk(o[vt][2] * rs * gv[2] * bflo(sr.y), o[vt][3] * rs * gv[3] * bfhi(sr.y));
                *(GAS mb_u32x2*)(OG + (size_t)(m0 + ct * 16 + lq) * 1024 + h * 128 + v) = w; } }
        __syncthreads();
    }
#undef GB_LOAD
}

__device__ __forceinline__ int list_off(int j) { return 256 * (31 * j - (j * (j - 1)) / 2); }
__device__ __forceinline__ void moba_kmean_phase(Frame& F) {
    PHASE_IDS;
    float* lf = (float*)(F.ldsg + RING_OFF); float* part = lf; float* pmx = lf + 512;
    const bf16* KM = (const bf16*)(F.ws + WS_KM); float* kmean = (float*)(F.ws + WS_KMEAN); float* knmax = (float*)(F.ws + WS_KNMAX);
    const int c8 = tid & 7, r0 = tid >> 3;
#pragma unroll 1
    for (int u = blockIdx.x; u < 1024; u += F.G) { const int bh = u >> 5, j = u & 31, b = bh >> 3, h = bh & 7; const size_t m0 = (size_t)b * SEQ + j * 256;
        v4u w[4];
#pragma unroll
        for (int i = 0; i < 4; ++i) w[i] = *(const GAS v4u*)(KM + (m0 + r0 + 64 * i) * 512 + h * 64 + c8 * 8);
        float acc[8]; float mx = 0.f;
#pragma unroll
        for (int e = 0; e < 8; ++e) acc[e] = 0.f;
#pragma unroll
        for (int i = 0; i < 4; ++i) { float f[8]; unpack8(w[i], f); float q = 0.f;
#pragma unroll
            for (int e = 0; e < 8; ++e) { acc[e] += f[e]; q += f[e] * f[e]; }
            q += __shfl_xor(q, 1); q += __shfl_xor(q, 2); q += __shfl_xor(q, 4); mx = fmaxf(mx, q); }
#pragma unroll
        for (int e = 0; e < 8; ++e) { acc[e] += __shfl_xor(acc[e], 8); acc[e] += __shfl_xor(acc[e], 16); acc[e] += __shfl_xor(acc[e], 32); }
        mx = wave_max(mx);
        if (lane < 8) {
#pragma unroll
            for (int e = 0; e < 8; ++e) part[wave * 64 + lane * 8 + e] = acc[e]; }
        if (lane == 0) pmx[wave] = mx;
        __syncthreads();
        if (tid < 64) { float t = 0.f;
#pragma unroll
            for (int w2 = 0; w2 < 8; ++w2) t += part[w2 * 64 + tid];
            kmean[u * 64 + tid] = t * (1.f / 256.f); }
        if (tid == 0) { float t = 0.f;
#pragma unroll
            for (int w2 = 0; w2 < 8; ++w2) t = fmaxf(t, pmx[w2]);
            knmax[u] = sqrtf(t); }
        __syncthreads();
    }
}
__device__ __forceinline__ void moba_gate_phase(Frame& F, const Args& A) {
    PHASE_IDS;
    LAS unsigned char* kmh = F.lds + RING_OFF; LAS unsigned char* kml = kmh + 32 * 144;
    float* lf = (float*)(F.ldsg + RING_OFF + 2 * 32 * 144); float* knm = lf; unsigned* hist = (unsigned*)(lf + 32); unsigned* hbase = hist + 32;
    const bf16* QM = (const bf16*)(F.ws + WS_QM); const float* kmean = (const float*)(F.ws + WS_KMEAN); const float* knmax = (const float*)(F.ws + WS_KNMAX);
    unsigned* SEL = (unsigned*)(F.ws + WS_SEL); float* REFS = (float*)(F.ws + WS_REFS); unsigned* LISTS = (unsigned*)(F.ws + WS_LISTS); const float* rb = A.in[3];
    const int lq = lane & 15, g = lane >> 4;
#pragma unroll 1
    for (int u = blockIdx.x, kk = 0; u < 1024; u += F.G, ++kk) { const int bh = u >> 5, qx = (kk & 2) ? ((u & 31) + 16) & 31 : (u & 31), qb = (kk & 1) ? 31 - qx : qx, b = bh >> 3, h = bh & 7;
        { const int j = tid >> 4, c4 = (tid & 15) * 4; const f32x4 v = *(const GAS f32x4*)(kmean + bh * 2048 + j * 64 + c4);
            const unsigned h0 = f2bf(v[0]), h1 = f2bf(v[1]), h2 = f2bf(v[2]), h3 = f2bf(v[3]);
            *(LAS mb_u32x2*)(kmh + j * 144 + c4 * 2) = (mb_u32x2){h0 | (h1 << 16), h2 | (h3 << 16)};
            *(LAS mb_u32x2*)(kml + j * 144 + c4 * 2) = (mb_u32x2){pk2(v[0] - __uint_as_float(h0 << 16), v[1] - __uint_as_float(h1 << 16)), pk2(v[2] - __uint_as_float(h2 << 16), v[3] - __uint_as_float(h3 << 16))}; }
        if (tid < 32) { knm[tid] = knmax[bh * 32 + tid]; hist[tid] = 0u; }
        __syncthreads();
        float bmx = rb[h];
#pragma unroll 1
        for (int k = 1; k < 32; ++k) bmx = fmaxf(bmx, rb[k * 8 + h]);
        const int nsel = qb < 3 ? qb : 3;
        int sel0[2], sel1[2], sel2[2]; unsigned rk0[2], rk1[2], rk2[2];
#pragma unroll
        for (int qt = 0; qt < 2; ++qt) { const int qi = (wave * 2 + qt) * 16 + lq, t = qb * 256 + qi; const size_t m = (size_t)b * SEQ + t;
            mb_bf16x8 qf[2]; qf[0] = *(const GAS mb_bf16x8*)(QM + m * 512 + h * 64 + 8 * g); qf[1] = *(const GAS mb_bf16x8*)(QM + m * 512 + h * 64 + 32 + 8 * g);
            float qn = 0.f;
#pragma unroll
            for (int ks = 0; ks < 2; ++ks) { const v4u w = __builtin_bit_cast(v4u, qf[ks]); float f[8]; unpack8(w, f);
#pragma unroll
                for (int e = 0; e < 8; ++e) qn += f[e] * f[e]; }
            qn += __shfl_xor(qn, 16); qn += __shfl_xor(qn, 32); qn = sqrtf(qn);
            f32x4 sc[2];
#pragma unroll
            for (int jt = 0; jt < 2; ++jt) { sc[jt] = (f32x4){0.f, 0.f, 0.f, 0.f};
#pragma unroll
                for (int ks = 0; ks < 2; ++ks) { const mb_bf16x8 ah = *(const LAS mb_bf16x8*)(kmh + (jt * 16 + lq) * 144 + ks * 64 + g * 16), al = *(const LAS mb_bf16x8*)(kml + (jt * 16 + lq) * 144 + ks * 64 + g * 16);
                    sc[jt] = __builtin_amdgcn_mfma_f32_16x16x32_bf16(ah, qf[ks], sc[jt], 0, 0, 0); sc[jt] = __builtin_amdgcn_mfma_f32_16x16x32_bf16(al, qf[ks], sc[jt], 0, 0, 0); } }
            float v0 = -INFINITY, v1 = -INFINITY, v2 = -INFINITY; int i0 = 0, i1 = 0, i2 = 0;
#define TOP3_INS(G_, J_) do { const float g_ = (G_); const int j_ = (J_); if (g_ > v0) { v2 = v1; i2 = i1; v1 = v0; i1 = i0; v0 = g_; i0 = j_; } else if (g_ > v1) { v2 = v1; i2 = i1; v1 = g_; i1 = j_; } else if (g_ > v2) { v2 = g_; i2 = j_; } } while (0)
#pragma unroll
            for (int jt = 0; jt < 2; ++jt)
#pragma unroll
                for (int r = 0; r < 4; ++r) { const int j = jt * 16 + 4 * g + r; const float gv = j < qb ? sc[jt][r] : -INFINITY; TOP3_INS(gv, j); }
#pragma unroll
            for (int mk = 16; mk <= 32; mk <<= 1) { const float p0 = __shfl_xor(v0, mk), p1 = __shfl_xor(v1, mk), p2 = __shfl_xor(v2, mk); const int j0 = __shfl_xor(i0, mk), j1 = __shfl_xor(i1, mk), j2 = __shfl_xor(i2, mk);
                TOP3_INS(p0, j0); TOP3_INS(p1, j1); TOP3_INS(p2, j2); }
#undef TOP3_INS
            sel0[qt] = i0; sel1[qt] = i1; sel2[qt] = i2; rk0[qt] = 0; rk1[qt] = 0; rk2[qt] = 0;
            if (g == 0) {
                float kx = knm[qb]; if (nsel > 0) kx = fmaxf(kx, knm[i0]); if (nsel > 1) kx = fmaxf(kx, knm[i1]); if (nsel > 2) kx = fmaxf(kx, knm[i2]);
                SEL[m * 8 + h] = (unsigned)i0 | ((unsigned)i1 << 5) | ((unsigned)i2 << 10) | ((unsigned)nsel << 15);
                REFS[m * 8 + h] = qn * kx + bmx * 1.4426950408889634f;
                if (nsel > 0) rk0[qt] = __hip_atomic_fetch_add(hist + i0, 1u, __ATOMIC_RELAXED, __HIP_MEMORY_SCOPE_WORKGROUP);
                if (nsel > 1) rk1[qt] = __hip_atomic_fetch_add(hist + i1, 1u, __ATOMIC_RELAXED, __HIP_MEMORY_SCOPE_WORKGROUP);
                if (nsel > 2) rk2[qt] = __hip_atomic_fetch_add(hist + i2, 1u, __ATOMIC_RELAXED, __HIP_MEMORY_SCOPE_WORKGROUP); } }
        __syncthreads();
        if (tid < qb) { const unsigned c = hist[tid]; hbase[tid] = c ? atomicAdd((unsigned*)(F.ctl + CW_LCNT) + bh * 32 + tid, c) : 0u; }
        __syncthreads();
        if (g == 0) { unsigned* lb = LISTS + (size_t)bh * LIST_CAP;
#pragma unroll
            for (int qt = 0; qt < 2; ++qt) { const unsigned tq = (unsigned)(qb * 256 + (wave * 2 + qt) * 16 + lq);
                if (nsel > 0) lb[list_off(sel0[qt]) + hbase[sel0[qt]] + rk0[qt]] = (tq << 2);
                if (nsel > 1) lb[list_off(sel1[qt]) + hbase[sel1[qt]] + rk1[qt]] = (tq << 2) | 1u;
                if (nsel > 2) lb[list_off(sel2[qt]) + hbase[sel2[qt]] + rk2[qt]] = (tq << 2) | 2u; } }
        __syncthreads();
    }
}
constexpr size_t PARTO_N1 = 524288;
constexpr int MB_KSTR = 144, MB_VSTR = 528, MB_KBYTES = 256 * MB_KSTR, MB_VBYTES = 80 * MB_VSTR, MB_TABX = MB_KBYTES + MB_VBYTES, MB_TABN = 768;
static_assert(MB_TABX + MB_TABN * 4 <= RING_BYTES, "MoBA LDS");
__device__ __forceinline__ void moba_stage_const(int tid, LAS unsigned char* Vl) {
    for (int i = tid; i < 16 * 32; i += NTHR) { const int r = i >> 5, c = i & 31; const unsigned w = r == 0 ? 0x3f803f80u : 0u; *(LAS v4u*)(Vl + (64 + r) * MB_VSTR + c * 16) = (v4u){w, w, w, w}; }
}
struct MobaStage { v4u kv[4], vv[4]; float tb[2]; };
__device__ __forceinline__ void moba_kv_load(Frame& F, int tid, const Args& A, int b, int h, int j, MobaStage& st) {
    const bf16* KM = (const bf16*)(F.ws + WS_KM); const bf16* VT = (const bf16*)(F.ws + WS_VT);
    const size_t mk = (size_t)b * SEQ + j * 256;
#pragma unroll
    for (int i = 0; i < 4; ++i) { const int ch = tid + i * NTHR, key = ch >> 3, c = ch & 7; st.kv[i] = *(const GAS v4u*)(KM + (mk + key) * 512 + h * 64 + c * 8); }
#pragma unroll
    for (int i = 0; i < 4; ++i) { const int ch = tid + i * NTHR, d = ch >> 5, c = ch & 31; st.vv[i] = *(const GAS v4u*)(VT + (size_t)(512 + h * 64 + d) * M + mk + c * 8); }
#pragma unroll
    for (int i = 0; i < 2; ++i) { const int idx = tid + i * NTHR, dist = idx - 255; st.tb[i] = (idx < MB_TABN && dist >= 0) ? A.in[3][t5_bucket(dist < 127 ? dist : 127) * 8 + h] * 1.4426950408889634f : -INFINITY; }
}
__device__ __forceinline__ void moba_kv_store(int tid, const MobaStage& st, LAS unsigned char* Kl, LAS unsigned char* Vl, LAS float* tabx) {
#pragma unroll
    for (int i = 0; i < 4; ++i) { const int ch = tid + i * NTHR, key = ch >> 3, c = ch & 7; *(LAS v4u*)(Kl + key * MB_KSTR + c * 16) = st.kv[i]; }
#pragma unroll
    for (int i = 0; i < 4; ++i) { const int ch = tid + i * NTHR, d = ch >> 5, c = ch & 31; *(LAS v4u*)(Vl + d * MB_VSTR + c * 16) = st.vv[i]; }
#pragma unroll
    for (int i = 0; i < 2; ++i) { const int idx = tid + i * NTHR; if (idx < MB_TABN) tabx[idx] = st.tb[i]; }
}
__device__ __forceinline__ void moba_stage_kv(Frame& F, int tid, const Args& A, int b, int h, int j, LAS unsigned char* Kl, LAS unsigned char* Vl, LAS float* tabx) {
    MobaStage st; moba_kv_load(F, tid, A, b, h, j, st); moba_kv_store(tid, st, Kl, Vl, tabx);
}
template <int NG>
__device__ __forceinline__ void moba_groups(const LAS unsigned char* Kl, const LAS unsigned char* Vl, const LAS float* tabx, const mb_bf16x8 (&qf)[NG][2], const float (&ref)[NG], const int (&qrel)[NG],
                                            const int (&ntile)[NG], const bool (&far)[NG], f32x4 (&o)[NG][5], int lane) {
    const int lq = lane & 15, g = lane >> 4;
    int nmax = ntile[0];
#pragma unroll
    for (int gi = 1; gi < NG; ++gi) nmax = ntile[gi] > nmax ? ntile[gi] : nmax;
    const LAS unsigned char* kp = Kl + lq * MB_KSTR + g * 16;
    const LAS unsigned char* vp = Vl + lq * MB_VSTR + g * 8;
#pragma unroll
    for (int hf = 0; hf < 2; ++hf) { if (8 * hf < nmax) {
        f32x4 sa[NG][8];
#pragma unroll
        for (int gi = 0; gi < NG; ++gi) {
            if (far[gi]) { const float c = tabx[255 + 127] - ref[gi];
#pragma unroll
                for (int t = 0; t < 8; ++t) sa[gi][t] = (f32x4){c, c, c, c}; }
            else { const int qc = qrel[gi] < 511 ? qrel[gi] : 511; const LAS float* lb = tabx + (qc - 4 * g + 12);
#pragma unroll
                for (int t = 0; t < 8; ++t) { sa[gi][t] = (f32x4){0.f, 0.f, 0.f, 0.f};
                    if (8 * hf + t < ntile[gi]) {
#pragma unroll
                        for (int r = 0; r < 4; ++r) sa[gi][t][r] = lb[243 - 16 * (8 * hf + t) - r] - ref[gi]; } } } }
#pragma unroll
        for (int t = 0; t < 8; ++t) { const int T = 8 * hf + t; if (T < nmax) {
                const mb_bf16x8 k0 = *(const LAS mb_bf16x8*)(kp + T * 16 * MB_KSTR), k1 = *(const LAS mb_bf16x8*)(kp + T * 16 * MB_KSTR + 64);
#pragma unroll
                for (int gi = 0; gi < NG; ++gi) if (T < ntile[gi]) { sa[gi][t] = __builtin_amdgcn_mfma_f32_16x16x32_bf16(k0, qf[gi][0], sa[gi][t], 0, 0, 0); sa[gi][t] = __builtin_amdgcn_mfma_f32_16x16x32_bf16(k1, qf[gi][1], sa[gi][t], 0, 0, 0); } } }
#pragma unroll
        for (int gi = 0; gi < NG; ++gi)
#pragma unroll
            for (int t = 0; t < 8; ++t) { if (8 * hf + t < ntile[gi]) {
#pragma unroll
                    for (int r = 0; r < 4; ++r) sa[gi][t][r] = __builtin_amdgcn_exp2f(sa[gi][t][r]); } }
#pragma unroll
        for (int k2 = 0; k2 < 4; ++k2) { const int ks = 4 * hf + k2; if (2 * ks < nmax) {
                mb_bf16x8 pb[NG];
#pragma unroll
                for (int gi = 0; gi < NG; ++gi) { v4u pw; pw.x = mb_cvt_pk(sa[gi][2 * k2][0], sa[gi][2 * k2][1]); pw.y = mb_cvt_pk(sa[gi][2 * k2][2], sa[gi][2 * k2][3]); pw.z = mb_cvt_pk(sa[gi][2 * k2 + 1][0], sa[gi][2 * k2 + 1][1]); pw.w = mb_cvt_pk(sa[gi][2 * k2 + 1][2], sa[gi][2 * k2 + 1][3]); pb[gi] = __builtin_bit_cast(mb_bf16x8, pw); }
#pragma unroll
                for (int dt = 0; dt < 5; ++dt) { const mb_u32x2 a0 = *(const LAS mb_u32x2*)(vp + dt * 16 * MB_VSTR + ks * 64), a1 = *(const LAS mb_u32x2*)(vp + dt * 16 * MB_VSTR + ks * 64 + 32);
                    v4u aw; aw.x = a0.x; aw.y = a0.y; aw.z = a1.x; aw.w = a1.y; const mb_bf16x8 af = __builtin_bit_cast(mb_bf16x8, aw);
#pragma unroll
                    for (int gi = 0; gi < NG; ++gi) if (2 * ks < ntile[gi]) o[gi][dt] = __builtin_amdgcn_mfma_f32_16x16x32_bf16(af, pb[gi], o[gi][dt], 0, 0, 0); } } } } }
}
__device__ __forceinline__ void moba_part_phase(Frame& F, const Args& A, int wq_word) {
    PHASE_IDS;
    LAS unsigned char* Kl = F.lds + RING_OFF; LAS unsigned char* Vl = Kl + MB_KBYTES; LAS float* tabx = (LAS float*)(F.lds + RING_OFF + MB_TABX); volatile LAS int* bc = (volatile LAS int*)(F.lds + TBL_BC);
    const bf16* QM = (const bf16*)(F.ws + WS_QM); const float* REFS = (const float*)(F.ws + WS_REFS); const unsigned* LISTS = (const unsigned*)(F.ws + WS_LISTS);
    bf16* PARTO0 = (bf16*)((unsigned char*)F.out + DO_PARTO); bf16* PARTO1 = (bf16*)(F.ws + WS_XB); float* PARTL = (float*)(F.ws + WS_PARTL);
    const int lq = lane & 15, g = lane >> 4;
    moba_stage_const(tid, Vl);
#pragma unroll 1
    for (;;) {
        PB(5); PB(8);
        if (tid == 0) bc[0] = (int)atomicAdd((unsigned*)(F.ctl + wq_word), 1u);
        __syncthreads();
        const int u = __builtin_amdgcn_readfirstlane(bc[0]);
        __syncthreads();
        if (u >= 31 * 32) break;
        const int j = u >> 5, bh = u & 31, b = bh >> 3, h = bh & 7;
        const int n = __builtin_amdgcn_readfirstlane((int)__hip_atomic_load((unsigned*)(F.ctl + CW_LCNT) + bh * 32 + j, RLX_AGENT));
        moba_stage_kv(F, tid, A, b, h, j, Kl, Vl, tabx);
        __syncthreads(); PE(5); PB(6);
        const unsigned* lst = LISTS + (size_t)bh * LIST_CAP + list_off(j);
#define MB_IDX(G_) (((G_) * 16 + lq < n) ? (G_) * 16 + lq : (((G_) * 16 < n) ? (G_) * 16 : 0))
#define MB_LOADQ(E_, Q_, R_) do { const size_t m_ = (size_t)b * SEQ + ((E_) >> 2); const bf16* qrow_ = QM + m_ * 512 + h * 64; Q_[0] = *(const GAS mb_bf16x8*)(qrow_ + 8 * g); Q_[1] = *(const GAS mb_bf16x8*)(qrow_ + 32 + 8 * g); R_ = REFS[m_ * 8 + h]; } while (0)
        int pr = wave;
        if (pr * 32 < n) {
            unsigned ea[2];
            ea[0] = lst[MB_IDX(2 * pr)]; ea[1] = lst[MB_IDX(2 * pr + 1)];
#pragma unroll 1
            for (;;) {
                unsigned eb[2]; eb[0] = lst[MB_IDX(2 * pr + 2 * NWAVES)]; eb[1] = lst[MB_IDX(2 * pr + 2 * NWAVES + 1)];
                mb_bf16x8 qa[2][2]; float ra[2];
                MB_LOADQ(ea[0], qa[0], ra[0]); MB_LOADQ(ea[1], qa[1], ra[1]);
                int qrel[2], nt[2]; bool far[2];
#pragma unroll
                for (int gi = 0; gi < 2; ++gi) { qrel[gi] = (int)(ea[gi] >> 2) - j * 256; far[gi] = __all(qrel[gi] - 255 >= 113); nt[gi] = ((2 * pr + gi) * 16 < n) ? 16 : 0; }
                f32x4 o[2][5];
#pragma unroll
                for (int gi = 0; gi < 2; ++gi)
#pragma unroll
                    for (int dt = 0; dt < 5; ++dt) o[gi][dt] = (f32x4){0.f, 0.f, 0.f, 0.f};
                if (PROBE_ACC == 9 || PROBE_ACC == 10) asm volatile("s_waitcnt vmcnt(0)" ::: "memory"); PB(9); moba_groups<2>(Kl, Vl, tabx, qa, ra, qrel, nt, far, o, lane); PE(9);
#pragma unroll
                for (int gi = 0; gi < 2; ++gi) { if ((2 * pr + gi) * 16 + lq < n) { const size_t m = (size_t)b * SEQ + (ea[gi] >> 2); const size_t pi = (m * 8 + h) * 3 + (ea[gi] & 3u); if (g == 0) PARTL[pi] = o[gi][4][0];
#pragma unroll
                        for (int dt = 0; dt < 4; ++dt) { mb_u32x2 w; w.x = mb_cvt_pk(o[gi][dt][0], o[gi][dt][1]); w.y = mb_cvt_pk(o[gi][dt][2], o[gi][dt][3]); *(GAS mb_u32x2*)((pi < PARTO_N1 ? PARTO0 + pi * 64 : PARTO1 + (pi - PARTO_N1) * 64) + dt * 16 + g * 4) = w; } } }
                pr += NWAVES; if (pr * 32 >= n) break;
                ea[0] = eb[0]; ea[1] = eb[1];
            }
        }
#undef MB_IDX
        PE(6); PB(7);
        __syncthreads(); PE(7); PE(8);
    }
}
__device__ __forceinline__ void moba_own_phase(Frame& F, const Args& A, bf16* OUT) {
    PHASE_IDS;
    LAS unsigned char* Kl = F.lds + RING_OFF; LAS unsigned char* Vl = Kl + MB_KBYTES; LAS float* tabx = (LAS float*)(F.lds + RING_OFF + MB_TABX);
    const bf16* QM = (const bf16*)(F.ws + WS_QM); const float* REFS = (const float*)(F.ws + WS_REFS);
    const bf16* PARTO0 = (const bf16*)((unsigned char*)F.out + DO_PARTO); const bf16* PARTO1 = (const bf16*)(F.ws + WS_XB); const float* PARTL = (const float*)(F.ws + WS_PARTL);
    const int lq = lane & 15, g = lane >> 4;
    moba_stage_const(tid, Vl);
    MobaStage st;
    if ((int)blockIdx.x < 1024) { const int u0 = blockIdx.x, bh0 = u0 >> 5; moba_kv_load(F, tid, A, bh0 >> 3, bh0 & 7, u0 & 31, st); }
#pragma unroll 1
    for (int u = blockIdx.x; u < 1024; u += F.G) { const int bh = u >> 5, qb = u & 31, b = bh >> 3, h = bh & 7; const int nsel = qb < 3 ? qb : 3;
        PB(1); PB(4); moba_kv_store(tid, st, Kl, Vl, tabx);
        int grp[2] = {wave, 15 - wave}; size_t mq[2]; mb_bf16x8 qa[2][2]; float ra[2];
#pragma unroll
        for (int gi = 0; gi < 2; ++gi) { mq[gi] = (size_t)b * SEQ + qb * 256 + grp[gi] * 16 + lq; MB_LOADQ(((unsigned)(qb * 256 + grp[gi] * 16 + lq)) << 2, qa[gi], ra[gi]); }
        float pl[3]; mb_u32x2 po[3][4];
#pragma unroll
        for (int r = 0; r < 3; ++r) { pl[r] = 0.f;
#pragma unroll
            for (int dt = 0; dt < 4; ++dt) po[r][dt] = (mb_u32x2){0u, 0u};
            if (r < nsel) { const size_t pi = (mq[0] * 8 + h) * 3 + r; pl[r] = PARTL[pi];
#pragma unroll
                for (int dt = 0; dt < 4; ++dt) po[r][dt] = *(const GAS mb_u32x2*)((pi < PARTO_N1 ? PARTO0 + pi * 64 : PARTO1 + (pi - PARTO_N1) * 64) + dt * 16 + g * 4); } }
        __syncthreads(); PE(1); PB(2);
        if (u + F.G < 1024) { const int un = u + F.G, bhn = un >> 5; moba_kv_load(F, tid, A, bhn >> 3, bhn & 7, un & 31, st); }
        { int qrel[2], nt[2]; bool far[2];
#pragma unroll
            for (int gi = 0; gi < 2; ++gi) { qrel[gi] = grp[gi] * 16 + lq; nt[gi] = grp[gi] + 1; far[gi] = false; }
            f32x4 o[2][5];
#pragma unroll
            for (int gi = 0; gi < 2; ++gi)
#pragma unroll
                for (int dt = 0; dt < 5; ++dt) o[gi][dt] = (f32x4){0.f, 0.f, 0.f, 0.f};
            moba_groups<2>(Kl, Vl, tabx, qa, ra, qrel, nt, far, o, lane); PE(2); PB(3);
#pragma unroll
            for (int gi = 0; gi < 2; ++gi) { float l = __shfl(o[gi][4][0], lq);
#pragma unroll
                for (int r = 0; r < 3; ++r) {
                    if (gi == 0) { l += pl[r];
#pragma unroll
                        for (int dt = 0; dt < 4; ++dt) { o[gi][dt][0] += bflo(po[r][dt].x); o[gi][dt][1] += bfhi(po[r][dt].x); o[gi][dt][2] += bflo(po[r][dt].y); o[gi][dt][3] += bfhi(po[r][dt].y); } }
                    else if (r < nsel) { const size_t pi = (mq[gi] * 8 + h) * 3 + r; l += PARTL[pi];
#pragma unroll
                        for (int dt = 0; dt < 4; ++dt) { const mb_u32x2 w = *(const GAS mb_u32x2*)((pi < PARTO_N1 ? PARTO0 + pi * 64 : PARTO1 + (pi - PARTO_N1) * 64) + dt * 16 + g * 4); o[gi][dt][0] += bflo(w.x); o[gi][dt][1] += bfhi(w.x); o[gi][dt][2] += bflo(w.y); o[gi][dt][3] += bfhi(w.y); } } }
                const float il = 1.f / l;
#pragma unroll
                for (int dt = 0; dt < 4; ++dt) { mb_u32x2 w; w.x = mb_cvt_pk(o[gi][dt][0] * il, o[gi][dt][1] * il); w.y = mb_cvt_pk(o[gi][dt][2] * il, o[gi][dt][3] * il); *(GAS mb_u32x2*)(OUT + mq[gi] * 1024 + 512 + h * 64 + dt * 16 + g * 4) = w; } } }
        PE(3);
        __syncthreads(); PE(4);
    }
#undef MB_LOADQ
}
constexpr int MA_KSTR = 272, MA_VSTR = 528, MA_KBYTES = 256 * MA_KSTR, MA_VBYTES = 128 * MA_VSTR;
static_assert(MA_KBYTES + MA_VBYTES <= RING_BYTES, "mem-attn LDS");
__device__ __forceinline__ void memattn_phase(Frame& F, bf16* OUT) {
    PHASE_IDS;
    LAS unsigned char* Kl = F.lds + RING_OFF; LAS unsigned char* Vl = Kl + MA_KBYTES;
    bf16* QC = (bf16*)(F.ws + WS_QC); const float* SS1 = (const float*)(F.ws + WS_SS1); const bf16* MK = (const bf16*)(F.ws + WS_MKV); const bf16* MVT = MK + 1024 * 512;
    const int lq = lane & 15, g = lane >> 4;
    const int per = (512 + F.G - 1) / F.G; int staged = -1;
#pragma unroll 1
    for (int u = blockIdx.x * per; u < blockIdx.x * per + per && u < 512; ++u) { const int qt = u & 31, bhd = u >> 5, b = bhd >> 2, hd = bhd & 3;
        if (bhd != staged) { __syncthreads();
#pragma unroll
            for (int i = 0; i < 8; ++i) { const int ch = tid + i * NTHR, key = ch >> 4, c = ch & 15; *(LAS v4u*)(Kl + key * MA_KSTR + c * 16) = *(const GAS v4u*)(MK + (size_t)(b * 256 + key) * 512 + hd * 128 + c * 8); }
#pragma unroll
            for (int i = 0; i < 8; ++i) { const int ch = tid + i * NTHR, d = ch >> 5, c = ch & 31; *(LAS v4u*)(Vl + d * MA_VSTR + c * 16) = *(const GAS v4u*)(MVT + (size_t)(hd * 128 + d) * 1024 + b * 256 + c * 8); }
            staged = bhd; __syncthreads(); }
#pragma unroll 1
        for (int grp = wave; grp < 16; grp += NWAVES) {
            const size_t m = (size_t)b * SEQ + qt * 256 + grp * 16 + lq; bf16* qrow = QC + m * 512 + hd * 128;
            mb_bf16x8 qf[4];
#pragma unroll
            for (int s = 0; s < 4; ++s) qf[s] = *(const GAS mb_bf16x8*)(qrow + 32 * s + 8 * g);
            f32x4 sa[16]; const LAS unsigned char* kp = Kl + lq * MA_KSTR + g * 16;
#pragma unroll
            for (int t = 0; t < 16; ++t) { sa[t] = (f32x4){0.f, 0.f, 0.f, 0.f};
#pragma unroll
                for (int s = 0; s < 4; ++s) { const mb_bf16x8 kf = *(const LAS mb_bf16x8*)(kp + t * 16 * MA_KSTR + s * 64); sa[t] = __builtin_amdgcn_mfma_f32_16x16x32_bf16(kf, qf[s], sa[t], 0, 0, 0); } }
            { float ssum = 0.f;
#pragma unroll
                for (int i = 0; i < 4; ++i) { const f32x4 p = *(const GAS f32x4*)(SS1 + m * 16 + 4 * i); ssum += (p[0] + p[1]) + (p[2] + p[3]); }
                const float rs1 = rsqrtf(ssum * (1.f / D) + EPS);
#pragma unroll
                for (int t = 0; t < 16; ++t) sa[t] = sa[t] * rs1; }
            float mx = -INFINITY;
#pragma unroll
            for (int t = 0; t < 16; ++t) mx = fmaxf(fmaxf(mx, fmaxf(sa[t][0], sa[t][1])), fmaxf(sa[t][2], sa[t][3]));
            mx = fmaxf(mx, __shfl_xor(mx, 16)); mx = fmaxf(mx, __shfl_xor(mx, 32));
            float l = 0.f;
#pragma unroll
            for (int t = 0; t < 16; ++t)
#pragma unroll
                for (int r = 0; r < 4; ++r) { const float p = __expf(sa[t][r] - mx); sa[t][r] = p; l += p; }
            l += __shfl_xor(l, 16); l += __shfl_xor(l, 32);
            f32x4 o[8];
#pragma unroll
            for (int dt = 0; dt < 8; ++dt) o[dt] = (f32x4){0.f, 0.f, 0.f, 0.f};
            const LAS unsigned char* vp = Vl + lq * MA_VSTR + g * 8;
#pragma unroll
            for (int ks = 0; ks < 8; ++ks) {
                v4u pw; pw.x = mb_cvt_pk(sa[2 * ks][0], sa[2 * ks][1]); pw.y = mb_cvt_pk(sa[2 * ks][2], sa[2 * ks][3]); pw.z = mb_cvt_pk(sa[2 * ks + 1][0], sa[2 * ks + 1][1]); pw.w = mb_cvt_pk(sa[2 * ks + 1][2], sa[2 * ks + 1][3]);
                const mb_bf16x8 pb = __builtin_bit_cast(mb_bf16x8, pw);
#pragma unroll
                for (int dt = 0; dt < 8; ++dt) { const mb_u32x2 a0 = *(const LAS mb_u32x2*)(vp + dt * 16 * MA_VSTR + ks * 64), a1 = *(const LAS mb_u32x2*)(vp + dt * 16 * MA_VSTR + ks * 64 + 32);
                    v4u aw; aw.x = a0.x; aw.y = a0.y; aw.z = a1.x; aw.w = a1.y;
                    o[dt] = __builtin_amdgcn_mfma_f32_16x16x32_bf16(__builtin_bit_cast(mb_bf16x8, aw), pb, o[dt], 0, 0, 0); } }
            const float il = 1.f / l;
#pragma unroll
            for (int dt = 0; dt < 8; ++dt) { mb_u32x2 w; w.x = mb_cvt_pk(o[dt][0] * il, o[dt][1] * il); w.y = mb_cvt_pk(o[dt][2] * il, o[dt][3] * il); *(GAS mb_u32x2*)(OUT + m * 512 + hd * 128 + dt * 16 + g * 4) = w; }
        }
    }
    __syncthreads();
}

template <bool SPLIT> __device__ __forceinline__ void rownorm_phase(Frame& F, bf16* dst, float* rstd) {
    PHASE_IDS;
    const int gw = F.vcu * NWAVES + wave, NGW = F.G * NWAVES; constexpr int LD = SPLIT ? 2048 : 1024;
    for (int m = gw; m < M; m += NGW) { const GAS f32x4* xr = (const GAS f32x4*)(F.out + (size_t)m * D) + lane; f32x4 v[4]; float s = 0.f;
#pragma unroll
        for (int j = 0; j < 4; ++j) { v[j] = xr[64 * j]; s += (v[j].x * v[j].x + v[j].y * v[j].y) + (v[j].z * v[j].z + v[j].w * v[j].w); }
        s = wave_sum(s); if (lane == 0) rstd[m] = rsqrtf(s * (1.f / D) + EPS);
        GAS unsigned long long* o8 = (GAS unsigned long long*)(dst + (size_t)m * LD) + lane;
#pragma unroll
        for (int j = 0; j < 4; ++j) { const unsigned h0 = f2bf(v[j].x), h1 = f2bf(v[j].y), h2 = f2bf(v[j].z), h3 = f2bf(v[j].w);
            o8[64 * j] = (unsigned long long)(h0 | (h1 << 16)) | ((unsigned long long)(h2 | (h3 << 16)) << 32);
            if (SPLIT) o8[256 + 64 * j] = (unsigned long long)pk2(v[j].x - __uint_as_float(h0 << 16), v[j].y - __uint_as_float(h1 << 16)) | ((unsigned long long)pk2(v[j].z - __uint_as_float(h2 << 16), v[j].w - __uint_as_float(h3 << 16)) << 32); } }
}
constexpr int RCH = 128, NCH = M / RCH;
__device__ __forceinline__ void route_phase(Frame& F, const Args& A) {
    PHASE_IDS;
    const float* LG = (const float*)(F.ws + WS_LG); const float* LG2 = (const float*)(F.ws + WS_LG2); const float* SS2 = (const float*)(F.ws + WS_SS2); float* rstd2 = (float*)(F.ws + WS_RSTD2); const float* brg = A.in[18]; const float* bre = A.in[20];
    int* ME = (int*)(F.ws + WS_MOE_E); int* MP = (int*)(F.ws + WS_MOE_POS); float* MW = (float*)(F.ws + WS_MOE_W); unsigned* CNT = (unsigned*)(F.ws + WS_TILE_E);
    unsigned* hist = (unsigned*)(F.ldsg + RING_OFF);
#pragma unroll 1
    for (int ch = blockIdx.x; ch < NCH; ch += F.G) {
        if (tid < 32) hist[tid] = 0u;
        __syncthreads();
        if (tid < RCH) { const int m = ch * RCH + tid; float ssum = 0.f;
#pragma unroll
            for (int i = 0; i < 4; ++i) { const f32x4 p = *(const GAS f32x4*)(SS2 + (size_t)m * 16 + 4 * i); ssum += (p[0] + p[1]) + (p[2] + p[3]); }
            const float rs = rsqrtf(ssum * (1.f / D) + EPS); rstd2[m] = rs; const float* lg = LG + (size_t)m * 72; const float* lg2 = LG2 + (size_t)m * 36;
            float gl[4]; int grp = 0; float gmx = -INFINITY;
#pragma unroll
            for (int o = 0; o < 4; ++o) { gl[o] = (lg[o] + lg[36 + o] + lg2[o]) * rs + brg[o]; if (gl[o] > gmx) { gmx = gl[o]; grp = o; } }
            float gs = 0.f;
#pragma unroll
            for (int o = 0; o < 4; ++o) gs += __expf(gl[o] - gmx);
            const float pg = 1.f / gs;
            float el[8]; float emx = -INFINITY;
#pragma unroll
            for (int i = 0; i < 8; ++i) { el[i] = (lg[4 + grp * 8 + i] + lg[40 + grp * 8 + i] + lg2[4 + grp * 8 + i]) * rs + bre[grp * 8 + i]; emx = fmaxf(emx, el[i]); }
            float p0 = -1.f, p1 = -1.f; int i0 = 0, i1 = 0;
#pragma unroll
            for (int i = 0; i < 8; ++i) { const float p = __expf(el[i] - emx); if (p > p0) { p1 = p0; i1 = i0; p0 = p; i0 = i; } else if (p > p1) { p1 = p; i1 = i; } }
            const float inv = pg / (p0 + p1);
            const int e0 = grp * 8 + i0, e1 = grp * 8 + i1;
            const unsigned q0 = __hip_atomic_fetch_add(hist + e0, 1u, __ATOMIC_RELAXED, __HIP_MEMORY_SCOPE_WORKGROUP), q1 = __hip_atomic_fetch_add(hist + e1, 1u, __ATOMIC_RELAXED, __HIP_MEMORY_SCOPE_WORKGROUP);
            ME[m * 2] = e0; ME[m * 2 + 1] = e1; MP[m * 2] = (int)q0; MP[m * 2 + 1] = (int)q1; MW[m * 2] = p0 * inv; MW[m * 2 + 1] = p1 * inv; }
        __syncthreads();
        if (tid < 32) CNT[ch * 32 + tid] = hist[tid];
        __syncthreads();
    }
}
__device__ __forceinline__ int moe_bases(Frame& F, int mych) {
    PHASE_IDS;
    volatile int* eb = (volatile int*)(F.ldsg + TBL_EB); volatile int* tl = (volatile int*)(F.ldsg + TBL_TILE); volatile int* part = (volatile int*)(F.ldsg + TBL_EB + 256);
    const unsigned* CNT = (const unsigned*)(F.ws + WS_TILE_E);
    { const int e = tid & 31, pt = tid >> 5; int s = 0, sp = 0;
#pragma unroll 1
        for (int c = pt * (NCH / 16); c < (pt + 1) * (NCH / 16); ++c) { const int v = (int)CNT[c * 32 + e]; s += v; if (c < mych) sp += v; }
        part[pt * 32 + e] = s; part[512 + pt * 32 + e] = sp; }
    __syncthreads();
    if (tid < 32) { int s = 0, sp = 0;
#pragma unroll
        for (int p = 0; p < 16; ++p) { s += part[p * 32 + tid]; sp += part[512 + p * 32 + tid]; }
        part[1024 + tid] = s; part[1056 + tid] = sp; }
    __syncthreads();
    if (tid == 0) { int base = 0;
        for (int e = 0; e < 32; ++e) { const int c = part[1024 + e]; eb[e] = base; const int nt = (c + 255) >> 8; for (int t = 0; t < nt; ++t) tl[(base >> 8) + t] = e; base += nt << 8; }
        eb[32] = base; }
    __syncthreads();
    return eb[32] >> 8;
}
__device__ __forceinline__ void moe_slot_phase(Frame& F) {
    PHASE_IDS;
    volatile int* eb = (volatile int*)(F.ldsg + TBL_EB); volatile int* part = (volatile int*)(F.ldsg + TBL_EB + 256);
    const int* ME = (const int*)(F.ws + WS_MOE_E); const int* MP = (const int*)(F.ws + WS_MOE_POS); const float* MW = (const float*)(F.ws + WS_MOE_W); int* SO = (int*)(F.ws + WS_SLOT_OF);
    float* WSL = (float*)(F.ws + WS_W_SLOT); float* RSL = (float*)(F.ws + WS_RSTD_SLOT); const float* rstd2 = (const float*)(F.ws + WS_RSTD2); int* TOK = (int*)(F.ws + WS_TOK);
#pragma unroll 1
    for (int ch = blockIdx.x; ch < NCH; ch += F.G) {
        (void)moe_bases(F, ch);
        if (ch < 32) { const int e = ch; for (int sl = eb[e] + part[1024 + e] + tid; sl < eb[e + 1]; sl += NTHR) { TOK[sl] = 0; WSL[sl] = 0.f; RSL[sl] = 1.f; } }
        if (tid < RCH * 2) { const int a = ch * RCH * 2 + tid, m = a >> 1; const int e = ME[a]; const int slot = eb[e] + part[1056 + e] + MP[a];
            SO[a] = slot; WSL[slot] = MW[a]; RSL[slot] = rstd2[m]; TOK[slot] = m; }
        __syncthreads();
    }
}
__device__ __forceinline__ void final_phase(Frame& F, const Args& A) {
    PHASE_IDS;
    const int gw = F.vcu * NWAVES + wave, NGW = F.G * NWAVES; const int* SO = (const int*)(F.ws + WS_SLOT_OF); const bf16* Y = (const bf16*)(F.ws + WS_XG); const float* gf = A.in[24];
    const bf16* XH = (const bf16*)(F.ws + WS_X2H); const bf16* XL = (const bf16*)(F.ws + WS_X2L);
    f32x4 gv[4];
#pragma unroll
    for (int j = 0; j < 4; ++j) gv[j] = ((const GAS f32x4*)gf)[64 * j + lane];
    typedef unsigned long long u64;
    u64 ya[4], yb[4], xh[4];
#define FIN_LOAD(m_) do { const int s0_ = SO[(m_) * 2], s1_ = SO[(m_) * 2 + 1]; const GAS u64* y0_ = (const GAS u64*)(Y + (size_t)s0_ * 1024) + lane; const GAS u64* y1_ = (const GAS u64*)(Y + (size_t)s1_ * 1024) + lane; \
        const GAS u64* h_ = (const GAS u64*)(XH + (size_t)(m_) * 1024) + lane; \
        _Pragma("unroll") for (int j = 0; j < 4; ++j) { ya[j] = y0_[64 * j]; yb[j] = y1_[64 * j]; xh[j] = h_[64 * j]; } } while (0)
    int m = gw; if (m >= M) return;
    FIN_LOAD(m);
#pragma unroll 1
    for (;;) {
        f32x4 v[4]; float s = 0.f;
#pragma unroll
        for (int j = 0; j < 4; ++j) { const u64 a = ya[j], c = yb[j], hh = xh[j];
            v[j].x = bflo((unsigned)hh) + (bflo((unsigned)a) + bflo((unsigned)c)); v[j].y = bfhi((unsigned)hh) + (bfhi((unsigned)a) + bfhi((unsigned)c));
            v[j].z = bflo((unsigned)(hh >> 32)) + (bflo((unsigned)(a >> 32)) + bflo((unsigned)(c >> 32))); v[j].w = bfhi((unsigned)(hh >> 32)) + (bfhi((unsigned)(a >> 32)) + bfhi((unsigned)(c >> 32)));
            s += (v[j].x * v[j].x + v[j].y * v[j].y) + (v[j].z * v[j].z + v[j].w * v[j].w); }
        const int mn = m + NGW; const bool more = mn < M;
        if (more) FIN_LOAD(mn);
        s = wave_sum(s); const float rs = rsqrtf(s * (1.f / D) + EPS); GAS f32x4* xr = (GAS f32x4*)(F.out + (size_t)m * D) + lane;
#pragma unroll
        for (int j = 0; j < 4; ++j) xr[64 * j] = (f32x4){v[j].x * rs * gv[j].x, v[j].y * rs * gv[j].y, v[j].z * rs * gv[j].z, v[j].w * rs * gv[j].w};
        if (!more) break;
        m = mn;
    }
#undef FIN_LOAD
}

__global__ void __launch_bounds__(NWAVES * 64, 2) fwd_kernel(Args args) {
    extern __shared__ __attribute__((aligned(16))) unsigned char lds[];
    Frame F; F.pacc = 0; F.pt0 = 0;
    F.lds = (LAS unsigned char*)lds; F.ldsg = lds;
    F.MISC = (volatile LAS unsigned*)(F.lds + MISC_OFF);
    const int tid = threadIdx.x;
    F.G = gridDim.x; { const int bx = blockIdx.x; F.vcu = (F.G % 8 == 0) ? (bx % 8) * (F.G / 8) + bx / 8 : bx; }
    F.ws = uniform_ptr(args.ws); F.out = uniform_ptr(args.out); F.ctl = (gu32*)(F.ws + WS_CTL);
    for (int u = tid; u < (LDS_BYTES - LDSCTL_OFF) / 4; u += NWAVES * 64) ((LAS unsigned*)(F.lds + LDSCTL_OFF))[u] = 0u;
    __syncthreads();
#if MK_ONE_LAUNCH
    XcdBarrier bar = xcd_barrier_post((unsigned*)(F.ctl + CW_BAR), F.MISC + 8);
#define GRID_BAR() xcd_barrier(bar)
#else
#define GRID_BAR() do { if (tid == 0) __hip_atomic_store(F.ctl + CW_TMO, 0xBADBA0u, RLX_AGENT); } while (0)
#endif
    const int lo = args.ph_lo, hi = args.ph_hi;
#define IN(k) (lo <= (k) && (k) < hi)
#ifndef PROBE_MASK
#define PROBE_MASK 0
#endif
#ifndef PG8_ALIGN_EPI
#define PG8_ALIGN_EPI true
#endif
#define REP(k) _Pragma("unroll") for (int rep_ = 0; rep_ < 1 + ((PROBE_MASK >> (k)) & 1); ++rep_)
#ifndef PROBE_A
#define PROBE_A -1
#define PROBE_B -1
#endif
#ifndef PROBE_AMP
#define PROBE_AMP 4
#endif
#ifndef PROBE_BLOCK
#define PROBE_BLOCK 0
#endif
    unsigned long long ts_a = 0, ts_b = 0;
#define STAMP(i) do { if ((i) == PROBE_A) ts_a = __builtin_amdgcn_s_memrealtime(); if ((i) == PROBE_B) ts_b = __builtin_amdgcn_s_memrealtime(); } while (0)
#define SEAM(k) do { if (IN(k) && IN((k) + 1)) { GRID_BAR(); if ((PROBE_MASK >> 6) & 1) GRID_BAR(); } STAMP((k) + 1); } while (0)
    STAMP(0);
    unsigned char* ws = F.ws;
    bf16* XB = (bf16*)(ws + WS_XB);
    const float* rstd0 = (const float*)(ws + WS_RSTD0);

    if (IN(0)) REP(0) { p0_prologue(F, args); } SEAM(0);
    if (IN(1)) REP(1) {
        constexpr int TS = 512 * 1024;
        static_assert(WS_XB % TS == 0 && WS_W1T % TS == 0 && WS_WVT % TS == 0 && WS_MEMN % TS == 0 && WS_WCKVT % TS == 0, "tile-aligned matrices");
        pg8::Gemm g{(const bf16*)ws, (const bf16*)ws, M, 4352, 1024};
        typedef pg8::MultiOrder<128, 17, (int)(WS_XB / TS), (int)(WS_W1T / TS), 4, 128, (int)(WS_WVT / TS), (int)(WS_XB / TS), 4, 2, (int)(WS_MEMN / TS), (int)(WS_WCKVT / TS), 2, 4, (int)(WS_WCKVT / TS) + 2, (int)(WS_MEMN / TS)> P1Order;
        P1Order S{F.G, (int)blockIdx.x};
        pg8::EpiP1 E{ pg8::EpiInProj{(bf16*)(ws + WS_QG), (bf16*)(ws + WS_KG), (bf16*)(ws + WS_SR), (bf16*)(ws + WS_QM), (bf16*)(ws + WS_KM), (bf16*)(ws + WS_SZ), (float*)((unsigned char*)F.out + DO_LA), rstd0, args.in[7]},
                      pg8::EpiVT{(bf16*)(ws + WS_VT), M, rstd0},
                      pg8::EpiRowBf16<0>{(bf16*)(ws + WS_MKV), 512, nullptr, 1.f}, pg8::EpiRowBf16<0>{(bf16*)(ws + WS_MKV) + 1024 * 512, 1024, nullptr, 1.f} };
        pg8::gemm_phase<pg8::EpiP1, P1Order, PG8_ALIGN_EPI, true>(F.lds + RING_OFF, g, S, E);
    } SEAM(1);
    if (IN(2)) { REP(2) gla_a_phase(F); STAMP(30); REP(5) moba_kmean_phase(F); } SEAM(2);
    if (IN(3)) { gla_scan_phase(F); STAMP(31); moba_gate_phase(F, args); } SEAM(3);
    if (IN(4)) { gla_b_phase(F, args); STAMP(32); moba_part_phase(F, args, CW_WQ); } SEAM(4);
    STAMP(6);
    if (IN(6)) { moba_own_phase(F, args, (bf16*)(ws + WS_OGM)); } SEAM(6);
    if (IN(7)) REP(1) { pg8::Gemm g{(const bf16*)(ws + WS_OGM), (const bf16*)(ws + WS_PGMT), M, 1024, 1024}; pg8::StaticOrder S; S.init(M, 1024, F.G, (int)blockIdx.x);
        pg8::EpiMerge2 E{(bf16*)(ws + WS_MG), (const bf16*)(ws + WS_SZ)};
        pg8::gemm_phase<pg8::EpiMerge2, pg8::StaticOrder, PG8_ALIGN_EPI, true>(F.lds + RING_OFF, g, S, E); } SEAM(7);
    if (IN(8)) REP(1) { pg8::Gemm g{(const bf16*)(ws + WS_MG), (const bf16*)(ws + WS_WOUTT), M, 1024, 1024}; pg8::StaticOrder S; S.init(M, 1024, F.G, (int)blockIdx.x);
        pg8::EpiResSplit<true, false> E{args.in[0], nullptr, nullptr, (bf16*)(ws + WS_X1H), nullptr, (float*)(ws + WS_SS1)};
        pg8::gemm_phase<pg8::EpiResSplit<true, false>, pg8::StaticOrder, PG8_ALIGN_EPI, true>(F.lds + RING_OFF, g, S, E); } SEAM(8);
    if (IN(10)) REP(1) { pg8::Gemm g{(const bf16*)(ws + WS_X1H), (const bf16*)(ws + WS_WCQT), M, 512, 1024}; pg8::StaticOrder S; S.init(M, 512, F.G, (int)blockIdx.x);
        pg8::EpiRowBf16<0> E{(bf16*)(ws + WS_QC), 512, nullptr, 0.08838834764831845f};
        pg8::gemm_phase<pg8::EpiRowBf16<0>, pg8::StaticOrder, PG8_ALIGN_EPI, true>(F.lds + RING_OFF, g, S, E); } SEAM(10);
    if (IN(11)) { memattn_phase(F, (bf16*)(ws + WS_QC)); } SEAM(11);
    if (IN(12)) { pg8::Gemm g{(const bf16*)(ws + WS_QC), (const bf16*)(ws + WS_WCOT), M, 1024, 512}; pg8::StaticOrder S; S.init(M, 1024, F.G, (int)blockIdx.x);
        pg8::EpiResSplit<false, true> E{nullptr, (const bf16*)(ws + WS_X1H), nullptr, (bf16*)(ws + WS_X2H), (bf16*)(ws + WS_X2L), (float*)(ws + WS_SS2)};
        pg8::gemm_phase<pg8::EpiResSplit<false, true>, pg8::StaticOrder, PG8_ALIGN_EPI, true>(F.lds + RING_OFF, g, S, E);
        expert_weights_gu(F, args); } SEAM(12);
    STAMP(14);
    if (IN(14)) REP(1) {
        { pg8::Gemm g{(const bf16*)(ws + WS_X2H), (const bf16*)(ws + WS_WRT), M, 256, 1024}; pg8::StaticOrder S; S.init(M, 256, F.G, (int)blockIdx.x);
          pg8::EpiLogits E{(float*)(ws + WS_LG), 72, 72};
          pg8::gemm_phase<pg8::EpiLogits, pg8::StaticOrder, PG8_ALIGN_EPI, true>(F.lds + RING_OFF, g, S, E); }
        { pg8::Gemm g{(const bf16*)(ws + WS_X2L), (const bf16*)(ws + WS_WRT) + 256 * 1024, M, 256, 1024}; pg8::StaticOrder S; S.init(M, 256, F.G, (int)((blockIdx.x + F.G / 2) % F.G));
          pg8::EpiLogits E{(float*)(ws + WS_LG2), 36, 36};
          pg8::gemm_phase<pg8::EpiLogits, pg8::StaticOrder, PG8_ALIGN_EPI, true>(F.lds + RING_OFF, g, S, E); }
    } SEAM(14);
    if (IN(15)) { route_phase(F, args); } SEAM(15);
    if (IN(16)) REP(0) { moe_slot_phase(F); } SEAM(16);
    if (IN(17)) REP(1) { const int ntile = moe_bases(F, 0);
        { LAS int* rows = (LAS int*)(F.lds + TBL_ROWS); const int* TOK = (const int*)(ws + WS_TOK);
          for (int i = threadIdx.x; i < 6 * 256; i += NTHR) { const long L = (long)(i >> 8) * F.G + blockIdx.x; rows[i] = (L < (long)ntile * 4) ? TOK[(int)(L >> 2) * 256 + (i & 255)] : 0; }
          __syncthreads(); }
        pg8::Gemm g{(const bf16*)(ws + WS_X2H), (const bf16*)(ws + WS_WGUT), MOE_CAP, 32 * 1024, 1024}; pg8::MoeGatherOrder S{(const LAS int*)(F.lds + TBL_TILE), (const LAS int*)(F.lds + TBL_ROWS), ntile, F.G, (int)blockIdx.x};
        pg8::EpiMoe1 E{(bf16*)(ws + WS_HID), (const float*)(ws + WS_RSTD_SLOT)};
        pg8::gemm_phase<pg8::EpiMoe1, pg8::MoeGatherOrder, PG8_ALIGN_EPI, true>(F.lds + RING_OFF, g, S, E);
        { const int total = ntile * 4, maxun = (total + F.G - 1) / F.G, rem = total - (maxun - 1) * F.G;
          const bool even = rem == F.G; expert_weights_dn(F, args, even ? (int)blockIdx.x : (int)blockIdx.x - rem, even ? F.G : F.G - rem); } } SEAM(17);
    if (IN(18)) REP(1) { const int ntile = moe_bases(F, 0);
        pg8::Gemm g{(const bf16*)(ws + WS_HID), (const bf16*)(ws + WS_WDT), MOE_CAP, 32 * 1024, 512}; pg8::MoeOrder S{(const LAS int*)(F.lds + TBL_TILE), ntile, F.G, (int)blockIdx.x};
        pg8::EpiMoe2 E{(bf16*)(ws + WS_XG), (const float*)(ws + WS_W_SLOT)};
        pg8::gemm_phase<pg8::EpiMoe2, pg8::MoeOrder, PG8_ALIGN_EPI, true>(F.lds + RING_OFF, g, S, E); } SEAM(18);
    if (IN(19)) { final_phase(F, args); }
    STAMP(20);
    if ((PROBE_A >= 0 || PROBE_ACC >= 0) && blockIdx.x == PROBE_BLOCK) { const unsigned long long dl = (PROBE_ACC >= 40 ? (unsigned long long)F.MISC[16] : PROBE_ACC >= 0 ? F.pacc : (ts_b - ts_a)) * PROBE_AMP, t0 = __builtin_amdgcn_s_memrealtime(); while (__builtin_amdgcn_s_memrealtime() - t0 < dl) __builtin_amdgcn_s_sleep(8); }
#undef IN
#undef SEAM
}

extern "C" void kernel_launch(void* const* d_in, const int* in_sizes, int n_in, void* d_out, int out_size, void* d_ws, size_t ws_size, hipStream_t stream) {
    static int grid = 0;
    if (grid == 0) {
        if (n_in != 25 || in_sizes[0] != M * D || out_size != M * D || ws_size < WS_END) { fprintf(stderr, "kernel_launch: unexpected shapes (n_in %d in0 %d out %d ws %zu)\n", n_in, n_in > 0 ? in_sizes[0] : -1, out_size, ws_size); grid = -1; return; }
        int dev = 0, cus = 0, per_cu = 0;
        if (hipGetDevice(&dev) != hipSuccess || hipDeviceGetAttribute(&cus, hipDeviceAttributeMultiprocessorCount, dev) != hipSuccess) { grid = -1; return; }
        if (hipFuncSetAttribute((const void*)fwd_kernel, hipFuncAttributeMaxDynamicSharedMemorySize, LDS_BYTES) != hipSuccess) { fprintf(stderr, "kernel_launch: hipFuncSetAttribute failed\n"); grid = -1; return; }
        if (hipOccupancyMaxActiveBlocksPerMultiprocessor(&per_cu, (const void*)fwd_kernel, NWAVES * 64, LDS_BYTES) != hipSuccess || per_cu < 1) fprintf(stderr, "kernel_launch: occupancy query reports %d\n", per_cu);
        (void)hipGetLastError();
        grid = cus;
    }
    if (grid < 0) return;
    if (hipMemsetAsync((char*)d_ws + WS_CTL, 0, CTL_ZERO_BYTES, stream) != hipSuccess) return;
    Args a{};
    for (int i = 0; i < 25; ++i) a.in[i] = (const float*)d_in[i];
    a.out = (float*)d_out; a.ws = (unsigned char*)d_ws;
#if MK_ONE_LAUNCH
    a.ph_lo = 0; a.ph_hi = NPHASE;
    hipLaunchKernelGGL(fwd_kernel, dim3(grid), dim3(NWAVES * 64), LDS_BYTES, stream, a);
#else
    for (int p = 0; p < NPHASE; ++p) { a.ph_lo = p; a.ph_hi = p + 1; hipLaunchKernelGGL(fwd_kernel, dim3(grid), dim3(NWAVES * 64), LDS_BYTES, stream, a); }
#endif
}
```

```cpp
#include <hip/hip_runtime.h>
#include <cstdio>
#include <cstdint>
#define MK_ONE_LAUNCH 1
namespace pg8 {
#define PG8_LAS __attribute__((address_space(3)))
typedef unsigned short bf16_t;
typedef short bf16x8 __attribute__((ext_vector_type(8)));
typedef float f32x4 __attribute__((ext_vector_type(4)));
typedef unsigned u32x4 __attribute__((ext_vector_type(4)));
constexpr int BM = 256, BK = 64, HALF = 128, HTB = HALF * BK * 2  , STAGE_BYTES = 8 * HTB, NXCD = 8, WGM = 8;

__host__ __device__ __forceinline__ int lds_byte(int r, int c) { const int st = (r >> 4) * 2 + (c >> 5), rr = r & 15, cc = c & 31, ob = rr * 64 + cc * 2; return st * 1024 + (ob ^ (((ob >> 9) & 1) << 5)); }
__host__ __device__ __forceinline__ void stage_rc(int b, int& R, int& C) { const int st = b / 1024, sb = b % 1024, swz = sb ^ (((sb >> 9) & 1) << 5); R = (st >> 1) * 16 + swz / 64; C = (st & 1) * 32 + (swz % 64) / 2; }
__host__ __device__ __forceinline__ int perm32(int rho) { const int n = rho >> 4, i = rho & 15; return 8 * (i >> 2) + 4 * n + (i & 3); }

struct Unit { int pm, pn, lm, ln, ty; };
struct Gemm { const bf16_t* A; const bf16_t* Bt; int M, N, K; };

struct StaticOrder {
    static constexpr bool GATHER = false;
    int nM, nN, nwg, G, c;
    __host__ __device__ void init(int M, int N, int G_, int c_) { nM = M / BM; nN = N / BM; nwg = nM * nN; G = G_; c = c_; }
    __host__ __device__ bool next(int i, Unit& u) const {
        const long L = (long)i * G + c; if (L >= nwg) return false;
        int wgid = (int)L; { const int q = nwg / NXCD, r = nwg % NXCD, xcd = wgid % NXCD, off = wgid / NXCD; wgid = (xcd < r ? xcd * (q + 1) : r * (q + 1) + (xcd - r) * q) + off; }
        const int nig = WGM * nN, gid = wgid / nig, fm = gid * WGM, gsz = (nM - fm) < WGM ? (nM - fm) : WGM;
        u.pm = fm + ((wgid % nig) % gsz); u.pn = (wgid % nig) / gsz; u.lm = u.pm; u.ln = u.pn; u.ty = 0; return true;
    }
    __device__ __forceinline__ void a_ready(const Unit&) const {}
    __device__ __forceinline__ void done(const Unit&) const {}
};

__device__ __forceinline__ unsigned cvt_pk_bf16(float lo, float hi) { unsigned r; asm volatile("v_cvt_pk_bf16_f32 %0, %1, %2" : "=v"(r) : "v"(lo), "v"(hi)); return r; }
typedef float f32x2 __attribute__((ext_vector_type(2)));
typedef __attribute__((address_space(1))) u32x4 gu4; typedef __attribute__((address_space(1))) const u32x4 gu4c; typedef __attribute__((address_space(1))) f32x4 gf4; typedef __attribute__((address_space(1))) const f32x4 gf4c;
typedef __attribute__((address_space(1))) float gf1; typedef __attribute__((address_space(1))) const float gf1c;
__device__ __forceinline__ float bf2f(unsigned short h) { return __uint_as_float(((unsigned)h) << 16); }
__device__ __forceinline__ float bflo(unsigned w) { return __uint_as_float(w << 16); }
__device__ __forceinline__ float bfhi(unsigned w) { return __uint_as_float(w & 0xffff0000u); }
__device__ __forceinline__ float sigmoid_f(float x) { return __builtin_amdgcn_rcpf(1.0f + __builtin_amdgcn_exp2f(-1.4426950408889634f * x)); }
__device__ __forceinline__ float silu_f(float x) { return x * __builtin_amdgcn_rcpf(1.0f + __builtin_amdgcn_exp2f(-1.4426950408889634f * x)); }
__device__ __forceinline__ float logsigmoid_f(float x) { return fminf(x, 0.f) - 0.6931471805599453f * __builtin_amdgcn_logf(1.0f + __builtin_amdgcn_exp2f(-1.4426950408889634f * fabsf(x))); }
__device__ __forceinline__ u32x4 pack8(const f32x4 v0, const f32x4 v1) { u32x4 w; w.x = cvt_pk_bf16(v0[0], v0[1]); w.y = cvt_pk_bf16(v0[2], v0[3]); w.z = cvt_pk_bf16(v1[0], v1[1]); w.w = cvt_pk_bf16(v1[2], v1[3]); return w; }

struct EpiInProj {
    static constexpr bool PERM = true, AFTER_DRAIN = false, MIDK = false;
    bf16_t *QG, *KG, *SR, *QM, *KM, *SZ; float* LA; const float* rstd; const float* b_alpha;
    template <int MODE> __device__ __forceinline__ void body(const f32x4 (&acc)[2][2][4][2], bf16_t* dst, int ldc, int row0, int col0, float sc) const {
        f32x4 ba[2][2];
        if (MODE == 3) {
#pragma unroll
            for (int bj = 0; bj < 2; ++bj) { ba[bj][0] = *(gf4c*)(b_alpha + col0 + bj * HALF); ba[bj][1] = *(gf4c*)(b_alpha + col0 + bj * HALF + 4); } }
#pragma unroll
        for (int ai = 0; ai < 2; ++ai)
#pragma unroll
            for (int m = 0; m < 4; ++m) { const int row = row0 + ai * HALF + m * 16;
#pragma unroll
                for (int bj = 0; bj < 2; ++bj) { f32x4 v0 = acc[ai][bj][m][0], v1 = acc[ai][bj][m][1]; const int col = col0 + bj * HALF;
                    if (MODE == 0) { v0 = v0 * sc; v1 = v1 * sc; }
                    if (MODE == 1) {
#pragma unroll
                        for (int e = 0; e < 4; ++e) { v0[e] = silu_f(v0[e]); v1[e] = silu_f(v1[e]); } }
                    if (MODE == 2) {
#pragma unroll
                        for (int e = 0; e < 4; ++e) { v0[e] = sigmoid_f(v0[e]); v1[e] = sigmoid_f(v1[e]); } }
                    if (MODE == 3) { const f32x4 b0 = ba[bj][0], b1 = ba[bj][1];
#pragma unroll
                        for (int e = 0; e < 4; ++e) { v0[e] = logsigmoid_f(v0[e] + b0[e]) * 0.0625f; v1[e] = logsigmoid_f(v1[e] + b1[e]) * 0.0625f; }
                        float* o = LA + (size_t)row * 256 + col; *(gf4*)o = v0; *(gf4*)(o + 4) = v1; }
                    else *(gu4*)(dst + (size_t)row * ldc + col) = pack8(v0, v1); } }
    }
    __device__ __forceinline__ void operator()(const f32x4 (&acc)[2][2][4][2], const Unit& u, int wr, int wc, int fr, int fq) const {
        const int pn = u.ln, row0 = u.lm * BM + wr * 64 + fr, cl = wc * 32 + 8 * fq;
        if (pn == 0) body<0>(acc, QG, 256, row0, cl, 0.125f);
        else if (pn == 1) body<0>(acc, KG, 256, row0, cl, 1.f);
        else if (pn <= 3) body<1>(acc, SR, 512, row0, (pn - 2) * 256 + cl, 1.f);
        else if (pn == 4) body<3>(acc, nullptr, 256, row0, cl, 1.f);
        else if (pn <= 6) body<0>(acc, QM, 512, row0, (pn - 5) * 256 + cl, 0.125f * 1.4426950408889634f);
        else if (pn <= 8) body<0>(acc, KM, 512, row0, (pn - 7) * 256 + cl, 1.f);
        else body<2>(acc, SZ, 2048, row0, (pn - 9) * 256 + cl, 1.f);
    }
};
struct EpiVT {
    static constexpr bool PERM = true, AFTER_DRAIN = false, MIDK = false;
    bf16_t* VT; int ldc; const float* rstd;
    __device__ __forceinline__ void operator()(const f32x4 (&acc)[2][2][4][2], const Unit& u, int wr, int wc, int fr, int fq) const {
        const int row0 = u.lm * BM + wr * 64 + fr, col0 = u.ln * BM + wc * 32 + 8 * fq;
        asm volatile("s_nop 15\n\ts_nop 15" ::: "memory");
#pragma unroll
        for (int ai = 0; ai < 2; ++ai)
#pragma unroll
            for (int m = 0; m < 4; ++m) { const int row = row0 + ai * HALF + m * 16;
#pragma unroll
                for (int bj = 0; bj < 2; ++bj) *(gu4*)(VT + (size_t)row * ldc + col0 + bj * HALF) = pack8(acc[ai][bj][m][0], acc[ai][bj][m][1]); }
    }
};
template <int ACT> struct EpiRowBf16 {
    static constexpr bool PERM = true, AFTER_DRAIN = false, MIDK = false;
    bf16_t* O; int ldc; const float* rowscale; float sc;
    __device__ __forceinline__ void operator()(const f32x4 (&acc)[2][2][4][2], const Unit& u, int wr, int wc, int fr, int fq) const {
        const int row0 = u.lm * BM + wr * 64 + fr, col0 = u.ln * BM + wc * 32 + 8 * fq;
#pragma unroll
        for (int ai = 0; ai < 2; ++ai)
#pragma unroll
            for (int m = 0; m < 4; ++m) { const int row = row0 + ai * HALF + m * 16; const float rs = (rowscale ? ((gf1c*)rowscale)[row] : 1.f) * sc;
#pragma unroll
                for (int bj = 0; bj < 2; ++bj) { f32x4 v0 = acc[ai][bj][m][0] * rs, v1 = acc[ai][bj][m][1] * rs;
                    if (ACT == 2) {
#pragma unroll
                        for (int e = 0; e < 4; ++e) { v0[e] = sigmoid_f(v0[e]); v1[e] = sigmoid_f(v1[e]); } }
                    *(gu4*)(O + (size_t)row * ldc + col0 + bj * HALF) = pack8(v0, v1); } }
    }
};
struct EpiMerge {
    static constexpr bool PERM = true, AFTER_DRAIN = false, MIDK = false;
    bf16_t* O; const bf16_t* SZ; const bf16_t* T1;
    __device__ __forceinline__ void operator()(const f32x4 (&acc)[2][2][4][2], const Unit& u, int wr, int wc, int fr, int fq) const {
        const int row0 = u.lm * BM + wr * 64 + fr, col0 = u.ln * BM + wc * 32 + 8 * fq;
#pragma unroll
        for (int ai = 0; ai < 2; ++ai)
#pragma unroll
            for (int m = 0; m < 4; ++m) { const int row = row0 + ai * HALF + m * 16;
#pragma unroll
                for (int bj = 0; bj < 2; ++bj) { const int col = col0 + bj * HALF;
                    const u32x4 g = *(gu4c*)(SZ + (size_t)row * 2048 + col), z = *(gu4c*)(SZ + (size_t)row * 2048 + 1024 + col), t = *(gu4c*)(T1 + (size_t)row * 1024 + col);
                    const f32x4 a0 = acc[ai][bj][m][0], a1 = acc[ai][bj][m][1]; f32x4 v0, v1;
                    v0[0] = bflo(g.x) * bflo(t.x) + bflo(z.x) * a0[0]; v0[1] = bfhi(g.x) * bfhi(t.x) + bfhi(z.x) * a0[1];
                    v0[2] = bflo(g.y) * bflo(t.y) + bflo(z.y) * a0[2]; v0[3] = bfhi(g.y) * bfhi(t.y) + bfhi(z.y) * a0[3];
                    v1[0] = bflo(g.z) * bflo(t.z) + bflo(z.z) * a1[0]; v1[1] = bfhi(g.z) * bfhi(t.z) + bfhi(z.z) * a1[1];
                    v1[2] = bflo(g.w) * bflo(t.w) + bflo(z.w) * a1[2]; v1[3] = bfhi(g.w) * bfhi(t.w) + bfhi(z.w) * a1[3];
                    *(gu4*)(O + (size_t)row * 1024 + col) = pack8(v0, v1); } }
    }
};
struct EpiResF32 {
    static constexpr bool PERM = false, AFTER_DRAIN = false, MIDK = false;
    const float* base; float* out;
    __device__ __forceinline__ void operator()(const f32x4 (&acc)[2][2][4][2], const Unit& u, int wr, int wc, int fr, int fq) const {
        const int row0 = u.lm * BM + wr * 64 + fr, col0 = u.ln * BM + wc * 32 + 4 * fq;
#pragma unroll
        for (int ai = 0; ai < 2; ++ai)
#pragma unroll
            for (int m = 0; m < 4; ++m) { const size_t off = (size_t)(row0 + ai * HALF + m * 16) * 1024 + col0;
#pragma unroll
                for (int bj = 0; bj < 2; ++bj)
#pragma unroll
                    for (int n = 0; n < 2; ++n) { const f32x4 b = *(gf4c*)(base + off + bj * HALF + n * 16); *(gf4*)(out + off + bj * HALF + n * 16) = b + acc[ai][bj][m][n]; } }
    }
};
template <bool SPLIT> struct EpiResNorm {
    static constexpr bool PERM = true, AFTER_DRAIN = false, MIDK = false;
    const float* base; float* out; bf16_t* H; bf16_t* L; float* SS;
    __device__ __forceinline__ void operator()(const f32x4 (&acc)[2][2][4][2], const Unit& u, int wr, int wc, int fr, int fq) const {
        const int row0 = u.lm * BM + wr * 64 + fr, col0 = u.ln * BM + wc * 32 + 8 * fq;
#pragma unroll
        for (int ai = 0; ai < 2; ++ai)
#pragma unroll
            for (int m = 0; m < 4; ++m) { const int row = row0 + ai * HALF + m * 16; const size_t off = (size_t)row * 1024 + col0; float ss = 0.f;
#pragma unroll
                for (int bj = 0; bj < 2; ++bj) { const f32x4 v0 = *(gf4c*)(base + off + bj * HALF) + acc[ai][bj][m][0], v1 = *(gf4c*)(base + off + bj * HALF + 4) + acc[ai][bj][m][1];
                    *(gf4*)(out + off + bj * HALF) = v0; *(gf4*)(out + off + bj * HALF + 4) = v1;
                    ss += (v0[0] * v0[0] + v0[1] * v0[1]) + (v0[2] * v0[2] + v0[3] * v0[3]) + (v1[0] * v1[0] + v1[1] * v1[1]) + (v1[2] * v1[2] + v1[3] * v1[3]);
                    const u32x4 h = pack8(v0, v1); *(gu4*)(H + off + bj * HALF) = h;
                    if (SPLIT) { f32x4 r0, r1; r0[0] = v0[0] - bflo(h.x); r0[1] = v0[1] - bfhi(h.x); r0[2] = v0[2] - bflo(h.y); r0[3] = v0[3] - bfhi(h.y); r1[0] = v1[0] - bflo(h.z); r1[1] = v1[1] - bfhi(h.z); r1[2] = v1[2] - bflo(h.w); r1[3] = v1[3] - bfhi(h.w);
                        *(gu4*)(L + off + bj * HALF) = pack8(r0, r1); } }
                ss += __shfl_xor(ss, 16); ss += __shfl_xor(ss, 32);
                if (fq == 0) ((gf1*)SS)[(size_t)row * 16 + u.ln * 4 + wc] = ss; }
    }
};
struct EpiLogits {
    static constexpr bool PERM = false, AFTER_DRAIN = false, MIDK = false;
    float* LG; int ld, ncols;
    __device__ __forceinline__ void operator()(const f32x4 (&acc)[2][2][4][2], const Unit& u, int wr, int wc, int fr, int fq) const {
        const int row0 = u.lm * BM + wr * 64 + fr, col0 = wc * 32 + 4 * fq;
#pragma unroll
        for (int ai = 0; ai < 2; ++ai)
#pragma unroll
            for (int m = 0; m < 4; ++m) { float* o = LG + (size_t)(row0 + ai * HALF + m * 16) * ld;
#pragma unroll
                for (int n = 0; n < 2; ++n) { const int col = col0 + n * 16; if (col < ncols) *(gf4*)(o + col) = acc[ai][0][m][n]; } }
    }
};
struct EpiMoe1 {
    static constexpr bool PERM = true, AFTER_DRAIN = false, MIDK = false;
    bf16_t* HID; const float* rstd_slot;
    __device__ __forceinline__ void operator()(const f32x4 (&acc)[2][2][4][2], const Unit& u, int wr, int wc, int fr, int fq) const {
        const int row0 = u.lm * BM + wr * 64 + fr, col0 = u.ln * 128 + wc * 32 + 8 * fq;
        float rsv[2][4];
#pragma unroll
        for (int ai = 0; ai < 2; ++ai)
#pragma unroll
            for (int m = 0; m < 4; ++m) rsv[ai][m] = ((gf1c*)rstd_slot)[row0 + ai * HALF + m * 16];
#pragma unroll
        for (int ai = 0; ai < 2; ++ai)
#pragma unroll
            for (int m = 0; m < 4; ++m) { const int row = row0 + ai * HALF + m * 16; const float rs = rsv[ai][m];
                f32x4 v0, v1;
#pragma unroll
                for (int e = 0; e < 4; ++e) { v0[e] = silu_f(acc[ai][0][m][0][e] * rs) * (acc[ai][1][m][0][e] * rs); v1[e] = silu_f(acc[ai][0][m][1][e] * rs) * (acc[ai][1][m][1][e] * rs); }
                *(gu4*)(HID + (size_t)row * 512 + col0) = pack8(v0, v1); }
    }
};
struct EpiMoe2 {
    static constexpr bool PERM = true, AFTER_DRAIN = false, MIDK = false;
    bf16_t* Y; const float* w_slot;
    __device__ __forceinline__ void operator()(const f32x4 (&acc)[2][2][4][2], const Unit& u, int wr, int wc, int fr, int fq) const {
        const int row0 = u.lm * BM + wr * 64 + fr, col0 = u.ln * BM + wc * 32 + 8 * fq;
        float rsv[2][4];
#pragma unroll
        for (int ai = 0; ai < 2; ++ai)
#pragma unroll
            for (int m = 0; m < 4; ++m) rsv[ai][m] = ((gf1c*)w_slot)[row0 + ai * HALF + m * 16];
#pragma unroll
        for (int ai = 0; ai < 2; ++ai)
#pragma unroll
            for (int m = 0; m < 4; ++m) { const int row = row0 + ai * HALF + m * 16; const float rs = rsv[ai][m];
#pragma unroll
                for (int bj = 0; bj < 2; ++bj) *(gu4*)(Y + (size_t)row * 1024 + col0 + bj * HALF) = pack8(acc[ai][bj][m][0] * rs, acc[ai][bj][m][1] * rs); }
    }
};
struct EpiP1 {
    static constexpr bool PERM = true, AFTER_DRAIN = false, MIDK = false;
    EpiInProj e0; EpiVT e1; EpiRowBf16<0> e2, e3;
    __device__ __forceinline__ void operator()(const f32x4 (&acc)[2][2][4][2], const Unit& u, int wr, int wc, int fr, int fq) const {
        if (u.ty == 0) e0(acc, u, wr, wc, fr, fq); else if (u.ty == 1) e1(acc, u, wr, wc, fr, fq); else if (u.ty == 2) e2(acc, u, wr, wc, fr, fq); else e3(acc, u, wr, wc, fr, fq);
    }
};
struct EpiMerge2 {
    static constexpr bool PERM = true, AFTER_DRAIN = false, MIDK = true;
    bf16_t* O; const bf16_t* SZ;
    __device__ __forceinline__ void mid(f32x4 (&acc)[2][2][4][2], const Unit& u, int wr, int wc, int fr, int fq) const {
        const int row0 = u.lm * BM + wr * 64 + fr, col0 = u.ln * BM + wc * 32 + 8 * fq;
#pragma unroll
        for (int ai = 0; ai < 2; ++ai) { u32x4 gq[4][2], zq[4][2];
#pragma unroll
            for (int m = 0; m < 4; ++m)
#pragma unroll
                for (int bj = 0; bj < 2; ++bj) { const bf16_t* p = SZ + (size_t)(row0 + ai * HALF + m * 16) * 2048 + col0 + bj * HALF; gq[m][bj] = *(gu4c*)p; zq[m][bj] = *(gu4c*)(p + 1024); }
            asm volatile("" ::: "memory");
#pragma unroll
            for (int m = 0; m < 4; ++m)
#pragma unroll
                for (int bj = 0; bj < 2; ++bj) { const u32x4 g = gq[m][bj], z = zq[m][bj]; f32x4 r0, r1;
                    r0[0] = bflo(g.x) * __builtin_amdgcn_rcpf(fmaxf(bflo(z.x), 1e-30f)); r0[1] = bfhi(g.x) * __builtin_amdgcn_rcpf(fmaxf(bfhi(z.x), 1e-30f)); r0[2] = bflo(g.y) * __builtin_amdgcn_rcpf(fmaxf(bflo(z.y), 1e-30f)); r0[3] = bfhi(g.y) * __builtin_amdgcn_rcpf(fmaxf(bfhi(z.y), 1e-30f));
                    r1[0] = bflo(g.z) * __builtin_amdgcn_rcpf(fmaxf(bflo(z.z), 1e-30f)); r1[1] = bfhi(g.z) * __builtin_amdgcn_rcpf(fmaxf(bfhi(z.z), 1e-30f)); r1[2] = bflo(g.w) * __builtin_amdgcn_rcpf(fmaxf(bflo(z.w), 1e-30f)); r1[3] = bfhi(g.w) * __builtin_amdgcn_rcpf(fmaxf(bfhi(z.w), 1e-30f));
                    acc[ai][bj][m][0] = acc[ai][bj][m][0] * r0; acc[ai][bj][m][1] = acc[ai][bj][m][1] * r1; } }
    }
    __device__ __forceinline__ void operator()(const f32x4 (&acc)[2][2][4][2], const Unit& u, int wr, int wc, int fr, int fq) const {
        const int row0 = u.lm * BM + wr * 64 + fr, col0 = u.ln * BM + wc * 32 + 8 * fq;
        u32x4 zq[2][4][2];
#pragma unroll
        for (int ai = 0; ai < 2; ++ai)
#pragma unroll
            for (int m = 0; m < 4; ++m)
#pragma unroll
                for (int bj = 0; bj < 2; ++bj) zq[ai][m][bj] = *(gu4c*)(SZ + (size_t)(row0 + ai * HALF + m * 16) * 2048 + 1024 + col0 + bj * HALF);
        asm volatile("" ::: "memory");
#pragma unroll
        for (int ai = 0; ai < 2; ++ai)
#pragma unroll
            for (int m = 0; m < 4; ++m)
#pragma unroll
                for (int bj = 0; bj < 2; ++bj) { const u32x4 z = zq[ai][m][bj]; f32x4 v0 = acc[ai][bj][m][0], v1 = acc[ai][bj][m][1];
                    v0[0] *= bflo(z.x); v0[1] *= bfhi(z.x); v0[2] *= bflo(z.y); v0[3] *= bfhi(z.y); v1[0] *= bflo(z.z); v1[1] *= bfhi(z.z); v1[2] *= bflo(z.w); v1[3] *= bfhi(z.w);
                    *(gu4*)(O + (size_t)(row0 + ai * HALF + m * 16) * 1024 + col0 + bj * HALF) = pack8(v0, v1); }
    }
};
template <bool BASE_F32, bool WRITE_L> struct EpiResSplit {
    static constexpr bool PERM = true, AFTER_DRAIN = false, MIDK = false;
    const float* basef; const bf16_t* baseH; const bf16_t* baseL; bf16_t* H; bf16_t* L; float* SS;
    struct Buf { f32x4 f0[2][2], f1[2][2]; u32x4 h[2][2]; };
    __device__ __forceinline__ void load(Buf& B, int row0, int col0, int q) const {
#pragma unroll
        for (int mm = 0; mm < 2; ++mm)
#pragma unroll
            for (int bj = 0; bj < 2; ++bj) { const size_t off = (size_t)(row0 + (q >> 1) * HALF + (2 * (q & 1) + mm) * 16) * 1024 + col0 + bj * HALF;
                if (BASE_F32) { B.f0[mm][bj] = *(gf4c*)(basef + off); B.f1[mm][bj] = *(gf4c*)(basef + off + 4); } else B.h[mm][bj] = *(gu4c*)(baseH + off); }
    }
    __device__ __forceinline__ void operator()(const f32x4 (&acc)[2][2][4][2], const Unit& u, int wr, int wc, int fr, int fq) const {
        const int row0 = u.lm * BM + wr * 64 + fr, col0 = u.ln * BM + wc * 32 + 8 * fq;
        Buf B[2]; load(B[0], row0, col0, 0);
#pragma unroll
        for (int q = 0; q < 4; ++q) { const int ai = q >> 1, mp = q & 1;
            if (q + 1 < 4) load(B[(q + 1) & 1], row0, col0, q + 1);
            const Buf& C = B[q & 1];
#pragma unroll
            for (int mm = 0; mm < 2; ++mm) { const int m = 2 * mp + mm; const int row = row0 + ai * HALF + m * 16; const size_t off = (size_t)row * 1024 + col0; float ss = 0.f;
#pragma unroll
                for (int bj = 0; bj < 2; ++bj) { f32x4 v0, v1;
                    if (BASE_F32) { v0 = C.f0[mm][bj]; v1 = C.f1[mm][bj]; }
                    else { const u32x4 b = C.h[mm][bj]; v0[0] = bflo(b.x); v0[1] = bfhi(b.x); v0[2] = bflo(b.y); v0[3] = bfhi(b.y); v1[0] = bflo(b.z); v1[1] = bfhi(b.z); v1[2] = bflo(b.w); v1[3] = bfhi(b.w); }
                    v0 = v0 + acc[ai][bj][m][0]; v1 = v1 + acc[ai][bj][m][1];
                    ss += (v0[0] * v0[0] + v0[1] * v0[1]) + (v0[2] * v0[2] + v0[3] * v0[3]) + (v1[0] * v1[0] + v1[1] * v1[1]) + (v1[2] * v1[2] + v1[3] * v1[3]);
                    const u32x4 h = pack8(v0, v1); *(gu4*)(H + off + bj * HALF) = h;
                    if (WRITE_L) { f32x4 r0, r1; r0[0] = v0[0] - bflo(h.x); r0[1] = v0[1] - bfhi(h.x); r0[2] = v0[2] - bflo(h.y); r0[3] = v0[3] - bfhi(h.y); r1[0] = v1[0] - bflo(h.z); r1[1] = v1[1] - bfhi(h.z); r1[2] = v1[2] - bflo(h.w); r1[3] = v1[3] - bfhi(h.w);
                        *(gu4*)(L + off + bj * HALF) = pack8(r0, r1); } }
                ss += __shfl_xor(ss, 16); ss += __shfl_xor(ss, 32);
                if (fq == 0) ((gf1*)SS)[(size_t)row * 16 + u.ln * 4 + wc] = ss; } }
    }
};
template <int NM0, int NN0, int A00, int B00, int NM1, int NN1, int A01, int B01, int NM2, int NN2, int A02, int B02, int NM3, int NN3, int A03, int B03>
struct MultiOrder {
    static constexpr bool GATHER = false;
    int G, c;
    __device__ __forceinline__ bool next(int i, Unit& u) const {
        constexpr int C0 = NM0 * NN0, C1 = NM1 * NN1, C2 = NM2 * NN2, C3 = NM3 * NN3;
        long L = (long)i * G + c; int s, nwg, nNs, nMs, a0s, b0s;
        if (L < C0) { s = 0; nwg = C0; nNs = NN0; nMs = NM0; a0s = A00; b0s = B00; }
        else if (L < C0 + C1) { L -= C0; s = 1; nwg = C1; nNs = NN1; nMs = NM1; a0s = A01; b0s = B01; }
        else if (L < C0 + C1 + C2) { L -= C0 + C1; s = 2; nwg = C2; nNs = NN2; nMs = NM2; a0s = A02; b0s = B02; }
        else if (L < C0 + C1 + C2 + C3) { L -= C0 + C1 + C2; s = 3; nwg = C3; nNs = NN3; nMs = NM3; a0s = A03; b0s = B03; }
        else return false;
        int wgid = (int)L; { const int q = nwg / NXCD, r = nwg % NXCD, xcd = wgid % NXCD, off = wgid / NXCD; wgid = (xcd < r ? xcd * (q + 1) : r * (q + 1) + (xcd - r) * q) + off; }
        const int nig = WGM * nNs, gid = wgid / nig, fm = gid * WGM, gsz = (nMs - fm) < WGM ? (nMs - fm) : WGM;
        u.lm = fm + ((wgid % nig) % gsz); u.ln = (wgid % nig) / gsz; u.pm = a0s + u.lm; u.pn = b0s + u.ln; u.ty = s; return true;
    }
    __device__ __forceinline__ void a_ready(const Unit&) const {}
    __device__ __forceinline__ void done(const Unit&) const {}
};
struct MoeOrder {
    static constexpr bool GATHER = false;
    const PG8_LAS int* tile_e; int ntile, G, c;
    __device__ __forceinline__ bool next(int i, Unit& u) const {
        const long L = (long)i * G + c; if (L >= (long)ntile * 4) return false;
        const int pm = (int)(L >> 2), j = (int)(L & 3); u.pm = pm; u.pn = __builtin_amdgcn_readfirstlane(tile_e[pm]) * 4 + j; u.lm = pm; u.ln = j; u.ty = 0; return true;
    }
    __device__ __forceinline__ void a_ready(const Unit&) const {}
    __device__ __forceinline__ void done(const Unit&) const {}
};
struct MoeGatherOrder {
    static constexpr bool GATHER = true;
    const PG8_LAS int* tile_e; const PG8_LAS int* rows; int ntile, G, c;
    __device__ __forceinline__ bool next(int i, Unit& u) const {
        const long L = (long)i * G + c; if (L >= (long)ntile * 4) return false;
        const int pm = (int)(L >> 2), j = (int)(L & 3); u.pm = pm; u.pn = __builtin_amdgcn_readfirstlane(tile_e[pm]) * 4 + j; u.lm = pm; u.ln = j; u.ty = 0; return true;
    }
    __device__ __forceinline__ int row(int ui, int r) const { return rows[ui * 256 + r]; }
    __device__ __forceinline__ void a_ready(const Unit&) const {}
    __device__ __forceinline__ void done(const Unit&) const {}
};
#ifndef PROBE_ACC
#define PROBE_ACC -1
#endif
#ifndef PROBE_N
#define PROBE_N 0
#endif
#define PG8_PB(id) do { if ((id) == PROBE_ACC && (PROBE_N == 0 || g.N == PROBE_N)) g_t0 = __builtin_amdgcn_s_memrealtime(); } while (0)
#define PG8_PE(id) do { if ((id) == PROBE_ACC && (PROBE_N == 0 || g.N == PROBE_N) && wid == 0 && lane == 0) { const unsigned d_ = (unsigned)(__builtin_amdgcn_s_memrealtime() - g_t0); __hip_atomic_fetch_add((PG8_LAS unsigned*)(lds + 147776 + 4 * 16), d_, __ATOMIC_RELAXED, __HIP_MEMORY_SCOPE_WORKGROUP); } } while (0)
template <class Epi, class Sched, bool ALIGN_EPI = false, bool SP2 = false>
__device__ __forceinline__ void gemm_phase(PG8_LAS unsigned char* lds, const Gemm g, const Sched& S, const Epi& E) {
    const int tid = threadIdx.x, wid = __builtin_amdgcn_readfirstlane(tid >> 6), lane = tid & 63, wr = wid >> 2, wc = wid & 3, fr = lane & 15, fq = lane >> 4;
    const int K = g.K, nt = K / BK; unsigned long long g_t0 = 0; (void)g_t0; PG8_PB(42);
    unsigned voffA[2], voffB[2];
#pragma unroll
    for (int i = 0; i < 2; ++i) { int R, C; stage_rc(tid * 16 + i * 8192, R, C); const int Rb = Epi::PERM ? ((R & ~31) + perm32(R & 31)) : R;
        voffA[i] = (unsigned)(R * K + C) * 2u; voffB[i] = (unsigned)(Rb * K + C) * 2u; }
    static_assert(!Sched::GATHER || SP2, "gathered A rows: SP2 loop only");
    unsigned gA[2][2], gN[2][2];
#define PG8_GOFF(dst, ui_) do { _Pragma("unroll") for (int _h = 0; _h < 2; ++_h) _Pragma("unroll") for (int _i = 0; _i < 2; ++_i) { int _R, _C; stage_rc(tid * 16 + _i * 8192, _R, _C); dst[_h][_i] = (unsigned)(S.row((ui_), _h * HALF + _R) * K + _C) * 2u; } } while (0)
#define PG8_STAGE_A(bufoff, gbase, hh, un_) do { if constexpr (Sched::GATHER) { unsigned _vo[2] = {(un_) ? gN[hh][0] : gA[hh][0], (un_) ? gN[hh][1] : gA[hh][1]}; PG8_STAGE(bufoff, gbase, _vo); } else { PG8_STAGE(bufoff, (gbase) + ((hh) ? hstep : 0), voffA); } } while (0)
    const size_t kstep = (size_t)(BK * 2);
    const size_t hstep = (size_t)HALF * K * 2;
    const size_t tstep = 2 * hstep;
    const unsigned ldsw = (unsigned)wid * 1024u;
    const int aoff = lds_byte(wr * 64 + fr, fq * 8), boff = lds_byte(wc * 32 + fr, fq * 8);
#define PG8_SA(b, h) (((b) * 2 + (h)) * HTB)
#define PG8_SB(b, h) ((4 + (b) * 2 + (h)) * HTB)
#define PG8_STAGE(bufoff, gbase, voff) do { _Pragma("unroll") for (int _i = 0; _i < 2; ++_i) \
        __builtin_amdgcn_global_load_lds((const unsigned*)((const char*)(gbase) + (voff)[_i]), (PG8_LAS unsigned*)(lds + (bufoff) + ldsw + _i * 8192), 16, 0, 0); } while (0)
#define PG8_LDA(dst, b, h) do { _Pragma("unroll") for (int m = 0; m < 4; ++m) _Pragma("unroll") for (int k = 0; k < 2; ++k) dst[m][k] = *(const PG8_LAS bf16x8*)(lds + PG8_SA(b, h) + aoff + m * 2048 + k * 1024); } while (0)
#define PG8_LDB(dst, b, h) do { _Pragma("unroll") for (int n = 0; n < 2; ++n) _Pragma("unroll") for (int k = 0; k < 2; ++k) dst[n][k] = *(const PG8_LAS bf16x8*)(lds + PG8_SB(b, h) + boff + n * 2048 + k * 1024); } while (0)
#define PG8_MMA(ai, bj, At, Bt) do { __builtin_amdgcn_s_setprio(1); _Pragma("unroll") for (int m = 0; m < 4; ++m) _Pragma("unroll") for (int n = 0; n < 2; ++n) _Pragma("unroll") for (int k = 0; k < 2; ++k) \
        acc[ai][bj][m][n] = __builtin_amdgcn_mfma_f32_16x16x32_bf16(Bt[n][k], At[m][k], acc[ai][bj][m][n], 0, 0, 0); __builtin_amdgcn_s_setprio(0); } while (0)
#define PG8_WAIT_V(n) asm volatile("s_waitcnt vmcnt(" #n ")" ::: "memory")
#define PG8_WAIT_L(n) asm volatile("s_waitcnt lgkmcnt(" #n ")" ::: "memory")
#define PG8_BAR __builtin_amdgcn_s_barrier()
#define PG8_SCHED __builtin_amdgcn_sched_barrier(0)
    Unit cur, nxt; int ui = 0;
    if (!S.next(0, cur)) return;
    f32x4 acc[2][2][4][2];
#pragma unroll
    for (int a = 0; a < 2; ++a)
#pragma unroll
        for (int b = 0; b < 2; ++b)
#pragma unroll
            for (int m = 0; m < 4; ++m)
#pragma unroll
                for (int n = 0; n < 2; ++n) acc[a][b][m][n] = (f32x4){0.f, 0.f, 0.f, 0.f};
    bf16x8 At[4][2], B0[2][2], B1[2][2];
    const char* cA = (const char*)g.A + (Sched::GATHER ? (size_t)0 : (size_t)cur.pm * tstep); const char* cB = (const char*)g.Bt + (size_t)cur.pn * tstep;
    if constexpr (Sched::GATHER) { PG8_GOFF(gA, 0); }
    S.a_ready(cur);
    if constexpr (SP2) {
        PG8_STAGE(PG8_SB(0, 0), cB, voffB); PG8_STAGE(PG8_SB(0, 1), cB + hstep, voffB); PG8_STAGE_A(PG8_SA(0, 0), cA, 0, false); PG8_STAGE_A(PG8_SA(0, 1), cA, 1, false);
        if (wr == 1) PG8_BAR;
        PG8_WAIT_V(2); PG8_BAR;
        PG8_STAGE(PG8_SB(1, 0), cB + kstep, voffB); PG8_STAGE_A(PG8_SA(1, 0), cA + kstep, 0, false); PG8_STAGE(PG8_SB(1, 1), cB + hstep + kstep, voffB);
        PG8_WAIT_V(6); PG8_BAR;
    } else {
        PG8_STAGE(PG8_SB(0, 0), cB, voffB); PG8_STAGE(PG8_SA(0, 0), cA, voffA); PG8_STAGE(PG8_SB(0, 1), cB + hstep, voffB); PG8_STAGE(PG8_SA(0, 1), cA + hstep, voffA);
        if (wr == 1) PG8_BAR;
        PG8_WAIT_V(4); PG8_BAR;
        PG8_STAGE(PG8_SB(1, 0), cB + kstep, voffB); PG8_STAGE(PG8_SA(1, 0), cA + kstep, voffA); PG8_STAGE(PG8_SB(1, 1), cB + hstep + kstep, voffB);
        PG8_WAIT_V(6); PG8_BAR;
    }
    PG8_PE(42);
    for (;;) {
        const bool has_next = S.next(ui + 1, nxt); PG8_PB(40);
        if constexpr (Sched::GATHER) { if (has_next) PG8_GOFF(gN, ui + 1); }
        const char* nA = (has_next && !Sched::GATHER) ? (const char*)g.A + (size_t)nxt.pm * tstep : cA; const char* nB = has_next ? (const char*)g.Bt + (size_t)nxt.pn * tstep : cB;
        for (int t = 0; t < nt; t += 2) {
            if constexpr (Epi::MIDK) { if (t == (nt >> 1)) { int t_ = threadIdx.x; asm volatile("" : "+v"(t_)); const int l_ = t_ & 63, w_ = __builtin_amdgcn_readfirstlane(t_ >> 6); E.mid(acc, cur, w_ >> 2, w_ & 3, l_ & 15, l_ >> 4); } }
            const bool last = (t == nt - 2); const bool un = last && has_next;
            const char* a1 = cA + (size_t)(t + 1) * kstep;
            const char* a2 = last ? nA : cA + (size_t)(t + 2) * kstep; const char* b2 = last ? nB : cB + (size_t)(t + 2) * kstep;
            const char* a3 = a2 + kstep; const char* b3 = b2 + kstep;
            if (last && has_next) S.a_ready(nxt);
            if constexpr (SP2) {
            PG8_LDB(B0, 0, 0); PG8_LDB(B1, 0, 1); PG8_SCHED; PG8_LDA(At, 0, 0); PG8_STAGE_A(PG8_SA(1, 1), a1, 1, false);
            PG8_WAIT_V(8); PG8_WAIT_L(0); PG8_BAR; PG8_MMA(0, 0, At, B0); PG8_MMA(0, 1, At, B1); PG8_BAR; PG8_SCHED;
            PG8_LDA(At, 0, 1); PG8_STAGE(PG8_SB(0, 0), b2, voffB); PG8_STAGE(PG8_SB(0, 1), b2 + hstep, voffB); PG8_STAGE_A(PG8_SA(0, 0), a2, 0, un);
            PG8_WAIT_V(8); PG8_WAIT_L(0); PG8_BAR; PG8_MMA(1, 0, At, B0); PG8_MMA(1, 1, At, B1); PG8_BAR; PG8_SCHED;
            PG8_LDB(B0, 1, 0); PG8_LDB(B1, 1, 1); PG8_SCHED; PG8_LDA(At, 1, 0); PG8_STAGE_A(PG8_SA(0, 1), a2, 1, un);
            PG8_WAIT_V(8); PG8_WAIT_L(0); PG8_BAR; PG8_MMA(0, 0, At, B0); PG8_MMA(0, 1, At, B1); PG8_BAR; PG8_SCHED;
            PG8_LDA(At, 1, 1); PG8_STAGE(PG8_SB(1, 0), b3, voffB); PG8_STAGE(PG8_SB(1, 1), b3 + hstep, voffB); PG8_STAGE_A(PG8_SA(1, 0), a3, 0, un);
            PG8_WAIT_V(8); PG8_WAIT_L(0); PG8_BAR; PG8_MMA(1, 0, At, B0); PG8_MMA(1, 1, At, B1); PG8_BAR; PG8_SCHED;
            } else {
            PG8_LDB(B0, 0, 0); PG8_SCHED; PG8_LDA(At, 0, 0); PG8_STAGE(PG8_SA(1, 1), a1 + hstep, voffA);
            PG8_WAIT_L(8); PG8_BAR; PG8_WAIT_L(0); PG8_MMA(0, 0, At, B0); PG8_BAR; PG8_SCHED;
            PG8_LDB(B1, 0, 1); PG8_STAGE(PG8_SB(0, 0), b2, voffB);
            PG8_BAR; PG8_WAIT_L(0); PG8_MMA(0, 1, At, B1); PG8_BAR;
            PG8_LDA(At, 0, 1); PG8_STAGE(PG8_SA(0, 0), a2, voffA);
            PG8_BAR; PG8_WAIT_L(0); PG8_MMA(1, 0, At, B0); PG8_BAR; PG8_SCHED;
            PG8_STAGE(PG8_SB(0, 1), b2 + hstep, voffB);
            PG8_WAIT_V(6); PG8_BAR; PG8_MMA(1, 1, At, B1); PG8_BAR;
            PG8_LDB(B0, 1, 0); PG8_SCHED; PG8_LDA(At, 1, 0); PG8_STAGE(PG8_SA(0, 1), a2 + hstep, voffA);
            PG8_WAIT_L(8); PG8_BAR; PG8_WAIT_L(0); PG8_MMA(0, 0, At, B0); PG8_BAR; PG8_SCHED;
            PG8_LDB(B1, 1, 1); PG8_STAGE(PG8_SB(1, 0), b3, voffB);
            PG8_BAR; PG8_WAIT_L(0); PG8_MMA(0, 1, At, B1); PG8_BAR;
            PG8_LDA(At, 1, 1); PG8_STAGE(PG8_SA(1, 0), a3, voffA);
            PG8_BAR; PG8_WAIT_L(0); PG8_MMA(1, 0, At, B0); PG8_BAR; PG8_SCHED;
            PG8_STAGE(PG8_SB(1, 1), b3 + hstep, voffB);
            PG8_WAIT_V(6); PG8_BAR; PG8_MMA(1, 1, At, B1); PG8_BAR;
            }
        }
        PG8_PE(40); PG8_PB(41);
        if constexpr (ALIGN_EPI) { if (wr == 0) PG8_BAR; }
        if constexpr (!Epi::AFTER_DRAIN) { int t_ = threadIdx.x; asm volatile("" : "+v"(t_)); const int l_ = t_ & 63, w_ = __builtin_amdgcn_readfirstlane(t_ >> 6); E(acc, cur, w_ >> 2, w_ & 3, l_ & 15, l_ >> 4); S.done(cur); }
        PG8_PE(41);
        if (!has_next) break;
#pragma unroll
        for (int a = 0; a < 2; ++a)
#pragma unroll
            for (int b = 0; b < 2; ++b)
#pragma unroll
                for (int m = 0; m < 4; ++m)
#pragma unroll
                    for (int n = 0; n < 2; ++n) acc[a][b][m][n] = (f32x4){0.f, 0.f, 0.f, 0.f};
        cur = nxt; cA = nA; cB = nB; ++ui;
        if constexpr (Sched::GATHER) { _Pragma("unroll") for (int _h = 0; _h < 2; ++_h) _Pragma("unroll") for (int _i = 0; _i < 2; ++_i) gA[_h][_i] = gN[_h][_i]; }
        if constexpr (ALIGN_EPI) { if (wr == 1) PG8_BAR; }
    }
    PG8_PB(43);
    PG8_WAIT_V(0);
    if constexpr (!ALIGN_EPI) { if (wr == 0) PG8_BAR; }
    PG8_BAR;
    if constexpr (Epi::AFTER_DRAIN) { E.fused(acc, cur, wr, wc, fr, fq, lds, wid, lane); S.done(cur); }
    PG8_PE(43);
#undef PG8_SA
#undef PG8_SB
#undef PG8_STAGE
#undef PG8_STAGE_A
#undef PG8_GOFF
#undef PG8_LDA
#undef PG8_LDB
#undef PG8_MMA
#undef PG8_WAIT_V
#undef PG8_WAIT_L
#undef PG8_BAR
#undef PG8_SCHED
}
}
#define GAS __attribute__((address_space(1)))
#define LAS __attribute__((address_space(3)))
typedef unsigned short bf16;
typedef unsigned v4u __attribute__((ext_vector_type(4)));
typedef float f32x4 __attribute__((ext_vector_type(4)));
typedef short bf16x8 __attribute__((ext_vector_type(8)));
typedef GAS unsigned gu32;
typedef GAS unsigned long long gu64;
#define RLX_AGENT __ATOMIC_RELAXED, __HIP_MEMORY_SCOPE_AGENT
#define LDS_WAIT() asm volatile("s_waitcnt lgkmcnt(0)" ::: "memory")
#define VM_WAIT() asm volatile("s_waitcnt vmcnt(0)" ::: "memory")
__device__ __forceinline__ unsigned long long rt() { return __builtin_amdgcn_s_memrealtime(); }
__device__ __forceinline__ unsigned f2bf(float f) { unsigned u = __builtin_bit_cast(unsigned, f); return (u + 0x7fffu + ((u >> 16) & 1u)) >> 16; }
__device__ __forceinline__ unsigned pk2(float lo, float hi) { return f2bf(lo) | (f2bf(hi) << 16); }
#define XB_TMO      128
#define XB_XCNT(j)  (256  + 64 * (j))
#define XB_XSUB(j)  (1280 + 64 * (j))
#define XB_XGEN(j)  (2304 + 64 * (j))
#define XB_TOP      3328
#define XB_TOPGEN   3392
#define XCD_BAR_WORDS 3456
#define XB_SPIN_CAP (1u << 18)

__device__ __forceinline__ unsigned xb_ld(unsigned* p)              { return __hip_atomic_load(p, __ATOMIC_RELAXED, __HIP_MEMORY_SCOPE_AGENT); }
__device__ __forceinline__ unsigned xb_add(unsigned* p, unsigned v) { return __hip_atomic_fetch_add(p, v, __ATOMIC_RELAXED, __HIP_MEMORY_SCOPE_AGENT); }
__device__ __forceinline__ unsigned xb_xcc_id() { return (unsigned)__builtin_amdgcn_s_getreg((3 << 11) | 20) & 0xFu; }
#define XB_SPIN(cond, bar) do { unsigned _sp = 0; while (cond) { __builtin_amdgcn_s_sleep(1); \
    if ((++_sp & 255u) == 0u) { if (xb_ld(&(bar)[XB_TMO])) break; if (_sp > XB_SPIN_CAP) { atomicAdd(&(bar)[XB_TMO], 1u); break; } } } } while (0)

struct XcdBarrier {
    unsigned* bar; unsigned x;
    volatile LAS unsigned* st;
};

__device__ __forceinline__ XcdBarrier xcd_barrier_post(unsigned* bar, volatile LAS unsigned* st) {
    XcdBarrier b; b.bar = bar; b.x = xb_xcc_id(); b.st = st;
    if (threadIdx.x == 0) (void)xb_add(&bar[XB_XCNT(b.x)], 1u);
    return b;
}
__device__ __forceinline__ void xcd_barrier_complete(unsigned* bar, unsigned x, unsigned& nloc, unsigned& nx) {
    const unsigned G = gridDim.x * gridDim.y * gridDim.z;
    unsigned sum, cnt, mine, sp = 0u;
    for (;;) {
        sum = 0u; cnt = 0u; mine = 0u;
#pragma unroll
        for (unsigned j = 0; j < 16; ++j) { const unsigned c = xb_ld(&bar[XB_XCNT(j)]); sum += c; cnt += (c > 0u) ? 1u : 0u; mine = (j == x) ? c : mine; }
        if (sum == G) break;
        __builtin_amdgcn_s_sleep(1);
        if ((++sp & 255u) == 0u) { if (xb_ld(&bar[XB_TMO])) break; if (sp > XB_SPIN_CAP) { atomicAdd(&bar[XB_TMO], 1u); break; } }
    }
    nloc = mine > 0u ? mine : 1u; nx = cnt > 0u ? cnt : 1u;
}

__device__ __forceinline__ void xcd_barrier(const XcdBarrier& b) {
    asm volatile("s_waitcnt vmcnt(0)" ::: "memory");
    __syncthreads();
    if (threadIdx.x == 0) {
        unsigned* bar = b.bar;
        __builtin_amdgcn_s_waitcnt(0);
        unsigned nloc = b.st[0], nx = b.st[1];
        if (nloc == 0u) { xcd_barrier_complete(bar, b.x, nloc, nx); b.st[0] = nloc; b.st[1] = nx; }
        const unsigned old = xb_add(&bar[XB_XSUB(b.x)], 1u);
        const unsigned gen = old / nloc;
        if (old + 1u == (gen + 1u) * nloc) {
            __builtin_amdgcn_fence(__ATOMIC_RELEASE, "agent");
            asm volatile("s_waitcnt vmcnt(0)" ::: "memory");
            const unsigned og = xb_add(&bar[XB_TOP], 1u);
            const unsigned tg = og / nx;
            if (og + 1u == (tg + 1u) * nx) xb_add(&bar[XB_TOPGEN], 1u);
            else XB_SPIN(xb_ld(&bar[XB_TOPGEN]) == tg, bar);
            __builtin_amdgcn_fence(__ATOMIC_ACQUIRE, "agent");
            xb_add(&bar[XB_XGEN(b.x)], 1u);
            asm volatile("s_waitcnt vmcnt(0)" ::: "memory");
        } else {
            XB_SPIN(xb_ld(&bar[XB_XGEN(b.x)]) == gen, bar);
            __builtin_amdgcn_fence(__ATOMIC_ACQUIRE, "agent");
            asm volatile("s_waitcnt vmcnt(0)" ::: "memory");
        }
    }
    __syncthreads();
}

constexpr int NWAVES = 8, NTHR = 512;
constexpr int M = 32768, D = 1024, SEQ = 8192, NB = 4;
constexpr int DIN = 5136;
constexpr int MOE_CAP_TILES = 288, MOE_CAP = MOE_CAP_TILES * 256;
constexpr int LIST_CAP = 256 * 496;
constexpr float EPS = 1e-6f;
#ifndef MK_ONE_LAUNCH
#define MK_ONE_LAUNCH 0
#endif
constexpr int NPHASE = 20;

constexpr size_t MiB = 1u << 20, KiB = 1u << 10;
constexpr size_t WS_CTL = 0, CTL_ZERO_BYTES = 128 * KiB;
constexpr int CW_TMO = 0, CW_CODE = 1, CW_BAR = 4096, CW_LCNT = 16384, CW_ECNT = 20480, CW_WQ = 24576;
static_assert((CW_WQ + 256) * 4 <= (int)CTL_ZERO_BYTES && CW_BAR + 3456 <= CW_LCNT, "control words inside the zeroed region");
constexpr size_t WS_RSTD0 = 1 * MiB, WS_RSTD1 = WS_RSTD0 + 128 * KiB, WS_RSTD2 = WS_RSTD1 + 128 * KiB;
constexpr size_t WS_DEC = 1 * MiB + 512 * KiB;
constexpr size_t WS_KMEAN = 2 * MiB, WS_KNMAX = 2 * MiB + 256 * KiB;
constexpr size_t WS_MOE_E = 2 * MiB + 512 * KiB, WS_MOE_POS = WS_MOE_E + 256 * KiB, WS_MOE_W = WS_MOE_POS + 256 * KiB, WS_SLOT_OF = WS_MOE_W + 256 * KiB;
constexpr size_t WS_W_SLOT = 4 * MiB, WS_RSTD_SLOT = 4 * MiB + 512 * KiB, WS_TILE_E = 5 * MiB;
constexpr size_t WS_MEMN = 6 * MiB, WS_MKV = 8 * MiB;
constexpr size_t WS_W1T = 10 * MiB  , WS_WVT = WS_W1T + 8704 * KiB, WS_PGMT = WS_WVT + 2 * MiB  , WS_WOUTT = WS_PGMT + 2 * MiB,
                 WS_WCQT = WS_WOUTT + 2 * MiB, WS_WCKVT = WS_WCQT + 1 * MiB, WS_WCOT = WS_WCKVT + 2 * MiB, WS_WRT = WS_WCOT + 1 * MiB;
static_assert(WS_WRT + 1 * MiB <= 30 * MiB, "weights");
constexpr size_t WS_XB = 30 * MiB, WS_QG = 94 * MiB, WS_KG = 110 * MiB, WS_SR = 126 * MiB, WS_QM = 158 * MiB, WS_KM = 190 * MiB, WS_VT = 222 * MiB, WS_OGM = 286 * MiB  , WS_SZ = 350 * MiB;
constexpr size_t WS_LISTS = 478 * MiB, WS_REFS = 494 * MiB, WS_SEL = 495 * MiB, WS_PARTL = 496 * MiB;
constexpr size_t WS_MG = 30 * MiB, WS_X1H = 94 * MiB, WS_X1L = 158 * MiB, WS_QC = 476 * MiB, WS_SS2 = 508 * MiB, WS_SS1 = 510 * MiB;
constexpr size_t WS_X2H = 222 * MiB, WS_X2L = 286 * MiB;
constexpr size_t WS_WGUT = 30 * MiB, WS_WDT = 350 * MiB, WS_LG = 454 * MiB, WS_LG2 = 464 * MiB, WS_HID = 382 * MiB, WS_XG = 30 * MiB  ;
constexpr size_t WS_END = 512 * MiB;
static_assert(WS_XG + 144 * MiB <= WS_X2H && WS_WDT + 32 * MiB <= WS_HID && WS_HID + 72 * MiB <= WS_LG && WS_LG2 + 5 * MiB <= WS_QC && WS_PARTL + 3 * MiB <= WS_END && WS_SS1 + 2 * MiB <= WS_END, "map");
constexpr size_t DO_ST = 0, DO_LA = 64 * MiB, DO_SB = 96 * MiB, DO_PARTO = 0;
constexpr size_t WS_TOK = 5 * MiB + 64 * KiB;
constexpr size_t WS_EMID = 5 * MiB + 512 * KiB;

constexpr int RING_OFF = 0, RING_BYTES = 147456;
constexpr int LDSCTL_OFF = RING_BYTES, MISC_OFF = LDSCTL_OFF + 320;
constexpr int TBL_TILE = RING_BYTES + 1024, TBL_TAB = TBL_TILE + 1280, TBL_BC = TBL_TAB + 512, TBL_EB = TBL_BC + 64;
constexpr int TBL_ROWS = 155648;
constexpr int LDS_BYTES = 163840;
static_assert(TBL_EB + 256 + 1088 * 4 <= TBL_ROWS && TBL_ROWS + 6 * 1024 <= LDS_BYTES, "LDS tables");
static_assert(TBL_EB + 256 + 1088 * 4 <= LDS_BYTES, "LDS map");

struct Args { const float* in[25]; float* out; unsigned char* ws; int ph_lo, ph_hi; };
struct Frame {
    unsigned long long pacc, pt0;
    LAS unsigned char* lds; unsigned char* ldsg;
    volatile LAS unsigned* MISC; gu32* ctl;
    int vcu, G;
    unsigned char* ws; float* out;
};
template <class T> __device__ __forceinline__ T* uniform_ptr(T* p) { const unsigned long long v = (unsigned long long)p; const unsigned lo = __builtin_amdgcn_readfirstlane((unsigned)v), hi = __builtin_amdgcn_readfirstlane((unsigned)(v >> 32)); return (T*)(((unsigned long long)hi << 32) | lo); }
__device__ __forceinline__ float wave_sum(float v) {
#pragma unroll
    for (int o = 1; o < 64; o <<= 1) v += __shfl_xor(v, o);
    return v;
}
__device__ __forceinline__ float wave_max(float v) {
#pragma unroll
    for (int o = 1; o < 64; o <<= 1) v = fmaxf(v, __shfl_xor(v, o));
    return v;
}
__device__ __forceinline__ float bf2f(bf16 h) { return __uint_as_float(((unsigned)h) << 16); }
__device__ __forceinline__ float bflo(unsigned w) { return __uint_as_float(w << 16); }
__device__ __forceinline__ float bfhi(unsigned w) { return __uint_as_float(w & 0xffff0000u); }
__device__ __forceinline__ void unpack8(const v4u w, float* f) { f[0] = bflo(w.x); f[1] = bfhi(w.x); f[2] = bflo(w.y); f[3] = bfhi(w.y); f[4] = bflo(w.z); f[5] = bfhi(w.z); f[6] = bflo(w.w); f[7] = bfhi(w.w); }
__device__ __forceinline__ v4u pack8f(const float* f) { v4u w; w.x = pk2(f[0], f[1]); w.y = pk2(f[2], f[3]); w.z = pk2(f[4], f[5]); w.w = pk2(f[6], f[7]); return w; }
__device__ __forceinline__ int t5_bucket(int n) {
    if (n < 16) return n;
    int b = 16;
    b += (n >= 19) + (n >= 21) + (n >= 24) + (n >= 27) + (n >= 31) + (n >= 35) + (n >= 40) + (n >= 46) + (n >= 52) + (n >= 59) + (n >= 67) + (n >= 77) + (n >= 87) + (n >= 99) + (n >= 113);
    return b;
}

#ifndef PROBE_ACC
#define PROBE_ACC -1
#endif
#define PB(i) do { if ((i) == PROBE_ACC) F.pt0 = __builtin_amdgcn_s_memrealtime(); } while (0)
#define PE(i) do { if ((i) == PROBE_ACC) F.pacc += __builtin_amdgcn_s_memrealtime() - F.pt0; } while (0)
#define PHASE_IDS int tid = threadIdx.x; asm volatile("" : "+v"(tid)); const int lane = tid & 63; const int wave = __builtin_amdgcn_readfirstlane(tid >> 6); (void)lane; (void)wave
struct TrDesc { const float* src; const float* gain; bf16* dst; int ldw, K, k0; };
__device__ __forceinline__ void tr_load(const TrDesc& t, int lane, f32x4 (&v)[8]) {
#pragma unroll
    for (int i = 0; i < 8; ++i) { const int id = i * 64 + lane, kk = id >> 3, c4 = (id & 7) * 4; v[i] = __builtin_nontemporal_load((const GAS f32x4*)(t.src + (size_t)(t.k0 + kk) * t.ldw + c4)); }
}
__device__ __forceinline__ void tr_finish(const TrDesc& t, int lane, const f32x4 (&v)[8], LAS float* scr) {
#pragma unroll
    for (int i = 0; i < 8; ++i) { const int id = i * 64 + lane, kk = id >> 3, c4 = (id & 7) * 4; const float g = t.gain ? t.gain[t.k0 + kk] : 1.f; LAS float* p = scr + kk * 33 + c4; p[0] = v[i][0] * g; p[1] = v[i][1] * g; p[2] = v[i][2] * g; p[3] = v[i][3] * g; }
    LDS_WAIT(); asm volatile("" ::: "memory");
    const int c = lane & 7;
#pragma unroll
    for (int j = 0; j < 4; ++j) { const int n = (lane >> 3) + 8 * j; const LAS float* s2 = scr + (8 * c) * 33 + n;
        v4u o; o.x = pk2(s2[0 * 33], s2[1 * 33]); o.y = pk2(s2[2 * 33], s2[3 * 33]); o.z = pk2(s2[4 * 33], s2[5 * 33]); o.w = pk2(s2[6 * 33], s2[7 * 33]);
        *(GAS v4u*)(t.dst + (size_t)n * t.K + t.k0 + 8 * c) = o; }
    LDS_WAIT(); asm volatile("" ::: "memory");
}
__device__ __forceinline__ void tr_item_alpha(const float* w_in, const float* wau, const float* gain, bf16* dst, int k0, int n0, LAS float* scr, int lane) {
    const float* a = w_in + (size_t)(k0 + lane) * DIN + 1536; const f32x4 a0 = *(const GAS f32x4*)a, a1 = *(const GAS f32x4*)(a + 4), a2 = *(const GAS f32x4*)(a + 8), a3 = *(const GAS f32x4*)(a + 12);
    const float gk = gain[k0 + lane]; const float av[16] = {a0[0], a0[1], a0[2], a0[3], a1[0], a1[1], a1[2], a1[3], a2[0], a2[1], a2[2], a2[3], a3[0], a3[1], a3[2], a3[3]};
#pragma unroll 4
    for (int n = 0; n < 32; ++n) { float v = 0.f;
#pragma unroll
        for (int r = 0; r < 16; ++r) v += av[r] * wau[r * 256 + n0 + n];
        scr[lane * 33 + n] = v * gk; }
    LDS_WAIT(); asm volatile("" ::: "memory");
    const int c = lane & 7;
#pragma unroll
    for (int j = 0; j < 4; ++j) { const int n = (lane >> 3) + 8 * j; const LAS float* s = scr + (8 * c) * 33 + n;
        v4u o; o.x = pk2(s[0 * 33], s[1 * 33]); o.y = pk2(s[2 * 33], s[3 * 33]); o.z = pk2(s[4 * 33], s[5 * 33]); o.w = pk2(s[6 * 33], s[7 * 33]);
        *(GAS v4u*)(dst + (size_t)(n0 + n) * 1024 + k0 + 8 * c) = o; }
    LDS_WAIT(); asm volatile("" ::: "memory");
}
struct TrJob { int src, col0, ldw, gain, K  , ncols, drow; unsigned dst_off_kib; int kdst  , koff  ; };
__constant__ TrJob kJobs[15] = {
    {5, 0, DIN, 4, 1024, 256, 0, (unsigned)(WS_W1T / 1024), 1024, 0},
    {5, 256, DIN, 4, 1024, 256, 256, (unsigned)(WS_W1T / 1024), 1024, 0},
    {5, 1024, DIN, 4, 1024, 512, 512, (unsigned)(WS_W1T / 1024), 1024, 0},
    {5, 1552, DIN, 4, 1024, 512, 1280, (unsigned)(WS_W1T / 1024), 1024, 0},
    {5, 2064, DIN, 4, 1024, 512, 1792, (unsigned)(WS_W1T / 1024), 1024, 0},
    {5, 3088, DIN, 4, 1024, 1024, 2304, (unsigned)(WS_W1T / 1024), 1024, 0},
    {5, 4112, DIN, 4, 1024, 1024, 3328, (unsigned)(WS_W1T / 1024), 1024, 0},
    {5, 512, DIN, 4, 1024, 512, 0, (unsigned)(WS_WVT / 1024), 1024, 0},
    {5, 2576, DIN, 4, 1024, 512, 512, (unsigned)(WS_WVT / 1024), 1024, 0},
    {9, 0, 1024, -1, 512, 1024, 0, (unsigned)(WS_PGMT / 1024), 1024, 0},
    {10, 0, 1024, -1, 512, 1024, 0, (unsigned)(WS_PGMT / 1024), 1024, 512},
    {11, 0, 1024, -1, 1024, 1024, 0, (unsigned)(WS_WOUTT / 1024), 1024, 0},
    {13, 0, 512, 12, 1024, 512, 0, (unsigned)(WS_WCQT / 1024), 1024, 0},
    {14, 0, 1024, -1, 1024, 1024, 0, (unsigned)(WS_WCKVT / 1024), 1024, 0},
    {15, 0, 1024, -1, 512, 1024, 0, (unsigned)(WS_WCOT / 1024), 512, 0},
};

__device__ __forceinline__ void p0_prologue(Frame& F, const Args& A) {
    PHASE_IDS;
    LAS float* scr = (LAS float*)(F.lds + RING_OFF + wave * 16384);
    const int gw = F.vcu * NWAVES + wave, NGW = F.G * NWAVES;
    PB(20);
    int total = 0;
#pragma unroll 1
    for (int j = 0; j < 15; ++j) total += (kJobs[j].K / 64) * (kJobs[j].ncols / 32);
    const int alpha_items = 16 * 8;
#pragma unroll 1
    for (int it = gw; it < total + alpha_items; it += NGW) {
        if (it >= total) { const int r = it - total; tr_item_alpha(A.in[5], A.in[6], A.in[4], (bf16*)(F.ws + WS_W1T) + (size_t)1024 * 1024, (r >> 3) * 64, (r & 7) * 32, scr, lane); continue; }
        int r = it, j = 0;
#pragma unroll 1
        for (; j < 15; ++j) { const int n = (kJobs[j].K / 64) * (kJobs[j].ncols / 32); if (r < n) break; r -= n; }
        const TrJob jb = kJobs[j]; const int nblk = jb.ncols / 32, kb = r / nblk, nb = r % nblk;
        const TrDesc t{A.in[jb.src] + jb.col0 + nb * 32, jb.gain >= 0 ? A.in[jb.gain] : nullptr, (bf16*)(F.ws + (size_t)jb.dst_off_kib * 1024) + (size_t)(jb.drow + nb * 32) * jb.kdst + jb.koff, jb.ldw, jb.kdst, kb * 64};
        f32x4 v[8]; tr_load(t, lane, v); tr_finish(t, lane, v, scr);
    }
    PE(20); PB(21);
    { bf16* wrt = (bf16*)(F.ws + WS_WRT); const float* g = A.in[16]; const float* wg = A.in[17]; const float* we = A.in[19];
        for (int i = blockIdx.x * NTHR + tid; i < 2 * 256 * 1024; i += F.G * NTHR) { const int mat = i >> 18, o = (i >> 10) & 255, kk = i & 1023; unsigned v = 0;
            if (o < (mat ? 36 : 72)) { const int oo = o < 36 ? o : o - 36; const float w = g[kk] * (oo < 4 ? wg[kk * 4 + oo] : we[kk * 32 + oo - 4]); const unsigned hi = f2bf(w);
                v = o < 36 ? hi : f2bf(w - __uint_as_float(hi << 16)); }
            wrt[i] = (bf16)v; } }
    PE(21); PB(22);
    { const float* x = A.in[0]; bf16* xb = (bf16*)(F.ws + WS_XB); float* rstd0 = (float*)(F.ws + WS_RSTD0);
        int m = gw;
        if (m < M) { f32x4 v[4];
#pragma unroll
            for (int j = 0; j < 4; ++j) v[j] = __builtin_nontemporal_load((const GAS f32x4*)(x + (size_t)m * D) + 64 * j + lane);
#pragma unroll 1
            for (;;) { const int mn = m + NGW; const bool more = mn < M; f32x4 w[4];
                if (more) {
#pragma unroll
                    for (int j = 0; j < 4; ++j) w[j] = __builtin_nontemporal_load((const GAS f32x4*)(x + (size_t)mn * D) + 64 * j + lane); }
                float s = 0.f;
#pragma unroll
                for (int j = 0; j < 4; ++j) s += (v[j].x * v[j].x + v[j].y * v[j].y) + (v[j].z * v[j].z + v[j].w * v[j].w);
                s = wave_sum(s); const float rs = rsqrtf(s * (1.f / D) + EPS);
                GAS unsigned long long* o8 = (GAS unsigned long long*)(xb + (size_t)m * D) + lane;
#pragma unroll
                for (int j = 0; j < 4; ++j) o8[64 * j] = (unsigned long long)pk2(v[j].x * rs, v[j].y * rs) | ((unsigned long long)pk2(v[j].z * rs, v[j].w * rs) << 32);
                if (!more) break;
                m = mn;
#pragma unroll
                for (int j = 0; j < 4; ++j) v[j] = w[j]; } } }
    PE(22); PB(23);
    { const float* mem = A.in[1]; const float* gm = A.in[2]; bf16* mn = (bf16*)(F.ws + WS_MEMN);
        for (int m = gw; m < 1024; m += NGW) { const GAS f32x4* xr = (const GAS f32x4*)(mem + (size_t)m * D) + lane; const GAS f32x4* gr = (const GAS f32x4*)gm + lane; f32x4 v[4]; float s = 0.f;
#pragma unroll
            for (int j = 0; j < 4; ++j) { v[j] = xr[64 * j]; s += (v[j].x * v[j].x + v[j].y * v[j].y) + (v[j].z * v[j].z + v[j].w * v[j].w); }
            s = wave_sum(s); const float rs = rsqrtf(s * (1.f / D) + EPS);
            GAS unsigned long long* o8 = (GAS unsigned long long*)(mn + (size_t)m * D) + lane;
#pragma unroll
            for (int j = 0; j < 4; ++j) { const f32x4 g = gr[64 * j]; o8[64 * j] = (unsigned long long)pk2(v[j].x * rs * g.x, v[j].y * rs * g.y) | ((unsigned long long)pk2(v[j].z * rs * g.z, v[j].w * rs * g.w) << 32); } } }
}
__device__ __forceinline__ TrDesc gu_item(const Args& A, unsigned char* ws, int it) {
    bf16* wgut = (bf16*)(ws + WS_WGUT); const int e = it >> 9, r = it & 511, up = r >> 8, rr = r & 255, kb = rr >> 4, nb = rr & 15, c0 = nb * 32;
    return TrDesc{A.in[up ? 22 : 21] + (size_t)e * 1024 * 512 + c0, A.in[16], wgut + ((size_t)e * 1024 + (c0 >> 7) * 256 + (c0 & 127) + up * 128) * 1024, 512, 1024, kb * 64};
}
__device__ __forceinline__ TrDesc dn_item(const Args& A, unsigned char* ws, int it) {
    bf16* wdt = (bf16*)(ws + WS_WDT); const int e = it >> 8, rr = it & 255, kb = rr >> 5, nb = rr & 31;
    return TrDesc{A.in[23] + (size_t)e * 512 * 1024 + nb * 32, nullptr, wdt + ((size_t)e * 1024 + nb * 32) * 512, 1024, 512, kb * 64};
}
__device__ __forceinline__ void expert_weights_gu(Frame& F, const Args& A) {
    PHASE_IDS;
    LAS float* scr = (LAS float*)(F.lds + RING_OFF + wave * 16384);
    const int gw = F.vcu * NWAVES + wave, NGW = F.G * NWAVES;
    int it = gw; if (it >= 16384) return;
    TrDesc cur = gu_item(A, F.ws, it); f32x4 v[8]; tr_load(cur, lane, v);
#pragma unroll 1
    for (;;) { const int nx = it + NGW; const bool more = nx < 16384;
        TrDesc nd = cur; f32x4 w[8];
        if (more) { nd = gu_item(A, F.ws, nx); tr_load(nd, lane, w); }
        tr_finish(cur, lane, v, scr);
        if (!more) break;
        cur = nd; it = nx;
#pragma unroll
        for (int i = 0; i < 8; ++i) v[i] = w[i]; }
}
__device__ __forceinline__ void expert_weights_dn(Frame& F, const Args& A, int li, int nl) {
    PHASE_IDS;
    if (li < 0) return;
    LAS float* scr = (LAS float*)(F.lds + RING_OFF + wave * 16384);
    const int gw = li * NWAVES + wave, NGW = nl * NWAVES;
    int it = gw; if (it >= 8192) return;
    TrDesc cur = dn_item(A, F.ws, it); f32x4 v[8]; tr_load(cur, lane, v);
#pragma unroll 1
    for (;;) { const int nx = it + NGW; const bool more = nx < 8192;
        TrDesc nd = cur; f32x4 w[8];
        if (more) { nd = dn_item(A, F.ws, nx); tr_load(nd, lane, w); }
        tr_finish(cur, lane, v, scr);
        if (!more) break;
        cur = nd; it = nx;
#pragma unroll
        for (int i = 0; i < 8; ++i) v[i] = w[i]; }
}

typedef short mb_bf16x8 __attribute__((ext_vector_type(8)));
typedef unsigned mb_u32x2 __attribute__((ext_vector_type(2)));
__device__ __forceinline__ unsigned mb_cvt_pk(float lo, float hi) { unsigned r; asm volatile("v_cvt_pk_bf16_f32 %0, %1, %2" : "=v"(r) : "v"(lo), "v"(hi)); return r; }
constexpr int GS = 65;
__device__ __forceinline__ void gla_load_b(Frame& F, int tid, const float* LA, int m0, int h, float* Bs) {
#pragma unroll 1
    for (int i = tid; i < 4096; i += NTHR) { const int c = i >> 6, d = i & 63; Bs[c * GS + d] = LA[(size_t)(m0 + c) * 256 + h * 64 + d]; }
    __syncthreads();
    if (tid < 64) { float s = 0.f;
#pragma unroll 8
        for (int c = 0; c < 64; ++c) { s += Bs[c * GS + tid]; Bs[c * GS + tid] = s; } }
    __syncthreads();
}
constexpr int GL_STR = 144;
__device__ __forceinline__ void gla_a_phase(Frame& F) {
    PHASE_IDS;
    LAS float* tot = (LAS float*)(F.lds + RING_OFF); LAS unsigned char* Kt = F.lds + RING_OFF + 2048;
    const float* LA = (const float*)((unsigned char*)F.out + DO_LA); bf16* ST = (bf16*)((unsigned char*)F.out + DO_ST);
    const bf16* KG = (const bf16*)(F.ws + WS_KG); const bf16* VT = (const bf16*)(F.ws + WS_VT); float* DEC = (float*)(F.ws + WS_DEC); float* EMID = (float*)(F.ws + WS_EMID);
    const int d = tid & 63, seg = wave, lq = lane & 15, g = lane >> 4;
#pragma unroll 1
    for (int u = blockIdx.x; u < 2048; u += F.G) {
        const int bh = u >> 7, n = u & 127, b = bh >> 2, h = bh & 3, m0 = b * SEQ + n * 64;
        float a[8], kk[8];
#pragma unroll
        for (int i = 0; i < 8; ++i) { const size_t gi = (size_t)(m0 + seg * 8 + i) * 256 + h * 64 + d; a[i] = LA[gi]; kk[i] = bf2f(KG[gi]); }
#pragma unroll
        for (int i = 1; i < 8; ++i) a[i] += a[i - 1];
        tot[seg * 64 + d] = a[7];
        __syncthreads();
        float off = 0.f, total = 0.f;
#pragma unroll
        for (int s2 = 0; s2 < 8; ++s2) { const float t = tot[s2 * 64 + d]; if (s2 < seg) off += t; total += t; }
        { v4u w; float e[8];
#pragma unroll
            for (int i = 0; i < 8; ++i) e[i] = kk[i] * __expf(total - (off + a[i]));
            w.x = pk2(e[0], e[1]); w.y = pk2(e[2], e[3]); w.z = pk2(e[4], e[5]); w.w = pk2(e[6], e[7]);
            *(LAS v4u*)(Kt + d * GL_STR + seg * 16) = w; }
        if (seg == 0) { DEC[u * 64 + d] = __expf(total); EMID[u * 64 + d] = __expf((tot[d] + tot[64 + d]) + (tot[128 + d] + tot[192 + d])); }
        __syncthreads();
        { mb_bf16x8 bf[2];
#pragma unroll
            for (int ks = 0; ks < 2; ++ks) bf[ks] = *(const GAS mb_bf16x8*)(VT + (size_t)(h * 128 + wave * 16 + lq) * M + m0 + 32 * ks + 8 * g);
#pragma unroll
            for (int dt = 0; dt < 4; ++dt) { f32x4 acc = (f32x4){0.f, 0.f, 0.f, 0.f};
#pragma unroll
                for (int ks = 0; ks < 2; ++ks) { const mb_bf16x8 af = *(const LAS mb_bf16x8*)(Kt + (dt * 16 + lq) * GL_STR + ks * 64 + g * 16); acc = __builtin_amdgcn_mfma_f32_16x16x32_bf16(af, bf[ks], acc, 0, 0, 0); }
                { mb_u32x2 w; w.x = pk2(acc[0], acc[1]); w.y = pk2(acc[2], acc[3]);
                  *(GAS mb_u32x2*)(ST + ((size_t)u * 128 + wave * 16 + lq) * 64 + dt * 16 + 4 * g) = w; } } }
        __syncthreads();
    }
}
__device__ __forceinline__ void gla_scan_phase(Frame& F) {
    PHASE_IDS;
    const bf16* ST = (const bf16*)((unsigned char*)F.out + DO_ST); bf16* SB = (bf16*)((unsigned char*)F.out + DO_SB); const float* DEC = (const float*)(F.ws + WS_DEC); const float* EMID = (const float*)(F.ws + WS_EMID);
#pragma unroll 1
    for (int g = blockIdx.x * NTHR + tid; g < 16 * 8192; g += F.G * NTHR) { const int bh = g >> 13, vd = g & 8191, d = vd & 63; float st = 0.f;
        const bf16* p = ST + (size_t)bh * 128 * 8192 + vd; bf16* q = SB + (size_t)bh * 128 * 8192 + vd; const float* dc = DEC + bh * 128 * 64 + d; const float* em = EMID + bh * 128 * 64 + d;
        bf16 kv[16]; float de[16], ee[16];
#pragma unroll
        for (int i = 0; i < 16; ++i) { kv[i] = p[(size_t)i * 8192]; de[i] = dc[i * 64]; ee[i] = em[i * 64]; }
#pragma unroll 1
        for (int n0 = 0; n0 < 128; n0 += 16) { bf16 kv2[16]; float de2[16], ee2[16]; const bool more = n0 + 16 < 128;
            if (more) {
#pragma unroll
                for (int i = 0; i < 16; ++i) { kv2[i] = p[(size_t)(n0 + 16 + i) * 8192]; de2[i] = dc[(n0 + 16 + i) * 64]; ee2[i] = em[(n0 + 16 + i) * 64]; } }
#pragma unroll
            for (int i = 0; i < 16; ++i) { q[(size_t)(n0 + i) * 8192] = (bf16)f2bf(st * ee[i]); st = de[i] * st + bf2f(kv[i]); }
            if (more) {
#pragma unroll
                for (int i = 0; i < 16; ++i) { kv[i] = kv2[i]; de[i] = de2[i]; ee[i] = ee2[i]; } } } }
}
constexpr int GB_TOT = 0, GB_QE = 2048, GB_KE = GB_QE + 64 * GL_STR, GB_VT = GB_KE + 64 * GL_STR, GB_SB = GB_VT + 128 * GL_STR, GB_UNIT = GB_SB + 128 * GL_STR;
static_assert(2 * GB_UNIT <= RING_BYTES && GB_UNIT % 16 == 0, "GLA-B LDS");
typedef float gb_f32x2 __attribute__((ext_vector_type(2)));
__device__ __forceinline__ void gla_b_phase(Frame& F, const Args& A) {
    PHASE_IDS;
    const float* LA = (const float*)((unsigned char*)F.out + DO_LA); const bf16* SB = (const bf16*)((unsigned char*)F.out + DO_SB);
    const bf16* QG = (const bf16*)(F.ws + WS_QG); const bf16* KG = (const bf16*)(F.ws + WS_KG); const bf16* VT = (const bf16*)(F.ws + WS_VT); const bf16* SR = (const bf16*)(F.ws + WS_SR);
    bf16* OG = (bf16*)(F.ws + WS_OGM); const float* gg = A.in[8];
    const int U = wave >> 2, lt = tid & 255, dp = lt & 31, seg = lt >> 5, lq = lane & 15, g = lane >> 4, ct = wave & 3;
    LAS unsigned char* base = F.lds + RING_OFF + U * GB_UNIT;
    LAS float* tot = (LAS float*)(base + GB_TOT); LAS unsigned char* Qe = base + GB_QE; LAS unsigned char* Ke = base + GB_KE; LAS unsigned char* Vt = base + GB_VT; LAS unsigned char* Sb = base + GB_SB;
    gb_f32x2 a[8]; unsigned q2[8], k2[8]; v4u vc[4], sc[4];
#define GB_LOAD(PR_) do { const int u_ = 2 * (PR_) + U, bh_ = u_ >> 7, n_ = u_ & 127, b_ = bh_ >> 2, h_ = bh_ & 3, m0_ = b_ * SEQ + n_ * 64; \
        _Pragma("unroll") for (int i = 0; i < 8; ++i) { const size_t gi = (size_t)(m0_ + seg * 8 + i) * 256 + h_ * 64 + 2 * dp; a[i] = *(const GAS gb_f32x2*)(LA + gi); q2[i] = *(const GAS unsigned*)(QG + gi); k2[i] = *(const GAS unsigned*)(KG + gi); } \
        _Pragma("unroll") for (int i = 0; i < 4; ++i) { const int ch = lt + i * 256, v = ch >> 3, c8 = ch & 7; vc[i] = *(const GAS v4u*)(VT + (size_t)(h_ * 128 + v) * M + m0_ + c8 * 8); sc[i] = *(const GAS v4u*)(SB + ((size_t)u_ * 128 + v) * 64 + c8 * 8); } } while (0)
    int pr = blockIdx.x;
    if (pr < 1024) GB_LOAD(pr);
#pragma unroll 1
    for (; pr < 1024; pr += F.G) {
        const int u = 2 * pr + U, bh = u >> 7, n = u & 127, b = bh >> 2, h = bh & 3, m0 = b * SEQ + n * 64;
#pragma unroll
        for (int i = 1; i < 8; ++i) a[i] += a[i - 1];
        *(LAS gb_f32x2*)(tot + seg * 64 + 2 * dp) = a[7];
#pragma unroll
        for (int i = 0; i < 4; ++i) { const int ch = lt + i * 256, v = ch >> 3, c8 = ch & 7; *(LAS v4u*)(Vt + v * GL_STR + c8 * 16) = vc[i]; *(LAS v4u*)(Sb + v * GL_STR + c8 * 16) = sc[i]; }
        __syncthreads();
        { gb_f32x2 off = (gb_f32x2){0.f, 0.f}, bmid = (gb_f32x2){0.f, 0.f};
#pragma unroll
            for (int s2 = 0; s2 < 7; ++s2) { const gb_f32x2 t = *(const LAS gb_f32x2*)(tot + s2 * 64 + 2 * dp); if (s2 < seg) off += t; if (s2 < 4) bmid += t; }
#pragma unroll
            for (int i = 0; i < 8; ++i) { const int c = seg * 8 + i; const gb_f32x2 bb = off + a[i];
                *(LAS unsigned*)(Qe + c * GL_STR + dp * 4) = mb_cvt_pk(bflo(q2[i]) * __expf(bb.x - bmid.x), bfhi(q2[i]) * __expf(bb.y - bmid.y));
                *(LAS unsigned*)(Ke + c * GL_STR + dp * 4) = mb_cvt_pk(bflo(k2[i]) * __expf(bmid.x - bb.x), bfhi(k2[i]) * __expf(bmid.y - bb.y)); } }
        __syncthreads();
        if (pr + F.G < 1024) GB_LOAD(pr + F.G);
        {
            const size_t mrow = (size_t)(m0 + ct * 16 + lq) * 512 + h * 128;
            mb_u32x2 srv[8];
#pragma unroll
            for (int vt = 0; vt < 8; ++vt) srv[vt] = *(const GAS mb_u32x2*)(SR + mrow + vt * 16 + 4 * g);
            mb_bf16x8 bq[2];
#pragma unroll
            for (int ks = 0; ks < 2; ++ks) bq[ks] = *(const LAS mb_bf16x8*)(Qe + (ct * 16 + lq) * GL_STR + ks * 64 + g * 16);
            f32x4 sa[4];
#pragma unroll
            for (int st = 0; st < 4; ++st) { sa[st] = (f32x4){0.f, 0.f, 0.f, 0.f};
                if (st <= ct) {
#pragma unroll
                    for (int ks = 0; ks < 2; ++ks) { const mb_bf16x8 af = *(const LAS mb_bf16x8*)(Ke + (st * 16 + lq) * GL_STR + ks * 64 + g * 16); sa[st] = __builtin_amdgcn_mfma_f32_16x16x32_bf16(af, bq[ks], sa[st], 0, 0, 0); }
                    if (st == ct) {
#pragma unroll
                        for (int r = 0; r < 4; ++r) if (4 * g + r > lq) sa[st][r] = 0.f; } } }
            asm volatile("s_nop 15\n\ts_nop 15" : "+v"(sa[0]), "+v"(sa[1]), "+v"(sa[2]), "+v"(sa[3]));
            mb_bf16x8 pb[2];
#pragma unroll
            for (int kp = 0; kp < 2; ++kp) { v4u pw; pw.x = mb_cvt_pk(sa[2 * kp][0], sa[2 * kp][1]); pw.y = mb_cvt_pk(sa[2 * kp][2], sa[2 * kp][3]); pw.z = mb_cvt_pk(sa[2 * kp + 1][0], sa[2 * kp + 1][1]); pw.w = mb_cvt_pk(sa[2 * kp + 1][2], sa[2 * kp + 1][3]); pb[kp] = __builtin_bit_cast(mb_bf16x8, pw); }
            f32x4 o[8]; float ss = 0.f;
#pragma unroll
            for (int vt = 0; vt < 8; ++vt) { o[vt] = (f32x4){0.f, 0.f, 0.f, 0.f};
#pragma unroll
                for (int kp = 0; kp < 2; ++kp) if (2 * kp <= ct) { const mb_u32x2 a0 = *(const LAS mb_u32x2*)(Vt + (vt * 16 + lq) * GL_STR + kp * 64 + g * 8), a1 = *(const LAS mb_u32x2*)(Vt + (vt * 16 + lq) * GL_STR + kp * 64 + 32 + g * 8);
                    v4u aw; aw.x = a0.x; aw.y = a0.y; aw.z = a1.x; aw.w = a1.y; o[vt] = __builtin_amdgcn_mfma_f32_16x16x32_bf16(__builtin_bit_cast(mb_bf16x8, aw), pb[kp], o[vt], 0, 0, 0); }
#pragma unroll
                for (int ks = 0; ks < 2; ++ks) { const mb_bf16x8 af = *(const LAS mb_bf16x8*)(Sb + (vt * 16 + lq) * GL_STR + ks * 64 + g * 16); o[vt] = __builtin_amdgcn_mfma_f32_16x16x32_bf16(af, bq[ks], o[vt], 0, 0, 0); }
                ss += (o[vt][0] * o[vt][0] + o[vt][1] * o[vt][1]) + (o[vt][2] * o[vt][2] + o[vt][3] * o[vt][3]); }
            ss += __shfl_xor(ss, 16); ss += __shfl_xor(ss, 32);
            const float rs = rsqrtf(ss * (1.f / 128.f) + EPS);
#pragma unroll
            for (int vt = 0; vt < 8; ++vt) { const int v = vt * 16 + 4 * g; const f32x4 gv = *(const GAS f32x4*)(gg + h * 128 + v); const mb_u32x2 sr = srv[vt];
                mb_u32x2 w; w.x = mb_cvt_pk(o[vt][0] * rs * gv[0] * bflo(sr.x), o[vt][1] * rs * gv[1] * bfhi(sr.x)); w.y = mb_cvt_pk(o[vt][2] * rs * gv[2] * bflo(sr.y), o[vt][3] * rs * gv[3] * bfhi(sr.y));
                *(GAS mb_u32x2*)(OG + (size_t)(m0 + ct * 16 + lq) * 1024 + h * 128 + v) = w; } }
        __syncthreads();
    }
#undef GB_LOAD
}

__device__ __forceinline__ int list_off(int j) { return 256 * (31 * j - (j * (j - 1)) / 2); }
__device__ __forceinline__ void moba_kmean_phase(Frame& F) {
    PHASE_IDS;
    float* lf = (float*)(F.ldsg + RING_OFF); float* part = lf; float* pmx = lf + 512;
    const bf16* KM = (const bf16*)(F.ws + WS_KM); float* kmean = (float*)(F.ws + WS_KMEAN); float* knmax = (float*)(F.ws + WS_KNMAX);
    const int c8 = tid & 7, r0 = tid >> 3;
#pragma unroll 1
    for (int u = blockIdx.x; u < 1024; u += F.G) { const int bh = u >> 5, j = u & 31, b = bh >> 3, h = bh & 7; const size_t m0 = (size_t)b * SEQ + j * 256;
        v4u w[4];
#pragma unroll
        for (int i = 0; i < 4; ++i) w[i] = *(const GAS v4u*)(KM + (m0 + r0 + 64 * i) * 512 + h * 64 + c8 * 8);
        float acc[8]; float mx = 0.f;
#pragma unroll
        for (int e = 0; e < 8; ++e) acc[e] = 0.f;
#pragma unroll
        for (int i = 0; i < 4; ++i) { float f[8]; unpack8(w[i], f); float q = 0.f;
#pragma unroll
            for (int e = 0; e < 8; ++e) { acc[e] += f[e]; q += f[e] * f[e]; }
            q += __shfl_xor(q, 1); q += __shfl_xor(q, 2); q += __shfl_xor(q, 4); mx = fmaxf(mx, q); }
#pragma unroll
        for (int e = 0; e < 8; ++e) { acc[e] += __shfl_xor(acc[e], 8); acc[e] += __shfl_xor(acc[e], 16); acc[e] += __shfl_xor(acc[e], 32); }
        mx = wave_max(mx);
        if (lane < 8) {
#pragma unroll
            for (int e = 0; e < 8; ++e) part[wave * 64 + lane * 8 + e] = acc[e]; }
        if (lane == 0) pmx[wave] = mx;
        __syncthreads();
        if (tid < 64) { float t = 0.f;
#pragma unroll
            for (int w2 = 0; w2 < 8; ++w2) t += part[w2 * 64 + tid];
            kmean[u * 64 + tid] = t * (1.f / 256.f); }
        if (tid == 0) { float t = 0.f;
#pragma unroll
            for (int w2 = 0; w2 < 8; ++w2) t = fmaxf(t, pmx[w2]);
            knmax[u] = sqrtf(t); }
        __syncthreads();
    }
}
__device__ __forceinline__ void moba_gate_phase(Frame& F, const Args& A) {
    PHASE_IDS;
    LAS unsigned char* kmh = F.lds + RING_OFF; LAS unsigned char* kml = kmh + 32 * 144;
    float* lf = (float*)(F.ldsg + RING_OFF + 2 * 32 * 144); float* knm = lf; unsigned* hist = (unsigned*)(lf + 32); unsigned* hbase = hist + 32;
    const bf16* QM = (const bf16*)(F.ws + WS_QM); const float* kmean = (const float*)(F.ws + WS_KMEAN); const float* knmax = (const float*)(F.ws + WS_KNMAX);
    unsigned* SEL = (unsigned*)(F.ws + WS_SEL); float* REFS = (float*)(F.ws + WS_REFS); unsigned* LISTS = (unsigned*)(F.ws + WS_LISTS); const float* rb = A.in[3];
    const int lq = lane & 15, g = lane >> 4;
    float* bmxs = (float*)(hbase + 32);
    if (tid < 8) { float m = rb[tid];
#pragma unroll
        for (int k = 1; k < 32; ++k) m = fmaxf(m, rb[k * 8 + tid]);
        bmxs[tid] = m; }
    __syncthreads();
#pragma unroll 1
    for (int u = blockIdx.x, kk = 0; u < 1024; u += F.G, ++kk) { const int bh = u >> 5, qx = (kk & 2) ? ((u & 31) + 16) & 31 : (u & 31), qb = (kk & 1) ? 31 - qx : qx, b = bh >> 3, h = bh & 7;
        { const int j = tid >> 4, c4 = (tid & 15) * 4; const f32x4 v = *(const GAS f32x4*)(kmean + bh * 2048 + j * 64 + c4);
            const unsigned h0 = f2bf(v[0]), h1 = f2bf(v[1]), h2 = f2bf(v[2]), h3 = f2bf(v[3]);
            *(LAS mb_u32x2*)(kmh + j * 144 + c4 * 2) = (mb_u32x2){h0 | (h1 << 16), h2 | (h3 << 16)};
            *(LAS mb_u32x2*)(kml + j * 144 + c4 * 2) = (mb_u32x2){pk2(v[0] - __uint_as_float(h0 << 16), v[1] - __uint_as_float(h1 << 16)), pk2(v[2] - __uint_as_float(h2 << 16), v[3] - __uint_as_float(h3 << 16))}; }
        if (tid < 32) { knm[tid] = knmax[bh * 32 + tid]; hist[tid] = 0u; }
        __syncthreads();
        const float bmx = bmxs[h];
        const int nsel = qb < 3 ? qb : 3;
        int sel0[2], sel1[2], sel2[2]; unsigned rk0[2], rk1[2], rk2[2];
#pragma unroll
        for (int qt = 0; qt < 2; ++qt) { const int qi = (wave * 2 + qt) * 16 + lq, t = qb * 256 + qi; const size_t m = (size_t)b * SEQ + t;
            mb_bf16x8 qf[2]; qf[0] = *(const GAS mb_bf16x8*)(QM + m * 512 + h * 64 + 8 * g); qf[1] = *(const GAS mb_bf16x8*)(QM + m * 512 + h * 64 + 32 + 8 * g);
            float qn = 0.f;
#pragma unroll
            for (int ks = 0; ks < 2; ++ks) { const v4u w = __builtin_bit_cast(v4u, qf[ks]); float f[8]; unpack8(w, f);
#pragma unroll
                for (int e = 0; e < 8; ++e) qn += f[e] * f[e]; }
            qn += __shfl_xor(qn, 16); qn += __shfl_xor(qn, 32); qn = sqrtf(qn);
            f32x4 sc[2];
#pragma unroll
            for (int jt = 0; jt < 2; ++jt) { sc[jt] = (f32x4){0.f, 0.f, 0.f, 0.f};
#pragma unroll
                for (int ks = 0; ks < 2; ++ks) { const mb_bf16x8 ah = *(const LAS mb_bf16x8*)(kmh + (jt * 16 + lq) * 144 + ks * 64 + g * 16), al = *(const LAS mb_bf16x8*)(kml + (jt * 16 + lq) * 144 + ks * 64 + g * 16);
                    sc[jt] = __builtin_amdgcn_mfma_f32_16x16x32_bf16(ah, qf[ks], sc[jt], 0, 0, 0); sc[jt] = __builtin_amdgcn_mfma_f32_16x16x32_bf16(al, qf[ks], sc[jt], 0, 0, 0); } }
            float v0 = -INFINITY, v1 = -INFINITY, v2 = -INFINITY; int i0 = 0, i1 = 0, i2 = 0;
#define TOP3_INS(G_, J_) do { const float g_ = (G_); const int j_ = (J_); if (g_ > v0) { v2 = v1; i2 = i1; v1 = v0; i1 = i0; v0 = g_; i0 = j_; } else if (g_ > v1) { v2 = v1; i2 = i1; v1 = g_; i1 = j_; } else if (g_ > v2) { v2 = g_; i2 = j_; } } while (0)
#pragma unroll
            for (int jt = 0; jt < 2; ++jt)
#pragma unroll
                for (int r = 0; r < 4; ++r) { const int j = jt * 16 + 4 * g + r; const float gv = j < qb ? sc[jt][r] : -INFINITY; TOP3_INS(gv, j); }
#pragma unroll
            for (int mk = 16; mk <= 32; mk <<= 1) { const float p0 = __shfl_xor(v0, mk), p1 = __shfl_xor(v1, mk), p2 = __shfl_xor(v2, mk); const int j0 = __shfl_xor(i0, mk), j1 = __shfl_xor(i1, mk), j2 = __shfl_xor(i2, mk);
                TOP3_INS(p0, j0); TOP3_INS(p1, j1); TOP3_INS(p2, j2); }
#undef TOP3_INS
            sel0[qt] = i0; sel1[qt] = i1; sel2[qt] = i2; rk0[qt] = 0; rk1[qt] = 0; rk2[qt] = 0;
            if (g == 0) {
                float kx = knm[qb]; if (nsel > 0) kx = fmaxf(kx, knm[i0]); if (nsel > 1) kx = fmaxf(kx, knm[i1]); if (nsel > 2) kx = fmaxf(kx, knm[i2]);
                SEL[m * 8 + h] = (unsigned)i0 | ((unsigned)i1 << 5) | ((unsigned)i2 << 10) | ((unsigned)nsel << 15);
                REFS[m * 8 + h] = qn * kx + bmx * 1.4426950408889634f;
                if (nsel > 0) rk0[qt] = __hip_atomic_fetch_add(hist + i0, 1u, __ATOMIC_RELAXED, __HIP_MEMORY_SCOPE_WORKGROUP);
                if (nsel > 1) rk1[qt] = __hip_atomic_fetch_add(hist + i1, 1u, __ATOMIC_RELAXED, __HIP_MEMORY_SCOPE_WORKGROUP);
                if (nsel > 2) rk2[qt] = __hip_atomic_fetch_add(hist + i2, 1u, __ATOMIC_RELAXED, __HIP_MEMORY_SCOPE_WORKGROUP); } }
        __syncthreads();
        if (tid < qb) { const unsigned c = hist[tid]; hbase[tid] = c ? atomicAdd((unsigned*)(F.ctl + CW_LCNT) + bh * 32 + tid, c) : 0u; }
        __syncthreads();
        if (g == 0) { unsigned* lb = LISTS + (size_t)bh * LIST_CAP;
#pragma unroll
            for (int qt = 0; qt < 2; ++qt) { const unsigned tq = (unsigned)(qb * 256 + (wave * 2 + qt) * 16 + lq);
                if (nsel > 0) lb[list_off(sel0[qt]) + hbase[sel0[qt]] + rk0[qt]] = (tq << 2);
                if (nsel > 1) lb[list_off(sel1[qt]) + hbase[sel1[qt]] + rk1[qt]] = (tq << 2) | 1u;
                if (nsel > 2) lb[list_off(sel2[qt]) + hbase[sel2[qt]] + rk2[qt]] = (tq << 2) | 2u; } }
        __syncthreads();
    }
}
constexpr size_t PARTO_N1 = 524288;
constexpr int MB_KSTR = 144, MB_VSTR = 528, MB_KBYTES = 256 * MB_KSTR, MB_VBYTES = 80 * MB_VSTR, MB_TABX = MB_KBYTES + MB_VBYTES, MB_TABN = 768;
static_assert(MB_TABX + MB_TABN * 4 <= RING_BYTES, "MoBA LDS");
__device__ __forceinline__ void moba_stage_const(int tid, LAS unsigned char* Vl) {
    for (int i = tid; i < 16 * 32; i += NTHR) { const int r = i >> 5, c = i & 31; const unsigned w = r == 0 ? 0x3f803f80u : 0u; *(LAS v4u*)(Vl + (64 + r) * MB_VSTR + c * 16) = (v4u){w, w, w, w}; }
}
struct MobaStage { v4u kv[4], vv[4]; float tb[2]; };
__device__ __forceinline__ void moba_kv_load(Frame& F, int tid, const Args& A, int b, int h, int j, MobaStage& st) {
    const bf16* KM = (const bf16*)(F.ws + WS_KM); const bf16* VT = (const bf16*)(F.ws + WS_VT);
    const size_t mk = (size_t)b * SEQ + j * 256;
#pragma unroll
    for (int i = 0; i < 4; ++i) { const int ch = tid + i * NTHR, key = ch >> 3, c = ch & 7; st.kv[i] = *(const GAS v4u*)(KM + (mk + key) * 512 + h * 64 + c * 8); }
#pragma unroll
    for (int i = 0; i < 4; ++i) { const int ch = tid + i * NTHR, d = ch >> 5, c = ch & 31; st.vv[i] = *(const GAS v4u*)(VT + (size_t)(512 + h * 64 + d) * M + mk + c * 8); }
#pragma unroll
    for (int i = 0; i < 2; ++i) { const int idx = tid + i * NTHR, dist = idx - 255; st.tb[i] = (idx < MB_TABN && dist >= 0) ? A.in[3][t5_bucket(dist < 127 ? dist : 127) * 8 + h] * 1.4426950408889634f : -INFINITY; }
}
__device__ __forceinline__ void moba_kv_store(int tid, const MobaStage& st, LAS unsigned char* Kl, LAS unsigned char* Vl, LAS float* tabx) {
#pragma unroll
    for (int i = 0; i < 4; ++i) { const int ch = tid + i * NTHR, key = ch >> 3, c = ch & 7; *(LAS v4u*)(Kl + key * MB_KSTR + c * 16) = st.kv[i]; }
#pragma unroll
    for (int i = 0; i < 4; ++i) { const int ch = tid + i * NTHR, d = ch >> 5, c = ch & 31, ks = c >> 2, m = c & 3; const int p0 = ((m & 1) * 32 + (m >> 1) * 8);
        LAS unsigned char* dst = Vl + d * MB_VSTR + ks * 64 + p0; *(LAS mb_u32x2*)dst = (mb_u32x2){st.vv[i].x, st.vv[i].y}; *(LAS mb_u32x2*)(dst + 16) = (mb_u32x2){st.vv[i].z, st.vv[i].w}; }
#pragma unroll
    for (int i = 0; i < 2; ++i) { const int idx = tid + i * NTHR; if (idx < MB_TABN) tabx[idx] = st.tb[i]; }
}
__device__ __forceinline__ void moba_stage_kv(Frame& F, int tid, const Args& A, int b, int h, int j, LAS unsigned char* Kl, LAS unsigned char* Vl, LAS float* tabx) {
    MobaStage st; moba_kv_load(F, tid, A, b, h, j, st); moba_kv_store(tid, st, Kl, Vl, tabx);
}
template <int NG, bool FULL>
__device__ __forceinline__ void moba_groups(const LAS unsigned char* Kl, const LAS unsigned char* Vl, const LAS float* tabx, const mb_bf16x8 (&qf)[NG][2], const float (&ref)[NG], const int (&qrel)[NG],
                                            const int (&ntile)[NG], const bool (&far)[NG], f32x4 (&o)[NG][5], int lane) {
    const int lq = lane & 15, g = lane >> 4;
    int nmax = FULL ? 16 : ntile[0];
#pragma unroll
    for (int gi = 1; gi < NG; ++gi) nmax = FULL ? 16 : (ntile[gi] > nmax ? ntile[gi] : nmax);
#define MB_NT(gi_) (FULL ? 16 : ntile[gi_])
    const LAS unsigned char* kp = Kl + lq * MB_KSTR + g * 16;
    const LAS unsigned char* vp = Vl + lq * MB_VSTR + g * 16;
#pragma unroll
    for (int hf = 0; hf < 2; ++hf) { if (8 * hf < nmax) {
        f32x4 sa[NG][8];
#pragma unroll
        for (int gi = 0; gi < NG; ++gi) {
            if (far[gi]) { const float c = tabx[255 + 127] - ref[gi]; const f32x4 cv = (f32x4){c, c, c, c};
#pragma unroll
                for (int t = 0; t < 8; ++t) { const int T = 8 * hf + t; if (T < MB_NT(gi)) { const mb_bf16x8 k0 = *(const LAS mb_bf16x8*)(kp + T * 16 * MB_KSTR); sa[gi][t] = __builtin_amdgcn_mfma_f32_16x16x32_bf16(k0, qf[gi][0], cv, 0, 0, 0); } else sa[gi][t] = (f32x4){0.f, 0.f, 0.f, 0.f}; } }
            else { const int qc = qrel[gi] < 511 ? qrel[gi] : 511; const LAS float* lb = tabx + (qc - 4 * g + 12);
#pragma unroll
                for (int t = 0; t < 8; ++t) { const int T = 8 * hf + t;
                    if (T < MB_NT(gi)) { f32x4 st;
#pragma unroll
                        for (int r = 0; r < 4; ++r) st[r] = lb[243 - 16 * T - r] - ref[gi];
                        const mb_bf16x8 k0 = *(const LAS mb_bf16x8*)(kp + T * 16 * MB_KSTR); sa[gi][t] = __builtin_amdgcn_mfma_f32_16x16x32_bf16(k0, qf[gi][0], st, 0, 0, 0); }
                    else sa[gi][t] = (f32x4){0.f, 0.f, 0.f, 0.f}; } } }
#pragma unroll
        for (int t = 0; t < 8; ++t) { const int T = 8 * hf + t; if (T < nmax) {
                const mb_bf16x8 k1 = *(const LAS mb_bf16x8*)(kp + T * 16 * MB_KSTR + 64);
#pragma unroll
                for (int gi = 0; gi < NG; ++gi) if (T < MB_NT(gi)) sa[gi][t] = __builtin_amdgcn_mfma_f32_16x16x32_bf16(k1, qf[gi][1], sa[gi][t], 0, 0, 0); } }
#pragma unroll
        for (int gi = 0; gi < NG; ++gi)
#pragma unroll
            for (int t = 0; t < 8; ++t) { if (8 * hf + t < MB_NT(gi)) {
#pragma unroll
                    for (int r = 0; r < 4; ++r) sa[gi][t][r] = __builtin_amdgcn_exp2f(sa[gi][t][r]); } }
#pragma unroll
        for (int k2 = 0; k2 < 4; ++k2) { const int ks = 4 * hf + k2; if (2 * ks < nmax) {
                mb_bf16x8 pb[NG];
#pragma unroll
                for (int gi = 0; gi < NG; ++gi) { v4u pw; pw.x = mb_cvt_pk(sa[gi][2 * k2][0], sa[gi][2 * k2][1]); pw.y = mb_cvt_pk(sa[gi][2 * k2][2], sa[gi][2 * k2][3]); pw.z = mb_cvt_pk(sa[gi][2 * k2 + 1][0], sa[gi][2 * k2 + 1][1]); pw.w = mb_cvt_pk(sa[gi][2 * k2 + 1][2], sa[gi][2 * k2 + 1][3]); pb[gi] = __builtin_bit_cast(mb_bf16x8, pw); }
#pragma unroll
                for (int dt = 0; dt < 5; ++dt) { const mb_bf16x8 af = *(const LAS mb_bf16x8*)(vp + dt * 16 * MB_VSTR + ks * 64);
#pragma unroll
                    for (int gi = 0; gi < NG; ++gi) if (2 * ks < MB_NT(gi)) o[gi][dt] = __builtin_amdgcn_mfma_f32_16x16x32_bf16(af, pb[gi], o[gi][dt], 0, 0, 0); } } } } }
#undef MB_NT
}
__device__ __forceinline__ void moba_part_phase(Frame& F, const Args& A, int wq_word) {
    PHASE_IDS;
    LAS unsigned char* Kl = F.lds + RING_OFF; LAS unsigned char* Vl = Kl + MB_KBYTES; LAS float* tabx = (LAS float*)(F.lds + RING_OFF + MB_TABX); volatile LAS int* bc = (volatile LAS int*)(F.lds + TBL_BC);
    const bf16* QM = (const bf16*)(F.ws + WS_QM); const float* REFS = (const float*)(F.ws + WS_REFS); const unsigned* LISTS = (const unsigned*)(F.ws + WS_LISTS);
    bf16* PARTO0 = (bf16*)((unsigned char*)F.out + DO_PARTO); bf16* PARTO1 = (bf16*)(F.ws + WS_XB); float* PARTL = (float*)(F.ws + WS_PARTL);
    const int lq = lane & 15, g = lane >> 4;
    moba_stage_const(tid, Vl);
#pragma unroll 1
    for (;;) {
        PB(5); PB(8);
        if (tid == 0) bc[0] = (int)atomicAdd((unsigned*)(F.ctl + wq_word), 1u);
        __syncthreads();
        const int u = __builtin_amdgcn_readfirstlane(bc[0]);
        __syncthreads();
        if (u >= 31 * 32) break;
        const int j = u >> 5, bh = u & 31, b = bh >> 3, h = bh & 7;
#define MB_IDX(G_) (((G_) * 16 + lq < n) ? (G_) * 16 + lq : (((G_) * 16 < n) ? (G_) * 16 : 0))
        MobaStage st; moba_kv_load(F, tid, A, b, h, j, st);
        const int n = __builtin_amdgcn_readfirstlane((int)__hip_atomic_load((unsigned*)(F.ctl + CW_LCNT) + bh * 32 + j, RLX_AGENT));
        const unsigned* lst = LISTS + (size_t)bh * LIST_CAP + list_off(j);
        unsigned ea[2] = {0u, 0u}, eb[2] = {0u, 0u};
        if (wave * 32 < n) { ea[0] = lst[MB_IDX(2 * wave)]; ea[1] = lst[MB_IDX(2 * wave + 1)]; eb[0] = lst[MB_IDX(2 * wave + 2 * NWAVES)]; eb[1] = lst[MB_IDX(2 * wave + 2 * NWAVES + 1)]; }
        moba_kv_store(tid, st, Kl, Vl, tabx);
        __syncthreads(); PE(5); PB(6);
#define MB_LOADQ(E_, Q_, R_) do { const size_t m_ = (size_t)b * SEQ + ((E_) >> 2); const bf16* qrow_ = QM + m_ * 512 + h * 64; Q_[0] = *(const GAS mb_bf16x8*)(qrow_ + 8 * g); Q_[1] = *(const GAS mb_bf16x8*)(qrow_ + 32 + 8 * g); R_ = REFS[m_ * 8 + h]; } while (0)
        int pr = wave;
        if (pr * 32 < n) {
            mb_bf16x8 qa[2][2]; float ra[2];
            MB_LOADQ(ea[0], qa[0], ra[0]); MB_LOADQ(ea[1], qa[1], ra[1]);
#pragma unroll 1
            for (;;) {
                unsigned ec[2]; ec[0] = lst[MB_IDX(2 * pr + 4 * NWAVES)]; ec[1] = lst[MB_IDX(2 * pr + 4 * NWAVES + 1)];
                int qrel[2], nt[2]; bool far[2];
#pragma unroll
                for (int gi = 0; gi < 2; ++gi) { qrel[gi] = (int)(ea[gi] >> 2) - j * 256; far[gi] = __all(qrel[gi] - 255 >= 113); nt[gi] = 16; }
                f32x4 o[2][5];
#pragma unroll
                for (int gi = 0; gi < 2; ++gi)
#pragma unroll
                    for (int dt = 0; dt < 5; ++dt) o[gi][dt] = (f32x4){0.f, 0.f, 0.f, 0.f};
                moba_groups<2, true>(Kl, Vl, tabx, qa, ra, qrel, nt, far, o, lane);
                asm volatile("s_nop 15\n\ts_nop 15" : "+v"(o[0][0]), "+v"(o[0][1]), "+v"(o[0][2]), "+v"(o[0][3]), "+v"(o[0][4]), "+v"(o[1][0]), "+v"(o[1][1]), "+v"(o[1][2]), "+v"(o[1][3]), "+v"(o[1][4]));
                const bool more = (pr + NWAVES) * 32 < n;
                if (more) { MB_LOADQ(eb[0], qa[0], ra[0]); MB_LOADQ(eb[1], qa[1], ra[1]); }
#pragma unroll
                for (int gi = 0; gi < 2; ++gi) { if ((2 * pr + gi) * 16 + lq < n) { const size_t m = (size_t)b * SEQ + (ea[gi] >> 2); const size_t pi = (m * 8 + h) * 3 + (ea[gi] & 3u); if (g == 0) PARTL[pi] = o[gi][4][0];
#pragma unroll
                        for (int dt = 0; dt < 4; ++dt) { mb_u32x2 w; w.x = mb_cvt_pk(o[gi][dt][0], o[gi][dt][1]); w.y = mb_cvt_pk(o[gi][dt][2], o[gi][dt][3]); *(GAS mb_u32x2*)((pi < PARTO_N1 ? PARTO0 + pi * 64 : PARTO1 + (pi - PARTO_N1) * 64) + dt * 16 + g * 4) = w; } } }
                if (!more) break;
                pr += NWAVES; ea[0] = eb[0]; ea[1] = eb[1]; eb[0] = ec[0]; eb[1] = ec[1];
            }
        }
#undef MB_IDX
        PE(6); PB(7);
        __syncthreads(); PE(7); PE(8);
    }
}
__device__ __forceinline__ void moba_own_phase(Frame& F, const Args& A, bf16* OUT) {
    PHASE_IDS;
    LAS unsigned char* Kl = F.lds + RING_OFF; LAS unsigned char* Vl = Kl + MB_KBYTES; LAS float* tabx = (LAS float*)(F.lds + RING_OFF + MB_TABX);
    const bf16* QM = (const bf16*)(F.ws + WS_QM); const float* REFS = (const float*)(F.ws + WS_REFS);
    const bf16* PARTO0 = (const bf16*)((unsigned char*)F.out + DO_PARTO); const bf16* PARTO1 = (const bf16*)(F.ws + WS_XB); const float* PARTL = (const float*)(F.ws + WS_PARTL);
    const int lq = lane & 15, g = lane >> 4;
    moba_stage_const(tid, Vl);
    MobaStage st;
    if ((int)blockIdx.x < 1024) { const int u0 = blockIdx.x, bh0 = u0 >> 5; moba_kv_load(F, tid, A, bh0 >> 3, bh0 & 7, u0 & 31, st); }
#pragma unroll 1
    for (int u = blockIdx.x; u < 1024; u += F.G) { const int bh = u >> 5, qb = u & 31, b = bh >> 3, h = bh & 7; const int nsel = qb < 3 ? qb : 3;
        PB(1); PB(4); moba_kv_store(tid, st, Kl, Vl, tabx);
        int grp[2] = {wave, 15 - wave}; size_t mq[2]; mb_bf16x8 qa[2][2]; float ra[2];
#pragma unroll
        for (int gi = 0; gi < 2; ++gi) { mq[gi] = (size_t)b * SEQ + qb * 256 + grp[gi] * 16 + lq; MB_LOADQ(((unsigned)(qb * 256 + grp[gi] * 16 + lq)) << 2, qa[gi], ra[gi]); }
        float pl[3]; mb_u32x2 po[3][4];
#pragma unroll
        for (int r = 0; r < 3; ++r) { pl[r] = 0.f;
#pragma unroll
            for (int dt = 0; dt < 4; ++dt) po[r][dt] = (mb_u32x2){0u, 0u};
            if (r < nsel) { const size_t pi = (mq[0] * 8 + h) * 3 + r; pl[r] = PARTL[pi];
#pragma unroll
                for (int dt = 0; dt < 4; ++dt) po[r][dt] = *(const GAS mb_u32x2*)((pi < PARTO_N1 ? PARTO0 + pi * 64 : PARTO1 + (pi - PARTO_N1) * 64) + dt * 16 + g * 4); } }
        __syncthreads(); PE(1); PB(2);
        if (u + F.G < 1024) { const int un = u + F.G, bhn = un >> 5; moba_kv_load(F, tid, A, bhn >> 3, bhn & 7, un & 31, st); }
        { int qrel[2], nt[2]; bool far[2];
#pragma unroll
            for (int gi = 0; gi < 2; ++gi) { qrel[gi] = grp[gi] * 16 + lq; nt[gi] = grp[gi] + 1; far[gi] = false; }
            f32x4 o[2][5];
#pragma unroll
            for (int gi = 0; gi < 2; ++gi)
#pragma unroll
                for (int dt = 0; dt < 5; ++dt) o[gi][dt] = (f32x4){0.f, 0.f, 0.f, 0.f};
            moba_groups<2, false>(Kl, Vl, tabx, qa, ra, qrel, nt, far, o, lane); PE(2); PB(3);
#pragma unroll
            for (int gi = 0; gi < 2; ++gi) { float l = __shfl(o[gi][4][0], lq);
#pragma unroll
                for (int r = 0; r < 3; ++r) {
                    if (gi == 0) { l += pl[r];
#pragma unroll
                        for (int dt = 0; dt < 4; ++dt) { o[gi][dt][0] += bflo(po[r][dt].x); o[gi][dt][1] += bfhi(po[r][dt].x); o[gi][dt][2] += bflo(po[r][dt].y); o[gi][dt][3] += bfhi(po[r][dt].y); } }
                    else if (r < nsel) { const size_t pi = (mq[gi] * 8 + h) * 3 + r; l += PARTL[pi];
#pragma unroll
                        for (int dt = 0; dt < 4; ++dt) { const mb_u32x2 w = *(const GAS mb_u32x2*)((pi < PARTO_N1 ? PARTO0 + pi * 64 : PARTO1 + (pi - PARTO_N1) * 64) + dt * 16 + g * 4); o[gi][dt][0] += bflo(w.x); o[gi][dt][1] += bfhi(w.x); o[gi][dt][2] += bflo(w.y); o[gi][dt][3] += bfhi(w.y); } } }
                const float il = 1.f / l;
#pragma unroll
                for (int dt = 0; dt < 4; ++dt) { mb_u32x2 w; w.x = mb_cvt_pk(o[gi][dt][0] * il, o[gi][dt][1] * il); w.y = mb_cvt_pk(o[gi][dt][2] * il, o[gi][dt][3] * il); *(GAS mb_u32x2*)(OUT + mq[gi] * 1024 + 512 + h * 64 + dt * 16 + g * 4) = w; } } }
        PE(3);
        __syncthreads(); PE(4);
    }
#undef MB_LOADQ
}
constexpr int MA_KSTR = 272, MA_VSTR = 528, MA_KBYTES = 256 * MA_KSTR, MA_VBYTES = 128 * MA_VSTR;
static_assert(MA_KBYTES + MA_VBYTES <= RING_BYTES, "mem-attn LDS");
__device__ __forceinline__ void memattn_phase(Frame& F, bf16* OUT) {
    PHASE_IDS;
    LAS unsigned char* Kl = F.lds + RING_OFF; LAS unsigned char* Vl = Kl + MA_KBYTES;
    bf16* QC = (bf16*)(F.ws + WS_QC); const float* SS1 = (const float*)(F.ws + WS_SS1); const bf16* MK = (const bf16*)(F.ws + WS_MKV); const bf16* MVT = MK + 1024 * 512;
    const int lq = lane & 15, g = lane >> 4;
    const int per = (512 + F.G - 1) / F.G; int staged = -1;
    const int u_lo = blockIdx.x * per, u_hi = (u_lo + per < 512) ? u_lo + per : 512;
    mb_bf16x8 qn[4]; f32x4 pn[4];
#define MA_LOADQ(U_, GRP_) do { const int bhd_ = (U_) >> 5; const size_t m_ = (size_t)(bhd_ >> 2) * SEQ + ((U_) & 31) * 256 + (GRP_) * 16 + lq; const bf16* qr_ = QC + m_ * 512 + (bhd_ & 3) * 128; \
        _Pragma("unroll") for (int s = 0; s < 4; ++s) qn[s] = *(const GAS mb_bf16x8*)(qr_ + 32 * s + 8 * g); \
        _Pragma("unroll") for (int i = 0; i < 4; ++i) pn[i] = *(const GAS f32x4*)(SS1 + m_ * 16 + 4 * i); } while (0)
    if (u_lo < u_hi) MA_LOADQ(u_lo, wave);
#pragma unroll 1
    for (int u = u_lo; u < u_hi; ++u) { const int qt = u & 31, bhd = u >> 5, b = bhd >> 2, hd = bhd & 3;
        if (bhd != staged) { __syncthreads();
#pragma unroll
            for (int i = 0; i < 8; ++i) { const int ch = tid + i * NTHR, key = ch >> 4, c = ch & 15; *(LAS v4u*)(Kl + key * MA_KSTR + c * 16) = *(const GAS v4u*)(MK + (size_t)(b * 256 + key) * 512 + hd * 128 + c * 8); }
#pragma unroll
            for (int i = 0; i < 8; ++i) { const int ch = tid + i * NTHR, d = ch >> 5, c = ch & 31, ks = c >> 2, m = c & 3; const v4u w = *(const GAS v4u*)(MVT + (size_t)(hd * 128 + d) * 1024 + b * 256 + c * 8);
                LAS unsigned char* dst = Vl + d * MA_VSTR + ks * 64 + (m & 1) * 32 + (m >> 1) * 8; *(LAS mb_u32x2*)dst = (mb_u32x2){w.x, w.y}; *(LAS mb_u32x2*)(dst + 16) = (mb_u32x2){w.z, w.w}; }
            staged = bhd; __syncthreads(); }
#pragma unroll 1
        for (int grp = wave; grp < 16; grp += NWAVES) {
            const size_t m = (size_t)b * SEQ + qt * 256 + grp * 16 + lq;
            mb_bf16x8 qf[4]; f32x4 pc[4];
#pragma unroll
            for (int s = 0; s < 4; ++s) { qf[s] = qn[s]; pc[s] = pn[s]; }
            if (grp + NWAVES < 16) MA_LOADQ(u, grp + NWAVES); else if (u + 1 < u_hi) MA_LOADQ(u + 1, wave);
            f32x4 sa[16]; const LAS unsigned char* kp = Kl + lq * MA_KSTR + g * 16;
#pragma unroll
            for (int t = 0; t < 16; ++t) { sa[t] = (f32x4){0.f, 0.f, 0.f, 0.f};
#pragma unroll
                for (int s = 0; s < 4; ++s) { const mb_bf16x8 kf = *(const LAS mb_bf16x8*)(kp + t * 16 * MA_KSTR + s * 64); sa[t] = __builtin_amdgcn_mfma_f32_16x16x32_bf16(kf, qf[s], sa[t], 0, 0, 0); } }
            { float ssum = 0.f;
#pragma unroll
                for (int i = 0; i < 4; ++i) { const f32x4 p = pc[i]; ssum += (p[0] + p[1]) + (p[2] + p[3]); }
                const float rs1 = rsqrtf(ssum * (1.f / D) + EPS) * 1.4426950408889634f;
#pragma unroll
                for (int t = 0; t < 16; ++t) sa[t] = sa[t] * rs1; }
            float mx = -INFINITY;
#pragma unroll
            for (int t = 0; t < 16; ++t) mx = fmaxf(fmaxf(mx, fmaxf(sa[t][0], sa[t][1])), fmaxf(sa[t][2], sa[t][3]));
            mx = fmaxf(mx, __shfl_xor(mx, 16)); mx = fmaxf(mx, __shfl_xor(mx, 32));
            float l = 0.f;
#pragma unroll
            for (int t = 0; t < 16; ++t)
#pragma unroll
                for (int r = 0; r < 4; ++r) { const float p = __builtin_amdgcn_exp2f(sa[t][r] - mx); sa[t][r] = p; l += p; }
            l += __shfl_xor(l, 16); l += __shfl_xor(l, 32);
            f32x4 o[8];
#pragma unroll
            for (int dt = 0; dt < 8; ++dt) o[dt] = (f32x4){0.f, 0.f, 0.f, 0.f};
            const LAS unsigned char* vp = Vl + lq * MA_VSTR + g * 16;
#pragma unroll
            for (int ks = 0; ks < 8; ++ks) {
                v4u pw; pw.x = mb_cvt_pk(sa[2 * ks][0], sa[2 * ks][1]); pw.y = mb_cvt_pk(sa[2 * ks][2], sa[2 * ks][3]); pw.z = mb_cvt_pk(sa[2 * ks + 1][0], sa[2 * ks + 1][1]); pw.w = mb_cvt_pk(sa[2 * ks + 1][2], sa[2 * ks + 1][3]);
                const mb_bf16x8 pb = __builtin_bit_cast(mb_bf16x8, pw);
#pragma unroll
                for (int dt = 0; dt < 8; ++dt) { const mb_bf16x8 af = *(const LAS mb_bf16x8*)(vp + dt * 16 * MA_VSTR + ks * 64);
                    o[dt] = __builtin_amdgcn_mfma_f32_16x16x32_bf16(af, pb, o[dt], 0, 0, 0); } }
            const float il = 1.f / l;
#pragma unroll
            for (int dt = 0; dt < 8; ++dt) { mb_u32x2 w; w.x = mb_cvt_pk(o[dt][0] * il, o[dt][1] * il); w.y = mb_cvt_pk(o[dt][2] * il, o[dt][3] * il); *(GAS mb_u32x2*)(OUT + m * 512 + hd * 128 + dt * 16 + g * 4) = w; }
        }
    }
#undef MA_LOADQ
    __syncthreads();
}

template <bool SPLIT> __device__ __forceinline__ void rownorm_phase(Frame& F, bf16* dst, float* rstd) {
    PHASE_IDS;
    const int gw = F.vcu * NWAVES + wave, NGW = F.G * NWAVES; constexpr int LD = SPLIT ? 2048 : 1024;
    for (int m = gw; m < M; m += NGW) { const GAS f32x4* xr = (const GAS f32x4*)(F.out + (size_t)m * D) + lane; f32x4 v[4]; float s = 0.f;
#pragma unroll
        for (int j = 0; j < 4; ++j) { v[j] = xr[64 * j]; s += (v[j].x * v[j].x + v[j].y * v[j].y) + (v[j].z * v[j].z + v[j].w * v[j].w); }
        s = wave_sum(s); if (lane == 0) rstd[m] = rsqrtf(s * (1.f / D) + EPS);
        GAS unsigned long long* o8 = (GAS unsigned long long*)(dst + (size_t)m * LD) + lane;
#pragma unroll
        for (int j = 0; j < 4; ++j) { const unsigned h0 = f2bf(v[j].x), h1 = f2bf(v[j].y), h2 = f2bf(v[j].z), h3 = f2bf(v[j].w);
            o8[64 * j] = (unsigned long long)(h0 | (h1 << 16)) | ((unsigned long long)(h2 | (h3 << 16)) << 32);
            if (SPLIT) o8[256 + 64 * j] = (unsigned long long)pk2(v[j].x - __uint_as_float(h0 << 16), v[j].y - __uint_as_float(h1 << 16)) | ((unsigned long long)pk2(v[j].z - __uint_as_float(h2 << 16), v[j].w - __uint_as_float(h3 << 16)) << 32); } }
}
constexpr int RCH = 128, NCH = M / RCH;
__device__ __forceinline__ void route_phase(Frame& F, const Args& A) {
    PHASE_IDS;
    const float* LG = (const float*)(F.ws + WS_LG); const float* LG2 = (const float*)(F.ws + WS_LG2); const float* SS2 = (const float*)(F.ws + WS_SS2); float* rstd2 = (float*)(F.ws + WS_RSTD2); const float* brg = A.in[18]; const float* bre = A.in[20];
    int* ME = (int*)(F.ws + WS_MOE_E); int* MP = (int*)(F.ws + WS_MOE_POS); float* MW = (float*)(F.ws + WS_MOE_W); unsigned* CNT = (unsigned*)(F.ws + WS_TILE_E);
    unsigned* hist = (unsigned*)(F.ldsg + RING_OFF);
#pragma unroll 1
    for (int ch = blockIdx.x; ch < NCH; ch += F.G) {
        if (tid < 32) hist[tid] = 0u;
        __syncthreads();
        if (tid < RCH) { const int m = ch * RCH + tid; float ssum = 0.f;
#pragma unroll
            for (int i = 0; i < 4; ++i) { const f32x4 p = *(const GAS f32x4*)(SS2 + (size_t)m * 16 + 4 * i); ssum += (p[0] + p[1]) + (p[2] + p[3]); }
            const float rs = rsqrtf(ssum * (1.f / D) + EPS); rstd2[m] = rs; const float* lg = LG + (size_t)m * 72; const float* lg2 = LG2 + (size_t)m * 36;
            float gl[4]; int grp = 0; float gmx = -INFINITY;
#pragma unroll
            for (int o = 0; o < 4; ++o) { gl[o] = (lg[o] + lg[36 + o] + lg2[o]) * rs + brg[o]; if (gl[o] > gmx) { gmx = gl[o]; grp = o; } }
            float gs = 0.f;
#pragma unroll
            for (int o = 0; o < 4; ++o) gs += __expf(gl[o] - gmx);
            const float pg = 1.f / gs;
            float el[8]; float emx = -INFINITY;
#pragma unroll
            for (int i = 0; i < 8; ++i) { el[i] = (lg[4 + grp * 8 + i] + lg[40 + grp * 8 + i] + lg2[4 + grp * 8 + i]) * rs + bre[grp * 8 + i]; emx = fmaxf(emx, el[i]); }
            float p0 = -1.f, p1 = -1.f; int i0 = 0, i1 = 0;
#pragma unroll
            for (int i = 0; i < 8; ++i) { const float p = __expf(el[i] - emx); if (p > p0) { p1 = p0; i1 = i0; p0 = p; i0 = i; } else if (p > p1) { p1 = p; i1 = i; } }
            const float inv = pg / (p0 + p1);
            const int e0 = grp * 8 + i0, e1 = grp * 8 + i1;
            const unsigned q0 = __hip_atomic_fetch_add(hist + e0, 1u, __ATOMIC_RELAXED, __HIP_MEMORY_SCOPE_WORKGROUP), q1 = __hip_atomic_fetch_add(hist + e1, 1u, __ATOMIC_RELAXED, __HIP_MEMORY_SCOPE_WORKGROUP);
            ME[m * 2] = e0; ME[m * 2 + 1] = e1; MP[m * 2] = (int)q0; MP[m * 2 + 1] = (int)q1; MW[m * 2] = p0 * inv; MW[m * 2 + 1] = p1 * inv; }
        __syncthreads();
        if (tid < 32) CNT[ch * 32 + tid] = hist[tid];
        __syncthreads();
    }
}
__device__ __forceinline__ int moe_bases(Frame& F, int mych) {
    PHASE_IDS;
    volatile int* eb = (volatile int*)(F.ldsg + TBL_EB); volatile int* tl = (volatile int*)(F.ldsg + TBL_TILE); volatile int* part = (volatile int*)(F.ldsg + TBL_EB + 256);
    const unsigned* CNT = (const unsigned*)(F.ws + WS_TILE_E);
    { const int e = tid & 31, pt = tid >> 5; int s = 0, sp = 0;
#pragma unroll
        for (int c2 = 0; c2 < NCH / 16; ++c2) { const int c = pt * (NCH / 16) + c2; const int v = (int)CNT[c * 32 + e]; s += v; if (c < mych) sp += v; }
        part[pt * 32 + e] = s; part[512 + pt * 32 + e] = sp; }
    __syncthreads();
    if (tid < 32) { int s = 0, sp = 0;
#pragma unroll
        for (int p = 0; p < 16; ++p) { s += part[p * 32 + tid]; sp += part[512 + p * 32 + tid]; }
        part[1024 + tid] = s; part[1056 + tid] = sp;
        const int pad = ((s + 255) >> 8) << 8; int inc = pad;
#pragma unroll
        for (int o = 1; o < 32; o <<= 1) { const int t = __shfl_up(inc, o); if (tid >= o) inc += t; }
        eb[tid] = inc - pad; if (tid == 31) eb[32] = inc; }
    __syncthreads();
    if (tid < MOE_CAP_TILES) { const int r0 = tid << 8; int e = 0;
        const LAS v4u* e4 = (const LAS v4u*)(F.lds + TBL_EB); v4u q[8];
#pragma unroll
        for (int k = 0; k < 8; ++k) q[k] = e4[k];
#pragma unroll
        for (int k = 0; k < 8; ++k) { if (k > 0) e += ((int)q[k].x <= r0) ? 1 : 0; e += ((int)q[k].y <= r0) ? 1 : 0; e += ((int)q[k].z <= r0) ? 1 : 0; e += ((int)q[k].w <= r0) ? 1 : 0; }
        tl[tid] = e; }
    __syncthreads();
    return eb[32] >> 8;
}
__device__ __forceinline__ bool moe_slot_phase(Frame& F) {
    PHASE_IDS;
    volatile int* eb = (volatile int*)(F.ldsg + TBL_EB); volatile int* part = (volatile int*)(F.ldsg + TBL_EB + 256);
    const int* ME = (const int*)(F.ws + WS_MOE_E); const int* MP = (const int*)(F.ws + WS_MOE_POS); const float* MW = (const float*)(F.ws + WS_MOE_W); int* SO = (int*)(F.ws + WS_SLOT_OF);
    float* WSL = (float*)(F.ws + WS_W_SLOT); float* RSL = (float*)(F.ws + WS_RSTD_SLOT); const float* rstd2 = (const float*)(F.ws + WS_RSTD2); int* TOK = (int*)(F.ws + WS_TOK);
    bool ran = false;
#pragma unroll 1
    for (int ch = blockIdx.x; ch < NCH; ch += F.G) {
        const int a = ch * RCH * 2 + (tid & (RCH * 2 - 1)), m = a >> 1; const int e_ = ME[a], mp_ = MP[a]; const float mw_ = MW[a], rs_ = rstd2[m];
        (void)moe_bases(F, ch);
        if (ch < 32) { const int e = ch; for (int sl = eb[e] + part[1024 + e] + tid; sl < eb[e + 1]; sl += NTHR) { TOK[sl] = 0; WSL[sl] = 0.f; RSL[sl] = 1.f; } }
        if (tid < RCH * 2) { const int slot = eb[e_] + part[1056 + e_] + mp_;
            SO[a] = slot; WSL[slot] = mw_; RSL[slot] = rs_; TOK[slot] = m; }
        __syncthreads();
        ran = true;
    }
    return ran;
}
__device__ __forceinline__ void final_phase(Frame& F, const Args& A) {
    PHASE_IDS;
    const int gw = F.vcu * NWAVES + wave, NGW = F.G * NWAVES; const int* SO = (const int*)(F.ws + WS_SLOT_OF); const bf16* Y = (const bf16*)(F.ws + WS_XG); const float* gf = A.in[24];
    const bf16* XH = (const bf16*)(F.ws + WS_X2H); const bf16* XL = (const bf16*)(F.ws + WS_X2L);
    f32x4 gv[4];
#pragma unroll
    for (int j = 0; j < 4; ++j) gv[j] = ((const GAS f32x4*)gf)[64 * j + lane];
    typedef unsigned long long u64;
    u64 ya[4], yb[4], xh[4];
#define FIN_LOAD(m_, s0_, s1_) do { const GAS u64* y0_ = (const GAS u64*)(Y + (size_t)s0_ * 1024) + lane; const GAS u64* y1_ = (const GAS u64*)(Y + (size_t)s1_ * 1024) + lane; \
        const GAS u64* h_ = (const GAS u64*)(XH + (size_t)(m_) * 1024) + lane; \
        _Pragma("unroll") for (int j = 0; j < 4; ++j) { ya[j] = __builtin_nontemporal_load(y0_ + 64 * j); yb[j] = __builtin_nontemporal_load(y1_ + 64 * j); xh[j] = __builtin_nontemporal_load(h_ + 64 * j); } } while (0)
    int m = gw; if (m >= M) return;
    int sa0 = SO[m * 2], sa1 = SO[m * 2 + 1], sb0 = 0, sb1 = 0;
    if (m + NGW < M) { sb0 = SO[(m + NGW) * 2]; sb1 = SO[(m + NGW) * 2 + 1]; }
    FIN_LOAD(m, sa0, sa1);
#pragma unroll 1
    for (;;) {
        f32x4 v[4]; float s = 0.f;
#pragma unroll
        for (int j = 0; j < 4; ++j) { const u64 a = ya[j], c = yb[j], hh = xh[j];
            v[j].x = bflo((unsigned)hh) + (bflo((unsigned)a) + bflo((unsigned)c)); v[j].y = bfhi((unsigned)hh) + (bfhi((unsigned)a) + bfhi((unsigned)c));
            v[j].z = bflo((unsigned)(hh >> 32)) + (bflo((unsigned)(a >> 32)) + bflo((unsigned)(c >> 32))); v[j].w = bfhi((unsigned)(hh >> 32)) + (bfhi((unsigned)(a >> 32)) + bfhi((unsigned)(c >> 32)));
            s += (v[j].x * v[j].x + v[j].y * v[j].y) + (v[j].z * v[j].z + v[j].w * v[j].w); }
        const int mn = m + NGW; const bool more = mn < M;
        if (more) { FIN_LOAD(mn, sb0, sb1); const int m2 = mn + NGW; if (m2 < M) { sb0 = SO[m2 * 2]; sb1 = SO[m2 * 2 + 1]; } }
        s = wave_sum(s); const float rs = rsqrtf(s * (1.f / D) + EPS); GAS f32x4* xr = (GAS f32x4*)(F.out + (size_t)m * D) + lane;
#pragma unroll
        for (int j = 0; j < 4; ++j) __builtin_nontemporal_store((f32x4){v[j].x * rs * gv[j].x, v[j].y * rs * gv[j].y, v[j].z * rs * gv[j].z, v[j].w * rs * gv[j].w}, xr + 64 * j);
        if (!more) break;
        m = mn;
    }
#undef FIN_LOAD
}

__global__ void __launch_bounds__(NWAVES * 64, 2) fwd_kernel(Args args) {
    extern __shared__ __attribute__((aligned(16))) unsigned char lds[];
    Frame F; F.pacc = 0; F.pt0 = 0;
    F.lds = (LAS unsigned char*)lds; F.ldsg = lds;
    F.MISC = (volatile LAS unsigned*)(F.lds + MISC_OFF);
    const int tid = threadIdx.x;
    F.G = gridDim.x; { const int bx = blockIdx.x; F.vcu = (F.G % 8 == 0) ? (bx % 8) * (F.G / 8) + bx / 8 : bx; }
    F.ws = uniform_ptr(args.ws); F.out = uniform_ptr(args.out); F.ctl = (gu32*)(F.ws + WS_CTL);
    for (int u = tid; u < (LDS_BYTES - LDSCTL_OFF) / 4; u += NWAVES * 64) ((LAS unsigned*)(F.lds + LDSCTL_OFF))[u] = 0u;
    __syncthreads();
#if MK_ONE_LAUNCH
    XcdBarrier bar = xcd_barrier_post((unsigned*)(F.ctl + CW_BAR), F.MISC + 8);
#define GRID_BAR() xcd_barrier(bar)
#else
#define GRID_BAR() do { if (tid == 0) __hip_atomic_store(F.ctl + CW_TMO, 0xBADBA0u, RLX_AGENT); } while (0)
#endif
    const int lo = args.ph_lo, hi = args.ph_hi;
#define IN(k) (lo <= (k) && (k) < hi)
#ifndef PROBE_MASK
#define PROBE_MASK 0
#endif
#ifndef PG8_ALIGN_EPI
#define PG8_ALIGN_EPI true
#endif
#define REP(k) _Pragma("unroll") for (int rep_ = 0; rep_ < 1 + ((PROBE_MASK >> (k)) & 1); ++rep_)
#ifndef PROBE_A
#define PROBE_A -1
#define PROBE_B -1
#endif
#ifndef PROBE_AMP
#define PROBE_AMP 4
#endif
#ifndef PROBE_BLOCK
#define PROBE_BLOCK 0
#endif
    unsigned long long ts_a = 0, ts_b = 0;
#define STAMP(i) do { if ((i) == PROBE_A) ts_a = __builtin_amdgcn_s_memrealtime(); if ((i) == PROBE_B) ts_b = __builtin_amdgcn_s_memrealtime(); } while (0)
#define SEAM(k) do { if (IN(k) && IN((k) + 1)) { GRID_BAR(); if ((PROBE_MASK >> 6) & 1) GRID_BAR(); } STAMP((k) + 1); } while (0)
    STAMP(0);
    unsigned char* ws = F.ws;
    bf16* XB = (bf16*)(ws + WS_XB);
    const float* rstd0 = (const float*)(ws + WS_RSTD0);

    if (IN(0)) REP(0) { p0_prologue(F, args); } SEAM(0);
    if (IN(1)) REP(1) {
        constexpr int TS = 512 * 1024;
        static_assert(WS_XB % TS == 0 && WS_W1T % TS == 0 && WS_WVT % TS == 0 && WS_MEMN % TS == 0 && WS_WCKVT % TS == 0, "tile-aligned matrices");
        pg8::Gemm g{(const bf16*)ws, (const bf16*)ws, M, 4352, 1024};
        typedef pg8::MultiOrder<128, 17, (int)(WS_XB / TS), (int)(WS_W1T / TS), 4, 128, (int)(WS_WVT / TS), (int)(WS_XB / TS), 4, 2, (int)(WS_MEMN / TS), (int)(WS_WCKVT / TS), 2, 4, (int)(WS_WCKVT / TS) + 2, (int)(WS_MEMN / TS)> P1Order;
        P1Order S{F.G, (int)blockIdx.x};
        pg8::EpiP1 E{ pg8::EpiInProj{(bf16*)(ws + WS_QG), (bf16*)(ws + WS_KG), (bf16*)(ws + WS_SR), (bf16*)(ws + WS_QM), (bf16*)(ws + WS_KM), (bf16*)(ws + WS_SZ), (float*)((unsigned char*)F.out + DO_LA), rstd0, args.in[7]},
                      pg8::EpiVT{(bf16*)(ws + WS_VT), M, rstd0},
                      pg8::EpiRowBf16<0>{(bf16*)(ws + WS_MKV), 512, nullptr, 1.f}, pg8::EpiRowBf16<0>{(bf16*)(ws + WS_MKV) + 1024 * 512, 1024, nullptr, 1.f} };
        pg8::gemm_phase<pg8::EpiP1, P1Order, PG8_ALIGN_EPI, true>(F.lds + RING_OFF, g, S, E);
    } SEAM(1);
    if (IN(2)) { REP(2) gla_a_phase(F); STAMP(30); REP(5) moba_kmean_phase(F); } SEAM(2);
    if (IN(3)) { gla_scan_phase(F); STAMP(31); moba_gate_phase(F, args); } SEAM(3);
    if (IN(4)) { gla_b_phase(F, args); STAMP(32); moba_part_phase(F, args, CW_WQ); } SEAM(4);
    STAMP(6);
    if (IN(6)) { moba_own_phase(F, args, (bf16*)(ws + WS_OGM)); } SEAM(6);
    if (IN(7)) REP(1) { pg8::Gemm g{(const bf16*)(ws + WS_OGM), (const bf16*)(ws + WS_PGMT), M, 1024, 1024}; pg8::StaticOrder S; S.init(M, 1024, F.G, (int)blockIdx.x);
        pg8::EpiMerge2 E{(bf16*)(ws + WS_MG), (const bf16*)(ws + WS_SZ)};
        pg8::gemm_phase<pg8::EpiMerge2, pg8::StaticOrder, PG8_ALIGN_EPI, true>(F.lds + RING_OFF, g, S, E); } SEAM(7);
    if (IN(8)) REP(1) { pg8::Gemm g{(const bf16*)(ws + WS_MG), (const bf16*)(ws + WS_WOUTT), M, 1024, 1024}; pg8::StaticOrder S; S.init(M, 1024, F.G, (int)blockIdx.x);
        pg8::EpiResSplit<true, false> E{args.in[0], nullptr, nullptr, (bf16*)(ws + WS_X1H), nullptr, (float*)(ws + WS_SS1)};
        pg8::gemm_phase<pg8::EpiResSplit<true, false>, pg8::StaticOrder, PG8_ALIGN_EPI, true>(F.lds + RING_OFF, g, S, E); } SEAM(8);
    if (IN(10)) REP(1) { pg8::Gemm g{(const bf16*)(ws + WS_X1H), (const bf16*)(ws + WS_WCQT), M, 512, 1024}; pg8::StaticOrder S; S.init(M, 512, F.G, (int)blockIdx.x);
        pg8::EpiRowBf16<0> E{(bf16*)(ws + WS_QC), 512, nullptr, 0.08838834764831845f};
        pg8::gemm_phase<pg8::EpiRowBf16<0>, pg8::StaticOrder, PG8_ALIGN_EPI, true>(F.lds + RING_OFF, g, S, E); } SEAM(10);
    if (IN(11)) { memattn_phase(F, (bf16*)(ws + WS_QC)); } SEAM(11);
    if (IN(12)) { pg8::Gemm g{(const bf16*)(ws + WS_QC), (const bf16*)(ws + WS_WCOT), M, 1024, 512}; pg8::StaticOrder S; S.init(M, 1024, F.G, (int)blockIdx.x);
        pg8::EpiResSplit<false, true> E{nullptr, (const bf16*)(ws + WS_X1H), nullptr, (bf16*)(ws + WS_X2H), (bf16*)(ws + WS_X2L), (float*)(ws + WS_SS2)};
        pg8::gemm_phase<pg8::EpiResSplit<false, true>, pg8::StaticOrder, PG8_ALIGN_EPI, true>(F.lds + RING_OFF, g, S, E);
        expert_weights_gu(F, args); } SEAM(12);
    STAMP(14);
    if (IN(14)) REP(1) {
        { pg8::Gemm g{(const bf16*)(ws + WS_X2H), (const bf16*)(ws + WS_WRT), M, 256, 1024}; pg8::StaticOrder S; S.init(M, 256, F.G, (int)blockIdx.x);
          pg8::EpiLogits E{(float*)(ws + WS_LG), 72, 72};
          pg8::gemm_phase<pg8::EpiLogits, pg8::StaticOrder, PG8_ALIGN_EPI, true>(F.lds + RING_OFF, g, S, E); }
        { pg8::Gemm g{(const bf16*)(ws + WS_X2L), (const bf16*)(ws + WS_WRT) + 256 * 1024, M, 256, 1024}; pg8::StaticOrder S; S.init(M, 256, F.G, (int)((blockIdx.x + F.G / 2) % F.G));
          pg8::EpiLogits E{(float*)(ws + WS_LG2), 36, 36};
          pg8::gemm_phase<pg8::EpiLogits, pg8::StaticOrder, PG8_ALIGN_EPI, true>(F.lds + RING_OFF, g, S, E); }
    } SEAM(14);
    if (IN(15)) { route_phase(F, args); } SEAM(15);
    bool moe_tbl = false;
    if (IN(16)) REP(0) { moe_tbl = moe_slot_phase(F); } SEAM(16);
    if (IN(17)) REP(1) { int rowv[3];
        { const int* TOK = (const int*)(ws + WS_TOK);
#pragma unroll
          for (int k = 0; k < 3; ++k) { const int i = (int)threadIdx.x + k * NTHR; const int L = (i >> 8) * F.G + F.vcu; const int tl_ = (L >> 2) < MOE_CAP_TILES ? (L >> 2) : MOE_CAP_TILES - 1; rowv[k] = TOK[tl_ * 256 + (i & 255)]; } }
        const int ntile = moe_tbl ? (((volatile int*)(F.ldsg + TBL_EB))[32] >> 8) : moe_bases(F, 0); moe_tbl = true;
        { LAS int* rows = (LAS int*)(F.lds + TBL_ROWS);
#pragma unroll
          for (int k = 0; k < 3; ++k) { const int i = (int)threadIdx.x + k * NTHR; const int L = (i >> 8) * F.G + F.vcu; rows[i] = (L < ntile * 4) ? rowv[k] : 0; }
          __syncthreads(); }
        pg8::Gemm g{(const bf16*)(ws + WS_X2H), (const bf16*)(ws + WS_WGUT), MOE_CAP, 32 * 1024, 1024}; pg8::MoeGatherOrder S{(const LAS int*)(F.lds + TBL_TILE), (const LAS int*)(F.lds + TBL_ROWS), ntile, F.G, F.vcu};
        pg8::EpiMoe1 E{(bf16*)(ws + WS_HID), (const float*)(ws + WS_RSTD_SLOT)};
        pg8::gemm_phase<pg8::EpiMoe1, pg8::MoeGatherOrder, PG8_ALIGN_EPI, true>(F.lds + RING_OFF, g, S, E);
        { const int total = ntile * 4, maxun = (total + F.G - 1) / F.G, rem = total - (maxun - 1) * F.G;
          const bool even = rem == F.G; expert_weights_dn(F, args, even ? F.vcu : F.vcu - rem, even ? F.G : F.G - rem); } } SEAM(17);
    if (IN(18)) REP(1) { const int ntile = moe_tbl ? (((volatile int*)(F.ldsg + TBL_EB))[32] >> 8) : moe_bases(F, 0);
        pg8::Gemm g{(const bf16*)(ws + WS_HID), (const bf16*)(ws + WS_WDT), MOE_CAP, 32 * 1024, 512}; pg8::MoeOrder S{(const LAS int*)(F.lds + TBL_TILE), ntile, F.G, F.vcu};
        pg8::EpiMoe2 E{(bf16*)(ws + WS_XG), (const float*)(ws + WS_W_SLOT)};
        pg8::gemm_phase<pg8::EpiMoe2, pg8::MoeOrder, PG8_ALIGN_EPI, true>(F.lds + RING_OFF, g, S, E); } SEAM(18);
    if (IN(19)) { final_phase(F, args); }
    STAMP(20);
    if ((PROBE_A >= 0 || PROBE_ACC >= 0) && blockIdx.x == PROBE_BLOCK) { const unsigned long long dl = (PROBE_ACC >= 40 ? (unsigned long long)F.MISC[16] : PROBE_ACC >= 0 ? F.pacc : (ts_b - ts_a)) * PROBE_AMP, t0 = __builtin_amdgcn_s_memrealtime(); while (__builtin_amdgcn_s_memrealtime() - t0 < dl) __builtin_amdgcn_s_sleep(8); }
#undef IN
#undef SEAM
}

extern "C" void kernel_launch(void* const* d_in, const int* in_sizes, int n_in, void* d_out, int out_size, void* d_ws, size_t ws_size, hipStream_t stream) {
    static int grid = 0;
    if (grid == 0) {
        if (n_in != 25 || in_sizes[0] != M * D || out_size != M * D || ws_size < WS_END) { fprintf(stderr, "kernel_launch: unexpected shapes (n_in %d in0 %d out %d ws %zu)\n", n_in, n_in > 0 ? in_sizes[0] : -1, out_size, ws_size); grid = -1; return; }
        int dev = 0, cus = 0, per_cu = 0;
        if (hipGetDevice(&dev) != hipSuccess || hipDeviceGetAttribute(&cus, hipDeviceAttributeMultiprocessorCount, dev) != hipSuccess) { grid = -1; return; }
        if (hipFuncSetAttribute((const void*)fwd_kernel, hipFuncAttributeMaxDynamicSharedMemorySize, LDS_BYTES) != hipSuccess) { fprintf(stderr, "kernel_launch: hipFuncSetAttribute failed\n"); grid = -1; return; }
        if (hipOccupancyMaxActiveBlocksPerMultiprocessor(&per_cu, (const void*)fwd_kernel, NWAVES * 64, LDS_BYTES) != hipSuccess || per_cu < 1) fprintf(stderr, "kernel_launch: occupancy query reports %d\n", per_cu);
        (void)hipGetLastError();
        grid = cus;
    }
    if (grid < 0) return;
    if (hipMemsetAsync((char*)d_ws + WS_CTL, 0, CTL_ZERO_BYTES, stream) != hipSuccess) return;
    Args a{};
    for (int i = 0; i < 25; ++i) a.in[i] = (const float*)d_in[i];
    a.out = (float*)d_out; a.ws = (unsigned char*)d_ws;
#if MK_ONE_LAUNCH
    a.ph_lo = 0; a.ph_hi = NPHASE;
    hipLaunchKernelGGL(fwd_kernel, dim3(grid), dim3(NWAVES * 64), LDS_BYTES, stream, a);
#else
    for (int p = 0; p < NPHASE; ++p) { a.ph_lo = p; a.ph_hi = p + 1; hipLaunchKernelGGL(fwd_kernel, dim3(grid), dim3(NWAVES * 64), LDS_BYTES, stream, a); }
#endif
}
```
